# Optimizing an MI355X kernel written in HIP

```python
import math
import jax
import jax.numpy as jnp
from jax import lax
import numpy as np

D_MODEL = 1024
BATCH = 4
SEQ = 4096
DEPTH = 2

N_BRANCH = 4
W_BRANCH = 256
NORM_EPS = 1e-6

S5_GROUP = 16
S5_GROUPS = W_BRANCH // S5_GROUP
S5_STATE = 64

ATT_HEADS = 4
ATT_DIM = W_BRANCH // ATT_HEADS
IDX_HEADS = 4
IDX_DIM = 32
TOPK_MAX = 256
Q_BLOCK = 128
ROPE_THETA = 10000.0

RG_BLOCKS = 4
RG_BDIM = W_BRANCH // RG_BLOCKS
RG_C = 8.0
CONV_WIDTH = 4

RW_HEADS = 4
RW_DIM = W_BRANCH // RW_HEADS
RW_DECAY_LORA = 32
RW_A_LORA = 32
RW_GATE_LORA = 64
RW_GN_EPS = 64e-5
RW_WIDTHS = (W_BRANCH, W_BRANCH, W_BRANCH, RW_DECAY_LORA, RW_A_LORA, RW_GATE_LORA)
RW_COLS = 3 * W_BRANCH + RW_DECAY_LORA + RW_A_LORA + RW_GATE_LORA

IN_WIDTHS = (W_BRANCH,
             W_BRANCH, W_BRANCH, W_BRANCH,
             IDX_HEADS * IDX_DIM, IDX_DIM, IDX_HEADS,
             W_BRANCH, W_BRANCH,
             RW_COLS)
D_IN = 6 * W_BRANCH + IDX_HEADS * IDX_DIM + IDX_DIM + IDX_HEADS + RW_COLS

N_EXPERTS = 16
N_GROUPS = 4
EXP_PER_GROUP = N_EXPERTS // N_GROUPS
TOP_K = 2
D_EXPERT = 512

kernel_name = 'hybrid_gated_s5_dsa_rglru_rwkv7_moe'


def _split(a, widths):
    offs = []
    o = 0
    for w in widths[:-1]:
        o += w
        offs.append(o)
    return jnp.split(a, offs, axis=-1)


def rmsnorm(x, g):
    xf = x.astype(jnp.float32)
    y = xf * lax.rsqrt(jnp.mean(xf * xf, axis=-1, keepdims=True) + NORM_EPS)
    return (y * g.astype(jnp.float32)).astype(x.dtype)


def rope(x, pos):
    half = x.shape[-1] // 2
    inv_freq = ROPE_THETA ** (-jnp.arange(half, dtype=jnp.float32) / half)
    ang = pos.astype(jnp.float32)[:, :, None, None] * inv_freq
    cos, sin = jnp.cos(ang), jnp.sin(ang)
    xf = x.astype(jnp.float32)
    x1, x2 = xf[..., :half], xf[..., half:]
    return jnp.concatenate([x1 * cos - x2 * sin, x2 * cos + x1 * sin], axis=-1).astype(x.dtype)


def linear_scan(a, b):
    def combine(left, right):
        return right[0] * left[0], right[0] * left[1] + right[1]
    return lax.associative_scan(combine, (a, b), axis=1)[1]


def s5_mixer(u, lam_re, lam_im, log_step, b_re, b_im, c_re, c_im, d_skip, glu_w, glu_b):
    bsz, seq, _ = u.shape
    f32 = jnp.float32
    lam = lax.complex(lam_re.astype(f32), lam_im.astype(f32))
    step = jnp.exp(log_step.astype(f32))[:, None]
    lam_bar = jnp.exp(lam * step)
    b_bar = ((lam_bar - 1.0) / lam)[:, :, None] * lax.complex(b_re.astype(f32), b_im.astype(f32))
    ug = u.astype(f32).reshape(bsz, seq, S5_GROUPS, S5_GROUP)
    bu = jnp.einsum('btgc,gpc->btgp', ug.astype(jnp.complex64), b_bar)
    states = linear_scan(jnp.broadcast_to(lam_bar, bu.shape), bu)
    c_mat = lax.complex(c_re.astype(f32), c_im.astype(f32))
    y = jnp.real(jnp.einsum('btgp,gcp->btgc', states, c_mat)) + d_skip.astype(f32).reshape(S5_GROUPS, S5_GROUP) * ug
    y = jax.nn.gelu(y.reshape(bsz, seq, W_BRANCH)).astype(u.dtype)
    return y * jax.nn.sigmoid(y @ glu_w + glu_b)


def dsa_mixer(q, k, v, iq, ik, iw, pos):
    bsz, seq = q.shape[:2]
    f32 = jnp.float32
    topk = min(TOPK_MAX, seq // 4)
    n_blocks = seq // Q_BLOCK
    q = rope(q, pos) * (ATT_DIM ** -0.5)
    k = rope(k, pos)
    iq = rope(iq, pos)
    ik = rope(ik[:, :, None, :], pos)[:, :, 0].astype(f32)
    key_pos = jnp.arange(seq)
    gather = jax.vmap(lambda arr, ix: arr[ix])

    def blocks(a):
        return a.reshape(bsz, n_blocks, Q_BLOCK, *a.shape[2:]).swapaxes(0, 1)

    def one_block(args):
        qb, iqb, iwb, t0 = args
        q_pos = t0 + jnp.arange(Q_BLOCK)
        causal = key_pos[None, :] <= q_pos[:, None]
        dots = jnp.einsum('bqhd,bsd->bqhs', iqb.astype(f32), ik)
        score = jnp.einsum('bqh,bqhs->bqs', iwb.astype(f32), jax.nn.relu(dots))
        score = jnp.where(causal[None], score, -jnp.inf)
        _, idx = lax.top_k(score, topk)
        k_sel = gather(k, idx).astype(f32)
        v_sel = gather(v, idx).astype(f32)
        logits = jnp.einsum('bqhd,bqkhd->bhqk', qb.astype(f32), k_sel)
        valid = (idx <= q_pos[None, :, None])[:, None]
        p = jax.nn.softmax(jnp.where(valid, logits, -jnp.inf), axis=-1)
        return jnp.einsum('bhqk,bqkhd->bqhd', p, v_sel).astype(qb.dtype)

    out = lax.map(one_block, (blocks(q), blocks(iq), blocks(iw), jnp.arange(n_blocks) * Q_BLOCK))
    return out.swapaxes(0, 1).reshape(bsz, seq, ATT_HEADS * ATT_DIM)


def rglru_mixer(xr, gate, conv_w, conv_b, w_r, b_r, w_i, b_i, lam):
    bsz, seq, width = xr.shape
    xc = lax.conv_general_dilated(xr, conv_w[:, None, :], window_strides=(1,),
                                  padding=[(CONV_WIDTH - 1, 0)],
                                  dimension_numbers=('NWC', 'WIO', 'NWC'),
                                  feature_group_count=width) + conv_b
    xc = xc.astype(jnp.float32)
    xb = xc.reshape(bsz, seq, RG_BLOCKS, RG_BDIM)
    r = jax.nn.sigmoid(jnp.einsum('btnc,ncd->btnd', xb, w_r) + b_r).reshape(bsz, seq, width)
    i = jax.nn.sigmoid(jnp.einsum('btnc,ncd->btnd', xb, w_i) + b_i).reshape(bsz, seq, width)
    log_a = -RG_C * r * jax.nn.softplus(-lam.astype(jnp.float32))
    a = jnp.exp(log_a)
    mult = jnp.sqrt(-jnp.expm1(2.0 * log_a))
    h = linear_scan(a, mult * i * xc)
    return (h * jax.nn.gelu(gate.astype(jnp.float32))).astype(xr.dtype)


def rwkv7_mixer(feat, mu, w0, w_up, a0, a_up, g_up, k_k, k_a, r_k, gn_w, gn_b):
    bsz, seq, _ = feat.shape
    f = feat.astype(jnp.float32)
    prev = jnp.pad(f, ((0, 0), (1, 0), (0, 0)))[:, :-1]
    f = f + (prev - f) * mu
    r, k, v, wd, ad, gd = _split(f, RW_WIDTHS)
    w = -jax.nn.softplus(-(w0 + jnp.tanh(wd) @ w_up)) - 0.5
    decay = jnp.exp(-jnp.exp(w))
    a = jax.nn.sigmoid(a0 + ad @ a_up)
    g = jax.nn.sigmoid(gd) @ g_up

    def heads(t):
        return t.reshape(bsz, seq, RW_HEADS, RW_DIM)

    kk = heads(k * k_k)
    kk = kk / jnp.maximum(jnp.linalg.norm(kk, axis=-1, keepdims=True), 1e-12)
    k = k * (1.0 + (a - 1.0) * k_a)
    r_h, k_h, v_h, a_h, d_h = heads(r), heads(k), heads(v), heads(a), heads(decay)

    def step(state, inp):
        r_t, d_t, k_t, v_t, kk_t, a_t = inp
        s_kk = jnp.einsum('bhvk,bhk->bhv', state, kk_t)
        state = (state * d_t[:, :, None, :]
                 - s_kk[..., None] * (kk_t * a_t)[:, :, None, :]
                 + v_t[..., None] * k_t[:, :, None, :])
        return state, jnp.einsum('bhvk,bhk->bhv', state, r_t)

    xs = tuple(jnp.moveaxis(t, 1, 0) for t in (r_h, d_h, k_h, v_h, kk, a_h))
    _, y = lax.scan(step, jnp.zeros((bsz, RW_HEADS, RW_DIM, RW_DIM), jnp.float32), xs)
    y = jnp.moveaxis(y, 0, 1)
    mean = jnp.mean(y, axis=-1, keepdims=True)
    var = jnp.mean(jnp.square(y - mean), axis=-1, keepdims=True)
    y = ((y - mean) * lax.rsqrt(var + RW_GN_EPS)).reshape(bsz, seq, W_BRANCH) * gn_w + gn_b
    bonus = jnp.sum(r_h * k_h * r_k, axis=-1, keepdims=True) * v_h
    y = y + bonus.reshape(bsz, seq, W_BRANCH)
    return (y * g).astype(feat.dtype)


def moe(h, router_w, router_b, w1, w3, w2):
    bsz, seq, d = h.shape
    hf = h.reshape(bsz * seq, d)
    scores = jax.nn.sigmoid(hf.astype(jnp.float32) @ router_w.astype(jnp.float32))
    biased = scores + router_b.astype(jnp.float32)
    group_score = jnp.sum(lax.top_k(biased.reshape(-1, N_GROUPS, EXP_PER_GROUP), TOP_K)[0], axis=-1)
    best_group = jnp.argmax(group_score, axis=-1)
    in_group = (jnp.arange(N_EXPERTS) // EXP_PER_GROUP)[None, :] == best_group[:, None]
    _, idx = lax.top_k(jnp.where(in_group, biased, -jnp.inf), TOP_K)
    sel = jnp.take_along_axis(scores, idx, axis=-1)
    weights = sel / jnp.sum(sel, axis=-1, keepdims=True)
    combine = jnp.sum(jax.nn.one_hot(idx, N_EXPERTS, dtype=jnp.float32) * weights[..., None], axis=1)

    def add_expert(acc, p):
        e_w1, e_w3, e_w2, e_c = p
        y = (jax.nn.silu(hf @ e_w1) * (hf @ e_w3)) @ e_w2
        return acc + e_c[:, None] * y.astype(jnp.float32), None

    out, _ = lax.scan(add_expert, jnp.zeros((bsz * seq, d), jnp.float32), (w1, w3, w2, combine.T))
    return out.reshape(bsz, seq, d).astype(h.dtype)


def _normal(key, shape, scale):
    return scale * jax.random.normal(key, shape, jnp.float32)


def setup_inputs(seed: int = 0) -> dict:
    key = jax.random.key(seed)
    ks = iter(jax.random.split(key, 48))
    L, D, W = DEPTH, D_MODEL, W_BRANCH
    G, P, C = S5_GROUPS, S5_STATE, S5_GROUP
    inp = {}
    inp['x'] = _normal(next(ks), (BATCH, SEQ, D), 1.0)
    inp['c'] = _normal(next(ks), (BATCH, D), 1.0)
    offset = jax.random.randint(next(ks), (BATCH, 1), 0, 2048)
    inp['positions'] = (offset + jnp.arange(SEQ)[None, :]).astype(jnp.int32)
    inp['ada_w'] = _normal(next(ks), (L, D, 6 * D), 0.5 * D ** -0.5)
    inp['ada_b'] = _normal(next(ks), (L, 6 * D), 0.02)
    inp['mix_norm_g'] = 1.0 + _normal(next(ks), (L, D), 0.02)
    inp['w_in'] = _normal(next(ks), (L, D, D_IN), D ** -0.5)
    inp['gate_w'] = _normal(next(ks), (L, D, N_BRANCH * D), D ** -0.5)
    inp['gate_b'] = _normal(next(ks), (L, N_BRANCH * D), 0.02)
    inp['branch_w'] = _normal(next(ks), (L, N_BRANCH, W, D), W ** -0.5)
    inp['out_w'] = _normal(next(ks), (L, D, D), D ** -0.5)
    inp['s5_lam_re'] = -0.5 + _normal(next(ks), (L, G, P), 0.01)
    inp['s5_lam_im'] = math.pi * jnp.arange(P, dtype=jnp.float32) + _normal(next(ks), (L, G, P), 0.01)
    inp['s5_log_step'] = jax.random.uniform(next(ks), (L, G), jnp.float32, math.log(1e-3), math.log(1e-1))
    inp['s5_b_re'] = _normal(next(ks), (L, G, P, C), (2 * C) ** -0.5)
    inp['s5_b_im'] = _normal(next(ks), (L, G, P, C), (2 * C) ** -0.5)
    inp['s5_c_re'] = _normal(next(ks), (L, G, C, P), (2 * P) ** -0.5)
    inp['s5_c_im'] = _normal(next(ks), (L, G, C, P), (2 * P) ** -0.5)
    inp['s5_d'] = _normal(next(ks), (L, W), 1.0)
    inp['s5_glu_w'] = _normal(next(ks), (L, W, W), W ** -0.5)
    inp['s5_glu_b'] = _normal(next(ks), (L, W), 0.02)
    inp['rg_conv_w'] = _normal(next(ks), (L, CONV_WIDTH, W), CONV_WIDTH ** -0.5)
    inp['rg_conv_b'] = _normal(next(ks), (L, W), 0.02)
    inp['rg_wr'] = _normal(next(ks), (L, RG_BLOCKS, RG_BDIM, RG_BDIM), RG_BDIM ** -0.5)
    inp['rg_br'] = _normal(next(ks), (L, RG_BLOCKS, RG_BDIM), 0.02)
    inp['rg_wi'] = _normal(next(ks), (L, RG_BLOCKS, RG_BDIM, RG_BDIM), RG_BDIM ** -0.5)
    inp['rg_bi'] = _normal(next(ks), (L, RG_BLOCKS, RG_BDIM), 0.02)
    a_pow = jax.random.uniform(next(ks), (L, W), jnp.float32, 0.9, 0.999)
    a_base = a_pow ** (1.0 / RG_C)
    inp['rg_lam'] = jnp.log(a_base) - jnp.log1p(-a_base)
    inp['rw_mu'] = jax.random.uniform(next(ks), (L, RW_COLS), jnp.float32, 0.0, 1.0)
    inp['rw_w0'] = jax.random.uniform(next(ks), (L, W), jnp.float32, -6.0, -1.0)
    inp['rw_w_up'] = _normal(next(ks), (L, RW_DECAY_LORA, W), 0.1 * RW_DECAY_LORA ** -0.5)
    inp['rw_a0'] = _normal(next(ks), (L, W), 0.1)
    inp['rw_a_up'] = _normal(next(ks), (L, RW_A_LORA, W), 0.5 * RW_A_LORA ** -0.5)
    inp['rw_g_up'] = _normal(next(ks), (L, RW_GATE_LORA, W), RW_GATE_LORA ** -0.5)
    inp['rw_k_k'] = 0.85 + _normal(next(ks), (L, W), 0.02)
    inp['rw_k_a'] = 1.0 + _normal(next(ks), (L, W), 0.02)
    inp['rw_r_k'] = _normal(next(ks), (L, RW_HEADS, RW_DIM), 0.1)
    inp['rw_gn_w'] = 1.0 + _normal(next(ks), (L, W), 0.02)
    inp['rw_gn_b'] = _normal(next(ks), (L, W), 0.02)
    inp['ffn_norm_g'] = 1.0 + _normal(next(ks), (L, D), 0.02)
    inp['router_w'] = _normal(next(ks), (D, N_EXPERTS), D ** -0.5)
    inp['router_b'] = _normal(next(ks), (N_EXPERTS,), 0.01)
    inp['exp_w1'] = _normal(next(ks), (L, N_EXPERTS, D, D_EXPERT), D ** -0.5)
    inp['exp_w3'] = _normal(next(ks), (L, N_EXPERTS, D, D_EXPERT), D ** -0.5)
    inp['exp_w2'] = _normal(next(ks), (L, N_EXPERTS, D_EXPERT, D), D_EXPERT ** -0.5)
    inp['final_norm_g'] = 1.0 + _normal(next(ks), (D,), 0.02)
    return inp


def reference(x, c, positions, ada_w, ada_b, mix_norm_g, w_in, gate_w, gate_b, branch_w, out_w,
              s5_lam_re, s5_lam_im, s5_log_step, s5_b_re, s5_b_im, s5_c_re, s5_c_im, s5_d, s5_glu_w, s5_glu_b,
              rg_conv_w, rg_conv_b, rg_wr, rg_br, rg_wi, rg_bi, rg_lam,
              rw_mu, rw_w0, rw_w_up, rw_a0, rw_a_up, rw_g_up, rw_k_k, rw_k_a, rw_r_k, rw_gn_w, rw_gn_b,
              ffn_norm_g, router_w, router_b, exp_w1, exp_w3, exp_w2, final_norm_g):
    bsz, seq, d = x.shape
    c_act = jax.nn.silu(c)
    for l in range(DEPTH):
        mod = (c_act @ ada_w[l] + ada_b[l]).reshape(bsz, 6, 1, d)
        shift1, scale1, gate1, shift2, scale2, gate2 = (mod[:, i] for i in range(6))
        h = rmsnorm(x, mix_norm_g[l]) * (1.0 + scale1) + shift1
        u, q, k, v, iq, ik, iw, rg_x, rg_g, rw_f = _split(h @ w_in[l], IN_WIDTHS)
        o_s5 = s5_mixer(u, s5_lam_re[l], s5_lam_im[l], s5_log_step[l], s5_b_re[l], s5_b_im[l],
                        s5_c_re[l], s5_c_im[l], s5_d[l], s5_glu_w[l], s5_glu_b[l])
        o_dsa = dsa_mixer(q.reshape(bsz, seq, ATT_HEADS, ATT_DIM),
                          k.reshape(bsz, seq, ATT_HEADS, ATT_DIM),
                          v.reshape(bsz, seq, ATT_HEADS, ATT_DIM),
                          iq.reshape(bsz, seq, IDX_HEADS, IDX_DIM), ik, iw, positions)
        o_rg = rglru_mixer(rg_x, rg_g, rg_conv_w[l], rg_conv_b[l], rg_wr[l], rg_br[l],
                           rg_wi[l], rg_bi[l], rg_lam[l])
        o_rw = rwkv7_mixer(rw_f, rw_mu[l], rw_w0[l], rw_w_up[l], rw_a0[l], rw_a_up[l], rw_g_up[l],
                           rw_k_k[l], rw_k_a[l], rw_r_k[l], rw_gn_w[l], rw_gn_b[l])
        branches = jnp.stack([o_s5, o_dsa, o_rg, o_rw], axis=2)
        up = jnp.einsum('btnw,nwd->btnd', branches, branch_w[l])
        gates = jax.nn.sigmoid(h @ gate_w[l] + gate_b[l]).reshape(bsz, seq, N_BRANCH, d)
        mixed = jnp.einsum('btnd,btnd->btd', gates, up) @ out_w[l]
        x = x + gate1 * mixed
        h2 = rmsnorm(x, ffn_norm_g[l]) * (1.0 + scale2) + shift2
        x = x + gate2 * moe(h2, router_w, router_b, exp_w1[l], exp_w3[l], exp_w2[l])
    return rmsnorm(x, final_norm_g)
```

```cpp
#include <hip/hip_runtime.h>
#include <stdint.h>
#include <stdio.h>
#include <math.h>

typedef _Float16 h16;
typedef _Float16 h16x8 __attribute__((ext_vector_type(8)));
typedef _Float16 h16x4 __attribute__((ext_vector_type(4)));
typedef float f32x4 __attribute__((ext_vector_type(4)));

#define NTOK 16384
#define SEQ 4096
#define NBATCH 4
#define DM 1024
#define DINW 2596
#define PJ 2432
#define IDXLD 192
#define P_U 0
#define P_Q 256
#define P_K 512
#define P_V 768
#define P_RGX 1024
#define P_RGG 1280
#define P_RW 1536
#define LCAP 16384

enum { I_X = 0, I_C, I_POS, I_ADAW, I_ADAB, I_MNG, I_WIN, I_GATEW, I_GATEB, I_BRW, I_OUTW,
       I_S5LRE, I_S5LIM, I_S5LS, I_S5BRE, I_S5BIM, I_S5CRE, I_S5CIM, I_S5D, I_S5GW, I_S5GB,
       I_RGCW, I_RGCB, I_RGWR, I_RGBR, I_RGWI, I_RGBI, I_RGLAM,
       I_RWMU, I_RWW0, I_RWWUP, I_RWA0, I_RWAUP, I_RWGUP, I_RWKK, I_RWKA, I_RWRK, I_RWGNW, I_RWGNB,
       I_FNG, I_ROUTW, I_ROUTB, I_W1, I_W3, I_W2, I_FINALG, N_IN };

struct Params {
    const float* in[N_IN];
    const int* pos;
    float* out;
    float* mods;
    h16 *Wp, *Widx, *Wg, *Wb, *Wo, *Wglu, *We13, *We2;
    float* x1;
    h16 *h_hi, *h_lo, *branches;
    h16* proj; float* idxf;
    h16 *q_r, *k_r; float *iq_r, *ik_r;
    h16* ybuf; float *s5E, *s5H;
    float *rg_hl, *rg_cp, *rg_agg;
    h16 *rw_r, *rw_w, *rw_k, *rw_kk, *rw_b, *rw_g, *rw_bonus, *rw_v; float* rw_y;
    h16* mixed;
    h16* act; int* lists; int* bcnt; float* cw;
};

__device__ __forceinline__ float sigm(float x) { return 1.f / (1.f + __expf(-x)); }
__device__ __forceinline__ float gelu_tanh(float x) { return 0.5f * x * (1.f + tanhf(0.7978845608028654f * (x + 0.044715f * x * x * x))); }
__device__ __forceinline__ float softplusf_(float x) { return fmaxf(x, 0.f) + log1pf(__expf(-fabsf(x))); }
__device__ __forceinline__ float wave_sum(float v) { for (int o = 32; o > 0; o >>= 1) v += __shfl_xor(v, o); return v; }
__device__ __forceinline__ float wave_max(float v) { for (int o = 32; o > 0; o >>= 1) v = fmaxf(v, __shfl_xor(v, o)); return v; }
__device__ __forceinline__ h16x4 pack4(float a, float b, float c, float d) { h16x4 r; r[0] = (h16)a; r[1] = (h16)b; r[2] = (h16)c; r[3] = (h16)d; return r; }

__global__ void __launch_bounds__(256) k_mods(Params p) {
    __shared__ float ca[4 * DM];
    for (int i = threadIdx.x; i < 4 * DM; i += 256) { float c = p.in[I_C][i]; ca[i] = c * sigm(c); }
    __syncthreads();
    int gid = blockIdx.x * 256 + threadIdx.x;
    int l = gid / 6144, j = gid % 6144;
    const float* w = p.in[I_ADAW] + (size_t)l * DM * 6144 + j;
    float a0 = 0, a1 = 0, a2 = 0, a3 = 0;
    for (int k = 0; k < DM; ++k) { float wv = w[(size_t)k * 6144]; a0 += ca[k] * wv; a1 += ca[DM + k] * wv; a2 += ca[2 * DM + k] * wv; a3 += ca[3 * DM + k] * wv; }
    float bb = p.in[I_ADAB][l * 6144 + j];
    float* m = p.mods + (size_t)l * 4 * 6144;
    m[0 * 6144 + j] = a0 + bb; m[1 * 6144 + j] = a1 + bb; m[2 * 6144 + j] = a2 + bb; m[3 * 6144 + j] = a3 + bb;
}

template <class SRC>
__device__ __forceinline__ void convT(h16* dst, int dstld, int nrows, int K, int koff, const SRC& src, int gtid, int gthreads) {
    const int kch = K / 8;
    const long total = (long)nrows * kch;
    for (long w = gtid; w < total; w += gthreads) {
        int n = (int)(w % nrows), kc = (int)(w / nrows);
        h16x8 v;
#pragma unroll
        for (int i = 0; i < 8; ++i) v[i] = (h16)src(n, kc * 8 + i);
        *(h16x8*)(dst + (size_t)n * dstld + koff + kc * 8) = v;
    }
}
__global__ void __launch_bounds__(256) k_convert_mix(Params p, int l) {
    const int gt = blockIdx.x * 256 + threadIdx.x, gn = gridDim.x * 256;
    { const float* s = p.in[I_WIN] + (size_t)l * DM * DINW;
      convT(p.Wp, DM, PJ, DM, 0, [=](int n, int k) { return s[(size_t)k * DINW + (n < 1024 ? n : n + 164)]; }, gt, gn);
      convT(p.Widx, 3072, 256, DM, 0, [=](int n, int k) { return n < 164 ? s[(size_t)k * DINW + 1024 + n] : 0.f; }, gt, gn);
      convT(p.Widx, 3072, 256, DM, 1024, [=](int n, int k) { return n < 164 ? s[(size_t)k * DINW + 1024 + n] : 0.f; }, gt, gn);
      convT(p.Widx, 3072, 256, DM, 2048, [=](int n, int k) { float w = n < 164 ? s[(size_t)k * DINW + 1024 + n] : 0.f; float hi = (float)(h16)w; return w - hi; }, gt, gn); }
    { const float* s = p.in[I_GATEW] + (size_t)l * DM * 4096;
      convT(p.Wg, DM, 4096, DM, 0, [=](int n, int k) { return s[(size_t)k * 4096 + n]; }, gt, gn); }
    { const float* s = p.in[I_BRW] + (size_t)l * 4 * 256 * DM;
      convT(p.Wb, 256, 4096, 256, 0, [=](int n, int k) { int br = n >> 10, d = n & 1023; return s[(size_t)br * 256 * DM + (size_t)k * DM + d]; }, gt, gn); }
    { const float* s = p.in[I_OUTW] + (size_t)l * DM * DM;
      convT(p.Wo, DM, DM, DM, 0, [=](int n, int k) { return s[(size_t)k * DM + n]; }, gt, gn); }
    { const float* s = p.in[I_S5GW] + (size_t)l * 256 * 256;
      convT(p.Wglu, 256, 256, 256, 0, [=](int n, int k) { return s[(size_t)k * 256 + n]; }, gt, gn); }
}
__global__ void __launch_bounds__(256) k_convert_moe(Params p, int l) {
    const int gt = blockIdx.x * 256 + threadIdx.x, gn = gridDim.x * 256;
    const float* s1 = p.in[I_W1] + (size_t)l * 16 * DM * 512;
    const float* s3 = p.in[I_W3] + (size_t)l * 16 * DM * 512;
    const float* s2 = p.in[I_W2] + (size_t)l * 16 * 512 * DM;
    convT(p.We13, DM, 16 * 1024, DM, 0, [=](int n, int k) { int e = n >> 10, r = n & 1023; int c = (r >> 5) * 16 + (r & 15); const float* s = ((r >> 4) & 1) ? s3 : s1;
                                                           return s[(size_t)e * DM * 512 + (size_t)k * 512 + c]; }, gt, gn);
    convT(p.We2, 512, 16 * 1024, 512, 0, [=](int n, int k) { int e = n >> 10, c = n & 1023; return s2[(size_t)e * 512 * DM + (size_t)k * DM + c]; }, gt, gn);
}

__global__ void __launch_bounds__(512) k_norm1(Params p, int l) {
    const float* xin = l == 0 ? p.in[I_X] : p.x1;
    const int lane = threadIdx.x & 63, wv = threadIdx.x >> 6;
    if (blockIdx.x == 0 && threadIdx.x < 24) p.bcnt[threadIdx.x] = 0;
    for (int tok = blockIdx.x * 8 + wv; tok < NTOK; tok += gridDim.x * 8) {
        const int b = tok / SEQ;
        const float* xr = xin + (size_t)tok * DM;
        f32x4 v[4]; float ss = 0.f;
#pragma unroll
        for (int i = 0; i < 4; ++i) { v[i] = *(const f32x4*)(xr + i * 256 + lane * 4); ss += v[i][0] * v[i][0] + v[i][1] * v[i][1] + v[i][2] * v[i][2] + v[i][3] * v[i][3]; }
        ss = wave_sum(ss);
        const float rs = rsqrtf(ss * (1.f / DM) + 1e-6f);
        const float* g = p.in[I_MNG] + l * DM;
        const float* md = p.mods + ((size_t)l * 4 + b) * 6144;
#pragma unroll
        for (int i = 0; i < 4; ++i) {
            const int c = i * 256 + lane * 4;
            f32x4 gg = *(const f32x4*)(g + c), sh = *(const f32x4*)(md + c), sc = *(const f32x4*)(md + 1024 + c);
            float hv[4]; h16x4 hi, lo;
#pragma unroll
            for (int e = 0; e < 4; ++e) { hv[e] = v[i][e] * rs * gg[e] * (1.f + sc[e]) + sh[e]; hi[e] = (h16)hv[e]; lo[e] = (h16)(hv[e] - (float)hi[e]); }
            *(h16x4*)(p.h_hi + (size_t)tok * DM + c) = hi;
            *(h16x4*)(p.h_lo + (size_t)tok * DM + c) = lo;
        }
    }
}

#define LDT 72
template <int BM, class AF, class BF>
__device__ __forceinline__ void gemm_kloop(char* smem, int K, const AF& af, const BF& bf, f32x4 (&acc)[BM / 64][4]) {
    constexpr int MT = BM / 64, WM = BM / 4, NA = BM / 64;
    h16* sA = (h16*)smem; h16* sB = sA + 2 * BM * LDT;
    const int tid = threadIdx.x, lane = tid & 63, wave = tid >> 6, wm = wave >> 1, wn = wave & 1;
    const int lrow = tid >> 3, lkc = (tid & 7) * 8;
    uint4 ra[NA], rb[2];
    const int nk = K / 64;
#pragma unroll
    for (int i = 0; i < NA; ++i) ra[i] = *(const uint4*)af(lrow + i * 64, lkc);
#pragma unroll
    for (int i = 0; i < 2; ++i) rb[i] = *(const uint4*)bf(lrow + i * 64, lkc);
#pragma unroll
    for (int i = 0; i < NA; ++i) *(uint4*)&sA[(lrow + i * 64) * LDT + lkc] = ra[i];
#pragma unroll
    for (int i = 0; i < 2; ++i) *(uint4*)&sB[(lrow + i * 64) * LDT + lkc] = rb[i];
    __syncthreads();
    for (int kt = 0; kt < nk; ++kt) {
        const int cur = kt & 1;
        if (kt + 1 < nk) {
            const int k = (kt + 1) * 64 + lkc;
#pragma unroll
            for (int i = 0; i < NA; ++i) ra[i] = *(const uint4*)af(lrow + i * 64, k);
#pragma unroll
            for (int i = 0; i < 2; ++i) rb[i] = *(const uint4*)bf(lrow + i * 64, k);
        }
        const h16* cA = sA + cur * BM * LDT; const h16* cB = sB + cur * 128 * LDT;
#pragma unroll
        for (int ks = 0; ks < 2; ++ks) {
            h16x8 a[MT], b[4];
#pragma unroll
            for (int i = 0; i < MT; ++i) a[i] = *(const h16x8*)&cA[(wm * WM + i * 16 + (lane & 15)) * LDT + ks * 32 + (lane >> 4) * 8];
#pragma unroll
            for (int j = 0; j < 4; ++j) b[j] = *(const h16x8*)&cB[(wn * 64 + j * 16 + (lane & 15)) * LDT + ks * 32 + (lane >> 4) * 8];
#pragma unroll
            for (int i = 0; i < MT; ++i)
#pragma unroll
                for (int j = 0; j < 4; ++j) acc[i][j] = __builtin_amdgcn_mfma_f32_16x16x32_f16(b[j], a[i], acc[i][j], 0, 0, 0);
        }
        if (kt + 1 < nk) {
            h16* nA = sA + (cur ^ 1) * BM * LDT; h16* nB = sB + (cur ^ 1) * 128 * LDT;
#pragma unroll
            for (int i = 0; i < NA; ++i) *(uint4*)&nA[(lrow + i * 64) * LDT + lkc] = ra[i];
#pragma unroll
            for (int i = 0; i < 2; ++i) *(uint4*)&nB[(lrow + i * 64) * LDT + lkc] = rb[i];
        }
        __syncthreads();
    }
}
template <int BM> __device__ __forceinline__ void zero_acc(f32x4 (&acc)[BM / 64][4]) {
#pragma unroll
    for (int i = 0; i < BM / 64; ++i)
#pragma unroll
        for (int j = 0; j < 4; ++j) acc[i][j] = (f32x4){0.f, 0.f, 0.f, 0.f};
}
template <int BM, class EPI>
__device__ __forceinline__ void gemm_epi(const f32x4 (&acc)[BM / 64][4], const EPI& epi) {
    const int lane = threadIdx.x & 63, wave = threadIdx.x >> 6, wm = wave >> 1, wn = wave & 1;
#pragma unroll
    for (int i = 0; i < BM / 64; ++i)
#pragma unroll
        for (int j = 0; j < 4; ++j) epi(wm * (BM / 4) + i * 16 + (lane & 15), wn * 64 + j * 16 + 4 * (lane >> 4), acc[i][j]);
}
#define GEMM_LDS(BM) (2 * (BM) * LDT * 2 + 2 * 128 * LDT * 2)

__global__ void __launch_bounds__(512) k_gemm1(Params p) {
    extern __shared__ __attribute__((aligned(16))) char smem[];
    const int nu_main = 64 * 19, nu = nu_main + 64 * 2;
    for (int u = blockIdx.x; u < nu; u += gridDim.x) {
        f32x4 acc[4][4]; zero_acc<256>(acc);
        if (u < nu_main) {
            const int mt = u / 19, nt = u % 19, m0 = mt * 256, n0 = nt * 128;
            const h16* A = p.h_hi + (size_t)m0 * DM; const h16* B = p.Wp + (size_t)n0 * DM;
            gemm_kloop<256>(smem, DM, [=](int r, int k) { return A + (size_t)r * DM + k; }, [=](int r, int k) { return B + (size_t)r * DM + k; }, acc);
            h16* O = p.proj + (size_t)m0 * PJ + n0;
            gemm_epi<256>(acc, [=](int ml, int nl, f32x4 v) { *(h16x4*)(O + (size_t)ml * PJ + nl) = pack4(v[0], v[1], v[2], v[3]); });
        } else {
            const int uu = u - nu_main, mt = uu >> 1, nt = uu & 1, m0 = mt * 256, n0 = nt * 128;
            const h16* Ah = p.h_hi + (size_t)m0 * DM; const h16* Al = p.h_lo + (size_t)m0 * DM; const h16* B = p.Widx + (size_t)n0 * 3072;
            gemm_kloop<256>(smem, 3072, [=](int r, int k) { const h16* base = (k >= 1024 && k < 2048) ? Al : Ah; return base + (size_t)r * DM + (k & 1023); },
                            [=](int r, int k) { return B + (size_t)r * 3072 + k; }, acc);
            float* O = p.idxf + (size_t)m0 * IDXLD + n0;
            gemm_epi<256>(acc, [=](int ml, int nl, f32x4 v) { if (n0 + nl < IDXLD) *(f32x4*)(O + (size_t)ml * IDXLD + nl) = v; });
        }
    }
}

template <int PASS>
__global__ void __launch_bounds__(512) k_s5_scan(Params p, int l) {
    const int lane = threadIdx.x & 63, wv = threadIdx.x >> 6;
    for (int u = blockIdx.x * 8 + wv; u < 4096; u += gridDim.x * 8) {
        const int g = u & 15, c = (u >> 4) & 63, b = u >> 10;
        const int pidx = (l * 16 + g) * 64 + lane;
        const double lre = p.in[I_S5LRE][pidx], lim = p.in[I_S5LIM][pidx], st = exp((double)p.in[I_S5LS][l * 16 + g]);
        const double er = exp(lre * st); double sn, cs; sincos(lim * st, &sn, &cs);
        const double lbr = er * cs, lbi = er * sn;
        const double nr = lbr - 1.0, ni = lbi, den = lre * lre + lim * lim;
        const double fr = (nr * lre + ni * lim) / den, fi = (ni * lre - nr * lim) / den;
        float Br[16], Bi[16];
#pragma unroll
        for (int cc = 0; cc < 16; ++cc) { const double br = p.in[I_S5BRE][(size_t)pidx * 16 + cc], bi = p.in[I_S5BIM][(size_t)pidx * 16 + cc];
                                          Br[cc] = (float)(fr * br - fi * bi); Bi[cc] = (float)(fr * bi + fi * br); }
        const float lr = (float)lbr, li = (float)lbi;
        float hr = 0.f, hi = 0.f;
        float Cr[16], Ci[16];
        if (PASS == 3) {
#pragma unroll
            for (int cc = 0; cc < 16; ++cc) { Cr[cc] = p.in[I_S5CRE][((size_t)(l * 16 + g) * 16 + cc) * 64 + lane]; Ci[cc] = p.in[I_S5CIM][((size_t)(l * 16 + g) * 16 + cc) * 64 + lane]; }
            const size_t hix = ((((size_t)b * 64 + c) * 16 + g) * 64 + lane) * 2;
            hr = p.s5H[hix]; hi = p.s5H[hix + 1];
        }
        const int t0 = b * SEQ + c * 64;
        const int oidx = ((lane >> 5) & 1) * 8 + ((lane >> 4) & 1) * 4 + ((lane >> 3) & 1) * 2 + ((lane >> 2) & 1);
        const float dsk = p.in[I_S5D][l * 256 + g * 16 + oidx];
        for (int t = 0; t < 64; ++t) {
            const h16* up = p.proj + (size_t)(t0 + t) * PJ + P_U + g * 16;
            h16x8 u0 = *(const h16x8*)up, u1 = *(const h16x8*)(up + 8);
            float uu[16];
#pragma unroll
            for (int cc = 0; cc < 8; ++cc) { uu[cc] = (float)u0[cc]; uu[8 + cc] = (float)u1[cc]; }
            float br = 0.f, bi = 0.f;
#pragma unroll
            for (int cc = 0; cc < 16; ++cc) { br += Br[cc] * uu[cc]; bi += Bi[cc] * uu[cc]; }
            const float nhr = lr * hr - li * hi + br, nhi = lr * hi + li * hr + bi;
            hr = nhr; hi = nhi;
            if (PASS == 3) {
                float v[16];
#pragma unroll
                for (int cc = 0; cc < 16; ++cc) v[cc] = Cr[cc] * hr - Ci[cc] * hi;
                float v8[8], v4[4], v2[2], v1;
                const bool b5 = lane & 32, b4 = lane & 16, b3 = lane & 8, b2 = lane & 4;
#pragma unroll
                for (int i = 0; i < 8; ++i) { float snd = b5 ? v[i] : v[i + 8], keep = b5 ? v[i + 8] : v[i]; v8[i] = keep + __shfl_xor(snd, 32); }
#pragma unroll
                for (int i = 0; i < 4; ++i) { float snd = b4 ? v8[i] : v8[i + 4], keep = b4 ? v8[i + 4] : v8[i]; v4[i] = keep + __shfl_xor(snd, 16); }
#pragma unroll
                for (int i = 0; i < 2; ++i) { float snd = b3 ? v4[i] : v4[i + 2], keep = b3 ? v4[i + 2] : v4[i]; v2[i] = keep + __shfl_xor(snd, 8); }
                { float snd = b2 ? v2[0] : v2[1], keep = b2 ? v2[1] : v2[0]; v1 = keep + __shfl_xor(snd, 4); }
                v1 += __shfl_xor(v1, 2); v1 += __shfl_xor(v1, 1);
                if ((lane & 3) == 0) {
                    const float y = v1 + dsk * uu[oidx];
                    p.ybuf[(size_t)(t0 + t) * 256 + g * 16 + oidx] = (h16)gelu_tanh(y);
                }
            }
        }
        if (PASS == 1) { const size_t eix = ((((size_t)b * 64 + c) * 16 + g) * 64 + lane) * 2; p.s5E[eix] = hr; p.s5E[eix + 1] = hi; }
    }
}
__global__ void __launch_bounds__(256) k_s5_carry(Params p, int l) {
    const int gid = blockIdx.x * 256 + threadIdx.x;
    const int pp = gid & 63, g = (gid >> 6) & 15, b = gid >> 10;
    const int pidx = (l * 16 + g) * 64 + pp;
    const double lre = p.in[I_S5LRE][pidx], lim = p.in[I_S5LIM][pidx], st = exp((double)p.in[I_S5LS][l * 16 + g]);
    const double er = exp(64.0 * lre * st); double sn, cs; sincos(64.0 * lim * st, &sn, &cs);
    const float ar = (float)(er * cs), ai = (float)(er * sn);
    float hr = 0.f, hi = 0.f;
    for (int c = 0; c < 64; ++c) {
        const size_t ix = ((((size_t)b * 64 + c) * 16 + g) * 64 + pp) * 2;
        p.s5H[ix] = hr; p.s5H[ix + 1] = hi;
        const float er_ = p.s5E[ix], ei_ = p.s5E[ix + 1];
        const float nr = ar * hr - ai * hi + er_, ni = ar * hi + ai * hr + ei_;
        hr = nr; hi = ni;
    }
}
__global__ void __launch_bounds__(512) k_s5_glu(Params p, int l) {
    extern __shared__ __attribute__((aligned(16))) char smem[];
    for (int u = blockIdx.x; u < 128; u += gridDim.x) {
        const int mt = u >> 1, nt = u & 1, m0 = mt * 256, n0 = nt * 128;
        f32x4 acc[4][4]; zero_acc<256>(acc);
        const h16* A = p.ybuf + (size_t)m0 * 256; const h16* B = p.Wglu + (size_t)n0 * 256;
        gemm_kloop<256>(smem, 256, [=](int r, int k) { return A + (size_t)r * 256 + k; }, [=](int r, int k) { return B + (size_t)r * 256 + k; }, acc);
        const float* gb = p.in[I_S5GB] + l * 256 + n0;
        const h16* Y = p.ybuf + (size_t)m0 * 256 + n0; h16* O = p.branches + (size_t)m0 * DM + n0;
        gemm_epi<256>(acc, [=](int ml, int nl, f32x4 v) {
            h16x4 y = *(const h16x4*)(Y + (size_t)ml * 256 + nl); f32x4 bb = *(const f32x4*)(gb + nl);
            *(h16x4*)(O + (size_t)ml * DM + nl) = pack4((float)y[0] * sigm(v[0] + bb[0]), (float)y[1] * sigm(v[1] + bb[1]), (float)y[2] * sigm(v[2] + bb[2]), (float)y[3] * sigm(v[3] + bb[3])); });
    }
}

__global__ void __launch_bounds__(512) k_rg_a(Params p, int l) {
    extern __shared__ __attribute__((aligned(16))) char smem[];
    float* xc = (float*)smem;
    float* aa = xc + 64 * 256;
    const int tid = threadIdx.x;
    for (int u = blockIdx.x; u < 256; u += gridDim.x) {
        const int b = u >> 6, c = u & 63, t0 = c * 64;
        __syncthreads();
        {
            const int ch = tid & 255;
            const float w0 = p.in[I_RGCW][(l * 4 + 0) * 256 + ch], w1 = p.in[I_RGCW][(l * 4 + 1) * 256 + ch], w2 = p.in[I_RGCW][(l * 4 + 2) * 256 + ch], w3 = p.in[I_RGCW][(l * 4 + 3) * 256 + ch];
            const float cb = p.in[I_RGCB][l * 256 + ch];
            for (int t = tid >> 8; t < 64; t += 2) {
                const int tt = t0 + t;
                const h16* xp = p.proj + (size_t)(b * SEQ + tt) * PJ + P_RGX + ch;
                float s = cb + w3 * (float)xp[0];
                if (tt >= 1) s += w2 * (float)xp[-(long)PJ];
                if (tt >= 2) s += w1 * (float)xp[-2 * (long)PJ];
                if (tt >= 3) s += w0 * (float)xp[-3 * (long)PJ];
                xc[t * 256 + ch] = s;
            }
        }
        __syncthreads();
        const int ch = tid & 255, half = tid >> 8, blk = ch >> 6, d = ch & 63;
        const float* wr = p.in[I_RGWR] + ((size_t)(l * 4 + blk) * 64) * 64 + d;
        const float* wi = p.in[I_RGWI] + ((size_t)(l * 4 + blk) * 64) * 64 + d;
        const float br = p.in[I_RGBR][l * 256 + ch], bi = p.in[I_RGBI][l * 256 + ch];
        const float spl = softplusf_(-p.in[I_RGLAM][l * 256 + ch]);
        float av[32], bv[32];
#pragma unroll
        for (int grp = 0; grp < 4; ++grp) {
            float ar[8], ai[8];
#pragma unroll
            for (int q = 0; q < 8; ++q) { ar[q] = br; ai[q] = bi; }
            const int tb = half * 32 + grp * 8;
            for (int cc = 0; cc < 64; ++cc) {
                const float wrv = wr[cc * 64], wiv = wi[cc * 64];
#pragma unroll
                for (int q = 0; q < 8; ++q) { const float xv = xc[(tb + q) * 256 + blk * 64 + cc]; ar[q] += xv * wrv; ai[q] += xv * wiv; }
            }
#pragma unroll
            for (int q = 0; q < 8; ++q) {
                const float r = sigm(ar[q]), ig = sigm(ai[q]);
                const float la = -8.f * r * spl;
                const float a = __expf(la), mult = sqrtf(-expm1f(2.f * la));
                av[grp * 8 + q] = a; bv[grp * 8 + q] = mult * ig * xc[(tb + q) * 256 + ch];
            }
        }
        __syncthreads();
#pragma unroll
        for (int q = 0; q < 32; ++q) { aa[(half * 32 + q) * 256 + ch] = av[q]; }
        __syncthreads();
#pragma unroll
        for (int q = 0; q < 32; ++q) { xc[(half * 32 + q) * 256 + ch] = bv[q]; }
        __syncthreads();
        if (tid < 256) {
            float h = 0.f, cp = 1.f;
            float* hl = p.rg_hl + (size_t)(b * SEQ + t0) * 256 + ch; float* cpo = p.rg_cp + (size_t)(b * SEQ + t0) * 256 + ch;
            for (int t = 0; t < 64; ++t) { const float a = aa[t * 256 + ch]; h = a * h + xc[t * 256 + ch]; cp *= a; hl[(size_t)t * 256] = h; cpo[(size_t)t * 256] = cp; }
            p.rg_agg[((size_t)(b * 64 + c) * 256 + ch) * 2] = cp; p.rg_agg[((size_t)(b * 64 + c) * 256 + ch) * 2 + 1] = h;
        }
    }
}
__global__ void __launch_bounds__(512) k_rg_c(Params p, int l) {
    __shared__ float carry[256];
    const int tid = threadIdx.x;
    for (int u = blockIdx.x; u < 256; u += gridDim.x) {
        const int b = u >> 6, c = u & 63, t0 = c * 64;
        __syncthreads();
        if (tid < 256) { float h = 0.f; for (int cc = 0; cc < c; ++cc) { const float* ag = p.rg_agg + ((size_t)(b * 64 + cc) * 256 + tid) * 2; h = ag[0] * h + ag[1]; } carry[tid] = h; }
        __syncthreads();
        const int ch = tid & 255;
        for (int t = tid >> 8; t < 64; t += 2) {
            const size_t tok = (size_t)b * SEQ + t0 + t;
            const float h = p.rg_hl[tok * 256 + ch] + p.rg_cp[tok * 256 + ch] * carry[ch];
            const float gt = (float)p.proj[tok * PJ + P_RGG + ch];
            p.branches[tok * DM + 512 + ch] = (h16)(h * gelu_tanh(gt));
        }
    }
}

__global__ void __launch_bounds__(512) k_rw_prep(Params p, int l) {
    extern __shared__ __attribute__((aligned(16))) char smem[];
    h16* wup = (h16*)smem;
    h16* aup = wup + 32 * 256;
    h16* gup = aup + 32 * 256;
    float* f = (float*)(gup + 64 * 256);
    const int tid = threadIdx.x, lane = tid & 63;
    for (int i = tid; i < 32 * 256; i += 512) { wup[i] = (h16)p.in[I_RWWUP][(size_t)l * 32 * 256 + i]; aup[i] = (h16)p.in[I_RWAUP][(size_t)l * 32 * 256 + i]; }
    for (int i = tid; i < 64 * 256; i += 512) gup[i] = (h16)p.in[I_RWGUP][(size_t)l * 64 * 256 + i];
    const float* mu = p.in[I_RWMU] + l * 896;
    const int ch = tid & 255, tg = tid >> 8;
    const float w0 = p.in[I_RWW0][l * 256 + ch], a0 = p.in[I_RWA0][l * 256 + ch], kkw = p.in[I_RWKK][l * 256 + ch], kaw = p.in[I_RWKA][l * 256 + ch];
    const float rk = p.in[I_RWRK][l * 256 + ch];
    for (int u = blockIdx.x; u < NTOK / 16; u += gridDim.x) {
        const int tok0 = u * 16;
        __syncthreads();
        for (int i = tid; i < 16 * 896; i += 512) {
            const int t = i / 896, cidx = i % 896; const int tok = tok0 + t;
            const float cur = (float)p.proj[(size_t)tok * PJ + P_RW + cidx];
            const float prv = (tok % SEQ) ? (float)p.proj[(size_t)(tok - 1) * PJ + P_RW + cidx] : 0.f;
            float v = cur + (prv - cur) * mu[cidx];
            if (cidx >= 768 && cidx < 800) v = tanhf(v);
            if (cidx >= 832) v = sigm(v);
            f[i] = v;
        }
        __syncthreads();
        for (int q = 0; q < 8; ++q) {
            const int t = tg * 8 + q; const int tok = tok0 + t;
            const float* ft = f + t * 896;
            float lw = 0.f, la = 0.f, lg = 0.f;
#pragma unroll 8
            for (int j = 0; j < 32; ++j) { lw += ft[768 + j] * (float)wup[j * 256 + ch]; la += ft[800 + j] * (float)aup[j * 256 + ch]; }
#pragma unroll 8
            for (int j = 0; j < 64; ++j) lg += ft[832 + j] * (float)gup[j * 256 + ch];
            const float w = -softplusf_(-(w0 + lw)) - 0.5f;
            const float wl = -__expf(w);
            const float a = sigm(a0 + la);
            const float r = ft[ch], k = ft[256 + ch], v = ft[512 + ch];
            float kk = k * kkw;
            const float nrm = sqrtf(wave_sum(kk * kk));
            kk = kk / fmaxf(nrm, 1e-12f);
            const float k2 = k * (1.f + (a - 1.f) * kaw);
            const float sb = wave_sum(r * k2 * rk);
            const size_t o = (size_t)tok * 256 + ch;
            p.rw_r[o] = (h16)r; p.rw_w[o] = (h16)wl; p.rw_k[o] = (h16)k2; p.rw_kk[o] = (h16)kk; p.rw_b[o] = (h16)(kk * a);
            p.rw_g[o] = (h16)lg; p.rw_bonus[o] = (h16)(sb * v); p.rw_v[o] = (h16)v;
        }
    }
}
__global__ void __launch_bounds__(64) k_rw_scan(Params p) {
    __shared__ float sv[5][64];
    const int b = blockIdx.x >> 2, h = blockIdx.x & 3, lane = threadIdx.x;
    float S[64];
#pragma unroll
    for (int k = 0; k < 64; ++k) S[k] = 0.f;
    for (int t = 0; t < SEQ; ++t) {
        const size_t tok = (size_t)b * SEQ + t; const size_t o = tok * 256 + h * 64 + lane;
        const float vv = (float)p.rw_v[o];
        sv[0][lane] = (float)p.rw_r[o]; sv[1][lane] = __expf((float)p.rw_w[o]); sv[2][lane] = (float)p.rw_k[o]; sv[3][lane] = (float)p.rw_kk[o]; sv[4][lane] = (float)p.rw_b[o];
        __syncthreads();
        float skk = 0.f;
#pragma unroll
        for (int k = 0; k < 64; ++k) skk += S[k] * sv[3][k];
        float y = 0.f;
#pragma unroll
        for (int k = 0; k < 64; ++k) { S[k] = S[k] * sv[1][k] - skk * sv[4][k] + vv * sv[2][k]; y += S[k] * sv[0][k]; }
        p.rw_y[o] = y;
        __syncthreads();
    }
}
__global__ void __launch_bounds__(512) k_rw_post(Params p, int l) {
    const int lane = threadIdx.x & 63, wv = threadIdx.x >> 6;
    for (int u = blockIdx.x * 8 + wv; u < NTOK * 4; u += gridDim.x * 8) {
        const int tok = u >> 2, h = u & 3; const size_t o = (size_t)tok * 256 + h * 64 + lane;
        const float y = p.rw_y[o];
        const float mean = wave_sum(y) * (1.f / 64.f);
        const float dv = y - mean;
        const float var = wave_sum(dv * dv) * (1.f / 64.f);
        float v = dv * rsqrtf(var + 64e-5f) * p.in[I_RWGNW][l * 256 + h * 64 + lane] + p.in[I_RWGNB][l * 256 + h * 64 + lane];
        v += (float)p.rw_bonus[o];
        p.branches[(size_t)tok * DM + 768 + h * 64 + lane] = (h16)(v * (float)p.rw_g[o]);
    }
}

__global__ void __launch_bounds__(512) k_dsa_pre(Params p) {
    const int lane = threadIdx.x & 63, wv = threadIdx.x >> 6;
    for (int tok = blockIdx.x * 8 + wv; tok < NTOK; tok += gridDim.x * 8) {
        const double pos = (double)p.pos[tok];
        const int i = lane & 31;
        double ang = pos * exp(-(double)i * (1.0 / 32.0) * 9.210340371976184);
        double sn, cs; sincos(ang, &sn, &cs);
        const float c = (float)cs, s = (float)sn;
        const int base = (lane < 32) ? P_Q : P_K;
        h16* dst = (lane < 32) ? p.q_r : p.k_r;
        const float scl = (lane < 32) ? 0.125f : 1.f;
#pragma unroll
        for (int h = 0; h < 4; ++h) {
            const float x1 = (float)p.proj[(size_t)tok * PJ + base + h * 64 + i], x2 = (float)p.proj[(size_t)tok * PJ + base + h * 64 + 32 + i];
            dst[(size_t)tok * 256 + h * 64 + i] = (h16)((x1 * c - x2 * s) * scl);
            dst[(size_t)tok * 256 + h * 64 + 32 + i] = (h16)((x2 * c + x1 * s) * scl);
        }
        const int i2 = lane & 15;
        double ang2 = pos * exp(-(double)i2 * (1.0 / 16.0) * 9.210340371976184);
        double sn2, cs2; sincos(ang2, &sn2, &cs2);
        const float c2 = (float)cs2, s2 = (float)sn2;
        const float* xf = p.idxf + (size_t)tok * IDXLD;
        if (lane < 16) {
#pragma unroll
            for (int h = 0; h < 4; ++h) {
                const float x1 = xf[h * 32 + i2], x2 = xf[h * 32 + 16 + i2];
                p.iq_r[(size_t)tok * 128 + h * 32 + i2] = x1 * c2 - x2 * s2;
                p.iq_r[(size_t)tok * 128 + h * 32 + 16 + i2] = x2 * c2 + x1 * s2;
            }
        } else if (lane < 32) {
            const float x1 = xf[128 + i2], x2 = xf[128 + 16 + i2];
            p.ik_r[(size_t)tok * 32 + i2] = x1 * c2 - x2 * s2;
            p.ik_r[(size_t)tok * 32 + 16 + i2] = x2 * c2 + x1 * s2;
        }
    }
}
__device__ __forceinline__ unsigned f2key(float x) { unsigned u = __float_as_uint(x); return (u & 0x80000000u) ? ~u : (u | 0x80000000u); }
__global__ void __launch_bounds__(512) k_dsa_naive(Params p) {
    extern __shared__ __attribute__((aligned(16))) char smem[];
    const int lane = threadIdx.x & 63, wv = threadIdx.x >> 6;
    unsigned* s_key = (unsigned*)smem + wv * 4096;
    float* s_p = (float*)s_key;
    float* s_iq = (float*)(smem + 8 * 4096 * 4) + wv * 128;
    float* s_q = (float*)(smem + 8 * 4096 * 4 + 8 * 128 * 4) + wv * 256;
    int* s_list = (int*)(smem + 8 * 4096 * 4 + 8 * 128 * 4 + 8 * 256 * 4) + wv * 256;
    const unsigned long long lt_mask = (lane == 0) ? 0ull : (~0ull >> (64 - lane));
    for (int tok = blockIdx.x * 8 + wv; tok < NTOK; tok += gridDim.x * 8) {
        const int b = tok / SEQ, t = tok % SEQ;
        s_iq[lane] = p.iq_r[(size_t)tok * 128 + lane]; s_iq[64 + lane] = p.iq_r[(size_t)tok * 128 + 64 + lane];
        for (int i = 0; i < 4; ++i) s_q[i * 64 + lane] = (float)p.q_r[(size_t)tok * 256 + i * 64 + lane];
        const float w0 = p.idxf[(size_t)tok * IDXLD + 160], w1 = p.idxf[(size_t)tok * IDXLD + 161], w2 = p.idxf[(size_t)tok * IDXLD + 162], w3 = p.idxf[(size_t)tok * IDXLD + 163];
        __builtin_amdgcn_s_waitcnt(0); __builtin_amdgcn_wave_barrier();
        const int n = t + 1;
        const int nch = (t >> 6) + 1;
#pragma unroll 1
        for (int i = 0; i < nch; ++i) {
            const int s = lane + 64 * i;
            unsigned kv_ = 0u;
            if (s <= t) {
                const float* kp = p.ik_r + ((size_t)b * SEQ + s) * 32;
                float d0 = 0.f, d1 = 0.f, d2 = 0.f, d3 = 0.f;
#pragma unroll
                for (int d4 = 0; d4 < 8; ++d4) {
                    const f32x4 kv = *(const f32x4*)(kp + d4 * 4);
#pragma unroll
                    for (int e = 0; e < 4; ++e) { const int d = d4 * 4 + e; d0 += s_iq[d] * kv[e]; d1 += s_iq[32 + d] * kv[e]; d2 += s_iq[64 + d] * kv[e]; d3 += s_iq[96 + d] * kv[e]; }
                }
                const float sc = w0 * fmaxf(d0, 0.f) + w1 * fmaxf(d1, 0.f) + w2 * fmaxf(d2, 0.f) + w3 * fmaxf(d3, 0.f);
                kv_ = f2key(sc + 0.f);
            }
            s_key[s] = kv_;
        }
        __builtin_amdgcn_s_waitcnt(0); __builtin_amdgcn_wave_barrier();
        int cnt_sel;
        if (n <= 256) {
            for (int i = 0; i < 4; ++i) { const int s = lane + 64 * i; if (s <= t) s_list[s] = s; }
            cnt_sel = n;
        } else {
            unsigned v = 0u;
#pragma unroll 1
            for (int bit = 31; bit >= 0; --bit) {
                const unsigned cand = v | (1u << bit);
                int c = 0;
#pragma unroll 4
                for (int i = 0; i < nch; ++i) c += __popcll(__ballot(s_key[lane + 64 * i] >= cand));
                if (c >= 256) v = cand;
            }
            int cgt = 0;
#pragma unroll 4
            for (int i = 0; i < nch; ++i) cgt += __popcll(__ballot(s_key[lane + 64 * i] > v));
            const int need = 256 - cgt;
            int nsel = 0, nties = 0;
#pragma unroll 1
            for (int i = 0; i < nch; ++i) {
                const unsigned kx = s_key[lane + 64 * i];
                const bool gt = kx > v, eq = kx == v;
                const unsigned long long eqm = __ballot(eq);
                const int trank = nties + __popcll(eqm & lt_mask);
                const bool sel = gt || (eq && trank < need);
                const unsigned long long sm = __ballot(sel);
                if (sel) s_list[nsel + __popcll(sm & lt_mask)] = lane + 64 * i;
                nsel += __popcll(sm); nties += __popcll(eqm);
            }
            cnt_sel = nsel;
        }
        __builtin_amdgcn_s_waitcnt(0); __builtin_amdgcn_wave_barrier();
        float lg[4][4];
#pragma unroll
        for (int jj = 0; jj < 4; ++jj) {
            const int j = lane + 64 * jj;
#pragma unroll
            for (int h = 0; h < 4; ++h) lg[jj][h] = -INFINITY;
            if (j < cnt_sel) {
                const int s = s_list[j];
                const h16* kp = p.k_r + ((size_t)b * SEQ + s) * 256;
#pragma unroll
                for (int h = 0; h < 4; ++h) {
                    float a = 0.f;
#pragma unroll
                    for (int d8 = 0; d8 < 8; ++d8) { const h16x8 kv = *(const h16x8*)(kp + h * 64 + d8 * 8);
#pragma unroll
                        for (int e = 0; e < 8; ++e) a += s_q[h * 64 + d8 * 8 + e] * (float)kv[e]; }
                    lg[jj][h] = a;
                }
            }
        }
        float inv[4];
#pragma unroll
        for (int h = 0; h < 4; ++h) {
            float m = fmaxf(fmaxf(lg[0][h], lg[1][h]), fmaxf(lg[2][h], lg[3][h]));
            m = wave_max(m);
            float sm = 0.f;
#pragma unroll
            for (int jj = 0; jj < 4; ++jj) { const float e = (lane + 64 * jj < cnt_sel) ? __expf(lg[jj][h] - m) : 0.f; s_p[h * 256 + lane + 64 * jj] = e; sm += e; }
            sm = wave_sum(sm);
            inv[h] = 1.f / sm;
        }
        __builtin_amdgcn_s_waitcnt(0); __builtin_amdgcn_wave_barrier();
        const int hh = lane >> 4;
        float o0 = 0.f, o1 = 0.f, o2 = 0.f, o3 = 0.f;
#pragma unroll 4
        for (int j = 0; j < cnt_sel; ++j) {
            const int s = s_list[j]; const float pj = s_p[hh * 256 + j];
            const h16x4 vv = *(const h16x4*)(p.proj + ((size_t)b * SEQ + s) * PJ + P_V + lane * 4);
            o0 += pj * (float)vv[0]; o1 += pj * (float)vv[1]; o2 += pj * (float)vv[2]; o3 += pj * (float)vv[3];
        }
        const float iv = (hh == 0) ? inv[0] : (hh == 1) ? inv[1] : (hh == 2) ? inv[2] : inv[3];
        *(h16x4*)(p.branches + (size_t)tok * DM + 256 + lane * 4) = pack4(o0 * iv, o1 * iv, o2 * iv, o3 * iv);
        __builtin_amdgcn_s_waitcnt(0); __builtin_amdgcn_wave_barrier();
    }
}
#define DSA_NAIVE_LDS (8 * 4096 * 4 + 8 * 128 * 4 + 8 * 256 * 4 + 8 * 256 * 4)

__global__ void __launch_bounds__(512) k_merge(Params p, int l) {
    extern __shared__ __attribute__((aligned(16))) char smem[];
    for (int u = blockIdx.x; u < 128 * 8; u += gridDim.x) {
        const int mt = u >> 3, nt = u & 7, m0 = mt * 128, n0 = nt * 128;
        f32x4 mx[2][4]; zero_acc<128>(mx);
        const int lane = threadIdx.x & 63, wave = threadIdx.x >> 6, wn = wave & 1;
        for (int n = 0; n < 4; ++n) {
            f32x4 ag[2][4], au[2][4]; zero_acc<128>(ag); zero_acc<128>(au);
            const h16* A = p.h_hi + (size_t)m0 * DM; const h16* B = p.Wg + ((size_t)n * 1024 + n0) * DM;
            gemm_kloop<128>(smem, DM, [=](int r, int k) { return A + (size_t)r * DM + k; }, [=](int r, int k) { return B + (size_t)r * DM + k; }, ag);
            const h16* A2 = p.branches + (size_t)m0 * DM + n * 256; const h16* B2 = p.Wb + ((size_t)n * 1024 + n0) * 256;
            gemm_kloop<128>(smem, 256, [=](int r, int k) { return A2 + (size_t)r * DM + k; }, [=](int r, int k) { return B2 + (size_t)r * 256 + k; }, au);
            const float* gb = p.in[I_GATEB] + (size_t)l * 4096 + n * 1024 + n0 + wn * 64 + 4 * (lane >> 4);
#pragma unroll
            for (int j = 0; j < 4; ++j) {
                const f32x4 bb = *(const f32x4*)(gb + j * 16);
#pragma unroll
                for (int i = 0; i < 2; ++i)
#pragma unroll
                    for (int e = 0; e < 4; ++e) mx[i][j][e] += sigm(ag[i][j][e] + bb[e]) * au[i][j][e];
            }
        }
        h16* O = p.mixed + (size_t)m0 * DM + n0;
        gemm_epi<128>(mx, [=](int ml, int nl, f32x4 v) { *(h16x4*)(O + (size_t)ml * DM + nl) = pack4(v[0], v[1], v[2], v[3]); });
    }
}
__global__ void __launch_bounds__(512) k_outproj(Params p, int l) {
    extern __shared__ __attribute__((aligned(16))) char smem[];
    const float* xin = l == 0 ? p.in[I_X] : p.x1;
    for (int u = blockIdx.x; u < 64 * 8; u += gridDim.x) {
        const int mt = u >> 3, nt = u & 7, m0 = mt * 256, n0 = nt * 128;
        f32x4 acc[4][4]; zero_acc<256>(acc);
        const h16* A = p.mixed + (size_t)m0 * DM; const h16* B = p.Wo + (size_t)n0 * DM;
        gemm_kloop<256>(smem, DM, [=](int r, int k) { return A + (size_t)r * DM + k; }, [=](int r, int k) { return B + (size_t)r * DM + k; }, acc);
        const float* g1 = p.mods + ((size_t)l * 4 + (m0 / SEQ)) * 6144 + 2 * 1024 + n0;
        const float* X = xin + (size_t)m0 * DM + n0; float* O = p.x1 + (size_t)m0 * DM + n0;
        gemm_epi<256>(acc, [=](int ml, int nl, f32x4 v) { const f32x4 xv = *(const f32x4*)(X + (size_t)ml * DM + nl), gg = *(const f32x4*)(g1 + nl);
                                                          *(f32x4*)(O + (size_t)ml * DM + nl) = xv + gg * v; });
    }
}

__constant__ int c_pair_lo[6] = {0, 0, 0, 1, 1, 2};
__constant__ int c_pair_hi[6] = {1, 2, 3, 2, 3, 3};
__global__ void __launch_bounds__(512) k_norm2_router(Params p, int l) {
    extern __shared__ __attribute__((aligned(16))) char smem[];
    float* rw = (float*)smem;
    for (int i = threadIdx.x; i < DM * 16; i += 512) rw[i] = p.in[I_ROUTW][i];
    __syncthreads();
    const int lane = threadIdx.x & 63, wv = threadIdx.x >> 6;
    for (int tok = blockIdx.x * 8 + wv; tok < NTOK; tok += gridDim.x * 8) {
        const int b = tok / SEQ;
        const float* xr = p.x1 + (size_t)tok * DM;
        f32x4 v[4]; float ss = 0.f;
#pragma unroll
        for (int i = 0; i < 4; ++i) { v[i] = *(const f32x4*)(xr + i * 256 + lane * 4); ss += v[i][0] * v[i][0] + v[i][1] * v[i][1] + v[i][2] * v[i][2] + v[i][3] * v[i][3]; }
        ss = wave_sum(ss);
        const float rs = rsqrtf(ss * (1.f / DM) + 1e-6f);
        const float* g = p.in[I_FNG] + l * DM;
        const float* md = p.mods + ((size_t)l * 4 + b) * 6144;
        float lg[16];
#pragma unroll
        for (int e = 0; e < 16; ++e) lg[e] = 0.f;
#pragma unroll 1
        for (int i = 0; i < 4; ++i) {
            const int c = i * 256 + lane * 4;
            f32x4 gg = *(const f32x4*)(g + c), sh = *(const f32x4*)(md + 3 * 1024 + c), sc = *(const f32x4*)(md + 4 * 1024 + c);
            float hv[4];
#pragma unroll
            for (int e = 0; e < 4; ++e) hv[e] = v[i][e] * rs * gg[e] * (1.f + sc[e]) + sh[e];
            *(h16x4*)(p.h_hi + (size_t)tok * DM + c) = pack4(hv[0], hv[1], hv[2], hv[3]);
#pragma unroll 1
            for (int e = 0; e < 4; ++e) {
                const float* rr = rw + (c + e) * 16;
                const float hve = e == 0 ? hv[0] : e == 1 ? hv[1] : e == 2 ? hv[2] : hv[3];
#pragma unroll
                for (int x4 = 0; x4 < 4; ++x4) { const f32x4 r4 = *(const f32x4*)(rr + x4 * 4); lg[x4 * 4] += hve * r4[0]; lg[x4 * 4 + 1] += hve * r4[1]; lg[x4 * 4 + 2] += hve * r4[2]; lg[x4 * 4 + 3] += hve * r4[3]; }
            }
        }
#pragma unroll
        for (int e = 0; e < 16; ++e) lg[e] = wave_sum(lg[e]);
        if (lane == 0) {
            float sc[16], bi[16];
#pragma unroll
            for (int e = 0; e < 16; ++e) { sc[e] = 1.f / (1.f + expf(-lg[e])); bi[e] = sc[e] + p.in[I_ROUTB][e]; }
            int bg = 0; float bgs = -INFINITY;
#pragma unroll
            for (int gI = 0; gI < 4; ++gI) {
                float m1 = -INFINITY, m2 = -INFINITY;
#pragma unroll
                for (int j = 0; j < 4; ++j) { const float x = bi[gI * 4 + j]; if (x > m1) { m2 = m1; m1 = x; } else if (x > m2) m2 = x; }
                const float gs = m1 + m2;
                if (gs > bgs) { bgs = gs; bg = gI; }
            }
            int e0 = 0; float b0 = -INFINITY;
#pragma unroll
            for (int j = 0; j < 4; ++j) { float x = -INFINITY;
#pragma unroll
                for (int gI = 0; gI < 4; ++gI) if (gI == bg) x = bi[gI * 4 + j];
                if (x > b0) { b0 = x; e0 = j; } }
            int e1 = 0; float b1 = -INFINITY;
#pragma unroll
            for (int j = 0; j < 4; ++j) { float x = -INFINITY;
#pragma unroll
                for (int gI = 0; gI < 4; ++gI) if (gI == bg) x = bi[gI * 4 + j];
                if (j != e0 && x > b1) { b1 = x; e1 = j; } }
            float s0 = 0.f, s1 = 0.f;
#pragma unroll
            for (int e = 0; e < 16; ++e) { if (e == bg * 4 + e0) s0 = sc[e]; if (e == bg * 4 + e1) s1 = sc[e]; }
            const float wsum = s0 + s1; const float wa = s0 / wsum, wb = s1 / wsum;
            const int lo = e0 < e1 ? e0 : e1, hi = e0 < e1 ? e1 : e0;
            const float clo = e0 < e1 ? wa : wb, chi = e0 < e1 ? wb : wa;
            int pr = 0;
#pragma unroll
            for (int q = 0; q < 6; ++q) if (c_pair_lo[q] == lo && c_pair_hi[q] == hi) pr = q;
            const int bucket = bg * 6 + pr;
            const int pos = atomicAdd(&p.bcnt[bucket], 1);
            p.lists[(size_t)bucket * LCAP + pos] = tok;
            p.cw[(size_t)tok * 2] = clo; p.cw[(size_t)tok * 2 + 1] = chi;
        }
    }
}

struct MoeTile { int bucket, i0, cnt, ea, eb; };
__device__ __forceinline__ bool moe_tile(const int* bcnt, int mt, MoeTile& o) {
    int acc = 0;
    for (int b = 0; b < 24; ++b) {
        const int c = bcnt[b]; const int nt = (c + 127) >> 7;
        if (mt < acc + nt) { o.bucket = b; o.i0 = (mt - acc) * 128; o.cnt = c; const int g = b / 6, pr = b % 6; o.ea = g * 4 + c_pair_lo[pr]; o.eb = g * 4 + c_pair_hi[pr]; return true; }
        acc += nt;
    }
    return false;
}
#define MOE_MAXT 152
__global__ void __launch_bounds__(512) k_moe1(Params p) {
    extern __shared__ __attribute__((aligned(16))) char smem[];
    for (int u = blockIdx.x; u < MOE_MAXT * 16; u += gridDim.x) {
        const int mt = u >> 4, nt = u & 15;
        MoeTile T; if (!moe_tile(p.bcnt, mt, T)) break;
        const int* lst = p.lists + (size_t)T.bucket * LCAP; const int i0 = T.i0, cnt = T.cnt;
        const h16* H = p.h_hi;
        const int second = nt >= 8;
        const h16* B = p.We13 + ((size_t)(second ? T.eb : T.ea) * 1024 + (nt & 7) * 128) * DM;
        f32x4 acc[2][4]; zero_acc<128>(acc);
        gemm_kloop<128>(smem, DM, [=](int r, int k) { const int i = i0 + r; const int tok = lst[i < cnt ? i : 0]; return H + (size_t)tok * DM + k; },
                        [=](int r, int k) { return B + (size_t)r * DM + k; }, acc);
        const int lane = threadIdx.x & 63, wave = threadIdx.x >> 6, wm = wave >> 1, wn = wave & 1;
#pragma unroll
        for (int i = 0; i < 2; ++i) {
            const int ml = wm * 32 + i * 16 + (lane & 15);
            const int ii = i0 + ml; const bool valid = ii < cnt;
            const float cwv = valid ? p.cw[(size_t)lst[ii] * 2 + second] : 0.f;
            h16* O = p.act + ((size_t)mt * 128 + ml) * 1024 + second * 512;
#pragma unroll
            for (int jj = 0; jj < 2; ++jj) {
                const f32x4 a = acc[i][2 * jj], bq = acc[i][2 * jj + 1];
                const int col = ((nt & 7) * 128 + wn * 64 + jj * 32) / 2 + 4 * (lane >> 4);
                float o[4];
#pragma unroll
                for (int e = 0; e < 4; ++e) o[e] = valid ? cwv * (a[e] * sigm(a[e])) * bq[e] : 0.f;
                *(h16x4*)(O + col) = pack4(o[0], o[1], o[2], o[3]);
            }
        }
    }
}
__global__ void __launch_bounds__(512) k_moe2(Params p, int l) {
    extern __shared__ __attribute__((aligned(16))) char smem[];
    for (int u = blockIdx.x; u < MOE_MAXT * 8; u += gridDim.x) {
        const int mt = u >> 3, nt = u & 7, n0 = nt * 128;
        MoeTile T; if (!moe_tile(p.bcnt, mt, T)) break;
        const int* lst = p.lists + (size_t)T.bucket * LCAP; const int i0 = T.i0, cnt = T.cnt;
        const h16* A = p.act + (size_t)mt * 128 * 1024;
        const h16* Ba = p.We2 + ((size_t)T.ea * 1024 + n0) * 512; const h16* Bb = p.We2 + ((size_t)T.eb * 1024 + n0) * 512;
        f32x4 acc[2][4]; zero_acc<128>(acc);
        gemm_kloop<128>(smem, 1024, [=](int r, int k) { return A + (size_t)r * 1024 + k; },
                        [=](int r, int k) { return (k < 512 ? Ba + k : Bb + (k - 512)) + (size_t)r * 512; }, acc);
        const float* md = p.mods + (size_t)l * 4 * 6144 + 5 * 1024 + n0;
        float* X = p.x1;
        gemm_epi<128>(acc, [=](int ml, int nl, f32x4 v) { const int ii = i0 + ml; if (ii < cnt) { const int tok = lst[ii]; const f32x4 gg = *(const f32x4*)(md + (size_t)(tok / SEQ) * 6144 + nl);
                                                          float* xp = X + (size_t)tok * DM + n0 + nl; *(f32x4*)xp = *(const f32x4*)xp + gg * v; } });
    }
}
__global__ void __launch_bounds__(512) k_final(Params p) {
    const int lane = threadIdx.x & 63, wv = threadIdx.x >> 6;
    for (int tok = blockIdx.x * 8 + wv; tok < NTOK; tok += gridDim.x * 8) {
        const float* xr = p.x1 + (size_t)tok * DM;
        f32x4 v[4]; float ss = 0.f;
#pragma unroll
        for (int i = 0; i < 4; ++i) { v[i] = *(const f32x4*)(xr + i * 256 + lane * 4); ss += v[i][0] * v[i][0] + v[i][1] * v[i][1] + v[i][2] * v[i][2] + v[i][3] * v[i][3]; }
        ss = wave_sum(ss);
        const float rs = rsqrtf(ss * (1.f / DM) + 1e-6f);
#pragma unroll
        for (int i = 0; i < 4; ++i) { const int c = i * 256 + lane * 4; const f32x4 gg = *(const f32x4*)(p.in[I_FINALG] + c); *(f32x4*)(p.out + (size_t)tok * DM + c) = v[i] * rs * gg; }
    }
}

static inline size_t al(size_t x) { return (x + 255) & ~(size_t)255; }
extern "C" void kernel_launch(void* const* d_in, const int* in_sizes, int n_in, void* d_out, int out_size, void* d_ws, size_t ws_size, hipStream_t stream) {
    Params p{};
    for (int i = 0; i < N_IN; ++i) p.in[i] = (const float*)d_in[i];
    p.pos = (const int*)d_in[I_POS];
    p.out = (float*)d_out;
    char* w = (char*)d_ws; size_t off = 0;
    auto take = [&](size_t bytes) { char* r = w + off; off += al(bytes); return r; };
    p.mods = (float*)take(2 * 4 * 6144 * 4);
    p.bcnt = (int*)take(256);
    p.Wp = (h16*)take((size_t)PJ * DM * 2); p.Widx = (h16*)take((size_t)256 * 3072 * 2); p.Wg = (h16*)take((size_t)4096 * DM * 2);
    p.Wb = (h16*)take((size_t)4096 * 256 * 2); p.Wo = (h16*)take((size_t)DM * DM * 2); p.Wglu = (h16*)take(256 * 256 * 2);
    p.x1 = (float*)take((size_t)NTOK * DM * 4);
    p.h_hi = (h16*)take((size_t)NTOK * DM * 2); p.h_lo = (h16*)take((size_t)NTOK * DM * 2); p.branches = p.h_lo;
    p.cw = (float*)take((size_t)NTOK * 2 * 4);
    p.lists = (int*)take((size_t)24 * LCAP * 4);
    const size_t offR = off;
    p.proj = (h16*)take((size_t)NTOK * PJ * 2); p.idxf = (float*)take((size_t)NTOK * IDXLD * 4);
    p.q_r = (h16*)take((size_t)NTOK * 256 * 2); p.k_r = (h16*)take((size_t)NTOK * 256 * 2); p.iq_r = (float*)take((size_t)NTOK * 128 * 4); p.ik_r = (float*)take((size_t)NTOK * 32 * 4);
    p.ybuf = (h16*)take((size_t)NTOK * 256 * 2); p.s5E = (float*)take((size_t)4 * 64 * 16 * 64 * 2 * 4); p.s5H = (float*)take((size_t)4 * 64 * 16 * 64 * 2 * 4);
    p.rg_hl = (float*)take((size_t)NTOK * 256 * 4); p.rg_cp = (float*)take((size_t)NTOK * 256 * 4); p.rg_agg = (float*)take((size_t)4 * 64 * 256 * 2 * 4);
    p.rw_r = (h16*)take((size_t)NTOK * 256 * 2); p.rw_w = (h16*)take((size_t)NTOK * 256 * 2); p.rw_k = (h16*)take((size_t)NTOK * 256 * 2); p.rw_kk = (h16*)take((size_t)NTOK * 256 * 2);
    p.rw_b = (h16*)take((size_t)NTOK * 256 * 2); p.rw_v = (h16*)take((size_t)NTOK * 256 * 2);
    p.rw_y = (float*)p.rg_hl; p.rw_g = (h16*)p.rg_cp; p.rw_bonus = (h16*)p.rg_cp + (size_t)NTOK * 256;
    const size_t endMix = off;
    p.mixed = (h16*)p.rg_hl;
    off = offR;
    p.We13 = (h16*)take((size_t)16 * 1024 * DM * 2); p.We2 = (h16*)take((size_t)16 * 1024 * 512 * 2); p.act = (h16*)take((size_t)MOE_MAXT * 128 * 1024 * 2);
    const size_t endMoe = off;
    const size_t need = endMix > endMoe ? endMix : endMoe;
    if (need > ws_size) { fprintf(stderr, "workspace too small: need %zu have %zu\n", need, ws_size); return; }
    static bool printed = false; if (!printed) { fprintf(stderr, "ws need %zu have %zu\n", need, ws_size); printed = true; }

    static bool attr_done = false;
    if (!attr_done) {
        (void)hipFuncSetAttribute((const void*)k_gemm1, hipFuncAttributeMaxDynamicSharedMemorySize, GEMM_LDS(256));
        (void)hipFuncSetAttribute((const void*)k_s5_glu, hipFuncAttributeMaxDynamicSharedMemorySize, GEMM_LDS(256));
        (void)hipFuncSetAttribute((const void*)k_rg_a, hipFuncAttributeMaxDynamicSharedMemorySize, 2 * 64 * 256 * 4);
        (void)hipFuncSetAttribute((const void*)k_rw_prep, hipFuncAttributeMaxDynamicSharedMemorySize, 128 * 256 * 2 + 16 * 896 * 4);
        (void)hipFuncSetAttribute((const void*)k_dsa_naive, hipFuncAttributeMaxDynamicSharedMemorySize, DSA_NAIVE_LDS);
        (void)hipFuncSetAttribute((const void*)k_merge, hipFuncAttributeMaxDynamicSharedMemorySize, GEMM_LDS(128));
        (void)hipFuncSetAttribute((const void*)k_outproj, hipFuncAttributeMaxDynamicSharedMemorySize, GEMM_LDS(256));
        (void)hipFuncSetAttribute((const void*)k_norm2_router, hipFuncAttributeMaxDynamicSharedMemorySize, DM * 16 * 4);
        (void)hipFuncSetAttribute((const void*)k_moe1, hipFuncAttributeMaxDynamicSharedMemorySize, GEMM_LDS(128));
        (void)hipFuncSetAttribute((const void*)k_moe2, hipFuncAttributeMaxDynamicSharedMemorySize, GEMM_LDS(128));
        attr_done = true;
    }
    const int G = 256;
    k_mods<<<48, 256, 0, stream>>>(p);
    for (int l = 0; l < 2; ++l) {
        k_convert_mix<<<1024, 256, 0, stream>>>(p, l);
        k_norm1<<<G, 512, 0, stream>>>(p, l);
        k_gemm1<<<G, 512, GEMM_LDS(256), stream>>>(p);
        k_s5_scan<1><<<G, 512, 0, stream>>>(p, l);
        k_s5_carry<<<16, 256, 0, stream>>>(p, l);
        k_s5_scan<3><<<G, 512, 0, stream>>>(p, l);
        k_s5_glu<<<128, 512, GEMM_LDS(256), stream>>>(p, l);
        k_rg_a<<<G, 512, 2 * 64 * 256 * 4, stream>>>(p, l);
        k_rg_c<<<G, 512, 0, stream>>>(p, l);
        k_rw_prep<<<G, 512, 128 * 256 * 2 + 16 * 896 * 4, stream>>>(p, l);
        k_rw_scan<<<16, 64, 0, stream>>>(p);
        k_rw_post<<<G, 512, 0, stream>>>(p, l);
        k_dsa_pre<<<G, 512, 0, stream>>>(p);
        k_dsa_naive<<<G, 512, DSA_NAIVE_LDS, stream>>>(p);
        k_merge<<<G, 512, GEMM_LDS(128), stream>>>(p, l);
        k_outproj<<<G, 512, GEMM_LDS(256), stream>>>(p, l);
        k_convert_moe<<<2048, 256, 0, stream>>>(p, l);
        k_norm2_router<<<G, 512, DM * 16 * 4, stream>>>(p, l);
        k_moe1<<<G, 512, GEMM_LDS(128), stream>>>(p);
        k_moe2<<<G, 512, GEMM_LDS(128), stream>>>(p, l);
    }
    k_final<<<G, 512, 0, stream>>>(p);
}
```

```cpp
#include <hip/hip_runtime.h>
#include <stdint.h>
#include <stdio.h>
#include <math.h>

typedef _Float16 h16;
typedef _Float16 h16x8 __attribute__((ext_vector_type(8)));
typedef _Float16 h16x4 __attribute__((ext_vector_type(4)));
typedef float f32x4 __attribute__((ext_vector_type(4)));

#define NTOK 16384
#define SEQ 4096
#define NBATCH 4
#define DM 1024
#define DINW 2596
#define PJ 2432
#define IDXLD 192
#define P_U 0
#define P_Q 256
#define P_K 512
#define P_V 768
#define P_RGX 1024
#define P_RGG 1280
#define P_RW 1536
#define LCAP 16384

enum { I_X = 0, I_C, I_POS, I_ADAW, I_ADAB, I_MNG, I_WIN, I_GATEW, I_GATEB, I_BRW, I_OUTW,
       I_S5LRE, I_S5LIM, I_S5LS, I_S5BRE, I_S5BIM, I_S5CRE, I_S5CIM, I_S5D, I_S5GW, I_S5GB,
       I_RGCW, I_RGCB, I_RGWR, I_RGBR, I_RGWI, I_RGBI, I_RGLAM,
       I_RWMU, I_RWW0, I_RWWUP, I_RWA0, I_RWAUP, I_RWGUP, I_RWKK, I_RWKA, I_RWRK, I_RWGNW, I_RWGNB,
       I_FNG, I_ROUTW, I_ROUTB, I_W1, I_W3, I_W2, I_FINALG, N_IN };

struct Params {
    const float* in[N_IN];
    const int* pos;
    float* out;
    unsigned* bar;
    float* mods;
    h16 *Wp, *Widx, *Wg, *Wb, *Wo, *Wglu, *We13, *We2;
    float* x1;
    h16 *h_hi, *h_lo, *branches;
    h16* proj; float* idxf;
    h16* ybuf; float *s5E, *s5H;
    float *rg_hl, *rg_cp, *rg_agg;
    h16 *rw_r, *rw_w, *rw_k, *rw_kk, *rw_b, *rw_g, *rw_bonus, *rw_v; float* rw_y;
    h16* mixed;
    h16* act; int* lists; int* bcnt; float* cw;
};

typedef const __attribute__((address_space(4))) Params& CP;
__device__ __forceinline__ float sigm(float x) { return 1.f / (1.f + __expf(-x)); }
__device__ __forceinline__ float gelu_tanh(float x) { return 0.5f * x * (1.f + tanhf(0.7978845608028654f * (x + 0.044715f * x * x * x))); }
__device__ __forceinline__ float softplusf_(float x) { return fmaxf(x, 0.f) + log1pf(__expf(-fabsf(x))); }
__device__ __forceinline__ float wave_sum(float v) { for (int o = 32; o > 0; o >>= 1) v += __shfl_xor(v, o); return v; }
__device__ __forceinline__ float wave_max(float v) { for (int o = 32; o > 0; o >>= 1) v = fmaxf(v, __shfl_xor(v, o)); return v; }
__device__ __forceinline__ h16x4 pack4(float a, float b, float c, float d) { h16x4 r; r[0] = (h16)a; r[1] = (h16)b; r[2] = (h16)c; r[3] = (h16)d; return r; }

__device__ __forceinline__ int oint(int x) { asm volatile("" : "+s"(x)); return x; }
__device__ __forceinline__ int otid() { int t = threadIdx.x; asm volatile("" : "+v"(t)); return t; }
__device__ __forceinline__ void ph_mods(CP p, int bid, int nblk, char* smem) {
    if (bid >= 24) return;
    float* ca = (float*)smem;
    for (int i = otid(); i < 4 * DM; i += 512) { float c = p.in[I_C][i]; ca[i] = c * sigm(c); }
    __syncthreads();
    int gid = bid * 512 + otid();
    int l = gid / 6144, j = gid % 6144;
    const float* w = p.in[I_ADAW] + (size_t)l * DM * 6144 + j;
    float a0 = 0, a1 = 0, a2 = 0, a3 = 0;
    for (int k = 0; k < DM; ++k) { float wv = w[(size_t)k * 6144]; a0 += ca[k] * wv; a1 += ca[DM + k] * wv; a2 += ca[2 * DM + k] * wv; a3 += ca[3 * DM + k] * wv; }
    float bb = p.in[I_ADAB][l * 6144 + j];
    float* m = p.mods + (size_t)l * 4 * 6144;
    m[0 * 6144 + j] = a0 + bb; m[1 * 6144 + j] = a1 + bb; m[2 * 6144 + j] = a2 + bb; m[3 * 6144 + j] = a3 + bb;
}

template <class SRC>
__device__ __forceinline__ void convT(h16* dst, int dstld, int nrows, int K, int koff, const SRC& src, int gtid, int gthreads) {
    const int kch = K / 8;
    const long total = (long)nrows * kch;
    for (long w = gtid; w < total; w += gthreads) {
        int n = (int)(w % nrows), kc = (int)(w / nrows);
        h16x8 v;
#pragma unroll
        for (int i = 0; i < 8; ++i) v[i] = (h16)src(n, kc * 8 + i);
        *(h16x8*)(dst + (size_t)n * dstld + koff + kc * 8) = v;
    }
}
__device__ __forceinline__ void ph_convert_mix(CP p, int l, int bid, int nblk) {
    const int gt = bid * 512 + otid(), gn = nblk * 512;
    { const float* s = p.in[I_WIN] + (size_t)l * DM * DINW;
      convT(p.Wp, DM, PJ, DM, 0, [=](int n, int k) { return s[(size_t)k * DINW + (n < 1024 ? n : n + 164)]; }, gt, gn);
      convT(p.Widx, 3072, 256, DM, 0, [=](int n, int k) { return n < 164 ? s[(size_t)k * DINW + 1024 + n] : 0.f; }, gt, gn);
      convT(p.Widx, 3072, 256, DM, 1024, [=](int n, int k) { return n < 164 ? s[(size_t)k * DINW + 1024 + n] : 0.f; }, gt, gn);
      convT(p.Widx, 3072, 256, DM, 2048, [=](int n, int k) { float w = n < 164 ? s[(size_t)k * DINW + 1024 + n] : 0.f; float hi = (float)(h16)w; return w - hi; }, gt, gn); }
    { const float* s = p.in[I_GATEW] + (size_t)l * DM * 4096;
      convT(p.Wg, DM, 4096, DM, 0, [=](int n, int k) { return s[(size_t)k * 4096 + n]; }, gt, gn); }
    { const float* s = p.in[I_BRW] + (size_t)l * 4 * 256 * DM;
      convT(p.Wb, 256, 4096, 256, 0, [=](int n, int k) { int br = n >> 10, d = n & 1023; return s[(size_t)br * 256 * DM + (size_t)k * DM + d]; }, gt, gn); }
    { const float* s = p.in[I_OUTW] + (size_t)l * DM * DM;
      convT(p.Wo, DM, DM, DM, 0, [=](int n, int k) { return s[(size_t)k * DM + n]; }, gt, gn); }
    { const float* s = p.in[I_S5GW] + (size_t)l * 256 * 256;
      convT(p.Wglu, 256, 256, 256, 0, [=](int n, int k) { return s[(size_t)k * 256 + n]; }, gt, gn); }
}
__device__ __forceinline__ void ph_convert_moe(CP p, int l, int bid, int nblk) {
    const int gt = bid * 512 + otid(), gn = nblk * 512;
    const float* s1 = p.in[I_W1] + (size_t)l * 16 * DM * 512;
    const float* s3 = p.in[I_W3] + (size_t)l * 16 * DM * 512;
    const float* s2 = p.in[I_W2] + (size_t)l * 16 * 512 * DM;
    convT(p.We13, DM, 16 * 1024, DM, 0, [=](int n, int k) { int e = n >> 10, r = n & 1023; int c = (r >> 5) * 16 + (r & 15); const float* s = ((r >> 4) & 1) ? s3 : s1;
                                                           return s[(size_t)e * DM * 512 + (size_t)k * 512 + c]; }, gt, gn);
    convT(p.We2, 512, 16 * 1024, 512, 0, [=](int n, int k) { int e = n >> 10, c = n & 1023; return s2[(size_t)e * 512 * DM + (size_t)k * DM + c]; }, gt, gn);
}

__device__ __forceinline__ void ph_norm1(CP p, int l, int bid, int nblk) {
    const float* xin = l == 0 ? p.in[I_X] : p.x1;
    const int lane = otid() & 63, wv = otid() >> 6;
    if (bid == 0 && otid() < 24) p.bcnt[otid()] = 0;
    for (int tok = bid * 8 + wv; tok < NTOK; tok += nblk * 8) {
        const int b = tok / SEQ;
        const float* xr = xin + (size_t)tok * DM;
        f32x4 v[4]; float ss = 0.f;
#pragma unroll
        for (int i = 0; i < 4; ++i) { v[i] = *(const f32x4*)(xr + i * 256 + lane * 4); ss += v[i][0] * v[i][0] + v[i][1] * v[i][1] + v[i][2] * v[i][2] + v[i][3] * v[i][3]; }
        ss = wave_sum(ss);
        const float rs = rsqrtf(ss * (1.f / DM) + 1e-6f);
        const float* g = p.in[I_MNG] + l * DM;
        const float* md = p.mods + ((size_t)l * 4 + b) * 6144;
#pragma unroll
        for (int i = 0; i < 4; ++i) {
            const int c = i * 256 + lane * 4;
            f32x4 gg = *(const f32x4*)(g + c), sh = *(const f32x4*)(md + c), sc = *(const f32x4*)(md + 1024 + c);
            float hv[4]; h16x4 hi, lo;
#pragma unroll
            for (int e = 0; e < 4; ++e) { hv[e] = v[i][e] * rs * gg[e] * (1.f + sc[e]) + sh[e]; hi[e] = (h16)hv[e]; lo[e] = (h16)(hv[e] - (float)hi[e]); }
            *(h16x4*)(p.h_hi + (size_t)tok * DM + c) = hi;
            *(h16x4*)(p.h_lo + (size_t)tok * DM + c) = lo;
        }
    }
}

#define LDT 72
template <int BM, class AF, class BF>
__device__ __forceinline__ void gemm_kloop(char* smem, int K, const AF& af, const BF& bf, f32x4 (&acc)[BM / 64][4]) {
    constexpr int MT = BM / 64, WM = BM / 4, NA = BM / 64;
    h16* sA = (h16*)smem; h16* sB = sA + 2 * BM * LDT;
    const int tid = otid(), lane = tid & 63, wave = tid >> 6, wm = wave >> 1, wn = wave & 1;
    const int lrow = tid >> 3, lkc = (tid & 7) * 8;
    uint4 ra[NA], rb[2];
    const int nk = K / 64;
#pragma unroll
    for (int i = 0; i < NA; ++i) ra[i] = *(const uint4*)af(lrow + i * 64, lkc);
#pragma unroll
    for (int i = 0; i < 2; ++i) rb[i] = *(const uint4*)bf(lrow + i * 64, lkc);
#pragma unroll
    for (int i = 0; i < NA; ++i) *(uint4*)&sA[(lrow + i * 64) * LDT + lkc] = ra[i];
#pragma unroll
    for (int i = 0; i < 2; ++i) *(uint4*)&sB[(lrow + i * 64) * LDT + lkc] = rb[i];
    __syncthreads();
    for (int kt = 0; kt < nk; ++kt) {
        const int cur = kt & 1;
        if (kt + 1 < nk) {
            const int k = (kt + 1) * 64 + lkc;
#pragma unroll
            for (int i = 0; i < NA; ++i) ra[i] = *(const uint4*)af(lrow + i * 64, k);
#pragma unroll
            for (int i = 0; i < 2; ++i) rb[i] = *(const uint4*)bf(lrow + i * 64, k);
        }
        const h16* cA = sA + cur * BM * LDT; const h16* cB = sB + cur * 128 * LDT;
#pragma unroll
        for (int ks = 0; ks < 2; ++ks) {
            h16x8 a[MT], b[4];
#pragma unroll
            for (int i = 0; i < MT; ++i) a[i] = *(const h16x8*)&cA[(wm * WM + i * 16 + (lane & 15)) * LDT + ks * 32 + (lane >> 4) * 8];
#pragma unroll
            for (int j = 0; j < 4; ++j) b[j] = *(const h16x8*)&cB[(wn * 64 + j * 16 + (lane & 15)) * LDT + ks * 32 + (lane >> 4) * 8];
#pragma unroll
            for (int i = 0; i < MT; ++i)
#pragma unroll
                for (int j = 0; j < 4; ++j) acc[i][j] = __builtin_amdgcn_mfma_f32_16x16x32_f16(b[j], a[i], acc[i][j], 0, 0, 0);
        }
        if (kt + 1 < nk) {
            h16* nA = sA + (cur ^ 1) * BM * LDT; h16* nB = sB + (cur ^ 1) * 128 * LDT;
#pragma unroll
            for (int i = 0; i < NA; ++i) *(uint4*)&nA[(lrow + i * 64) * LDT + lkc] = ra[i];
#pragma unroll
            for (int i = 0; i < 2; ++i) *(uint4*)&nB[(lrow + i * 64) * LDT + lkc] = rb[i];
        }
        __syncthreads();
    }
}
template <int BM> __device__ __forceinline__ void zero_acc(f32x4 (&acc)[BM / 64][4]) {
#pragma unroll
    for (int i = 0; i < BM / 64; ++i)
#pragma unroll
        for (int j = 0; j < 4; ++j) acc[i][j] = (f32x4){0.f, 0.f, 0.f, 0.f};
}
template <int BM, class EPI>
__device__ __forceinline__ void gemm_epi(const f32x4 (&acc)[BM / 64][4], const EPI& epi) {
    const int lane = otid() & 63, wave = otid() >> 6, wm = wave >> 1, wn = wave & 1;
#pragma unroll
    for (int i = 0; i < BM / 64; ++i)
#pragma unroll
        for (int j = 0; j < 4; ++j) epi(wm * (BM / 4) + i * 16 + (lane & 15), wn * 64 + j * 16 + 4 * (lane >> 4), acc[i][j]);
}
#define GEMM_LDS(BM) (2 * (BM) * LDT * 2 + 2 * 128 * LDT * 2)

__device__ __forceinline__ void ph_gemm1(CP p, int bid, int nblk, char* smem) {
    const int nu_main = 64 * 19, nu = nu_main + 64 * 2;
    for (int u = bid; u < nu; u += nblk) {
        f32x4 acc[4][4]; zero_acc<256>(acc);
        if (u < nu_main) {
            const int mt = u / 19, nt = u % 19, m0 = mt * 256, n0 = nt * 128;
            const h16* A = p.h_hi + (size_t)m0 * DM; const h16* B = p.Wp + (size_t)n0 * DM;
            gemm_kloop<256>(smem, DM, [=](int r, int k) { return A + (size_t)r * DM + k; }, [=](int r, int k) { return B + (size_t)r * DM + k; }, acc);
            h16* O = p.proj + (size_t)m0 * PJ + n0;
            gemm_epi<256>(acc, [=](int ml, int nl, f32x4 v) { *(h16x4*)(O + (size_t)ml * PJ + nl) = pack4(v[0], v[1], v[2], v[3]); });
        } else {
            const int uu = u - nu_main, mt = uu >> 1, nt = uu & 1, m0 = mt * 256, n0 = nt * 128;
            const h16* Ah = p.h_hi + (size_t)m0 * DM; const h16* Al = p.h_lo + (size_t)m0 * DM; const h16* B = p.Widx + (size_t)n0 * 3072;
            gemm_kloop<256>(smem, 3072, [=](int r, int k) { const h16* base = (k >= 1024 && k < 2048) ? Al : Ah; return base + (size_t)r * DM + (k & 1023); },
                            [=](int r, int k) { return B + (size_t)r * 3072 + k; }, acc);
            float* O = p.idxf + (size_t)m0 * IDXLD + n0;
            gemm_epi<256>(acc, [=](int ml, int nl, f32x4 v) { if (n0 + nl < IDXLD) *(f32x4*)(O + (size_t)ml * IDXLD + nl) = v; });
        }
    }
}

template <int PASS>
__device__ __forceinline__ void ph_s5_scan(CP p, int l, int bid, int nblk) {
    const int lane = otid() & 63, wv = otid() >> 6;
    for (int u = bid * 8 + wv; u < 4096; u += nblk * 8) {
        const int g = u & 15, c = (u >> 4) & 63, b = u >> 10;
        const int pidx = (l * 16 + g) * 64 + lane;
        const double lre = p.in[I_S5LRE][pidx], lim = p.in[I_S5LIM][pidx], st = exp((double)p.in[I_S5LS][l * 16 + g]);
        const double er = exp(lre * st); double sn, cs; sincos(lim * st, &sn, &cs);
        const double lbr = er * cs, lbi = er * sn;
        const double nr = lbr - 1.0, ni = lbi, den = lre * lre + lim * lim;
        const double fr = (nr * lre + ni * lim) / den, fi = (ni * lre - nr * lim) / den;
        float Br[16], Bi[16];
#pragma unroll
        for (int cc = 0; cc < 16; ++cc) { const double br = p.in[I_S5BRE][(size_t)pidx * 16 + cc], bi = p.in[I_S5BIM][(size_t)pidx * 16 + cc];
                                          Br[cc] = (float)(fr * br - fi * bi); Bi[cc] = (float)(fr * bi + fi * br); }
        const float lr = (float)lbr, li = (float)lbi;
        float hr = 0.f, hi = 0.f;
        float Cr[16], Ci[16];
        if (PASS == 3) {
#pragma unroll
            for (int cc = 0; cc < 16; ++cc) { Cr[cc] = p.in[I_S5CRE][((size_t)(l * 16 + g) * 16 + cc) * 64 + lane]; Ci[cc] = p.in[I_S5CIM][((size_t)(l * 16 + g) * 16 + cc) * 64 + lane]; }
            const size_t hix = ((((size_t)b * 64 + c) * 16 + g) * 64 + lane) * 2;
            hr = p.s5H[hix]; hi = p.s5H[hix + 1];
        }
        const int t0 = b * SEQ + c * 64;
        const int oidx = ((lane >> 5) & 1) * 8 + ((lane >> 4) & 1) * 4 + ((lane >> 3) & 1) * 2 + ((lane >> 2) & 1);
        const float dsk = p.in[I_S5D][l * 256 + g * 16 + oidx];
        for (int t = 0; t < 64; ++t) {
            const h16* up = p.proj + (size_t)(t0 + t) * PJ + P_U + g * 16;
            h16x8 u0 = *(const h16x8*)up, u1 = *(const h16x8*)(up + 8);
            float uu[16];
#pragma unroll
            for (int cc = 0; cc < 8; ++cc) { uu[cc] = (float)u0[cc]; uu[8 + cc] = (float)u1[cc]; }
            float br = 0.f, bi = 0.f;
#pragma unroll
            for (int cc = 0; cc < 16; ++cc) { br += Br[cc] * uu[cc]; bi += Bi[cc] * uu[cc]; }
            const float nhr = lr * hr - li * hi + br, nhi = lr * hi + li * hr + bi;
            hr = nhr; hi = nhi;
            if (PASS == 3) {
                float v[16];
#pragma unroll
                for (int cc = 0; cc < 16; ++cc) v[cc] = Cr[cc] * hr - Ci[cc] * hi;
                float v8[8], v4[4], v2[2], v1;
                const bool b5 = lane & 32, b4 = lane & 16, b3 = lane & 8, b2 = lane & 4;
#pragma unroll
                for (int i = 0; i < 8; ++i) { float snd = b5 ? v[i] : v[i + 8], keep = b5 ? v[i + 8] : v[i]; v8[i] = keep + __shfl_xor(snd, 32); }
#pragma unroll
                for (int i = 0; i < 4; ++i) { float snd = b4 ? v8[i] : v8[i + 4], keep = b4 ? v8[i + 4] : v8[i]; v4[i] = keep + __shfl_xor(snd, 16); }
#pragma unroll
                for (int i = 0; i < 2; ++i) { float snd = b3 ? v4[i] : v4[i + 2], keep = b3 ? v4[i + 2] : v4[i]; v2[i] = keep + __shfl_xor(snd, 8); }
                { float snd = b2 ? v2[0] : v2[1], keep = b2 ? v2[1] : v2[0]; v1 = keep + __shfl_xor(snd, 4); }
                v1 += __shfl_xor(v1, 2); v1 += __shfl_xor(v1, 1);
                if ((lane & 3) == 0) {
                    const float y = v1 + dsk * uu[oidx];
                    p.ybuf[(size_t)(t0 + t) * 256 + g * 16 + oidx] = (h16)gelu_tanh(y);
                }
            }
        }
        if (PASS == 1) { const size_t eix = ((((size_t)b * 64 + c) * 16 + g) * 64 + lane) * 2; p.s5E[eix] = hr; p.s5E[eix + 1] = hi; }
    }
}
__device__ __forceinline__ void ph_s5_carry(CP p, int l, int bid, int nblk) {
    if (bid >= 8) return;
    const int gid = bid * 512 + otid();
    const int pp = gid & 63, g = (gid >> 6) & 15, b = gid >> 10;
    const int pidx = (l * 16 + g) * 64 + pp;
    const double lre = p.in[I_S5LRE][pidx], lim = p.in[I_S5LIM][pidx], st = exp((double)p.in[I_S5LS][l * 16 + g]);
    const double er = exp(64.0 * lre * st); double sn, cs; sincos(64.0 * lim * st, &sn, &cs);
    const float ar = (float)(er * cs), ai = (float)(er * sn);
    float hr = 0.f, hi = 0.f;
    for (int c = 0; c < 64; ++c) {
        const size_t ix = ((((size_t)b * 64 + c) * 16 + g) * 64 + pp) * 2;
        p.s5H[ix] = hr; p.s5H[ix + 1] = hi;
        const float er_ = p.s5E[ix], ei_ = p.s5E[ix + 1];
        const float nr = ar * hr - ai * hi + er_, ni = ar * hi + ai * hr + ei_;
        hr = nr; hi = ni;
    }
}
__device__ __forceinline__ void ph_s5_glu(CP p, int l, int bid, int nblk, char* smem) {
    for (int u = bid; u < 128; u += nblk) {
        const int mt = u >> 1, nt = u & 1, m0 = mt * 256, n0 = nt * 128;
        f32x4 acc[4][4]; zero_acc<256>(acc);
        const h16* A = p.ybuf + (size_t)m0 * 256; const h16* B = p.Wglu + (size_t)n0 * 256;
        gemm_kloop<256>(smem, 256, [=](int r, int k) { return A + (size_t)r * 256 + k; }, [=](int r, int k) { return B + (size_t)r * 256 + k; }, acc);
        const float* gb = p.in[I_S5GB] + l * 256 + n0;
        const h16* Y = p.ybuf + (size_t)m0 * 256 + n0; h16* O = p.branches + (size_t)m0 * DM + n0;
        gemm_epi<256>(acc, [=](int ml, int nl, f32x4 v) {
            h16x4 y = *(const h16x4*)(Y + (size_t)ml * 256 + nl); f32x4 bb = *(const f32x4*)(gb + nl);
            *(h16x4*)(O + (size_t)ml * DM + nl) = pack4((float)y[0] * sigm(v[0] + bb[0]), (float)y[1] * sigm(v[1] + bb[1]), (float)y[2] * sigm(v[2] + bb[2]), (float)y[3] * sigm(v[3] + bb[3])); });
    }
}

__device__ __forceinline__ void ph_rg_a(CP p, int l, int bid, int nblk, char* smem) {
    float* xc = (float*)smem;
    float* aa = xc + 32 * 256;
    float* bx = aa + 32 * 256;
    const int tid = otid();
    for (int u = bid; u < 512; u += nblk) {
        const int b = u >> 7, c = u & 127, t0 = c * 32;
        __syncthreads();
        {
            const int ch = tid & 255;
            const float w0 = p.in[I_RGCW][(l * 4 + 0) * 256 + ch], w1 = p.in[I_RGCW][(l * 4 + 1) * 256 + ch], w2 = p.in[I_RGCW][(l * 4 + 2) * 256 + ch], w3 = p.in[I_RGCW][(l * 4 + 3) * 256 + ch];
            const float cb = p.in[I_RGCB][l * 256 + ch];
            for (int t = tid >> 8; t < 32; t += 2) {
                const int tt = t0 + t;
                const h16* xp = p.proj + (size_t)(b * SEQ + tt) * PJ + P_RGX + ch;
                float s = cb + w3 * (float)xp[0];
                if (tt >= 1) s += w2 * (float)xp[-(long)PJ];
                if (tt >= 2) s += w1 * (float)xp[-2 * (long)PJ];
                if (tt >= 3) s += w0 * (float)xp[-3 * (long)PJ];
                xc[t * 256 + ch] = s;
            }
        }
        __syncthreads();
        const int ch = tid & 255, half = tid >> 8, blk = ch >> 6, d = ch & 63;
        const float* wr = p.in[I_RGWR] + ((size_t)(l * 4 + blk) * 64) * 64 + d;
        const float* wi = p.in[I_RGWI] + ((size_t)(l * 4 + blk) * 64) * 64 + d;
        const float br = p.in[I_RGBR][l * 256 + ch], bi = p.in[I_RGBI][l * 256 + ch];
        const float spl = softplusf_(-p.in[I_RGLAM][l * 256 + ch]);
#pragma unroll 1
        for (int grp = 0; grp < 2; ++grp) {
            float ar[8], ai[8];
#pragma unroll
            for (int q = 0; q < 8; ++q) { ar[q] = br; ai[q] = bi; }
            const int tb = half * 16 + grp * 8;
            for (int cc = 0; cc < 64; ++cc) {
                const float wrv = wr[cc * 64], wiv = wi[cc * 64];
#pragma unroll
                for (int q = 0; q < 8; ++q) { const float xv = xc[(tb + q) * 256 + blk * 64 + cc]; ar[q] += xv * wrv; ai[q] += xv * wiv; }
            }
#pragma unroll
            for (int q = 0; q < 8; ++q) {
                const float r = sigm(ar[q]), ig = sigm(ai[q]);
                const float la = -8.f * r * spl;
                const float a = __expf(la), mult = sqrtf(-expm1f(2.f * la));
                aa[(tb + q) * 256 + ch] = a; bx[(tb + q) * 256 + ch] = mult * ig * xc[(tb + q) * 256 + ch];
            }
        }
        __syncthreads();
        if (tid < 256) {
            float h = 0.f, cp = 1.f;
            float* hl = p.rg_hl + (size_t)(b * SEQ + t0) * 256 + ch; float* cpo = p.rg_cp + (size_t)(b * SEQ + t0) * 256 + ch;
            for (int t = 0; t < 32; ++t) { const float a = aa[t * 256 + ch]; h = a * h + bx[t * 256 + ch]; cp *= a; hl[(size_t)t * 256] = h; cpo[(size_t)t * 256] = cp; }
            p.rg_agg[((size_t)(b * 128 + c) * 256 + ch) * 2] = cp; p.rg_agg[((size_t)(b * 128 + c) * 256 + ch) * 2 + 1] = h;
        }
    }
}
__device__ __forceinline__ void ph_rg_c(CP p, int l, int bid, int nblk, char* smem) {
    float* carry = (float*)smem;
    const int tid = otid();
    for (int u = bid; u < 512; u += nblk) {
        const int b = u >> 7, c = u & 127, t0 = c * 32;
        __syncthreads();
        if (tid < 256) { float h = 0.f; for (int cc = 0; cc < c; ++cc) { const float* ag = p.rg_agg + ((size_t)(b * 128 + cc) * 256 + tid) * 2; h = ag[0] * h + ag[1]; } carry[tid] = h; }
        __syncthreads();
        const int ch = tid & 255;
        for (int t = tid >> 8; t < 32; t += 2) {
            const size_t tok = (size_t)b * SEQ + t0 + t;
            const float h = p.rg_hl[tok * 256 + ch] + p.rg_cp[tok * 256 + ch] * carry[ch];
            const float gt = (float)p.proj[tok * PJ + P_RGG + ch];
            p.branches[tok * DM + 512 + ch] = (h16)(h * gelu_tanh(gt));
        }
    }
}

__device__ __forceinline__ void ph_rw_prep(CP p, int l, int bid, int nblk, char* smem) {
    h16* wup = (h16*)smem;
    h16* aup = wup + 32 * 256;
    h16* gup = aup + 32 * 256;
    float* f = (float*)(gup + 64 * 256);
    const int tid = otid(), lane = tid & 63;
    for (int i = tid; i < 32 * 256; i += 512) { wup[i] = (h16)p.in[I_RWWUP][(size_t)l * 32 * 256 + i]; aup[i] = (h16)p.in[I_RWAUP][(size_t)l * 32 * 256 + i]; }
    for (int i = tid; i < 64 * 256; i += 512) gup[i] = (h16)p.in[I_RWGUP][(size_t)l * 64 * 256 + i];
    const float* mu = p.in[I_RWMU] + l * 896;
    const int ch = tid & 255, tg = tid >> 8;
    const float w0 = p.in[I_RWW0][l * 256 + ch], a0 = p.in[I_RWA0][l * 256 + ch], kkw = p.in[I_RWKK][l * 256 + ch], kaw = p.in[I_RWKA][l * 256 + ch];
    const float rk = p.in[I_RWRK][l * 256 + ch];
    __syncthreads();
    for (int u = bid; u < NTOK / 16; u += nblk) {
        const int tok0 = u * 16;
        __syncthreads();
        for (int i = tid; i < 16 * 896; i += 512) {
            const int t = i / 896, cidx = i % 896; const int tok = tok0 + t;
            const float cur = (float)p.proj[(size_t)tok * PJ + P_RW + cidx];
            const float prv = (tok % SEQ) ? (float)p.proj[(size_t)(tok - 1) * PJ + P_RW + cidx] : 0.f;
            float v = cur + (prv - cur) * mu[cidx];
            if (cidx >= 768 && cidx < 800) v = tanhf(v);
            if (cidx >= 832) v = sigm(v);
            f[i] = v;
        }
        __syncthreads();
        for (int q = 0; q < 8; ++q) {
            const int t = tg * 8 + q; const int tok = tok0 + t;
            const float* ft = f + t * 896;
            float lw = 0.f, la = 0.f, lg = 0.f;
#pragma unroll 8
            for (int j = 0; j < 32; ++j) { lw += ft[768 + j] * (float)wup[j * 256 + ch]; la += ft[800 + j] * (float)aup[j * 256 + ch]; }
#pragma unroll 8
            for (int j = 0; j < 64; ++j) lg += ft[832 + j] * (float)gup[j * 256 + ch];
            const float w = -softplusf_(-(w0 + lw)) - 0.5f;
            const float wl = -__expf(w);
            const float a = sigm(a0 + la);
            const float r = ft[ch], k = ft[256 + ch], v = ft[512 + ch];
            float kk = k * kkw;
            const float nrm = sqrtf(wave_sum(kk * kk));
            kk = kk / fmaxf(nrm, 1e-12f);
            const float k2 = k * (1.f + (a - 1.f) * kaw);
            const float sb = wave_sum(r * k2 * rk);
            const size_t o = (size_t)tok * 256 + ch;
            p.rw_r[o] = (h16)r; p.rw_w[o] = (h16)wl; p.rw_k[o] = (h16)k2; p.rw_kk[o] = (h16)kk; p.rw_b[o] = (h16)(kk * a);
            p.rw_g[o] = (h16)lg; p.rw_bonus[o] = (h16)(sb * v); p.rw_v[o] = (h16)v;
        }
    }
}
__device__ __forceinline__ void ph_rw_scan(CP p, int bid, char* smem) {
    if (bid >= 16 || otid() >= 64) return;
    float (*sv)[64] = (float (*)[64])smem;
    const int b = bid >> 2, h = bid & 3, lane = otid();
    float S[64];
#pragma unroll
    for (int k = 0; k < 64; ++k) S[k] = 0.f;
    for (int t = 0; t < SEQ; ++t) {
        const size_t tok = (size_t)b * SEQ + t; const size_t o = tok * 256 + h * 64 + lane;
        const float vv = (float)p.rw_v[o];
        sv[0][lane] = (float)p.rw_r[o]; sv[1][lane] = __expf((float)p.rw_w[o]); sv[2][lane] = (float)p.rw_k[o]; sv[3][lane] = (float)p.rw_kk[o]; sv[4][lane] = (float)p.rw_b[o];
        __builtin_amdgcn_s_waitcnt(0); __builtin_amdgcn_wave_barrier();
        float skk = 0.f;
#pragma unroll
        for (int k = 0; k < 64; ++k) skk += S[k] * sv[3][k];
        float y = 0.f;
#pragma unroll
        for (int k = 0; k < 64; ++k) { S[k] = S[k] * sv[1][k] - skk * sv[4][k] + vv * sv[2][k]; y += S[k] * sv[0][k]; }
        p.rw_y[o] = y;
        __builtin_amdgcn_s_waitcnt(0); __builtin_amdgcn_wave_barrier();
    }
}
__device__ __forceinline__ void ph_rw_post(CP p, int l, int bid, int nblk) {
    const int lane = otid() & 63, wv = otid() >> 6;
    for (int u = bid * 8 + wv; u < NTOK * 4; u += nblk * 8) {
        const int tok = u >> 2, h = u & 3; const size_t o = (size_t)tok * 256 + h * 64 + lane;
        const float y = p.rw_y[o];
        const float mean = wave_sum(y) * (1.f / 64.f);
        const float dv = y - mean;
        const float var = wave_sum(dv * dv) * (1.f / 64.f);
        float v = dv * rsqrtf(var + 64e-5f) * p.in[I_RWGNW][l * 256 + h * 64 + lane] + p.in[I_RWGNB][l * 256 + h * 64 + lane];
        v += (float)p.rw_bonus[o];
        p.branches[(size_t)tok * DM + 768 + h * 64 + lane] = (h16)(v * (float)p.rw_g[o]);
    }
}

__device__ __forceinline__ void ph_dsa_pre(CP p, int bid, int nblk) {
    const int lane = otid() & 63, wv = otid() >> 6;
    for (int tok = bid * 8 + wv; tok < NTOK; tok += nblk * 8) {
        const double pos = (double)p.pos[tok];
        const int i = lane & 31;
        double ang = pos * exp(-(double)i * (1.0 / 32.0) * 9.210340371976184);
        double sn, cs; sincos(ang, &sn, &cs);
        const float c = (float)cs, s = (float)sn;
        const int base = (lane < 32) ? P_Q : P_K;
        h16* dst = p.proj + (size_t)tok * PJ + base;
        const float scl = (lane < 32) ? 0.125f : 1.f;
#pragma unroll
        for (int h = 0; h < 4; ++h) {
            const float x1 = (float)dst[h * 64 + i], x2 = (float)dst[h * 64 + 32 + i];
            dst[h * 64 + i] = (h16)((x1 * c - x2 * s) * scl);
            dst[h * 64 + 32 + i] = (h16)((x2 * c + x1 * s) * scl);
        }
        const int i2 = lane & 15;
        double ang2 = pos * exp(-(double)i2 * (1.0 / 16.0) * 9.210340371976184);
        double sn2, cs2; sincos(ang2, &sn2, &cs2);
        const float c2 = (float)cs2, s2 = (float)sn2;
        float* xf = p.idxf + (size_t)tok * IDXLD;
        if (lane < 16) {
#pragma unroll
            for (int h = 0; h < 4; ++h) {
                const float x1 = xf[h * 32 + i2], x2 = xf[h * 32 + 16 + i2];
                xf[h * 32 + i2] = x1 * c2 - x2 * s2;
                xf[h * 32 + 16 + i2] = x2 * c2 + x1 * s2;
            }
        } else if (lane < 32) {
            const float x1 = xf[128 + i2], x2 = xf[128 + 16 + i2];
            xf[128 + i2] = x1 * c2 - x2 * s2;
            xf[128 + 16 + i2] = x2 * c2 + x1 * s2;
        }
    }
}
__device__ __forceinline__ unsigned f2key(float x) { unsigned u = __float_as_uint(x); return (u & 0x80000000u) ? ~u : (u | 0x80000000u); }
__device__ __forceinline__ void ph_dsa_naive(CP p, int bid, int nblk, char* smem) {
    const int lane = otid() & 63, wv = otid() >> 6;
    unsigned* s_key = (unsigned*)smem + wv * 4096;
    float* s_p = (float*)s_key;
    float* s_iq = (float*)(smem + 8 * 4096 * 4) + wv * 128;
    float* s_q = (float*)(smem + 8 * 4096 * 4 + 8 * 128 * 4) + wv * 256;
    int* s_list = (int*)(smem + 8 * 4096 * 4 + 8 * 128 * 4 + 8 * 256 * 4) + wv * 256;
    const unsigned long long lt_mask = (lane == 0) ? 0ull : (~0ull >> (64 - lane));
    for (int tok = bid * 8 + wv; tok < NTOK; tok += nblk * 8) {
        const int b = tok / SEQ, t = tok % SEQ;
        s_iq[lane] = p.idxf[(size_t)tok * IDXLD + lane]; s_iq[64 + lane] = p.idxf[(size_t)tok * IDXLD + 64 + lane];
        for (int i = 0; i < 4; ++i) s_q[i * 64 + lane] = (float)p.proj[(size_t)tok * PJ + P_Q + i * 64 + lane];
        const float w0 = p.idxf[(size_t)tok * IDXLD + 160], w1 = p.idxf[(size_t)tok * IDXLD + 161], w2 = p.idxf[(size_t)tok * IDXLD + 162], w3 = p.idxf[(size_t)tok * IDXLD + 163];
        __builtin_amdgcn_s_waitcnt(0); __builtin_amdgcn_wave_barrier();
        const int n = t + 1;
        const int nch = (t >> 6) + 1;
#pragma unroll 1
        for (int i = 0; i < nch; ++i) {
            const int s = lane + 64 * i;
            unsigned kv_ = 0u;
            if (s <= t) {
                const float* kp = p.idxf + ((size_t)b * SEQ + s) * IDXLD + 128;
                float d0 = 0.f, d1 = 0.f, d2 = 0.f, d3 = 0.f;
#pragma unroll
                for (int d4 = 0; d4 < 8; ++d4) {
                    const f32x4 kv = *(const f32x4*)(kp + d4 * 4);
#pragma unroll
                    for (int e = 0; e < 4; ++e) { const int d = d4 * 4 + e; d0 += s_iq[d] * kv[e]; d1 += s_iq[32 + d] * kv[e]; d2 += s_iq[64 + d] * kv[e]; d3 += s_iq[96 + d] * kv[e]; }
                }
                const float sc = w0 * fmaxf(d0, 0.f) + w1 * fmaxf(d1, 0.f) + w2 * fmaxf(d2, 0.f) + w3 * fmaxf(d3, 0.f);
                kv_ = f2key(sc + 0.f);
            }
            s_key[s] = kv_;
        }
        __builtin_amdgcn_s_waitcnt(0); __builtin_amdgcn_wave_barrier();
        int cnt_sel;
        if (n <= 256) {
            for (int i = 0; i < 4; ++i) { const int s = lane + 64 * i; if (s <= t) s_list[s] = s; }
            cnt_sel = n;
        } else {
            unsigned v = 0u;
#pragma unroll 1
            for (int bit = 31; bit >= 0; --bit) {
                const unsigned cand = v | (1u << bit);
                int c = 0;
#pragma unroll 4
                for (int i = 0; i < nch; ++i) c += __popcll(__ballot(s_key[lane + 64 * i] >= cand));
                if (c >= 256) v = cand;
            }
            int cgt = 0;
#pragma unroll 4
            for (int i = 0; i < nch; ++i) cgt += __popcll(__ballot(s_key[lane + 64 * i] > v));
            const int need = 256 - cgt;
            int nsel = 0, nties = 0;
#pragma unroll 1
            for (int i = 0; i < nch; ++i) {
                const unsigned kx = s_key[lane + 64 * i];
                const bool gt = kx > v, eq = kx == v;
                const unsigned long long eqm = __ballot(eq);
                const int trank = nties + __popcll(eqm & lt_mask);
                const bool sel = gt || (eq && trank < need);
                const unsigned long long sm = __ballot(sel);
                if (sel) s_list[nsel + __popcll(sm & lt_mask)] = lane + 64 * i;
                nsel += __popcll(sm); nties += __popcll(eqm);
            }
            cnt_sel = nsel;
        }
        __builtin_amdgcn_s_waitcnt(0); __builtin_amdgcn_wave_barrier();
        float lg[4][4];
#pragma unroll
        for (int jj = 0; jj < 4; ++jj) {
            const int j = lane + 64 * jj;
#pragma unroll
            for (int h = 0; h < 4; ++h) lg[jj][h] = -INFINITY;
            if (j < cnt_sel) {
                const int s = s_list[j];
                const h16* kp = p.proj + ((size_t)b * SEQ + s) * PJ + P_K;
#pragma unroll
                for (int h = 0; h < 4; ++h) {
                    float a = 0.f;
#pragma unroll
                    for (int d8 = 0; d8 < 8; ++d8) { const h16x8 kv = *(const h16x8*)(kp + h * 64 + d8 * 8);
#pragma unroll
                        for (int e = 0; e < 8; ++e) a += s_q[h * 64 + d8 * 8 + e] * (float)kv[e]; }
                    lg[jj][h] = a;
                }
            }
        }
        float inv[4];
#pragma unroll
        for (int h = 0; h < 4; ++h) {
            float m = fmaxf(fmaxf(lg[0][h], lg[1][h]), fmaxf(lg[2][h], lg[3][h]));
            m = wave_max(m);
            float sm = 0.f;
#pragma unroll
            for (int jj = 0; jj < 4; ++jj) { const float e = (lane + 64 * jj < cnt_sel) ? __expf(lg[jj][h] - m) : 0.f; s_p[h * 256 + lane + 64 * jj] = e; sm += e; }
            sm = wave_sum(sm);
            inv[h] = 1.f / sm;
        }
        __builtin_amdgcn_s_waitcnt(0); __builtin_amdgcn_wave_barrier();
        const int hh = lane >> 4;
        float o0 = 0.f, o1 = 0.f, o2 = 0.f, o3 = 0.f;
#pragma unroll 4
        for (int j = 0; j < cnt_sel; ++j) {
            const int s = s_list[j]; const float pj = s_p[hh * 256 + j];
            const h16x4 vv = *(const h16x4*)(p.proj + ((size_t)b * SEQ + s) * PJ + P_V + lane * 4);
            o0 += pj * (float)vv[0]; o1 += pj * (float)vv[1]; o2 += pj * (float)vv[2]; o3 += pj * (float)vv[3];
        }
        const float iv = (hh == 0) ? inv[0] : (hh == 1) ? inv[1] : (hh == 2) ? inv[2] : inv[3];
        *(h16x4*)(p.branches + (size_t)tok * DM + 256 + lane * 4) = pack4(o0 * iv, o1 * iv, o2 * iv, o3 * iv);
        __builtin_amdgcn_s_waitcnt(0); __builtin_amdgcn_wave_barrier();
    }
}
#define DSA_NAIVE_LDS (8 * 4096 * 4 + 8 * 128 * 4 + 8 * 256 * 4 + 8 * 256 * 4)

__device__ __forceinline__ void ph_merge(CP p, int l, int bid, int nblk, char* smem) {
    for (int u = bid; u < 128 * 8; u += nblk) {
        const int mt = u >> 3, nt = u & 7, m0 = mt * 128, n0 = nt * 128;
        f32x4 mx[2][4]; zero_acc<128>(mx);
        const int lane = otid() & 63, wave = otid() >> 6, wn = wave & 1;
        for (int n = 0; n < 4; ++n) {
            f32x4 ag[2][4], au[2][4]; zero_acc<128>(ag); zero_acc<128>(au);
            const h16* A = p.h_hi + (size_t)m0 * DM; const h16* B = p.Wg + ((size_t)n * 1024 + n0) * DM;
            gemm_kloop<128>(smem, DM, [=](int r, int k) { return A + (size_t)r * DM + k; }, [=](int r, int k) { return B + (size_t)r * DM + k; }, ag);
            const h16* A2 = p.branches + (size_t)m0 * DM + n * 256; const h16* B2 = p.Wb + ((size_t)n * 1024 + n0) * 256;
            gemm_kloop<128>(smem, 256, [=](int r, int k) { return A2 + (size_t)r * DM + k; }, [=](int r, int k) { return B2 + (size_t)r * 256 + k; }, au);
            const float* gb = p.in[I_GATEB] + (size_t)l * 4096 + n * 1024 + n0 + wn * 64 + 4 * (lane >> 4);
#pragma unroll
            for (int j = 0; j < 4; ++j) {
                const f32x4 bb = *(const f32x4*)(gb + j * 16);
#pragma unroll
                for (int i = 0; i < 2; ++i)
#pragma unroll
                    for (int e = 0; e < 4; ++e) mx[i][j][e] += sigm(ag[i][j][e] + bb[e]) * au[i][j][e];
            }
        }
        h16* O = p.mixed + (size_t)m0 * DM + n0;
        gemm_epi<128>(mx, [=](int ml, int nl, f32x4 v) { *(h16x4*)(O + (size_t)ml * DM + nl) = pack4(v[0], v[1], v[2], v[3]); });
    }
}
__device__ __forceinline__ void ph_outproj(CP p, int l, int bid, int nblk, char* smem) {
    const float* xin = l == 0 ? p.in[I_X] : p.x1;
    for (int u = bid; u < 64 * 8; u += nblk) {
        const int mt = u >> 3, nt = u & 7, m0 = mt * 256, n0 = nt * 128;
        f32x4 acc[4][4]; zero_acc<256>(acc);
        const h16* A = p.mixed + (size_t)m0 * DM; const h16* B = p.Wo + (size_t)n0 * DM;
        gemm_kloop<256>(smem, DM, [=](int r, int k) { return A + (size_t)r * DM + k; }, [=](int r, int k) { return B + (size_t)r * DM + k; }, acc);
        const float* g1 = p.mods + ((size_t)l * 4 + (m0 / SEQ)) * 6144 + 2 * 1024 + n0;
        const float* X = xin + (size_t)m0 * DM + n0; float* O = p.x1 + (size_t)m0 * DM + n0;
        gemm_epi<256>(acc, [=](int ml, int nl, f32x4 v) { const f32x4 xv = *(const f32x4*)(X + (size_t)ml * DM + nl), gg = *(const f32x4*)(g1 + nl);
                                                          *(f32x4*)(O + (size_t)ml * DM + nl) = xv + gg * v; });
    }
}

__constant__ int c_pair_lo[6] = {0, 0, 0, 1, 1, 2};
__constant__ int c_pair_hi[6] = {1, 2, 3, 2, 3, 3};
__device__ __forceinline__ void ph_norm2_router(CP p, int l, int bid, int nblk, char* smem) {
    float* rw = (float*)smem;
    for (int i = otid(); i < DM * 16; i += 512) rw[i] = p.in[I_ROUTW][i];
    __syncthreads();
    const int lane = otid() & 63, wv = otid() >> 6;
    for (int tok = bid * 8 + wv; tok < NTOK; tok += nblk * 8) {
        const int b = tok / SEQ;
        const float* xr = p.x1 + (size_t)tok * DM;
        f32x4 v[4]; float ss = 0.f;
#pragma unroll
        for (int i = 0; i < 4; ++i) { v[i] = *(const f32x4*)(xr + i * 256 + lane * 4); ss += v[i][0] * v[i][0] + v[i][1] * v[i][1] + v[i][2] * v[i][2] + v[i][3] * v[i][3]; }
        ss = wave_sum(ss);
        const float rs = rsqrtf(ss * (1.f / DM) + 1e-6f);
        const float* g = p.in[I_FNG] + l * DM;
        const float* md = p.mods + ((size_t)l * 4 + b) * 6144;
        float lg[16];
#pragma unroll
        for (int e = 0; e < 16; ++e) lg[e] = 0.f;
#pragma unroll 1
        for (int i = 0; i < 4; ++i) {
            const int c = i * 256 + lane * 4;
            f32x4 gg = *(const f32x4*)(g + c), sh = *(const f32x4*)(md + 3 * 1024 + c), sc = *(const f32x4*)(md + 4 * 1024 + c);
            float hv[4];
#pragma unroll
            for (int e = 0; e < 4; ++e) hv[e] = v[i][e] * rs * gg[e] * (1.f + sc[e]) + sh[e];
            *(h16x4*)(p.h_hi + (size_t)tok * DM + c) = pack4(hv[0], hv[1], hv[2], hv[3]);
#pragma unroll 1
            for (int e = 0; e < 4; ++e) {
                const float* rr = rw + (c + e) * 16;
                const float hve = e == 0 ? hv[0] : e == 1 ? hv[1] : e == 2 ? hv[2] : hv[3];
#pragma unroll
                for (int x4 = 0; x4 < 4; ++x4) { const f32x4 r4 = *(const f32x4*)(rr + x4 * 4); lg[x4 * 4] += hve * r4[0]; lg[x4 * 4 + 1] += hve * r4[1]; lg[x4 * 4 + 2] += hve * r4[2]; lg[x4 * 4 + 3] += hve * r4[3]; }
            }
        }
#pragma unroll
        for (int e = 0; e < 16; ++e) lg[e] = wave_sum(lg[e]);
        if (lane == 0) {
            float sc[16], bi[16];
#pragma unroll
            for (int e = 0; e < 16; ++e) { sc[e] = 1.f / (1.f + expf(-lg[e])); bi[e] = sc[e] + p.in[I_ROUTB][e]; }
            int bg = 0; float bgs = -INFINITY;
#pragma unroll
            for (int gI = 0; gI < 4; ++gI) {
                float m1 = -INFINITY, m2 = -INFINITY;
#pragma unroll
                for (int j = 0; j < 4; ++j) { const float x = bi[gI * 4 + j]; if (x > m1) { m2 = m1; m1 = x; } else if (x > m2) m2 = x; }
                const float gs = m1 + m2;
                if (gs > bgs) { bgs = gs; bg = gI; }
            }
            int e0 = 0; float b0 = -INFINITY;
#pragma unroll
            for (int j = 0; j < 4; ++j) { float x = -INFINITY;
#pragma unroll
                for (int gI = 0; gI < 4; ++gI) if (gI == bg) x = bi[gI * 4 + j];
                if (x > b0) { b0 = x; e0 = j; } }
            int e1 = 0; float b1 = -INFINITY;
#pragma unroll
            for (int j = 0; j < 4; ++j) { float x = -INFINITY;
#pragma unroll
                for (int gI = 0; gI < 4; ++gI) if (gI == bg) x = bi[gI * 4 + j];
                if (j != e0 && x > b1) { b1 = x; e1 = j; } }
            float s0 = 0.f, s1 = 0.f;
#pragma unroll
            for (int e = 0; e < 16; ++e) { if (e == bg * 4 + e0) s0 = sc[e]; if (e == bg * 4 + e1) s1 = sc[e]; }
            const float wsum = s0 + s1; const float wa = s0 / wsum, wb = s1 / wsum;
            const int lo = e0 < e1 ? e0 : e1, hi = e0 < e1 ? e1 : e0;
            const float clo = e0 < e1 ? wa : wb, chi = e0 < e1 ? wb : wa;
            int pr = 0;
#pragma unroll
            for (int q = 0; q < 6; ++q) if (c_pair_lo[q] == lo && c_pair_hi[q] == hi) pr = q;
            const int bucket = bg * 6 + pr;
            const int pos = atomicAdd(&p.bcnt[bucket], 1);
            p.lists[(size_t)bucket * LCAP + pos] = tok;
            p.cw[(size_t)tok * 2] = clo; p.cw[(size_t)tok * 2 + 1] = chi;
        }
    }
}

struct MoeTile { int bucket, i0, cnt, ea, eb; };
__device__ __forceinline__ bool moe_tile(const int* bcnt, int mt, MoeTile& o) {
    int acc = 0;
    for (int b = 0; b < 24; ++b) {
        const int c = bcnt[b]; const int nt = (c + 127) >> 7;
        if (mt < acc + nt) { o.bucket = b; o.i0 = (mt - acc) * 128; o.cnt = c; const int g = b / 6, pr = b % 6; o.ea = g * 4 + c_pair_lo[pr]; o.eb = g * 4 + c_pair_hi[pr]; return true; }
        acc += nt;
    }
    return false;
}
#define MOE_MAXT 152
__device__ __forceinline__ void ph_moe1(CP p, int bid, int nblk, char* smem) {
    for (int u = bid; u < MOE_MAXT * 16; u += nblk) {
        const int mt = u >> 4, nt = u & 15;
        MoeTile T; if (!moe_tile(p.bcnt, mt, T)) break;
        const int* lst = p.lists + (size_t)T.bucket * LCAP; const int i0 = T.i0, cnt = T.cnt;
        const h16* H = p.h_hi;
        const int second = nt >= 8;
        const h16* B = p.We13 + ((size_t)(second ? T.eb : T.ea) * 1024 + (nt & 7) * 128) * DM;
        f32x4 acc[2][4]; zero_acc<128>(acc);
        gemm_kloop<128>(smem, DM, [=](int r, int k) { const int i = i0 + r; const int tok = lst[i < cnt ? i : 0]; return H + (size_t)tok * DM + k; },
                        [=](int r, int k) { return B + (size_t)r * DM + k; }, acc);
        const int lane = otid() & 63, wave = otid() >> 6, wm = wave >> 1, wn = wave & 1;
#pragma unroll
        for (int i = 0; i < 2; ++i) {
            const int ml = wm * 32 + i * 16 + (lane & 15);
            const int ii = i0 + ml; const bool valid = ii < cnt;
            const float cwv = valid ? p.cw[(size_t)lst[ii] * 2 + second] : 0.f;
            h16* O = p.act + ((size_t)mt * 128 + ml) * 1024 + second * 512;
#pragma unroll
            for (int jj = 0; jj < 2; ++jj) {
                const f32x4 a = acc[i][2 * jj], bq = acc[i][2 * jj + 1];
                const int col = ((nt & 7) * 128 + wn * 64 + jj * 32) / 2 + 4 * (lane >> 4);
                float o[4];
#pragma unroll
                for (int e = 0; e < 4; ++e) o[e] = valid ? cwv * (a[e] * sigm(a[e])) * bq[e] : 0.f;
                *(h16x4*)(O + col) = pack4(o[0], o[1], o[2], o[3]);
            }
        }
    }
}
__device__ __forceinline__ void ph_moe2(CP p, int l, int bid, int nblk, char* smem) {
    for (int u = bid; u < MOE_MAXT * 8; u += nblk) {
        const int mt = u >> 3, nt = u & 7, n0 = nt * 128;
        MoeTile T; if (!moe_tile(p.bcnt, mt, T)) break;
        const int* lst = p.lists + (size_t)T.bucket * LCAP; const int i0 = T.i0, cnt = T.cnt;
        const h16* A = p.act + (size_t)mt * 128 * 1024;
        const h16* Ba = p.We2 + ((size_t)T.ea * 1024 + n0) * 512; const h16* Bb = p.We2 + ((size_t)T.eb * 1024 + n0) * 512;
        f32x4 acc[2][4]; zero_acc<128>(acc);
        gemm_kloop<128>(smem, 1024, [=](int r, int k) { return A + (size_t)r * 1024 + k; },
                        [=](int r, int k) { return (k < 512 ? Ba + k : Bb + (k - 512)) + (size_t)r * 512; }, acc);
        const float* md = p.mods + (size_t)l * 4 * 6144 + 5 * 1024 + n0;
        float* X = p.x1;
        gemm_epi<128>(acc, [=](int ml, int nl, f32x4 v) { const int ii = i0 + ml; if (ii < cnt) { const int tok = lst[ii]; const f32x4 gg = *(const f32x4*)(md + (size_t)(tok / SEQ) * 6144 + nl);
                                                          float* xp = X + (size_t)tok * DM + n0 + nl; *(f32x4*)xp = *(const f32x4*)xp + gg * v; } });
    }
}
__device__ __forceinline__ void ph_final(CP p, int bid, int nblk) {
    const int lane = otid() & 63, wv = otid() >> 6;
    for (int tok = bid * 8 + wv; tok < NTOK; tok += nblk * 8) {
        const float* xr = p.x1 + (size_t)tok * DM;
        f32x4 v[4]; float ss = 0.f;
#pragma unroll
        for (int i = 0; i < 4; ++i) { v[i] = *(const f32x4*)(xr + i * 256 + lane * 4); ss += v[i][0] * v[i][0] + v[i][1] * v[i][1] + v[i][2] * v[i][2] + v[i][3] * v[i][3]; }
        ss = wave_sum(ss);
        const float rs = rsqrtf(ss * (1.f / DM) + 1e-6f);
#pragma unroll
        for (int i = 0; i < 4; ++i) { const int c = i * 256 + lane * 4; const f32x4 gg = *(const f32x4*)(p.in[I_FINALG] + c); *(f32x4*)(p.out + (size_t)tok * DM + c) = v[i] * rs * gg; }
    }
}

#define XB_TMO      128
#define XB_XCNT(j)  (256  + 64 * (j))
#define XB_XSUB(j)  (1280 + 64 * (j))
#define XB_XGEN(j)  (2304 + 64 * (j))
#define XB_TOP      3328
#define XB_TOPGEN   3392
#define XCD_BAR_WORDS 3456
#define XB_SPIN_CAP (1u << 24)
#define LAS __attribute__((address_space(3)))

__device__ __forceinline__ unsigned xb_ld(unsigned* p)              { return __hip_atomic_load(p, __ATOMIC_RELAXED, __HIP_MEMORY_SCOPE_AGENT); }
__device__ __forceinline__ unsigned xb_add(unsigned* p, unsigned v) { return __hip_atomic_fetch_add(p, v, __ATOMIC_RELAXED, __HIP_MEMORY_SCOPE_AGENT); }
__device__ __forceinline__ unsigned xb_xcc_id() { return (unsigned)__builtin_amdgcn_s_getreg((3 << 11) | 20) & 0xFu; }
#define XB_SPIN(cond, bar) do { unsigned _sp = 0; while (cond) { __builtin_amdgcn_s_sleep(1); \
    if ((++_sp & 255u) == 0u) { if (xb_ld(&(bar)[XB_TMO])) break; if (_sp > XB_SPIN_CAP) { atomicAdd(&(bar)[XB_TMO], 1u); break; } } } } while (0)

struct XcdBarrier { unsigned* bar; unsigned x; volatile LAS unsigned* st; };

__device__ __forceinline__ XcdBarrier xcd_barrier_post(unsigned* bar, volatile LAS unsigned* st) {
    XcdBarrier b; b.bar = bar; b.x = xb_xcc_id(); b.st = st;
    if (threadIdx.x == 0) (void)xb_add(&bar[XB_XCNT(b.x)], 1u);
    return b;
}
__device__ __forceinline__ void xcd_barrier_complete(unsigned* bar, unsigned x, unsigned& nloc, unsigned& nx) {
    const unsigned G = gridDim.x * gridDim.y * gridDim.z;
    unsigned sum, cnt, mine, sp = 0u;
    for (;;) {
        sum = 0u; cnt = 0u; mine = 0u;
#pragma unroll
        for (unsigned j = 0; j < 16; ++j) { const unsigned c = xb_ld(&bar[XB_XCNT(j)]); sum += c; cnt += (c > 0u) ? 1u : 0u; mine = (j == x) ? c : mine; }
        if (sum == G) break;
        __builtin_amdgcn_s_sleep(1);
        if ((++sp & 255u) == 0u) { if (xb_ld(&bar[XB_TMO])) break; if (sp > XB_SPIN_CAP) { atomicAdd(&bar[XB_TMO], 1u); break; } }
    }
    nloc = mine > 0u ? mine : 1u; nx = cnt > 0u ? cnt : 1u;
}
__device__ __forceinline__ void xcd_barrier(const XcdBarrier& b) {
    asm volatile("s_waitcnt vmcnt(0)" ::: "memory");
    __syncthreads();
    if (threadIdx.x == 0) {
        unsigned* bar = b.bar;
        __builtin_amdgcn_s_waitcnt(0);
        unsigned nloc = b.st[0], nx = b.st[1];
        if (nloc == 0u) { xcd_barrier_complete(bar, b.x, nloc, nx); b.st[0] = nloc; b.st[1] = nx; }
        const unsigned old = xb_add(&bar[XB_XSUB(b.x)], 1u);
        const unsigned gen = old / nloc;
        if (old + 1u == (gen + 1u) * nloc) {
            __builtin_amdgcn_fence(__ATOMIC_RELEASE, "agent");
            asm volatile("s_waitcnt vmcnt(0)" ::: "memory");
            const unsigned og = xb_add(&bar[XB_TOP], 1u);
            const unsigned tg = og / nx;
            if (og + 1u == (tg + 1u) * nx) xb_add(&bar[XB_TOPGEN], 1u);
            else XB_SPIN(xb_ld(&bar[XB_TOPGEN]) == tg, bar);
            __builtin_amdgcn_fence(__ATOMIC_ACQUIRE, "agent");
            xb_add(&bar[XB_XGEN(b.x)], 1u);
            asm volatile("s_waitcnt vmcnt(0)" ::: "memory");
        } else {
            XB_SPIN(xb_ld(&bar[XB_XGEN(b.x)]) == gen, bar);
            __builtin_amdgcn_fence(__ATOMIC_ACQUIRE, "agent");
            asm volatile("s_waitcnt vmcnt(0)" ::: "memory");
        }
    }
    __syncthreads();
}

__device__ __forceinline__ const __attribute__((address_space(4))) Params* lp(const __attribute__((address_space(4))) Params* q) { asm volatile("" : "+s"(q)); return q; }
#define MEGA_LDS 151552
__global__ void __launch_bounds__(512) k_mega(Params p) {
    extern __shared__ __attribute__((aligned(16))) char smem[];
    __shared__ uint4 xb_words;
    if (threadIdx.x == 0) xb_words = make_uint4(0u, 0u, 0u, 0u);
    __syncthreads();
    XcdBarrier bar = xcd_barrier_post(p.bar, (volatile LAS unsigned*)&xb_words);
    const int bid0 = blockIdx.x, nblk0 = gridDim.x;
    const __attribute__((address_space(4))) Params* kp = (const __attribute__((address_space(4))) Params*)__builtin_amdgcn_kernarg_segment_ptr();
#define PQ (*lp(kp))
#define BID oint(bid0)
#define NBLK oint(nblk0)
    ph_mods(PQ, BID, NBLK, smem);
    ph_convert_mix(PQ, 0, BID, NBLK);
    xcd_barrier(bar);
    for (int l0 = 0; l0 < 2; ++l0) {
#define LL oint(l0)
        ph_norm1(PQ, LL, BID, NBLK);
        xcd_barrier(bar);
        ph_gemm1(PQ, BID, NBLK, smem);
        xcd_barrier(bar);
        ph_s5_scan<1>(PQ, LL, BID, NBLK);
        __syncthreads();
        ph_rg_a(PQ, LL, BID, NBLK, smem);
        __syncthreads();
        ph_rw_prep(PQ, LL, BID, NBLK, smem);
        __syncthreads();
        ph_dsa_pre(PQ, BID, NBLK);
        xcd_barrier(bar);
        if (BID < 16) ph_rw_scan(PQ, BID, smem);
        else {
            ph_s5_carry(PQ, LL, BID - 16, NBLK - 16);
            ph_rg_c(PQ, LL, BID - 16, NBLK - 16, smem);
            __syncthreads();
            ph_dsa_naive(PQ, BID - 16, NBLK - 16, smem);
        }
        xcd_barrier(bar);
        ph_s5_scan<3>(PQ, LL, BID, NBLK);
        ph_rw_post(PQ, LL, BID, NBLK);
        xcd_barrier(bar);
        ph_s5_glu(PQ, LL, BID, NBLK, smem);
        xcd_barrier(bar);
        ph_merge(PQ, LL, BID, NBLK, smem);
        xcd_barrier(bar);
        ph_outproj(PQ, LL, BID, NBLK, smem);
        ph_convert_moe(PQ, LL, BID, NBLK);
        xcd_barrier(bar);
        ph_norm2_router(PQ, LL, BID, NBLK, smem);
        if (LL == 0) ph_convert_mix(PQ, 1, BID, NBLK);
        xcd_barrier(bar);
        ph_moe1(PQ, BID, NBLK, smem);
        xcd_barrier(bar);
        ph_moe2(PQ, LL, BID, NBLK, smem);
        xcd_barrier(bar);
    }
    ph_final(PQ, BID, NBLK);
}

static inline size_t al(size_t x) { return (x + 255) & ~(size_t)255; }
extern "C" void kernel_launch(void* const* d_in, const int* in_sizes, int n_in, void* d_out, int out_size, void* d_ws, size_t ws_size, hipStream_t stream) {
    Params p{};
    for (int i = 0; i < N_IN; ++i) p.in[i] = (const float*)d_in[i];
    p.pos = (const int*)d_in[I_POS];
    p.out = (float*)d_out;
    char* w = (char*)d_ws; size_t off = 0;
    auto take = [&](size_t bytes) { char* r = w + off; off += al(bytes); return r; };
    p.bar = (unsigned*)take(XCD_BAR_WORDS * 4);
    p.mods = (float*)take(2 * 4 * 6144 * 4);
    p.bcnt = (int*)take(256);
    p.Wp = (h16*)take((size_t)PJ * DM * 2); p.Widx = (h16*)take((size_t)256 * 3072 * 2); p.Wg = (h16*)take((size_t)4096 * DM * 2);
    p.Wb = (h16*)take((size_t)4096 * 256 * 2); p.Wo = (h16*)take((size_t)DM * DM * 2); p.Wglu = (h16*)take(256 * 256 * 2);
    p.x1 = (float*)take((size_t)NTOK * DM * 4);
    p.h_hi = (h16*)take((size_t)NTOK * DM * 2); p.h_lo = (h16*)take((size_t)NTOK * DM * 2); p.branches = p.h_lo;
    p.cw = (float*)take((size_t)NTOK * 2 * 4);
    p.lists = (int*)take((size_t)24 * LCAP * 4);
    const size_t offR = off;
    p.proj = (h16*)take((size_t)NTOK * PJ * 2); p.idxf = (float*)take((size_t)NTOK * IDXLD * 4);
    p.ybuf = (h16*)take((size_t)NTOK * 256 * 2); p.s5E = (float*)take((size_t)4 * 64 * 16 * 64 * 2 * 4); p.s5H = (float*)take((size_t)4 * 64 * 16 * 64 * 2 * 4);
    p.rg_hl = (float*)take((size_t)NTOK * 256 * 4); p.rg_cp = (float*)take((size_t)NTOK * 256 * 4); p.rg_agg = (float*)take((size_t)4 * 128 * 256 * 2 * 4);
    p.rw_r = (h16*)take((size_t)NTOK * 256 * 2); p.rw_w = (h16*)take((size_t)NTOK * 256 * 2); p.rw_k = (h16*)take((size_t)NTOK * 256 * 2); p.rw_kk = (h16*)take((size_t)NTOK * 256 * 2);
    p.rw_b = (h16*)take((size_t)NTOK * 256 * 2); p.rw_v = (h16*)take((size_t)NTOK * 256 * 2); p.rw_g = (h16*)take((size_t)NTOK * 256 * 2); p.rw_bonus = (h16*)take((size_t)NTOK * 256 * 2);
    p.rw_y = (float*)take((size_t)NTOK * 256 * 4);
    const size_t endMix = off;
    p.mixed = (h16*)p.rg_hl;
    off = offR;
    p.We13 = (h16*)take((size_t)16 * 1024 * DM * 2); p.We2 = (h16*)take((size_t)16 * 1024 * 512 * 2); p.act = (h16*)take((size_t)MOE_MAXT * 128 * 1024 * 2);
    const size_t endMoe = off;
    const size_t need = endMix > endMoe ? endMix : endMoe;
    if (need > ws_size || (char*)p.act + (size_t)MOE_MAXT * 128 * 1024 * 2 > (char*)p.ybuf) { fprintf(stderr, "workspace layout problem: need %zu have %zu\n", need, ws_size); return; }

    static int grid = 0;
    if (!grid) {
        (void)hipFuncSetAttribute((const void*)k_mega, hipFuncAttributeMaxDynamicSharedMemorySize, MEGA_LDS);
        int dev = 0, cus = 0, per_cu = 0;
        (void)hipGetDevice(&dev);
        (void)hipDeviceGetAttribute(&cus, hipDeviceAttributeMultiprocessorCount, dev);
        (void)hipOccupancyMaxActiveBlocksPerMultiprocessor(&per_cu, (const void*)k_mega, 512, MEGA_LDS);
        if (per_cu < 1) { fprintf(stderr, "k_mega not launchable (occupancy 0)\n"); return; }
        grid = cus;
        fprintf(stderr, "k_mega: grid %d (cus %d, per_cu %d), ws need %zu have %zu\n", grid, cus, per_cu, need, ws_size);
    }
    (void)hipMemsetAsync(p.bar, 0, XCD_BAR_WORDS * 4, stream);
    k_mega<<<grid, 512, MEGA_LDS, stream>>>(p);
}
```

```cpp
#include <hip/hip_runtime.h>
#include <stdint.h>
#include <stdio.h>
#include <math.h>

typedef _Float16 h16;
typedef _Float16 h16x8 __attribute__((ext_vector_type(8)));
typedef _Float16 h16x4 __attribute__((ext_vector_type(4)));
typedef float f32x4 __attribute__((ext_vector_type(4)));

#define NTOK 16384
#define SEQ 4096
#define NBATCH 4
#define DM 1024
#define DINW 2596
#define PJ 2432
#define IDXLD 192
#define P_U 0
#define P_Q 256
#define P_K 512
#define P_V 768
#define P_RGX 1024
#define P_RGG 1280
#define P_RW 1536
#define LCAP 16384

enum { I_X = 0, I_C, I_POS, I_ADAW, I_ADAB, I_MNG, I_WIN, I_GATEW, I_GATEB, I_BRW, I_OUTW,
       I_S5LRE, I_S5LIM, I_S5LS, I_S5BRE, I_S5BIM, I_S5CRE, I_S5CIM, I_S5D, I_S5GW, I_S5GB,
       I_RGCW, I_RGCB, I_RGWR, I_RGBR, I_RGWI, I_RGBI, I_RGLAM,
       I_RWMU, I_RWW0, I_RWWUP, I_RWA0, I_RWAUP, I_RWGUP, I_RWKK, I_RWKA, I_RWRK, I_RWGNW, I_RWGNB,
       I_FNG, I_ROUTW, I_ROUTB, I_W1, I_W3, I_W2, I_FINALG, N_IN };

struct Params {
    const float* in[N_IN];
    const int* pos;
    float* out;
    unsigned* bar;
    float* mods;
    h16 *Wp, *Widx, *Wg, *Wb, *Wo, *Wglu, *We13, *We2;
    float* x1;
    h16 *h_hi, *h_lo, *branches;
    h16* proj; float* idxf;
    h16* ybuf; float *s5E, *s5H, *s5c, *ropet;
    float *rg_hl, *rg_cp, *rg_agg;
    h16 *rw_r, *rw_w, *rw_k, *rw_kk, *rw_b, *rw_g, *rw_bonus, *rw_v; float* rw_y;
    h16 *rw_W, *rw_U0, *rw_Ry, *rw_Y0, *rw_Be, *rw_VK, *rw_S0; float* rw_gam;
    h16* mixed;
    h16* act; int* lists; int* bcnt; float* cw;
};

typedef const __attribute__((address_space(4))) Params& CP;
__device__ __forceinline__ float sigm(float x) { return 1.f / (1.f + __expf(-x)); }
__device__ __forceinline__ float gelu_tanh(float x) { return 0.5f * x * (1.f + tanhf(0.7978845608028654f * (x + 0.044715f * x * x * x))); }
__device__ __forceinline__ float softplusf_(float x) { return fmaxf(x, 0.f) + log1pf(__expf(-fabsf(x))); }
__device__ __forceinline__ float wave_sum(float v) { for (int o = 32; o > 0; o >>= 1) v += __shfl_xor(v, o); return v; }
__device__ __forceinline__ float wave_max(float v) { for (int o = 32; o > 0; o >>= 1) v = fmaxf(v, __shfl_xor(v, o)); return v; }
__device__ __forceinline__ float egl_get(const float* egl, int k) { return egl[k]; }
__device__ __forceinline__ h16x4 pack4(float a, float b, float c, float d) { h16x4 r; r[0] = (h16)a; r[1] = (h16)b; r[2] = (h16)c; r[3] = (h16)d; return r; }

__device__ __forceinline__ int oint(int x) { asm volatile("" : "+s"(x)); return x; }
__device__ __forceinline__ int otid() { int t = threadIdx.x; asm volatile("" : "+v"(t)); return t; }
__device__ __forceinline__ void ph_mods(CP p, int bid, int nblk, char* smem) {
    if (bid >= 24) return;
    float* ca = (float*)smem;
    for (int i = otid(); i < 4 * DM; i += 512) { float c = p.in[I_C][i]; ca[i] = c * sigm(c); }
    __syncthreads();
    int gid = bid * 512 + otid();
    int l = gid / 6144, j = gid % 6144;
    const float* w = p.in[I_ADAW] + (size_t)l * DM * 6144 + j;
    float a0 = 0, a1 = 0, a2 = 0, a3 = 0;
    for (int k = 0; k < DM; ++k) { float wv = w[(size_t)k * 6144]; a0 += ca[k] * wv; a1 += ca[DM + k] * wv; a2 += ca[2 * DM + k] * wv; a3 += ca[3 * DM + k] * wv; }
    float bb = p.in[I_ADAB][l * 6144 + j];
    float* m = p.mods + (size_t)l * 4 * 6144;
    m[0 * 6144 + j] = a0 + bb; m[1 * 6144 + j] = a1 + bb; m[2 * 6144 + j] = a2 + bb; m[3 * 6144 + j] = a3 + bb;
}

__device__ __forceinline__ void ph_tables(CP p, int bid, int nblk) {
    const int gt = bid * 512 + otid(), gn = nblk * 512;
    for (int i = gt; i < NTOK * 32; i += gn) {
        const int tok = i >> 5, f = i & 31;
        const double ang = (double)p.pos[tok] * exp(-(double)f * (1.0 / 32.0) * 9.210340371976184);
        double sn, cs; sincos(ang, &sn, &cs);
        p.ropet[(size_t)i * 2] = (float)cs; p.ropet[(size_t)i * 2 + 1] = (float)sn;
    }
    for (int i = gt; i < 2 * 16 * 64; i += gn) {
        const int g = (i >> 6) & 15, l = i >> 10;
        const double lre = p.in[I_S5LRE][i], lim = p.in[I_S5LIM][i], st = exp((double)p.in[I_S5LS][l * 16 + g]);
        const double er = exp(lre * st); double sn, cs; sincos(lim * st, &sn, &cs);
        const double lbr = er * cs, lbi = er * sn;
        const double nr = lbr - 1.0, ni = lbi, den = lre * lre + lim * lim;
        const double fr = (nr * lre + ni * lim) / den, fi = (ni * lre - nr * lim) / den;
        const double e64 = exp(64.0 * lre * st); double s64, c64; sincos(64.0 * lim * st, &s64, &c64);
        float* o = p.s5c + (size_t)i * 36;
        o[0] = (float)lbr; o[1] = (float)lbi; o[2] = (float)(e64 * c64); o[3] = (float)(e64 * s64);
        for (int cc = 0; cc < 16; ++cc) { const double br = p.in[I_S5BRE][(size_t)i * 16 + cc], bi = p.in[I_S5BIM][(size_t)i * 16 + cc];
                                          o[4 + cc] = (float)(fr * br - fi * bi); o[20 + cc] = (float)(fr * bi + fi * br); }
    }
}
template <class SRC>
__device__ __forceinline__ void convT(h16* dst, int dstld, int nrows, int K, int koff, const SRC& src, int gtid, int gthreads) {
    const int kch = K / 8;
    const long total = (long)nrows * kch;
    for (long w = gtid; w < total; w += gthreads) {
        int n = (int)(w % nrows), kc = (int)(w / nrows);
        h16x8 v;
#pragma unroll
        for (int i = 0; i < 8; ++i) v[i] = (h16)src(n, kc * 8 + i);
        *(h16x8*)(dst + (size_t)n * dstld + koff + kc * 8) = v;
    }
}
__device__ __forceinline__ void ph_convert_mix(CP p, int l, int bid, int nblk) {
    const int gt = bid * 512 + otid(), gn = nblk * 512;
    { const float* s = p.in[I_WIN] + (size_t)l * DM * DINW;
      convT(p.Wp, DM, PJ, DM, 0, [=](int n, int k) { return s[(size_t)k * DINW + (n < 1024 ? n : n + 164)]; }, gt, gn);
      convT(p.Widx, 3072, 256, DM, 0, [=](int n, int k) { return n < 164 ? s[(size_t)k * DINW + 1024 + n] : 0.f; }, gt, gn);
      convT(p.Widx, 3072, 256, DM, 1024, [=](int n, int k) { return n < 164 ? s[(size_t)k * DINW + 1024 + n] : 0.f; }, gt, gn);
      convT(p.Widx, 3072, 256, DM, 2048, [=](int n, int k) { float w = n < 164 ? s[(size_t)k * DINW + 1024 + n] : 0.f; float hi = (float)(h16)w; return w - hi; }, gt, gn); }
    { const float* s = p.in[I_GATEW] + (size_t)l * DM * 4096;
      convT(p.Wg, DM, 4096, DM, 0, [=](int n, int k) { return s[(size_t)k * 4096 + n]; }, gt, gn); }
    { const float* s = p.in[I_BRW] + (size_t)l * 4 * 256 * DM;
      convT(p.Wb, 256, 4096, 256, 0, [=](int n, int k) { int br = n >> 10, d = n & 1023; return s[(size_t)br * 256 * DM + (size_t)k * DM + d]; }, gt, gn); }
    { const float* s = p.in[I_OUTW] + (size_t)l * DM * DM;
      convT(p.Wo, DM, DM, DM, 0, [=](int n, int k) { return s[(size_t)k * DM + n]; }, gt, gn); }
    { const float* s = p.in[I_S5GW] + (size_t)l * 256 * 256;
      convT(p.Wglu, 256, 256, 256, 0, [=](int n, int k) { return s[(size_t)k * 256 + n]; }, gt, gn); }
}
__device__ __forceinline__ void ph_convert_moe(CP p, int l, int bid, int nblk) {
    const int gt = bid * 512 + otid(), gn = nblk * 512;
    const float* s1 = p.in[I_W1] + (size_t)l * 16 * DM * 512;
    const float* s3 = p.in[I_W3] + (size_t)l * 16 * DM * 512;
    const float* s2 = p.in[I_W2] + (size_t)l * 16 * 512 * DM;
    convT(p.We13, DM, 16 * 1024, DM, 0, [=](int n, int k) { int e = n >> 10, r = n & 1023; int c = (r >> 5) * 16 + (r & 15); const float* s = ((r >> 4) & 1) ? s3 : s1;
                                                           return s[(size_t)e * DM * 512 + (size_t)k * 512 + c]; }, gt, gn);
    convT(p.We2, 512, 16 * 1024, 512, 0, [=](int n, int k) { int e = n >> 10, c = n & 1023; return s2[(size_t)e * 512 * DM + (size_t)k * DM + c]; }, gt, gn);
}

__device__ __forceinline__ void ph_norm1(CP p, int l, int bid, int nblk) {
    const float* xin = l == 0 ? p.in[I_X] : p.x1;
    const int lane = otid() & 63, wv = otid() >> 6;
    if (bid == 0 && otid() < 24) p.bcnt[otid()] = 0;
    for (int tok = bid * 8 + wv; tok < NTOK; tok += nblk * 8) {
        const int b = tok / SEQ;
        const float* xr = xin + (size_t)tok * DM;
        f32x4 v[4]; float ss = 0.f;
#pragma unroll
        for (int i = 0; i < 4; ++i) { v[i] = *(const f32x4*)(xr + i * 256 + lane * 4); ss += v[i][0] * v[i][0] + v[i][1] * v[i][1] + v[i][2] * v[i][2] + v[i][3] * v[i][3]; }
        ss = wave_sum(ss);
        const float rs = rsqrtf(ss * (1.f / DM) + 1e-6f);
        const float* g = p.in[I_MNG] + l * DM;
        const float* md = p.mods + ((size_t)l * 4 + b) * 6144;
#pragma unroll
        for (int i = 0; i < 4; ++i) {
            const int c = i * 256 + lane * 4;
            f32x4 gg = *(const f32x4*)(g + c), sh = *(const f32x4*)(md + c), sc = *(const f32x4*)(md + 1024 + c);
            float hv[4]; h16x4 hi, lo;
#pragma unroll
            for (int e = 0; e < 4; ++e) { hv[e] = v[i][e] * rs * gg[e] * (1.f + sc[e]) + sh[e]; hi[e] = (h16)hv[e]; lo[e] = (h16)(hv[e] - (float)hi[e]); }
            *(h16x4*)(p.h_hi + (size_t)tok * DM + c) = hi;
            *(h16x4*)(p.h_lo + (size_t)tok * DM + c) = lo;
        }
    }
}

#define LDT 72
template <int BM, class AF, class BF>
__device__ __forceinline__ void gemm_kloop(char* smem, int K, const AF& af, const BF& bf, f32x4 (&acc)[BM / 64][4]) {
    constexpr int MT = BM / 64, WM = BM / 4, NA = BM / 64;
    h16* sA = (h16*)smem; h16* sB = sA + 2 * BM * LDT;
    const int tid = otid(), lane = tid & 63, wave = tid >> 6, wm = wave >> 1, wn = wave & 1;
    const int lrow = tid >> 3, lkc = (tid & 7) * 8;
    uint4 ra[NA], rb[2];
    const int nk = K / 64;
#pragma unroll
    for (int i = 0; i < NA; ++i) ra[i] = *(const uint4*)af(lrow + i * 64, lkc);
#pragma unroll
    for (int i = 0; i < 2; ++i) rb[i] = *(const uint4*)bf(lrow + i * 64, lkc);
#pragma unroll
    for (int i = 0; i < NA; ++i) *(uint4*)&sA[(lrow + i * 64) * LDT + lkc] = ra[i];
#pragma unroll
    for (int i = 0; i < 2; ++i) *(uint4*)&sB[(lrow + i * 64) * LDT + lkc] = rb[i];
    __syncthreads();
    for (int kt = 0; kt < nk; ++kt) {
        const int cur = kt & 1;
        if (kt + 1 < nk) {
            const int k = (kt + 1) * 64 + lkc;
#pragma unroll
            for (int i = 0; i < NA; ++i) ra[i] = *(const uint4*)af(lrow + i * 64, k);
#pragma unroll
            for (int i = 0; i < 2; ++i) rb[i] = *(const uint4*)bf(lrow + i * 64, k);
        }
        const h16* cA = sA + cur * BM * LDT; const h16* cB = sB + cur * 128 * LDT;
#pragma unroll
        for (int ks = 0; ks < 2; ++ks) {
            h16x8 a[MT], b[4];
#pragma unroll
            for (int i = 0; i < MT; ++i) a[i] = *(const h16x8*)&cA[(wm * WM + i * 16 + (lane & 15)) * LDT + ks * 32 + (lane >> 4) * 8];
#pragma unroll
            for (int j = 0; j < 4; ++j) b[j] = *(const h16x8*)&cB[(wn * 64 + j * 16 + (lane & 15)) * LDT + ks * 32 + (lane >> 4) * 8];
#pragma unroll
            for (int i = 0; i < MT; ++i)
#pragma unroll
                for (int j = 0; j < 4; ++j) acc[i][j] = __builtin_amdgcn_mfma_f32_16x16x32_f16(b[j], a[i], acc[i][j], 0, 0, 0);
        }
        if (kt + 1 < nk) {
            h16* nA = sA + (cur ^ 1) * BM * LDT; h16* nB = sB + (cur ^ 1) * 128 * LDT;
#pragma unroll
            for (int i = 0; i < NA; ++i) *(uint4*)&nA[(lrow + i * 64) * LDT + lkc] = ra[i];
#pragma unroll
            for (int i = 0; i < 2; ++i) *(uint4*)&nB[(lrow + i * 64) * LDT + lkc] = rb[i];
        }
        __syncthreads();
    }
}
template <int BM> __device__ __forceinline__ void zero_acc(f32x4 (&acc)[BM / 64][4]) {
#pragma unroll
    for (int i = 0; i < BM / 64; ++i)
#pragma unroll
        for (int j = 0; j < 4; ++j) acc[i][j] = (f32x4){0.f, 0.f, 0.f, 0.f};
}
template <int BM, class EPI>
__device__ __forceinline__ void gemm_epi(const f32x4 (&acc)[BM / 64][4], const EPI& epi) {
    const int lane = otid() & 63, wave = otid() >> 6, wm = wave >> 1, wn = wave & 1;
#pragma unroll
    for (int i = 0; i < BM / 64; ++i)
#pragma unroll
        for (int j = 0; j < 4; ++j) epi(wm * (BM / 4) + i * 16 + (lane & 15), wn * 64 + j * 16 + 4 * (lane >> 4), acc[i][j]);
}
#define GEMM_LDS(BM) (2 * (BM) * LDT * 2 + 2 * 128 * LDT * 2)

__device__ __forceinline__ void ph_gemm1(CP p, int bid, int nblk, char* smem) {
    const int nu_main = 64 * 19, nu = nu_main + 64 * 2;
    for (int u = bid; u < nu; u += nblk) {
        f32x4 acc[4][4]; zero_acc<256>(acc);
        if (u < nu_main) {
            const int mt = u / 19, nt = u % 19, m0 = mt * 256, n0 = nt * 128;
            const h16* A = p.h_hi + (size_t)m0 * DM; const h16* B = p.Wp + (size_t)n0 * DM;
            gemm_kloop<256>(smem, DM, [=](int r, int k) { return A + (size_t)r * DM + k; }, [=](int r, int k) { return B + (size_t)r * DM + k; }, acc);
            h16* O = p.proj + (size_t)m0 * PJ + n0;
            gemm_epi<256>(acc, [=](int ml, int nl, f32x4 v) { *(h16x4*)(O + (size_t)ml * PJ + nl) = pack4(v[0], v[1], v[2], v[3]); });
        } else {
            const int uu = u - nu_main, mt = uu >> 1, nt = uu & 1, m0 = mt * 256, n0 = nt * 128;
            const h16* Ah = p.h_hi + (size_t)m0 * DM; const h16* Al = p.h_lo + (size_t)m0 * DM; const h16* B = p.Widx + (size_t)n0 * 3072;
            gemm_kloop<256>(smem, 3072, [=](int r, int k) { const h16* base = (k >= 1024 && k < 2048) ? Al : Ah; return base + (size_t)r * DM + (k & 1023); },
                            [=](int r, int k) { return B + (size_t)r * 3072 + k; }, acc);
            float* O = p.idxf + (size_t)m0 * IDXLD + n0;
            gemm_epi<256>(acc, [=](int ml, int nl, f32x4 v) { if (n0 + nl < IDXLD) *(f32x4*)(O + (size_t)ml * IDXLD + nl) = v; });
        }
    }
}

template <int PASS>
__device__ __forceinline__ void ph_s5_scan(CP p, int l, int bid, int nblk) {
    const int lane = otid() & 63, wv = otid() >> 6;
    for (int u = bid * 8 + wv; u < 4096; u += nblk * 8) {
        const int g = u & 15, c = (u >> 4) & 63, b = u >> 10;
        const int pidx = (l * 16 + g) * 64 + lane;
        const float* sc_ = p.s5c + (size_t)pidx * 36;
        float Br[16], Bi[16];
#pragma unroll
        for (int cc = 0; cc < 16; ++cc) { Br[cc] = sc_[4 + cc]; Bi[cc] = sc_[20 + cc]; }
        const float lr = sc_[0], li = sc_[1];
        float hr = 0.f, hi = 0.f;
        float Cr[16], Ci[16];
        if (PASS == 3) {
#pragma unroll
            for (int cc = 0; cc < 16; ++cc) { Cr[cc] = p.in[I_S5CRE][((size_t)(l * 16 + g) * 16 + cc) * 64 + lane]; Ci[cc] = p.in[I_S5CIM][((size_t)(l * 16 + g) * 16 + cc) * 64 + lane]; }
            const size_t hix = ((((size_t)b * 64 + c) * 16 + g) * 64 + lane) * 2;
            hr = p.s5H[hix]; hi = p.s5H[hix + 1];
        }
        const int t0 = b * SEQ + c * 64;
        const int oidx = ((lane >> 5) & 1) * 8 + ((lane >> 4) & 1) * 4 + ((lane >> 3) & 1) * 2 + ((lane >> 2) & 1);
        const float dsk = p.in[I_S5D][l * 256 + g * 16 + oidx];
        for (int t = 0; t < 64; ++t) {
            const h16* up = p.proj + (size_t)(t0 + t) * PJ + P_U + g * 16;
            h16x8 u0 = *(const h16x8*)up, u1 = *(const h16x8*)(up + 8);
            float uu[16];
#pragma unroll
            for (int cc = 0; cc < 8; ++cc) { uu[cc] = (float)u0[cc]; uu[8 + cc] = (float)u1[cc]; }
            float br = 0.f, bi = 0.f;
#pragma unroll
            for (int cc = 0; cc < 16; ++cc) { br += Br[cc] * uu[cc]; bi += Bi[cc] * uu[cc]; }
            const float nhr = lr * hr - li * hi + br, nhi = lr * hi + li * hr + bi;
            hr = nhr; hi = nhi;
            if (PASS == 3) {
                float v[16];
#pragma unroll
                for (int cc = 0; cc < 16; ++cc) v[cc] = Cr[cc] * hr - Ci[cc] * hi;
                float v8[8], v4[4], v2[2], v1;
                const bool b5 = lane & 32, b4 = lane & 16, b3 = lane & 8, b2 = lane & 4;
#pragma unroll
                for (int i = 0; i < 8; ++i) { float snd = b5 ? v[i] : v[i + 8], keep = b5 ? v[i + 8] : v[i]; v8[i] = keep + __shfl_xor(snd, 32); }
#pragma unroll
                for (int i = 0; i < 4; ++i) { float snd = b4 ? v8[i] : v8[i + 4], keep = b4 ? v8[i + 4] : v8[i]; v4[i] = keep + __shfl_xor(snd, 16); }
#pragma unroll
                for (int i = 0; i < 2; ++i) { float snd = b3 ? v4[i] : v4[i + 2], keep = b3 ? v4[i + 2] : v4[i]; v2[i] = keep + __shfl_xor(snd, 8); }
                { float snd = b2 ? v2[0] : v2[1], keep = b2 ? v2[1] : v2[0]; v1 = keep + __shfl_xor(snd, 4); }
                v1 += __shfl_xor(v1, 2); v1 += __shfl_xor(v1, 1);
                if ((lane & 3) == 0) {
                    const float y = v1 + dsk * uu[oidx];
                    p.ybuf[(size_t)(t0 + t) * 256 + g * 16 + oidx] = (h16)gelu_tanh(y);
                }
            }
        }
        if (PASS == 1) { const size_t eix = ((((size_t)b * 64 + c) * 16 + g) * 64 + lane) * 2; p.s5E[eix] = hr; p.s5E[eix + 1] = hi; }
    }
}
__device__ __forceinline__ void ph_s5_carry(CP p, int l, int bid, int nblk) {
    if (bid >= 8) return;
    const int gid = bid * 512 + otid();
    const int pp = gid & 63, g = (gid >> 6) & 15, b = gid >> 10;
    const int pidx = (l * 16 + g) * 64 + pp;
    const float ar = p.s5c[(size_t)pidx * 36 + 2], ai = p.s5c[(size_t)pidx * 36 + 3];
    float hr = 0.f, hi = 0.f;
    for (int c = 0; c < 64; ++c) {
        const size_t ix = ((((size_t)b * 64 + c) * 16 + g) * 64 + pp) * 2;
        p.s5H[ix] = hr; p.s5H[ix + 1] = hi;
        const float er_ = p.s5E[ix], ei_ = p.s5E[ix + 1];
        const float nr = ar * hr - ai * hi + er_, ni = ar * hi + ai * hr + ei_;
        hr = nr; hi = ni;
    }
}
__device__ __forceinline__ void ph_s5_glu(CP p, int l, int bid, int nblk, char* smem) {
    for (int u = bid; u < 128; u += nblk) {
        const int mt = u >> 1, nt = u & 1, m0 = mt * 256, n0 = nt * 128;
        f32x4 acc[4][4]; zero_acc<256>(acc);
        const h16* A = p.ybuf + (size_t)m0 * 256; const h16* B = p.Wglu + (size_t)n0 * 256;
        gemm_kloop<256>(smem, 256, [=](int r, int k) { return A + (size_t)r * 256 + k; }, [=](int r, int k) { return B + (size_t)r * 256 + k; }, acc);
        const float* gb = p.in[I_S5GB] + l * 256 + n0;
        const h16* Y = p.ybuf + (size_t)m0 * 256 + n0; h16* O = p.branches + (size_t)m0 * DM + n0;
        gemm_epi<256>(acc, [=](int ml, int nl, f32x4 v) {
            h16x4 y = *(const h16x4*)(Y + (size_t)ml * 256 + nl); f32x4 bb = *(const f32x4*)(gb + nl);
            *(h16x4*)(O + (size_t)ml * DM + nl) = pack4((float)y[0] * sigm(v[0] + bb[0]), (float)y[1] * sigm(v[1] + bb[1]), (float)y[2] * sigm(v[2] + bb[2]), (float)y[3] * sigm(v[3] + bb[3])); });
    }
}

__device__ __forceinline__ void ph_rg_a(CP p, int l, int bid, int nblk, char* smem) {
    float* xc = (float*)smem;
    float* aa = xc + 32 * 256;
    float* bx = aa + 32 * 256;
    const int tid = otid();
    for (int u = bid; u < 512; u += nblk) {
        const int b = u >> 7, c = u & 127, t0 = c * 32;
        __syncthreads();
        {
            const int ch = tid & 255;
            const float w0 = p.in[I_RGCW][(l * 4 + 0) * 256 + ch], w1 = p.in[I_RGCW][(l * 4 + 1) * 256 + ch], w2 = p.in[I_RGCW][(l * 4 + 2) * 256 + ch], w3 = p.in[I_RGCW][(l * 4 + 3) * 256 + ch];
            const float cb = p.in[I_RGCB][l * 256 + ch];
            for (int t = tid >> 8; t < 32; t += 2) {
                const int tt = t0 + t;
                const h16* xp = p.proj + (size_t)(b * SEQ + tt) * PJ + P_RGX + ch;
                float s = cb + w3 * (float)xp[0];
                if (tt >= 1) s += w2 * (float)xp[-(long)PJ];
                if (tt >= 2) s += w1 * (float)xp[-2 * (long)PJ];
                if (tt >= 3) s += w0 * (float)xp[-3 * (long)PJ];
                xc[t * 256 + ch] = s;
            }
        }
        __syncthreads();
        const int ch = tid & 255, half = tid >> 8, blk = ch >> 6, d = ch & 63;
        const float* wr = p.in[I_RGWR] + ((size_t)(l * 4 + blk) * 64) * 64 + d;
        const float* wi = p.in[I_RGWI] + ((size_t)(l * 4 + blk) * 64) * 64 + d;
        const float br = p.in[I_RGBR][l * 256 + ch], bi = p.in[I_RGBI][l * 256 + ch];
        const float spl = softplusf_(-p.in[I_RGLAM][l * 256 + ch]);
#pragma unroll 1
        for (int grp = 0; grp < 2; ++grp) {
            float ar[8], ai[8];
#pragma unroll
            for (int q = 0; q < 8; ++q) { ar[q] = br; ai[q] = bi; }
            const int tb = half * 16 + grp * 8;
            for (int cc = 0; cc < 64; ++cc) {
                const float wrv = wr[cc * 64], wiv = wi[cc * 64];
#pragma unroll
                for (int q = 0; q < 8; ++q) { const float xv = xc[(tb + q) * 256 + blk * 64 + cc]; ar[q] += xv * wrv; ai[q] += xv * wiv; }
            }
#pragma unroll
            for (int q = 0; q < 8; ++q) {
                const float r = sigm(ar[q]), ig = sigm(ai[q]);
                const float la = -8.f * r * spl;
                const float a = __expf(la), mult = sqrtf(-expm1f(2.f * la));
                aa[(tb + q) * 256 + ch] = a; bx[(tb + q) * 256 + ch] = mult * ig * xc[(tb + q) * 256 + ch];
            }
        }
        __syncthreads();
        if (tid < 256) {
            float h = 0.f, cp = 1.f;
            float* hl = p.rg_hl + (size_t)(b * SEQ + t0) * 256 + ch; float* cpo = p.rg_cp + (size_t)(b * SEQ + t0) * 256 + ch;
            for (int t = 0; t < 32; ++t) { const float a = aa[t * 256 + ch]; h = a * h + bx[t * 256 + ch]; cp *= a; hl[(size_t)t * 256] = h; cpo[(size_t)t * 256] = cp; }
            p.rg_agg[((size_t)(b * 128 + c) * 256 + ch) * 2] = cp; p.rg_agg[((size_t)(b * 128 + c) * 256 + ch) * 2 + 1] = h;
        }
    }
}
__device__ __forceinline__ void ph_rg_c(CP p, int l, int bid, int nblk, char* smem) {
    float* carry = (float*)smem;
    const int tid = otid();
    for (int u = bid; u < 512; u += nblk) {
        const int b = u >> 7, c = u & 127, t0 = c * 32;
        __syncthreads();
        if (tid < 256) { float h = 0.f; for (int cc = 0; cc < c; ++cc) { const float* ag = p.rg_agg + ((size_t)(b * 128 + cc) * 256 + tid) * 2; h = ag[0] * h + ag[1]; } carry[tid] = h; }
        __syncthreads();
        const int ch = tid & 255;
        for (int t = tid >> 8; t < 32; t += 2) {
            const size_t tok = (size_t)b * SEQ + t0 + t;
            const float h = p.rg_hl[tok * 256 + ch] + p.rg_cp[tok * 256 + ch] * carry[ch];
            const float gt = (float)p.proj[tok * PJ + P_RGG + ch];
            p.branches[tok * DM + 512 + ch] = (h16)(h * gelu_tanh(gt));
        }
    }
}

__device__ __forceinline__ void ph_rw_prep(CP p, int l, int bid, int nblk, char* smem) {
    h16* wup = (h16*)smem;
    h16* aup = wup + 32 * 256;
    h16* gup = aup + 32 * 256;
    float* f = (float*)(gup + 64 * 256);
    const int tid = otid(), lane = tid & 63;
    for (int i = tid; i < 32 * 256; i += 512) { wup[i] = (h16)p.in[I_RWWUP][(size_t)l * 32 * 256 + i]; aup[i] = (h16)p.in[I_RWAUP][(size_t)l * 32 * 256 + i]; }
    for (int i = tid; i < 64 * 256; i += 512) gup[i] = (h16)p.in[I_RWGUP][(size_t)l * 64 * 256 + i];
    const float* mu = p.in[I_RWMU] + l * 896;
    const int ch = tid & 255, tg = tid >> 8;
    const float w0 = p.in[I_RWW0][l * 256 + ch], a0 = p.in[I_RWA0][l * 256 + ch], kkw = p.in[I_RWKK][l * 256 + ch], kaw = p.in[I_RWKA][l * 256 + ch];
    const float rk = p.in[I_RWRK][l * 256 + ch];
    __syncthreads();
    for (int u = bid; u < NTOK / 16; u += nblk) {
        const int tok0 = u * 16;
        __syncthreads();
        for (int i = tid; i < 16 * 896; i += 512) {
            const int t = i / 896, cidx = i % 896; const int tok = tok0 + t;
            const float cur = (float)p.proj[(size_t)tok * PJ + P_RW + cidx];
            const float prv = (tok % SEQ) ? (float)p.proj[(size_t)(tok - 1) * PJ + P_RW + cidx] : 0.f;
            float v = cur + (prv - cur) * mu[cidx];
            if (cidx >= 768 && cidx < 800) v = tanhf(v);
            if (cidx >= 832) v = sigm(v);
            f[i] = v;
        }
        __syncthreads();
        for (int q = 0; q < 8; ++q) {
            const int t = tg * 8 + q; const int tok = tok0 + t;
            const float* ft = f + t * 896;
            float lw = 0.f, la = 0.f, lg = 0.f;
#pragma unroll 8
            for (int j = 0; j < 32; ++j) { lw += ft[768 + j] * (float)wup[j * 256 + ch]; la += ft[800 + j] * (float)aup[j * 256 + ch]; }
#pragma unroll 8
            for (int j = 0; j < 64; ++j) lg += ft[832 + j] * (float)gup[j * 256 + ch];
            const float w = -softplusf_(-(w0 + lw)) - 0.5f;
            const float wl = -__expf(w);
            const float a = sigm(a0 + la);
            const float r = ft[ch], k = ft[256 + ch], v = ft[512 + ch];
            float kk = k * kkw;
            const float nrm = sqrtf(wave_sum(kk * kk));
            kk = kk / fmaxf(nrm, 1e-12f);
            const float k2 = k * (1.f + (a - 1.f) * kaw);
            const float sb = wave_sum(r * k2 * rk);
            const size_t o = (size_t)tok * 256 + ch;
            p.rw_r[o] = (h16)r; p.rw_w[o] = (h16)wl; p.rw_k[o] = (h16)k2; p.rw_kk[o] = (h16)kk; p.rw_b[o] = (h16)(kk * a);
            p.rw_g[o] = (h16)lg; p.rw_bonus[o] = (h16)(sb * v); p.rw_v[o] = (h16)v;
        }
    }
}
__device__ __forceinline__ void ph_rw_scan(CP p, int bid, char* smem) {
    if (bid >= 16 || otid() >= 64) return;
    float (*sv)[64] = (float (*)[64])smem;
    const int b = bid >> 2, h = bid & 3, lane = otid();
    float S[64];
#pragma unroll
    for (int k = 0; k < 64; ++k) S[k] = 0.f;
    for (int t = 0; t < SEQ; ++t) {
        const size_t tok = (size_t)b * SEQ + t; const size_t o = tok * 256 + h * 64 + lane;
        const float vv = (float)p.rw_v[o];
        sv[0][lane] = (float)p.rw_r[o]; sv[1][lane] = __expf((float)p.rw_w[o]); sv[2][lane] = (float)p.rw_k[o]; sv[3][lane] = (float)p.rw_kk[o]; sv[4][lane] = (float)p.rw_b[o];
        __builtin_amdgcn_s_waitcnt(0); __builtin_amdgcn_wave_barrier();
        float skk = 0.f;
#pragma unroll
        for (int k = 0; k < 64; ++k) skk += S[k] * sv[3][k];
        float y = 0.f;
#pragma unroll
        for (int k = 0; k < 64; ++k) { S[k] = S[k] * sv[1][k] - skk * sv[4][k] + vv * sv[2][k]; y += S[k] * sv[0][k]; }
        p.rw_y[o] = y;
        __builtin_amdgcn_s_waitcnt(0); __builtin_amdgcn_wave_barrier();
    }
}
__device__ __forceinline__ void ph_rw_post(CP p, int l, int bid, int nblk) {
    const int lane = otid() & 63, wv = otid() >> 6;
    for (int u = bid * 8 + wv; u < NTOK * 4; u += nblk * 8) {
        const int tok = u >> 2, h = u & 3; const size_t o = (size_t)tok * 256 + h * 64 + lane;
        const float y = p.rw_y[o];
        const float mean = wave_sum(y) * (1.f / 64.f);
        const float dv = y - mean;
        const float var = wave_sum(dv * dv) * (1.f / 64.f);
        float v = dv * rsqrtf(var + 64e-5f) * p.in[I_RWGNW][l * 256 + h * 64 + lane] + p.in[I_RWGNB][l * 256 + h * 64 + lane];
        v += (float)p.rw_bonus[o];
        p.branches[(size_t)tok * DM + 768 + h * 64 + lane] = (h16)(v * (float)p.rw_g[o]);
    }
}

#define RS 68
template <int MODE>
__device__ __forceinline__ void mm_nt(float* out, const float* X, const float* Y, int wave, int nw, int lane) {
    const int g = lane >> 4, c = lane & 15;
    for (int idx = wave; idx < 16; idx += nw) {
        const int ti = idx >> 2, tj = idx & 3;
        f32x4 acc = {0.f, 0.f, 0.f, 0.f};
        if (MODE == 0 || tj <= ti) {
#pragma unroll
            for (int kb = 0; kb < 4; ++kb) {
                const f32x4 a4 = *(const f32x4*)&X[(ti * 16 + c) * RS + kb * 16 + 4 * g];
                const f32x4 b4 = *(const f32x4*)&Y[(tj * 16 + c) * RS + kb * 16 + 4 * g];
#pragma unroll
                for (int i = 0; i < 4; ++i) acc = __builtin_amdgcn_mfma_f32_16x16x4f32(a4[i], b4[i], acc, 0, 0, 0);
            }
        }
#pragma unroll
        for (int r = 0; r < 4; ++r) {
            const int row = ti * 16 + 4 * g + r, col = tj * 16 + c;
            float v = acc[r];
            if (MODE == 1 && col >= row) v = 0.f;
            if (MODE == 2 && col > row) v = 0.f;
            out[row * RS + col] = v;
        }
    }
}
__device__ __forceinline__ f32x4 mm_nn_tile(f32x4 acc, const float* X, const float* Y, int ti, int tj, int lane, float sign) {
    const int g = lane >> 4, c = lane & 15;
#pragma unroll
    for (int kb = 0; kb < 4; ++kb) {
        const f32x4 a4 = *(const f32x4*)&X[(ti * 16 + c) * RS + kb * 16 + 4 * g];
#pragma unroll
        for (int i = 0; i < 4; ++i) acc = __builtin_amdgcn_mfma_f32_16x16x4f32(sign * a4[i], Y[(kb * 16 + 4 * g + i) * RS + tj * 16 + c], acc, 0, 0, 0);
    }
    return acc;
}
template <int T> struct FwdRow {
    static __device__ __forceinline__ void run(float (&x)[64], const float* Nm) {
        FwdRow<T - 1>::run(x, Nm);
        float acc = x[T];
#pragma unroll
        for (int s4 = 0; s4 < (T + 3) / 4; ++s4) {
            const f32x4 n4 = *(const f32x4*)&Nm[T * RS + s4 * 4];
#pragma unroll
            for (int e = 0; e < 4; ++e) if (s4 * 4 + e < T) acc -= n4[e] * x[s4 * 4 + e];
        }
        x[T] = acc;
    }
};
template <> struct FwdRow<0> { static __device__ __forceinline__ void run(float (&)[64], const float*) {} };
#define RWA_LDS (16384 + 8 * 64 * RS * 4)
__device__ __forceinline__ void ph_rw_a(CP p, int l, int bid, int nblk, char* smem) {
    h16* fs = (h16*)smem;
    float* Ah = (float*)(smem + 16384);
    float* Rh = Ah + 64 * RS; float* Bh = Rh + 64 * RS; float* Kh = Bh + 64 * RS; float* Vv = Kh + 64 * RS;
    float* Nm = Vv + 64 * RS; float* Mm = Nm + 64 * RS; float* T1 = Mm + 64 * RS;
    h16* lw_ = (h16*)Nm;
    float* tot = (float*)fs;
    float* egl = tot + 8 * 64;
    for (int u = bid; u < 1024; u += nblk) {
        int tid = otid(), lane = tid & 63, wave = tid >> 6;
        const float* mu = p.in[I_RWMU] + oint(l) * 896;
        const int h = u & 3, c = (u >> 2) & 63, b = u >> 8;
        const int t0 = c * 64; const size_t tok0 = (size_t)b * SEQ + t0;
        __syncthreads();
        for (int i = tid; i < 64 * 128; i += 512) {
            const int t = i >> 7, j = i & 127; const size_t tok = tok0 + t;
            const float cur = (float)p.proj[tok * PJ + P_RW + 768 + j];
            const float prv = (t0 + t) ? (float)p.proj[(tok - 1) * PJ + P_RW + 768 + j] : 0.f;
            float v = cur + (prv - cur) * mu[768 + j];
            if (j < 32) v = tanhf(v); else if (j >= 64) v = sigm(v);
            fs[i] = (h16)v;
        }
        for (int i = tid; i < 128 * 64; i += 512) {
            const int j = i >> 6, cc = i & 63;
            float wv;
            if (j < 32) wv = p.in[I_RWWUP][((size_t)l * 32 + j) * 256 + h * 64 + cc];
            else if (j < 64) wv = p.in[I_RWAUP][((size_t)l * 32 + (j - 32)) * 256 + h * 64 + cc];
            else wv = p.in[I_RWGUP][((size_t)l * 64 + (j - 64)) * 256 + h * 64 + cc];
            lw_[i] = (h16)wv;
        }
        __syncthreads();
        tid = otid(); lane = tid & 63; wave = tid >> 6;
        {
            const int ll = oint(l);
            const int ch = h * 64 + lane;
            const float w0 = p.in[I_RWW0][ll * 256 + ch], a0 = p.in[I_RWA0][ll * 256 + ch], kkw = p.in[I_RWKK][ll * 256 + ch], kaw = p.in[I_RWKA][ll * 256 + ch], rkw = p.in[I_RWRK][ll * 256 + ch];
            const float mur = mu[ch], muk = mu[256 + ch], muv = mu[512 + ch];
            float run = 0.f;
#pragma unroll 1
            for (int q = 0; q < 8; ++q) {
                const int t = wave * 8 + q; const size_t tok = tok0 + t;
                const h16* ft = fs + t * 128;
                float lw = 0.f, la = 0.f, lg = 0.f;
#pragma unroll 8
                for (int j = 0; j < 32; ++j) { lw += (float)ft[j] * (float)lw_[j * 64 + lane]; la += (float)ft[32 + j] * (float)lw_[(32 + j) * 64 + lane]; }
#pragma unroll 8
                for (int j = 0; j < 64; ++j) lg += (float)ft[64 + j] * (float)lw_[(64 + j) * 64 + lane];
                const h16* pc = p.proj + tok * PJ + P_RW + ch;
                const bool hp = (t0 + t) > 0;
                const float rc = (float)pc[0], kc = (float)pc[256], vc = (float)pc[512];
                const float rp = hp ? (float)pc[-(long)PJ] : 0.f, kp_ = hp ? (float)pc[256 - (long)PJ] : 0.f, vp = hp ? (float)pc[512 - (long)PJ] : 0.f;
                const float r = rc + (rp - rc) * mur, k = kc + (kp_ - kc) * muk, v = vc + (vp - vc) * muv;
                const float w = -softplusf_(-(w0 + lw)) - 0.5f;
                const float wl = -__expf(w);
                const float a = sigm(a0 + la);
                float kk = k * kkw;
                const float nrm = sqrtf(wave_sum(kk * kk));
                kk = kk / fmaxf(nrm, 1e-12f);
                const float k2 = k * (1.f + (a - 1.f) * kaw);
                const float sb = wave_sum(r * k2 * rkw);
                p.rw_g[tok * 256 + ch] = (h16)lg; p.rw_bonus[tok * 256 + ch] = (h16)(sb * v);
                run += wl;
                Ah[t * RS + lane] = kk; Rh[t * RS + lane] = r; Bh[t * RS + lane] = kk * a; Kh[t * RS + lane] = k2; Vv[t * RS + lane] = v; T1[t * RS + lane] = run;
            }
            __syncthreads();
            tot[wave * 64 + lane] = run;
            __syncthreads();
            float offs = 0.f, gl = 0.f;
#pragma unroll
            for (int w8 = 0; w8 < 8; ++w8) { const float tv = tot[w8 * 64 + lane]; if (w8 < wave) offs += tv; gl += tv; }
            if (wave == 0) { egl[lane] = __expf(gl); p.rw_gam[(size_t)u * 64 + lane] = __expf(gl); }
            float gprev = offs;
#pragma unroll 1
            for (int q = 0; q < 8; ++q) {
                const int t = wave * 8 + q;
                const float G = offs + T1[t * RS + lane];
                const float eg = __expf(G), egp = __expf(gprev), egi = __expf(-G);
                Ah[t * RS + lane] *= egp; Rh[t * RS + lane] *= eg; Bh[t * RS + lane] *= egi; Kh[t * RS + lane] *= egi;
                gprev = G;
            }
        }
        __syncthreads();
        tid = otid(); lane = tid & 63; wave = tid >> 6;
        mm_nt<1>(Nm, Ah, Bh, wave, 8, lane);
        mm_nt<1>(Mm, Ah, Kh, wave, 8, lane);
        __syncthreads();
        tid = otid(); lane = tid & 63; wave = tid >> 6;
        for (int idx = wave; idx < 16; idx += 8) {
            const int ti = idx >> 2, tj = idx & 3;
            f32x4 acc = {0.f, 0.f, 0.f, 0.f};
            acc = mm_nn_tile(acc, Mm, Vv, ti, tj, lane, 1.f);
#pragma unroll
            for (int r = 0; r < 4; ++r) T1[(ti * 16 + 4 * (lane >> 4) + r) * RS + tj * 16 + (lane & 15)] = acc[r];
        }
        __syncthreads();
        tid = otid(); lane = tid & 63; wave = tid >> 6;
        const size_t ub = (size_t)u * 4096;
        if (wave < 2) {
            float* src = wave == 0 ? Ah : T1;
            h16* og = (wave == 0 ? p.rw_W : p.rw_U0) + ub;
#pragma unroll
            for (int I = 0; I < 4; ++I) {
                float acc[16];
#pragma unroll
                for (int r = 0; r < 16; ++r) acc[r] = src[(16 * I + r) * RS + lane];
#pragma unroll 1
                for (int s4 = 0; s4 < 4 * I; ++s4) {
                    const float x0 = src[(s4 * 4 + 0) * RS + lane], x1 = src[(s4 * 4 + 1) * RS + lane], x2 = src[(s4 * 4 + 2) * RS + lane], x3 = src[(s4 * 4 + 3) * RS + lane];
#pragma unroll
                    for (int r = 0; r < 16; ++r) { const f32x4 n4 = *(const f32x4*)&Nm[(16 * I + r) * RS + s4 * 4]; acc[r] -= n4[0] * x0 + n4[1] * x1 + n4[2] * x2 + n4[3] * x3; }
                }
#pragma unroll
                for (int r = 1; r < 16; ++r) {
#pragma unroll
                    for (int q4 = 0; q4 < 4; ++q4) {
                        if (q4 * 4 < r) {
                            const f32x4 n4 = *(const f32x4*)&Nm[(16 * I + r) * RS + 16 * I + q4 * 4];
#pragma unroll
                            for (int e = 0; e < 4; ++e) if (q4 * 4 + e < r) acc[r] -= n4[e] * acc[q4 * 4 + e];
                        }
                    }
                }
#pragma unroll
                for (int r = 0; r < 16; ++r) { src[(16 * I + r) * RS + lane] = acc[r]; og[(16 * I + r) * 64 + lane] = (h16)acc[r]; }
            }
        } else {
            mm_nt<2>(Mm, Rh, Bh, wave - 2, 6, lane);
            for (int i = tid - 128; i < 4096; i += 384) { const int k = i >> 6, t = i & 63; p.rw_Be[ub + i] = (h16)(-Bh[t * RS + k] * egl_get(egl, k)); }
            for (int idx = wave - 2; idx < 16; idx += 6) {
                const int ti = idx >> 2, tj = idx & 3, g = lane >> 4, cc = lane & 15;
                f32x4 acc = {0.f, 0.f, 0.f, 0.f};
#pragma unroll
                for (int tb = 0; tb < 4; ++tb)
#pragma unroll
                    for (int i = 0; i < 4; ++i) acc = __builtin_amdgcn_mfma_f32_16x16x4f32(Kh[(tb * 16 + 4 * g + i) * RS + ti * 16 + cc], Vv[(tb * 16 + 4 * g + i) * RS + tj * 16 + cc], acc, 0, 0, 0);
#pragma unroll
                for (int r = 0; r < 4; ++r) { const int k = ti * 16 + 4 * g + r; p.rw_VK[ub + k * 64 + tj * 16 + cc] = (h16)(acc[r] * egl_get(egl, k)); }
            }
        }
        __syncthreads();
        tid = otid(); lane = tid & 63; wave = tid >> 6;
        mm_nt<2>(Nm, Rh, Kh, wave, 8, lane);
        __syncthreads();
        tid = otid(); lane = tid & 63; wave = tid >> 6;
        for (int idx = wave; idx < 16; idx += 8) {
            const int ti = idx >> 2, tj = idx & 3, g = lane >> 4, cc = lane & 15;
            f32x4 a1, a2 = {0.f, 0.f, 0.f, 0.f};
#pragma unroll
            for (int r = 0; r < 4; ++r) a1[r] = Rh[(ti * 16 + 4 * g + r) * RS + tj * 16 + cc];
            a1 = mm_nn_tile(a1, Mm, Ah, ti, tj, lane, -1.f);
            a2 = mm_nn_tile(a2, Nm, Vv, ti, tj, lane, 1.f);
            a2 = mm_nn_tile(a2, Mm, T1, ti, tj, lane, -1.f);
#pragma unroll
            for (int r = 0; r < 4; ++r) { const int row = ti * 16 + 4 * g + r, col = tj * 16 + cc; p.rw_Ry[ub + row * 64 + col] = (h16)a1[r]; p.rw_Y0[ub + row * 64 + col] = (h16)a2[r]; }
        }
    }
}
__device__ __forceinline__ void ph_rw_b(CP p, int bid, char* smem) {
    h16* Sh = (h16*)smem;
    h16* Uh = Sh + 64 * 72;
    const int tid = otid(), lane = tid & 63, wave = tid >> 6, g = lane >> 4, cc = lane & 15;
    const int vt = wave >> 1, hf = wave & 1;
    const int b = bid >> 2, h = bid & 3;
    f32x4 S[2];
    S[0] = (f32x4){0.f, 0.f, 0.f, 0.f}; S[1] = S[0];
    h16x8 Wf[2][2], Bf[2][2]; h16x4 U0i[2], VKi[2]; float gam[2];
    auto ld = [&](int c, h16x8 (&W_)[2][2], h16x8 (&B_)[2][2], h16x4 (&U_)[2], h16x4 (&V_)[2], float (&G_)[2]) {
        const size_t ub = ((size_t)(b * 64 + c) * 4 + h) * 4096;
#pragma unroll
        for (int j = 0; j < 2; ++j) {
            const int rowi = (2 * hf + j) * 16 + cc;
#pragma unroll
            for (int ks = 0; ks < 2; ++ks) { W_[j][ks] = *(const h16x8*)(p.rw_W + ub + rowi * 64 + ks * 32 + 8 * g); B_[j][ks] = *(const h16x8*)(p.rw_Be + ub + rowi * 64 + ks * 32 + 8 * g); }
            U_[j] = *(const h16x4*)(p.rw_U0 + ub + rowi * 64 + vt * 16 + 4 * g);
            V_[j] = *(const h16x4*)(p.rw_VK + ub + rowi * 64 + vt * 16 + 4 * g);
            G_[j] = p.rw_gam[((size_t)(b * 64 + c) * 4 + h) * 64 + rowi];
        }
    };
    ld(0, Wf, Bf, U0i, VKi, gam);
    for (int c = 0; c < 64; ++c) {
        h16x8 Wn[2][2], Bn[2][2]; h16x4 Un[2], Vn[2]; float Gn[2];
        if (c + 1 < 64) ld(c + 1, Wn, Bn, Un, Vn, Gn);
#pragma unroll
        for (int j = 0; j < 2; ++j)
#pragma unroll
            for (int r = 0; r < 4; ++r) Sh[(vt * 16 + 4 * g + r) * 72 + (2 * hf + j) * 16 + cc] = (h16)S[j][r];
        __syncthreads();
        { const int row = tid >> 3, kc = (tid & 7) * 8; *(h16x8*)(p.rw_S0 + ((size_t)(b * 64 + c) * 4 + h) * 4096 + row * 64 + kc) = *(const h16x8*)&Sh[row * 72 + kc]; }
        h16x8 Af[2];
#pragma unroll
        for (int ks = 0; ks < 2; ++ks) Af[ks] = *(const h16x8*)&Sh[(vt * 16 + cc) * 72 + ks * 32 + 8 * g];
        f32x4 Ut[2];
#pragma unroll
        for (int j = 0; j < 2; ++j) {
            f32x4 acc = {(float)U0i[j][0], (float)U0i[j][1], (float)U0i[j][2], (float)U0i[j][3]};
            acc = __builtin_amdgcn_mfma_f32_16x16x32_f16(Af[0], Wf[j][0], acc, 0, 0, 0);
            acc = __builtin_amdgcn_mfma_f32_16x16x32_f16(Af[1], Wf[j][1], acc, 0, 0, 0);
            Ut[j] = acc;
        }
#pragma unroll
        for (int j = 0; j < 2; ++j)
#pragma unroll
            for (int r = 0; r < 4; ++r) Uh[(vt * 16 + 4 * g + r) * 72 + (2 * hf + j) * 16 + cc] = (h16)Ut[j][r];
        __syncthreads();
#pragma unroll
        for (int ks = 0; ks < 2; ++ks) Af[ks] = *(const h16x8*)&Uh[(vt * 16 + cc) * 72 + ks * 32 + 8 * g];
#pragma unroll
        for (int j = 0; j < 2; ++j) {
            f32x4 acc;
#pragma unroll
            for (int r = 0; r < 4; ++r) acc[r] = S[j][r] * gam[j] + (float)VKi[j][r];
            acc = __builtin_amdgcn_mfma_f32_16x16x32_f16(Af[0], Bf[j][0], acc, 0, 0, 0);
            acc = __builtin_amdgcn_mfma_f32_16x16x32_f16(Af[1], Bf[j][1], acc, 0, 0, 0);
            S[j] = acc;
        }
        if (c + 1 < 64) {
#pragma unroll
            for (int j = 0; j < 2; ++j) { Wf[j][0] = Wn[j][0]; Wf[j][1] = Wn[j][1]; Bf[j][0] = Bn[j][0]; Bf[j][1] = Bn[j][1]; U0i[j] = Un[j]; VKi[j] = Vn[j]; gam[j] = Gn[j]; }
        }
    }
}
__device__ __forceinline__ void ph_rw_c(CP p, int l, int bid, int nblk) {
    const int tid = otid(), lane = tid & 63, wave = tid >> 6, g = lane >> 4, cc = lane & 15;
    const int h = wave >> 1, th = wave & 1;
    for (int u = bid; u < 256; u += nblk) {
        const int b = u >> 6, c = u & 63;
        const size_t ub = ((size_t)(b * 64 + c) * 4 + h) * 4096;
        h16x8 Af[4][2];
#pragma unroll
        for (int vt = 0; vt < 4; ++vt)
#pragma unroll
            for (int ks = 0; ks < 2; ++ks) Af[vt][ks] = *(const h16x8*)(p.rw_S0 + ub + (vt * 16 + cc) * 64 + ks * 32 + 8 * g);
#pragma unroll
        for (int j = 0; j < 2; ++j) {
            const int t = (2 * th + j) * 16 + cc;
            const h16x8 B0 = *(const h16x8*)(p.rw_Ry + ub + t * 64 + 8 * g), B1 = *(const h16x8*)(p.rw_Ry + ub + t * 64 + 32 + 8 * g);
            f32x4 y[4]; float sum = 0.f;
#pragma unroll
            for (int vt = 0; vt < 4; ++vt) {
                const h16x4 yi = *(const h16x4*)(p.rw_Y0 + ub + t * 64 + vt * 16 + 4 * g);
                f32x4 acc = {(float)yi[0], (float)yi[1], (float)yi[2], (float)yi[3]};
                acc = __builtin_amdgcn_mfma_f32_16x16x32_f16(Af[vt][0], B0, acc, 0, 0, 0);
                acc = __builtin_amdgcn_mfma_f32_16x16x32_f16(Af[vt][1], B1, acc, 0, 0, 0);
                y[vt] = acc; sum += acc[0] + acc[1] + acc[2] + acc[3];
            }
            sum += __shfl_xor(sum, 16); sum += __shfl_xor(sum, 32);
            const float mean = sum * (1.f / 64.f);
            float vs = 0.f;
#pragma unroll
            for (int vt = 0; vt < 4; ++vt)
#pragma unroll
                for (int r = 0; r < 4; ++r) { const float d = y[vt][r] - mean; vs += d * d; }
            vs += __shfl_xor(vs, 16); vs += __shfl_xor(vs, 32);
            const float rstd = rsqrtf(vs * (1.f / 64.f) + 64e-5f);
            const size_t tok = (size_t)b * SEQ + c * 64 + t;
#pragma unroll
            for (int vt = 0; vt < 4; ++vt) {
                const int ch = h * 64 + vt * 16 + 4 * g;
                const f32x4 gw = *(const f32x4*)(p.in[I_RWGNW] + l * 256 + ch), gb = *(const f32x4*)(p.in[I_RWGNB] + l * 256 + ch);
                const h16x4 bo = *(const h16x4*)(p.rw_bonus + tok * 256 + ch), gg = *(const h16x4*)(p.rw_g + tok * 256 + ch);
                float o[4];
#pragma unroll
                for (int r = 0; r < 4; ++r) o[r] = ((y[vt][r] - mean) * rstd * gw[r] + gb[r] + (float)bo[r]) * (float)gg[r];
                *(h16x4*)(p.branches + tok * DM + 768 + ch) = pack4(o[0], o[1], o[2], o[3]);
            }
        }
    }
}

__device__ __forceinline__ void ph_dsa_pre(CP p, int bid, int nblk) {
    const int lane = otid() & 63, wv = otid() >> 6;
    for (int tok = bid * 8 + wv; tok < NTOK; tok += nblk * 8) {
        const int i = lane & 31;
        const float c = p.ropet[((size_t)tok * 32 + i) * 2], s = p.ropet[((size_t)tok * 32 + i) * 2 + 1];
        const int base = (lane < 32) ? P_Q : P_K;
        h16* dst = p.proj + (size_t)tok * PJ + base;
        const float scl = (lane < 32) ? 0.125f : 1.f;
#pragma unroll
        for (int h = 0; h < 4; ++h) {
            const float x1 = (float)dst[h * 64 + i], x2 = (float)dst[h * 64 + 32 + i];
            dst[h * 64 + i] = (h16)((x1 * c - x2 * s) * scl);
            dst[h * 64 + 32 + i] = (h16)((x2 * c + x1 * s) * scl);
        }
        const int i2 = lane & 15;
        const float c2 = p.ropet[((size_t)tok * 32 + 2 * i2) * 2], s2 = p.ropet[((size_t)tok * 32 + 2 * i2) * 2 + 1];
        float* xf = p.idxf + (size_t)tok * IDXLD;
        if (lane < 16) {
#pragma unroll
            for (int h = 0; h < 4; ++h) {
                const float x1 = xf[h * 32 + i2], x2 = xf[h * 32 + 16 + i2];
                xf[h * 32 + i2] = x1 * c2 - x2 * s2;
                xf[h * 32 + 16 + i2] = x2 * c2 + x1 * s2;
            }
        } else if (lane < 32) {
            const float x1 = xf[128 + i2], x2 = xf[128 + 16 + i2];
            xf[128 + i2] = x1 * c2 - x2 * s2;
            xf[128 + 16 + i2] = x2 * c2 + x1 * s2;
        }
    }
}
__device__ __forceinline__ unsigned f2key(float x) { unsigned u = __float_as_uint(x); return (u & 0x80000000u) ? ~u : (u | 0x80000000u); }
__device__ __forceinline__ void ph_dsa_naive(CP p, int bid, int nblk, char* smem) {
    const int lane = otid() & 63, wv = otid() >> 6;
    unsigned* s_key = (unsigned*)smem + wv * 4096;
    float* s_p = (float*)s_key;
    float* s_iq = (float*)(smem + 8 * 4096 * 4) + wv * 128;
    float* s_q = (float*)(smem + 8 * 4096 * 4 + 8 * 128 * 4) + wv * 256;
    int* s_list = (int*)(smem + 8 * 4096 * 4 + 8 * 128 * 4 + 8 * 256 * 4) + wv * 256;
    const unsigned long long lt_mask = (lane == 0) ? 0ull : (~0ull >> (64 - lane));
    for (int tok = bid * 8 + wv; tok < NTOK; tok += nblk * 8) {
        const int b = tok / SEQ, t = tok % SEQ;
        s_iq[lane] = p.idxf[(size_t)tok * IDXLD + lane]; s_iq[64 + lane] = p.idxf[(size_t)tok * IDXLD + 64 + lane];
        for (int i = 0; i < 4; ++i) s_q[i * 64 + lane] = (float)p.proj[(size_t)tok * PJ + P_Q + i * 64 + lane];
        const float w0 = p.idxf[(size_t)tok * IDXLD + 160], w1 = p.idxf[(size_t)tok * IDXLD + 161], w2 = p.idxf[(size_t)tok * IDXLD + 162], w3 = p.idxf[(size_t)tok * IDXLD + 163];
        __builtin_amdgcn_s_waitcnt(0); __builtin_amdgcn_wave_barrier();
        const int n = t + 1;
        const int nch = (t >> 6) + 1;
#pragma unroll 1
        for (int i = 0; i < nch; ++i) {
            const int s = lane + 64 * i;
            unsigned kv_ = 0u;
            if (s <= t) {
                const float* kp = p.idxf + ((size_t)b * SEQ + s) * IDXLD + 128;
                float d0 = 0.f, d1 = 0.f, d2 = 0.f, d3 = 0.f;
#pragma unroll
                for (int d4 = 0; d4 < 8; ++d4) {
                    const f32x4 kv = *(const f32x4*)(kp + d4 * 4);
#pragma unroll
                    for (int e = 0; e < 4; ++e) { const int d = d4 * 4 + e; d0 += s_iq[d] * kv[e]; d1 += s_iq[32 + d] * kv[e]; d2 += s_iq[64 + d] * kv[e]; d3 += s_iq[96 + d] * kv[e]; }
                }
                const float sc = w0 * fmaxf(d0, 0.f) + w1 * fmaxf(d1, 0.f) + w2 * fmaxf(d2, 0.f) + w3 * fmaxf(d3, 0.f);
                kv_ = f2key(sc + 0.f);
            }
            s_key[s] = kv_;
        }
        __builtin_amdgcn_s_waitcnt(0); __builtin_amdgcn_wave_barrier();
        int cnt_sel;
        if (n <= 256) {
            for (int i = 0; i < 4; ++i) { const int s = lane + 64 * i; if (s <= t) s_list[s] = s; }
            cnt_sel = n;
        } else {
            unsigned v = 0u;
#pragma unroll 1
            for (int bit = 31; bit >= 0; --bit) {
                const unsigned cand = v | (1u << bit);
                int c = 0;
#pragma unroll 4
                for (int i = 0; i < nch; ++i) c += __popcll(__ballot(s_key[lane + 64 * i] >= cand));
                if (c >= 256) v = cand;
            }
            int cgt = 0;
#pragma unroll 4
            for (int i = 0; i < nch; ++i) cgt += __popcll(__ballot(s_key[lane + 64 * i] > v));
            const int need = 256 - cgt;
            int nsel = 0, nties = 0;
#pragma unroll 1
            for (int i = 0; i < nch; ++i) {
                const unsigned kx = s_key[lane + 64 * i];
                const bool gt = kx > v, eq = kx == v;
                const unsigned long long eqm = __ballot(eq);
                const int trank = nties + __popcll(eqm & lt_mask);
                const bool sel = gt || (eq && trank < need);
                const unsigned long long sm = __ballot(sel);
                if (sel) s_list[nsel + __popcll(sm & lt_mask)] = lane + 64 * i;
                nsel += __popcll(sm); nties += __popcll(eqm);
            }
            cnt_sel = nsel;
        }
        __builtin_amdgcn_s_waitcnt(0); __builtin_amdgcn_wave_barrier();
        float lg[4][4];
#pragma unroll
        for (int jj = 0; jj < 4; ++jj) {
            const int j = lane + 64 * jj;
#pragma unroll
            for (int h = 0; h < 4; ++h) lg[jj][h] = -INFINITY;
            if (j < cnt_sel) {
                const int s = s_list[j];
                const h16* kp = p.proj + ((size_t)b * SEQ + s) * PJ + P_K;
#pragma unroll
                for (int h = 0; h < 4; ++h) {
                    float a = 0.f;
#pragma unroll
                    for (int d8 = 0; d8 < 8; ++d8) { const h16x8 kv = *(const h16x8*)(kp + h * 64 + d8 * 8);
#pragma unroll
                        for (int e = 0; e < 8; ++e) a += s_q[h * 64 + d8 * 8 + e] * (float)kv[e]; }
                    lg[jj][h] = a;
                }
            }
        }
        float inv[4];
#pragma unroll
        for (int h = 0; h < 4; ++h) {
            float m = fmaxf(fmaxf(lg[0][h], lg[1][h]), fmaxf(lg[2][h], lg[3][h]));
            m = wave_max(m);
            float sm = 0.f;
#pragma unroll
            for (int jj = 0; jj < 4; ++jj) { const float e = (lane + 64 * jj < cnt_sel) ? __expf(lg[jj][h] - m) : 0.f; s_p[h * 256 + lane + 64 * jj] = e; sm += e; }
            sm = wave_sum(sm);
            inv[h] = 1.f / sm;
        }
        __builtin_amdgcn_s_waitcnt(0); __builtin_amdgcn_wave_barrier();
        const int hh = lane >> 4;
        float o0 = 0.f, o1 = 0.f, o2 = 0.f, o3 = 0.f;
#pragma unroll 4
        for (int j = 0; j < cnt_sel; ++j) {
            const int s = s_list[j]; const float pj = s_p[hh * 256 + j];
            const h16x4 vv = *(const h16x4*)(p.proj + ((size_t)b * SEQ + s) * PJ + P_V + lane * 4);
            o0 += pj * (float)vv[0]; o1 += pj * (float)vv[1]; o2 += pj * (float)vv[2]; o3 += pj * (float)vv[3];
        }
        const float iv = (hh == 0) ? inv[0] : (hh == 1) ? inv[1] : (hh == 2) ? inv[2] : inv[3];
        *(h16x4*)(p.branches + (size_t)tok * DM + 256 + lane * 4) = pack4(o0 * iv, o1 * iv, o2 * iv, o3 * iv);
        __builtin_amdgcn_s_waitcnt(0); __builtin_amdgcn_wave_barrier();
    }
}
#define DSA_NAIVE_LDS (8 * 4096 * 4 + 8 * 128 * 4 + 8 * 256 * 4 + 8 * 256 * 4)

__device__ __forceinline__ void ph_merge(CP p, int l, int bid, int nblk, char* smem) {
    for (int u = bid; u < 128 * 8; u += nblk) {
        const int mt = u >> 3, nt = u & 7, m0 = mt * 128, n0 = nt * 128;
        f32x4 mx[2][4]; zero_acc<128>(mx);
        const int lane = otid() & 63, wave = otid() >> 6, wn = wave & 1;
        for (int n = 0; n < 4; ++n) {
            f32x4 ag[2][4], au[2][4]; zero_acc<128>(ag); zero_acc<128>(au);
            const h16* A = p.h_hi + (size_t)m0 * DM; const h16* B = p.Wg + ((size_t)n * 1024 + n0) * DM;
            gemm_kloop<128>(smem, DM, [=](int r, int k) { return A + (size_t)r * DM + k; }, [=](int r, int k) { return B + (size_t)r * DM + k; }, ag);
            const h16* A2 = p.branches + (size_t)m0 * DM + n * 256; const h16* B2 = p.Wb + ((size_t)n * 1024 + n0) * 256;
            gemm_kloop<128>(smem, 256, [=](int r, int k) { return A2 + (size_t)r * DM + k; }, [=](int r, int k) { return B2 + (size_t)r * 256 + k; }, au);
            const float* gb = p.in[I_GATEB] + (size_t)l * 4096 + n * 1024 + n0 + wn * 64 + 4 * (lane >> 4);
#pragma unroll
            for (int j = 0; j < 4; ++j) {
                const f32x4 bb = *(const f32x4*)(gb + j * 16);
#pragma unroll
                for (int i = 0; i < 2; ++i)
#pragma unroll
                    for (int e = 0; e < 4; ++e) mx[i][j][e] += sigm(ag[i][j][e] + bb[e]) * au[i][j][e];
            }
        }
        h16* O = p.mixed + (size_t)m0 * DM + n0;
        gemm_epi<128>(mx, [=](int ml, int nl, f32x4 v) { *(h16x4*)(O + (size_t)ml * DM + nl) = pack4(v[0], v[1], v[2], v[3]); });
    }
}
__device__ __forceinline__ void ph_outproj(CP p, int l, int bid, int nblk, char* smem) {
    const float* xin = l == 0 ? p.in[I_X] : p.x1;
    for (int u = bid; u < 64 * 8; u += nblk) {
        const int mt = u >> 3, nt = u & 7, m0 = mt * 256, n0 = nt * 128;
        f32x4 acc[4][4]; zero_acc<256>(acc);
        const h16* A = p.mixed + (size_t)m0 * DM; const h16* B = p.Wo + (size_t)n0 * DM;
        gemm_kloop<256>(smem, DM, [=](int r, int k) { return A + (size_t)r * DM + k; }, [=](int r, int k) { return B + (size_t)r * DM + k; }, acc);
        const float* g1 = p.mods + ((size_t)l * 4 + (m0 / SEQ)) * 6144 + 2 * 1024 + n0;
        const float* X = xin + (size_t)m0 * DM + n0; float* O = p.x1 + (size_t)m0 * DM + n0;
        gemm_epi<256>(acc, [=](int ml, int nl, f32x4 v) { const f32x4 xv = *(const f32x4*)(X + (size_t)ml * DM + nl), gg = *(const f32x4*)(g1 + nl);
                                                          *(f32x4*)(O + (size_t)ml * DM + nl) = xv + gg * v; });
    }
}

__constant__ int c_pair_lo[6] = {0, 0, 0, 1, 1, 2};
__constant__ int c_pair_hi[6] = {1, 2, 3, 2, 3, 3};
__device__ __forceinline__ void ph_norm2_router(CP p, int l, int bid, int nblk, char* smem) {
    float* rw = (float*)smem;
    for (int i = otid(); i < DM * 16; i += 512) rw[i] = p.in[I_ROUTW][i];
    __syncthreads();
    const int lane = otid() & 63, wv = otid() >> 6;
    for (int tok = bid * 8 + wv; tok < NTOK; tok += nblk * 8) {
        const int b = tok / SEQ;
        const float* xr = p.x1 + (size_t)tok * DM;
        f32x4 v[4]; float ss = 0.f;
#pragma unroll
        for (int i = 0; i < 4; ++i) { v[i] = *(const f32x4*)(xr + i * 256 + lane * 4); ss += v[i][0] * v[i][0] + v[i][1] * v[i][1] + v[i][2] * v[i][2] + v[i][3] * v[i][3]; }
        ss = wave_sum(ss);
        const float rs = rsqrtf(ss * (1.f / DM) + 1e-6f);
        const float* g = p.in[I_FNG] + l * DM;
        const float* md = p.mods + ((size_t)l * 4 + b) * 6144;
        float lg[16];
#pragma unroll
        for (int e = 0; e < 16; ++e) lg[e] = 0.f;
#pragma unroll 1
        for (int i = 0; i < 4; ++i) {
            const int c = i * 256 + lane * 4;
            f32x4 gg = *(const f32x4*)(g + c), sh = *(const f32x4*)(md + 3 * 1024 + c), sc = *(const f32x4*)(md + 4 * 1024 + c);
            float hv[4];
#pragma unroll
            for (int e = 0; e < 4; ++e) hv[e] = v[i][e] * rs * gg[e] * (1.f + sc[e]) + sh[e];
            *(h16x4*)(p.h_hi + (size_t)tok * DM + c) = pack4(hv[0], hv[1], hv[2], hv[3]);
#pragma unroll 1
            for (int e = 0; e < 4; ++e) {
                const float* rr = rw + (c + e) * 16;
                const float hve = e == 0 ? hv[0] : e == 1 ? hv[1] : e == 2 ? hv[2] : hv[3];
#pragma unroll
                for (int x4 = 0; x4 < 4; ++x4) { const f32x4 r4 = *(const f32x4*)(rr + x4 * 4); lg[x4 * 4] += hve * r4[0]; lg[x4 * 4 + 1] += hve * r4[1]; lg[x4 * 4 + 2] += hve * r4[2]; lg[x4 * 4 + 3] += hve * r4[3]; }
            }
        }
#pragma unroll
        for (int e = 0; e < 16; ++e) lg[e] = wave_sum(lg[e]);
        if (lane == 0) {
            float sc[16], bi[16];
#pragma unroll
            for (int e = 0; e < 16; ++e) { sc[e] = 1.f / (1.f + expf(-lg[e])); bi[e] = sc[e] + p.in[I_ROUTB][e]; }
            int bg = 0; float bgs = -INFINITY;
#pragma unroll
            for (int gI = 0; gI < 4; ++gI) {
                float m1 = -INFINITY, m2 = -INFINITY;
#pragma unroll
                for (int j = 0; j < 4; ++j) { const float x = bi[gI * 4 + j]; if (x > m1) { m2 = m1; m1 = x; } else if (x > m2) m2 = x; }
                const float gs = m1 + m2;
                if (gs > bgs) { bgs = gs; bg = gI; }
            }
            int e0 = 0; float b0 = -INFINITY;
#pragma unroll
            for (int j = 0; j < 4; ++j) { float x = -INFINITY;
#pragma unroll
                for (int gI = 0; gI < 4; ++gI) if (gI == bg) x = bi[gI * 4 + j];
                if (x > b0) { b0 = x; e0 = j; } }
            int e1 = 0; float b1 = -INFINITY;
#pragma unroll
            for (int j = 0; j < 4; ++j) { float x = -INFINITY;
#pragma unroll
                for (int gI = 0; gI < 4; ++gI) if (gI == bg) x = bi[gI * 4 + j];
                if (j != e0 && x > b1) { b1 = x; e1 = j; } }
            float s0 = 0.f, s1 = 0.f;
#pragma unroll
            for (int e = 0; e < 16; ++e) { if (e == bg * 4 + e0) s0 = sc[e]; if (e == bg * 4 + e1) s1 = sc[e]; }
            const float wsum = s0 + s1; const float wa = s0 / wsum, wb = s1 / wsum;
            const int lo = e0 < e1 ? e0 : e1, hi = e0 < e1 ? e1 : e0;
            const float clo = e0 < e1 ? wa : wb, chi = e0 < e1 ? wb : wa;
            int pr = 0;
#pragma unroll
            for (int q = 0; q < 6; ++q) if (c_pair_lo[q] == lo && c_pair_hi[q] == hi) pr = q;
            const int bucket = bg * 6 + pr;
            const int pos = atomicAdd(&p.bcnt[bucket], 1);
            p.lists[(size_t)bucket * LCAP + pos] = tok;
            p.cw[(size_t)tok * 2] = clo; p.cw[(size_t)tok * 2 + 1] = chi;
        }
    }
}

struct MoeTile { int bucket, i0, cnt, ea, eb; };
__device__ __forceinline__ bool moe_tile(const int* bcnt, int mt, MoeTile& o) {
    int acc = 0;
    for (int b = 0; b < 24; ++b) {
        const int c = bcnt[b]; const int nt = (c + 127) >> 7;
        if (mt < acc + nt) { o.bucket = b; o.i0 = (mt - acc) * 128; o.cnt = c; const int g = b / 6, pr = b % 6; o.ea = g * 4 + c_pair_lo[pr]; o.eb = g * 4 + c_pair_hi[pr]; return true; }
        acc += nt;
    }
    return false;
}
#define MOE_MAXT 152
__device__ __forceinline__ void ph_moe1(CP p, int bid, int nblk, char* smem) {
    for (int u = bid; u < MOE_MAXT * 16; u += nblk) {
        const int mt = u >> 4, nt = u & 15;
        MoeTile T; if (!moe_tile(p.bcnt, mt, T)) break;
        const int* lst = p.lists + (size_t)T.bucket * LCAP; const int i0 = T.i0, cnt = T.cnt;
        const h16* H = p.h_hi;
        const int second = nt >= 8;
        const h16* B = p.We13 + ((size_t)(second ? T.eb : T.ea) * 1024 + (nt & 7) * 128) * DM;
        f32x4 acc[2][4]; zero_acc<128>(acc);
        gemm_kloop<128>(smem, DM, [=](int r, int k) { const int i = i0 + r; const int tok = lst[i < cnt ? i : 0]; return H + (size_t)tok * DM + k; },
                        [=](int r, int k) { return B + (size_t)r * DM + k; }, acc);
        const int lane = otid() & 63, wave = otid() >> 6, wm = wave >> 1, wn = wave & 1;
#pragma unroll
        for (int i = 0; i < 2; ++i) {
            const int ml = wm * 32 + i * 16 + (lane & 15);
            const int ii = i0 + ml; const bool valid = ii < cnt;
            const float cwv = valid ? p.cw[(size_t)lst[ii] * 2 + second] : 0.f;
            h16* O = p.act + ((size_t)mt * 128 + ml) * 1024 + second * 512;
#pragma unroll
            for (int jj = 0; jj < 2; ++jj) {
                const f32x4 a = acc[i][2 * jj], bq = acc[i][2 * jj + 1];
                const int col = ((nt & 7) * 128 + wn * 64 + jj * 32) / 2 + 4 * (lane >> 4);
                float o[4];
#pragma unroll
                for (int e = 0; e < 4; ++e) o[e] = valid ? cwv * (a[e] * sigm(a[e])) * bq[e] : 0.f;
                *(h16x4*)(O + col) = pack4(o[0], o[1], o[2], o[3]);
            }
        }
    }
}
__device__ __forceinline__ void ph_moe2(CP p, int l, int bid, int nblk, char* smem) {
    for (int u = bid; u < MOE_MAXT * 8; u += nblk) {
        const int mt = u >> 3, nt = u & 7, n0 = nt * 128;
        MoeTile T; if (!moe_tile(p.bcnt, mt, T)) break;
        const int* lst = p.lists + (size_t)T.bucket * LCAP; const int i0 = T.i0, cnt = T.cnt;
        const h16* A = p.act + (size_t)mt * 128 * 1024;
        const h16* Ba = p.We2 + ((size_t)T.ea * 1024 + n0) * 512; const h16* Bb = p.We2 + ((size_t)T.eb * 1024 + n0) * 512;
        f32x4 acc[2][4]; zero_acc<128>(acc);
        gemm_kloop<128>(smem, 1024, [=](int r, int k) { return A + (size_t)r * 1024 + k; },
                        [=](int r, int k) { return (k < 512 ? Ba + k : Bb + (k - 512)) + (size_t)r * 512; }, acc);
        const float* md = p.mods + (size_t)l * 4 * 6144 + 5 * 1024 + n0;
        float* X = p.x1;
        gemm_epi<128>(acc, [=](int ml, int nl, f32x4 v) { const int ii = i0 + ml; if (ii < cnt) { const int tok = lst[ii]; const f32x4 gg = *(const f32x4*)(md + (size_t)(tok / SEQ) * 6144 + nl);
                                                          float* xp = X + (size_t)tok * DM + n0 + nl; *(f32x4*)xp = *(const f32x4*)xp + gg * v; } });
    }
}
__device__ __forceinline__ void ph_final(CP p, int bid, int nblk) {
    const int lane = otid() & 63, wv = otid() >> 6;
    for (int tok = bid * 8 + wv; tok < NTOK; tok += nblk * 8) {
        const float* xr = p.x1 + (size_t)tok * DM;
        f32x4 v[4]; float ss = 0.f;
#pragma unroll
        for (int i = 0; i < 4; ++i) { v[i] = *(const f32x4*)(xr + i * 256 + lane * 4); ss += v[i][0] * v[i][0] + v[i][1] * v[i][1] + v[i][2] * v[i][2] + v[i][3] * v[i][3]; }
        ss = wave_sum(ss);
        const float rs = rsqrtf(ss * (1.f / DM) + 1e-6f);
#pragma unroll
        for (int i = 0; i < 4; ++i) { const int c = i * 256 + lane * 4; const f32x4 gg = *(const f32x4*)(p.in[I_FINALG] + c); *(f32x4*)(p.out + (size_t)tok * DM + c) = v[i] * rs * gg; }
    }
}

#define XB_TMO      128
#define XB_XCNT(j)  (256  + 64 * (j))
#define XB_XSUB(j)  (1280 + 64 * (j))
#define XB_XGEN(j)  (2304 + 64 * (j))
#define XB_TOP      3328
#define XB_TOPGEN   3392
#define XCD_BAR_WORDS 3456
#define XB_SPIN_CAP (1u << 24)
#define LAS __attribute__((address_space(3)))

__device__ __forceinline__ unsigned xb_ld(unsigned* p)              { return __hip_atomic_load(p, __ATOMIC_RELAXED, __HIP_MEMORY_SCOPE_AGENT); }
__device__ __forceinline__ unsigned xb_add(unsigned* p, unsigned v) { return __hip_atomic_fetch_add(p, v, __ATOMIC_RELAXED, __HIP_MEMORY_SCOPE_AGENT); }
__device__ __forceinline__ unsigned xb_xcc_id() { return (unsigned)__builtin_amdgcn_s_getreg((3 << 11) | 20) & 0xFu; }
#define XB_SPIN(cond, bar) do { unsigned _sp = 0; while (cond) { __builtin_amdgcn_s_sleep(1); \
    if ((++_sp & 255u) == 0u) { if (xb_ld(&(bar)[XB_TMO])) break; if (_sp > XB_SPIN_CAP) { atomicAdd(&(bar)[XB_TMO], 1u); break; } } } } while (0)

struct XcdBarrier { unsigned* bar; unsigned x; volatile LAS unsigned* st; };

__device__ __forceinline__ XcdBarrier xcd_barrier_post(unsigned* bar, volatile LAS unsigned* st) {
    XcdBarrier b; b.bar = bar; b.x = xb_xcc_id(); b.st = st;
    if (threadIdx.x == 0) (void)xb_add(&bar[XB_XCNT(b.x)], 1u);
    return b;
}
__device__ __forceinline__ void xcd_barrier_complete(unsigned* bar, unsigned x, unsigned& nloc, unsigned& nx) {
    const unsigned G = gridDim.x * gridDim.y * gridDim.z;
    unsigned sum, cnt, mine, sp = 0u;
    for (;;) {
        sum = 0u; cnt = 0u; mine = 0u;
#pragma unroll
        for (unsigned j = 0; j < 16; ++j) { const unsigned c = xb_ld(&bar[XB_XCNT(j)]); sum += c; cnt += (c > 0u) ? 1u : 0u; mine = (j == x) ? c : mine; }
        if (sum == G) break;
        __builtin_amdgcn_s_sleep(1);
        if ((++sp & 255u) == 0u) { if (xb_ld(&bar[XB_TMO])) break; if (sp > XB_SPIN_CAP) { atomicAdd(&bar[XB_TMO], 1u); break; } }
    }
    nloc = mine > 0u ? mine : 1u; nx = cnt > 0u ? cnt : 1u;
}
__device__ __forceinline__ void xcd_barrier(const XcdBarrier& b) {
    asm volatile("s_waitcnt vmcnt(0)" ::: "memory");
    __syncthreads();
    if (threadIdx.x == 0) {
        unsigned* bar = b.bar;
        __builtin_amdgcn_s_waitcnt(0);
        unsigned nloc = b.st[0], nx = b.st[1];
        if (nloc == 0u) { xcd_barrier_complete(bar, b.x, nloc, nx); b.st[0] = nloc; b.st[1] = nx; }
        const unsigned old = xb_add(&bar[XB_XSUB(b.x)], 1u);
        const unsigned gen = old / nloc;
        if (old + 1u == (gen + 1u) * nloc) {
            __builtin_amdgcn_fence(__ATOMIC_RELEASE, "agent");
            asm volatile("s_waitcnt vmcnt(0)" ::: "memory");
            const unsigned og = xb_add(&bar[XB_TOP], 1u);
            const unsigned tg = og / nx;
            if (og + 1u == (tg + 1u) * nx) xb_add(&bar[XB_TOPGEN], 1u);
            else XB_SPIN(xb_ld(&bar[XB_TOPGEN]) == tg, bar);
            __builtin_amdgcn_fence(__ATOMIC_ACQUIRE, "agent");
            xb_add(&bar[XB_XGEN(b.x)], 1u);
            asm volatile("s_waitcnt vmcnt(0)" ::: "memory");
        } else {
            XB_SPIN(xb_ld(&bar[XB_XGEN(b.x)]) == gen, bar);
            __builtin_amdgcn_fence(__ATOMIC_ACQUIRE, "agent");
            asm volatile("s_waitcnt vmcnt(0)" ::: "memory");
        }
    }
    __syncthreads();
}

__device__ __forceinline__ const __attribute__((address_space(4))) Params* lp(const __attribute__((address_space(4))) Params* q) { asm volatile("" : "+s"(q)); return q; }
#define MEGA_LDS 155648
__global__ void __launch_bounds__(512) k_mega(Params p) {
    extern __shared__ __attribute__((aligned(16))) char smem[];
    __shared__ uint4 xb_words;
    if (threadIdx.x == 0) xb_words = make_uint4(0u, 0u, 0u, 0u);
    __syncthreads();
    XcdBarrier bar = xcd_barrier_post(p.bar, (volatile LAS unsigned*)&xb_words);
    const int bid0 = blockIdx.x, nblk0 = gridDim.x;
    const __attribute__((address_space(4))) Params* kp = (const __attribute__((address_space(4))) Params*)__builtin_amdgcn_kernarg_segment_ptr();
#define PQ (*lp(kp))
#define BID oint(bid0)
#define NBLK oint(nblk0)
    ph_mods(PQ, BID, NBLK, smem);
    ph_tables(PQ, BID, NBLK);
    ph_convert_mix(PQ, 0, BID, NBLK);
    xcd_barrier(bar);
    for (int l0 = 0; l0 < 2; ++l0) {
#define LL oint(l0)
        ph_norm1(PQ, LL, BID, NBLK);
        xcd_barrier(bar);
        ph_gemm1(PQ, BID, NBLK, smem);
        xcd_barrier(bar);
        ph_s5_scan<1>(PQ, LL, BID, NBLK);
        __syncthreads();
        ph_rg_a(PQ, LL, BID, NBLK, smem);
        __syncthreads();
        ph_rw_a(PQ, LL, BID, NBLK, smem);
        __syncthreads();
        ph_dsa_pre(PQ, BID, NBLK);
        xcd_barrier(bar);
        if (BID < 16) ph_rw_b(PQ, BID, smem);
        else {
            ph_s5_carry(PQ, LL, BID - 16, NBLK - 16);
            ph_rg_c(PQ, LL, BID - 16, NBLK - 16, smem);
            __syncthreads();
            ph_dsa_naive(PQ, BID - 16, NBLK - 16, smem);
        }
        xcd_barrier(bar);
        ph_s5_scan<3>(PQ, LL, BID, NBLK);
        ph_rw_c(PQ, LL, BID, NBLK);
        xcd_barrier(bar);
        ph_s5_glu(PQ, LL, BID, NBLK, smem);
        xcd_barrier(bar);
        ph_merge(PQ, LL, BID, NBLK, smem);
        xcd_barrier(bar);
        ph_outproj(PQ, LL, BID, NBLK, smem);
        ph_convert_moe(PQ, LL, BID, NBLK);
        xcd_barrier(bar);
        ph_norm2_router(PQ, LL, BID, NBLK, smem);
        if (LL == 0) ph_convert_mix(PQ, 1, BID, NBLK);
        xcd_barrier(bar);
        ph_moe1(PQ, BID, NBLK, smem);
        xcd_barrier(bar);
        ph_moe2(PQ, LL, BID, NBLK, smem);
        xcd_barrier(bar);
    }
    ph_final(PQ, BID, NBLK);
}

static inline size_t al(size_t x) { return (x + 255) & ~(size_t)255; }
extern "C" void kernel_launch(void* const* d_in, const int* in_sizes, int n_in, void* d_out, int out_size, void* d_ws, size_t ws_size, hipStream_t stream) {
    Params p{};
    for (int i = 0; i < N_IN; ++i) p.in[i] = (const float*)d_in[i];
    p.pos = (const int*)d_in[I_POS];
    p.out = (float*)d_out;
    char* w = (char*)d_ws; size_t off = 0;
    auto take = [&](size_t bytes) { char* r = w + off; off += al(bytes); return r; };
    p.bar = (unsigned*)take(XCD_BAR_WORDS * 4);
    p.mods = (float*)take(2 * 4 * 6144 * 4);
    p.bcnt = (int*)take(256);
    p.s5c = (float*)take((size_t)2 * 16 * 64 * 36 * 4); p.ropet = (float*)take((size_t)NTOK * 32 * 2 * 4);
    p.Wp = (h16*)take((size_t)PJ * DM * 2); p.Widx = (h16*)take((size_t)256 * 3072 * 2); p.Wg = (h16*)take((size_t)4096 * DM * 2);
    p.Wb = (h16*)take((size_t)4096 * 256 * 2); p.Wo = (h16*)take((size_t)DM * DM * 2); p.Wglu = (h16*)take(256 * 256 * 2);
    p.x1 = (float*)take((size_t)NTOK * DM * 4);
    p.h_hi = (h16*)take((size_t)NTOK * DM * 2); p.h_lo = (h16*)take((size_t)NTOK * DM * 2); p.branches = p.h_lo;
    p.cw = (float*)take((size_t)NTOK * 2 * 4);
    p.lists = (int*)take((size_t)24 * LCAP * 4);
    const size_t offR = off;
    p.proj = (h16*)take((size_t)NTOK * PJ * 2); p.idxf = (float*)take((size_t)NTOK * IDXLD * 4);
    p.ybuf = (h16*)take((size_t)NTOK * 256 * 2); p.s5E = (float*)take((size_t)4 * 64 * 16 * 64 * 2 * 4); p.s5H = (float*)take((size_t)4 * 64 * 16 * 64 * 2 * 4);
    p.rg_hl = (float*)take((size_t)NTOK * 256 * 4); p.rg_cp = (float*)take((size_t)NTOK * 256 * 4); p.rg_agg = (float*)take((size_t)4 * 128 * 256 * 2 * 4);
    p.rw_g = (h16*)take((size_t)NTOK * 256 * 2); p.rw_bonus = (h16*)take((size_t)NTOK * 256 * 2);
    p.rw_W = (h16*)take((size_t)1024 * 4096 * 2); p.rw_U0 = (h16*)take((size_t)1024 * 4096 * 2); p.rw_Ry = (h16*)take((size_t)1024 * 4096 * 2); p.rw_Y0 = (h16*)take((size_t)1024 * 4096 * 2);
    p.rw_Be = (h16*)take((size_t)1024 * 4096 * 2); p.rw_VK = (h16*)take((size_t)1024 * 4096 * 2); p.rw_S0 = (h16*)take((size_t)1024 * 4096 * 2); p.rw_gam = (float*)take((size_t)1024 * 64 * 4);
    const size_t endMix = off;
    p.mixed = (h16*)p.rg_hl;
    off = offR;
    p.We13 = (h16*)take((size_t)16 * 1024 * DM * 2); p.We2 = (h16*)take((size_t)16 * 1024 * 512 * 2); p.act = (h16*)take((size_t)MOE_MAXT * 128 * 1024 * 2);
    const size_t endMoe = off;
    const size_t need = endMix > endMoe ? endMix : endMoe;
    if (need > ws_size || (char*)p.act + (size_t)MOE_MAXT * 128 * 1024 * 2 > (char*)p.ybuf) { fprintf(stderr, "workspace layout problem: need %zu have %zu\n", need, ws_size); return; }

    static int grid = 0;
    if (!grid) {
        (void)hipFuncSetAttribute((const void*)k_mega, hipFuncAttributeMaxDynamicSharedMemorySize, MEGA_LDS);
        int dev = 0, cus = 0, per_cu = 0;
        (void)hipGetDevice(&dev);
        (void)hipDeviceGetAttribute(&cus, hipDeviceAttributeMultiprocessorCount, dev);
        (void)hipOccupancyMaxActiveBlocksPerMultiprocessor(&per_cu, (const void*)k_mega, 512, MEGA_LDS);
        if (per_cu < 1) { fprintf(stderr, "k_mega not launchable (occupancy 0)\n"); return; }
        grid = cus;
        fprintf(stderr, "k_mega: grid %d (cus %d, per_cu %d), ws need %zu have %zu\n", grid, cus, per_cu, need, ws_size);
    }
    (void)hipMemsetAsync(p.bar, 0, XCD_BAR_WORDS * 4, stream);
    k_mega<<<grid, 512, MEGA_LDS, stream>>>(p);
}
```

```cpp
#ifndef PROBE
#define PROBE 0
#endif
#include <hip/hip_runtime.h>
#include <stdint.h>
#include <stdio.h>
#include <math.h>

typedef _Float16 h16;
typedef _Float16 h16x8 __attribute__((ext_vector_type(8)));
typedef _Float16 h16x4 __attribute__((ext_vector_type(4)));
typedef float f32x4 __attribute__((ext_vector_type(4)));
typedef unsigned u32x4 __attribute__((ext_vector_type(4)));

#define NTOK 16384
#define SEQ 4096
#define NBATCH 4
#define DM 1024
#define DINW 2596
#define PJ 2432
#define IDXLD 192
#define P_U 0
#define P_Q 256
#define P_K 512
#define P_V 768
#define P_RGX 1024
#define P_RGG 1280
#define P_RW 1536
#define LCAP 16384

enum { I_X = 0, I_C, I_POS, I_ADAW, I_ADAB, I_MNG, I_WIN, I_GATEW, I_GATEB, I_BRW, I_OUTW,
       I_S5LRE, I_S5LIM, I_S5LS, I_S5BRE, I_S5BIM, I_S5CRE, I_S5CIM, I_S5D, I_S5GW, I_S5GB,
       I_RGCW, I_RGCB, I_RGWR, I_RGBR, I_RGWI, I_RGBI, I_RGLAM,
       I_RWMU, I_RWW0, I_RWWUP, I_RWA0, I_RWAUP, I_RWGUP, I_RWKK, I_RWKA, I_RWRK, I_RWGNW, I_RWGNB,
       I_FNG, I_ROUTW, I_ROUTB, I_W1, I_W3, I_W2, I_FINALG, N_IN };

struct Params {
    const float* in[N_IN];
    const int* pos;
    float* out;
    unsigned* bar;
    float* mods;
    h16 *Wp, *Widx, *Wg, *Wb, *Wo, *Wglu, *We13, *We2;
    float* x1;
    h16 *h_hi, *h_lo, *branches;
    h16* proj; float* idxf;
    h16* ybuf; float *s5E, *s5H, *s5c, *ropet;
    h16* vT; unsigned* dthr; int* dcut;
    float *rg_hl, *rg_cp, *rg_agg;
    h16 *rw_r, *rw_w, *rw_k, *rw_kk, *rw_b, *rw_g, *rw_bonus, *rw_v; float* rw_y;
    h16 *rw_W, *rw_U0, *rw_Ry, *rw_Y0, *rw_Be, *rw_VK, *rw_S0; float* rw_gam;
    h16* mixed; h16* gates;
    h16* act; int* lists; int* bcnt; float* cw;
};

typedef const __attribute__((address_space(4))) Params& CP;
__device__ __forceinline__ float sigm(float x) { return 1.f / (1.f + __expf(-x)); }
__device__ __forceinline__ float gelu_tanh(float x) { return 0.5f * x * (1.f + tanhf(0.7978845608028654f * (x + 0.044715f * x * x * x))); }
__device__ __forceinline__ float softplusf_(float x) { return fmaxf(x, 0.f) + log1pf(__expf(-fabsf(x))); }
template <int CTRL> __device__ __forceinline__ float dppf(float x) { return __int_as_float(__builtin_amdgcn_update_dpp(0, __float_as_int(x), CTRL, 0xf, 0xf, false)); }
__device__ __forceinline__ float x16_sum(float x) { auto r = __builtin_amdgcn_permlane16_swap(__float_as_uint(x), __float_as_uint(x), false, false); return __uint_as_float(r[0]) + __uint_as_float(r[1]); }
__device__ __forceinline__ float x32_sum(float x) { auto r = __builtin_amdgcn_permlane32_swap(__float_as_uint(x), __float_as_uint(x), false, false); return __uint_as_float(r[0]) + __uint_as_float(r[1]); }
__device__ __forceinline__ float x16_max(float x) { auto r = __builtin_amdgcn_permlane16_swap(__float_as_uint(x), __float_as_uint(x), false, false); return fmaxf(__uint_as_float(r[0]), __uint_as_float(r[1])); }
__device__ __forceinline__ float x32_max(float x) { auto r = __builtin_amdgcn_permlane32_swap(__float_as_uint(x), __float_as_uint(x), false, false); return fmaxf(__uint_as_float(r[0]), __uint_as_float(r[1])); }
__device__ __forceinline__ int x16_isum(int x) { auto r = __builtin_amdgcn_permlane16_swap((unsigned)x, (unsigned)x, false, false); return (int)(r[0] + r[1]); }
__device__ __forceinline__ int x32_isum(int x) { auto r = __builtin_amdgcn_permlane32_swap((unsigned)x, (unsigned)x, false, false); return (int)(r[0] + r[1]); }
__device__ __forceinline__ float rows_sum(float x) { return x32_sum(x16_sum(x)); }
__device__ __forceinline__ float rows_max(float x) { return x32_max(x16_max(x)); }
__device__ __forceinline__ int rows_isum(int x) { return x32_isum(x16_isum(x)); }
__device__ __forceinline__ float wave_sum(float v) { v += dppf<0xB1>(v); v += dppf<0x4E>(v); v += dppf<0x124>(v); v += dppf<0x128>(v); return rows_sum(v); }
__device__ __forceinline__ float wave_max(float v) { v = fmaxf(v, dppf<0xB1>(v)); v = fmaxf(v, dppf<0x4E>(v)); v = fmaxf(v, dppf<0x124>(v)); v = fmaxf(v, dppf<0x128>(v)); return rows_max(v); }
__device__ __forceinline__ float egl_get(const float* egl, int k) { return egl[k]; }
__device__ __forceinline__ h16x4 pack4(float a, float b, float c, float d) { h16x4 r; r[0] = (h16)a; r[1] = (h16)b; r[2] = (h16)c; r[3] = (h16)d; return r; }

__device__ __forceinline__ int oint(int x) { asm volatile("" : "+s"(x)); return x; }
__device__ __forceinline__ int otid() { int t = threadIdx.x; asm volatile("" : "+v"(t)); return t; }
__device__ __forceinline__ void ph_mods(CP p, int bid, int nblk, char* smem) {
    if (bid >= 24) return;
    float* ca = (float*)smem;
    for (int i = otid(); i < 4 * DM; i += 512) { float c = p.in[I_C][i]; ca[i] = c * sigm(c); }
    __syncthreads();
    int gid = bid * 512 + otid();
    int l = gid / 6144, j = gid % 6144;
    const float* w = p.in[I_ADAW] + (size_t)l * DM * 6144 + j;
    float a0 = 0, a1 = 0, a2 = 0, a3 = 0;
    for (int k = 0; k < DM; ++k) { float wv = w[(size_t)k * 6144]; a0 += ca[k] * wv; a1 += ca[DM + k] * wv; a2 += ca[2 * DM + k] * wv; a3 += ca[3 * DM + k] * wv; }
    float bb = p.in[I_ADAB][l * 6144 + j];
    float* m = p.mods + (size_t)l * 4 * 6144;
    m[0 * 6144 + j] = a0 + bb; m[1 * 6144 + j] = a1 + bb; m[2 * 6144 + j] = a2 + bb; m[3 * 6144 + j] = a3 + bb;
}

__device__ __forceinline__ void ph_tables(CP p, int bid, int nblk) {
    const int gt = bid * 512 + otid(), gn = nblk * 512;
    for (int i = gt; i < NTOK * 32; i += gn) {
        const int tok = i >> 5, f = i & 31;
        const double ang = (double)p.pos[tok] * exp(-(double)f * (1.0 / 32.0) * 9.210340371976184);
        double sn, cs; sincos(ang, &sn, &cs);
        p.ropet[(size_t)i * 2] = (float)cs; p.ropet[(size_t)i * 2 + 1] = (float)sn;
    }
    for (int i = gt; i < 2 * 16 * 64; i += gn) {
        const int g = (i >> 6) & 15, l = i >> 10;
        const double lre = p.in[I_S5LRE][i], lim = p.in[I_S5LIM][i], st = exp((double)p.in[I_S5LS][l * 16 + g]);
        const double er = exp(lre * st); double sn, cs; sincos(lim * st, &sn, &cs);
        const double lbr = er * cs, lbi = er * sn;
        const double nr = lbr - 1.0, ni = lbi, den = lre * lre + lim * lim;
        const double fr = (nr * lre + ni * lim) / den, fi = (ni * lre - nr * lim) / den;
        const double e64 = exp(64.0 * lre * st); double s64, c64; sincos(64.0 * lim * st, &s64, &c64);
        float* o = p.s5c + (size_t)i * 36;
        o[0] = (float)lbr; o[1] = (float)lbi; o[2] = (float)(e64 * c64); o[3] = (float)(e64 * s64);
        for (int cc = 0; cc < 16; ++cc) { const double br = p.in[I_S5BRE][(size_t)i * 16 + cc], bi = p.in[I_S5BIM][(size_t)i * 16 + cc];
                                          o[4 + cc] = (float)(fr * br - fi * bi); o[20 + cc] = (float)(fr * bi + fi * br); }
    }
}
template <class SRC>
__device__ __forceinline__ void convT(h16* dst, int dstld, int nrows, int K, int koff, const SRC& src, int gtid, int gthreads) {
    const int kch = K / 8;
    const long total = (long)nrows * kch;
    for (long w = gtid; w < total; w += gthreads) {
        int n = (int)(w % nrows), kc = (int)(w / nrows);
        h16x8 v;
#pragma unroll
        for (int i = 0; i < 8; ++i) v[i] = (h16)src(n, kc * 8 + i);
        *(h16x8*)(dst + (size_t)n * dstld + koff + kc * 8) = v;
    }
}
__device__ __forceinline__ void ph_convert_mix(CP p, int l, int bid, int nblk) {
    const int gt = bid * 512 + otid(), gn = nblk * 512;
    { const float* s = p.in[I_WIN] + (size_t)l * DM * DINW;
      convT(p.Wp, DM, 2560, DM, 0, [=](int n, int k) { return n < PJ ? s[(size_t)k * DINW + (n < 1024 ? n : n + 164)] : 0.f; }, gt, gn);
      convT(p.Widx, 3072, 256, DM, 0, [=](int n, int k) { return n < 164 ? s[(size_t)k * DINW + 1024 + n] : 0.f; }, gt, gn);
      convT(p.Widx, 3072, 256, DM, 1024, [=](int n, int k) { return n < 164 ? s[(size_t)k * DINW + 1024 + n] : 0.f; }, gt, gn);
      convT(p.Widx, 3072, 256, DM, 2048, [=](int n, int k) { float w = n < 164 ? s[(size_t)k * DINW + 1024 + n] : 0.f; float hi = (float)(h16)w; return w - hi; }, gt, gn); }
    { const float* s = p.in[I_GATEW] + (size_t)l * DM * 4096;
      convT(p.Wg, DM, 4096, DM, 0, [=](int n, int k) { return s[(size_t)k * 4096 + n]; }, gt, gn); }
    { const float* s = p.in[I_BRW] + (size_t)l * 4 * 256 * DM;
      convT(p.Wb, 256, 4096, 256, 0, [=](int n, int k) { int br = n >> 10, d = n & 1023; return s[(size_t)br * 256 * DM + (size_t)k * DM + d]; }, gt, gn); }
    { const float* s = p.in[I_OUTW] + (size_t)l * DM * DM;
      convT(p.Wo, DM, DM, DM, 0, [=](int n, int k) { return s[(size_t)k * DM + n]; }, gt, gn); }
    { const float* s = p.in[I_S5GW] + (size_t)l * 256 * 256;
      convT(p.Wglu, 256, 256, 256, 0, [=](int n, int k) { return s[(size_t)k * 256 + n]; }, gt, gn); }
}
__device__ __forceinline__ void ph_convert_moe(CP p, int l, int bid, int nblk) {
    const int gt = bid * 512 + otid(), gn = nblk * 512;
    const float* s1 = p.in[I_W1] + (size_t)l * 16 * DM * 512;
    const float* s3 = p.in[I_W3] + (size_t)l * 16 * DM * 512;
    const float* s2 = p.in[I_W2] + (size_t)l * 16 * 512 * DM;
    convT(p.We13, DM, 16 * 1024, DM, 0, [=](int n, int k) { int e = n >> 10, r = n & 1023; int c = (r >> 5) * 16 + (r & 15); const float* s = ((r >> 4) & 1) ? s3 : s1;
                                                           return s[(size_t)e * DM * 512 + (size_t)k * 512 + c]; }, gt, gn);
    convT(p.We2, 512, 16 * 1024, 512, 0, [=](int n, int k) { int e = n >> 10, c = n & 1023; return s2[(size_t)e * 512 * DM + (size_t)k * DM + c]; }, gt, gn);
}

__device__ __forceinline__ void ph_norm1(CP p, int l, int bid, int nblk) {
    const float* xin = l == 0 ? p.in[I_X] : p.x1;
    const int lane = otid() & 63, wv = otid() >> 6;
    if (bid == 0 && otid() < 24) p.bcnt[otid()] = 0;
    for (int tok = bid * 8 + wv; tok < NTOK; tok += nblk * 8) {
        const int b = tok / SEQ;
        const float* xr = xin + (size_t)tok * DM;
        f32x4 v[4]; float ss = 0.f;
#pragma unroll
        for (int i = 0; i < 4; ++i) { v[i] = *(const f32x4*)(xr + i * 256 + lane * 4); ss += v[i][0] * v[i][0] + v[i][1] * v[i][1] + v[i][2] * v[i][2] + v[i][3] * v[i][3]; }
        ss = wave_sum(ss);
        const float rs = rsqrtf(ss * (1.f / DM) + 1e-6f);
        const float* g = p.in[I_MNG] + l * DM;
        const float* md = p.mods + ((size_t)l * 4 + b) * 6144;
#pragma unroll
        for (int i = 0; i < 4; ++i) {
            const int c = i * 256 + lane * 4;
            f32x4 gg = *(const f32x4*)(g + c), sh = *(const f32x4*)(md + c), sc = *(const f32x4*)(md + 1024 + c);
            float hv[4]; h16x4 hi, lo;
#pragma unroll
            for (int e = 0; e < 4; ++e) { hv[e] = v[i][e] * rs * gg[e] * (1.f + sc[e]) + sh[e]; hi[e] = (h16)hv[e]; lo[e] = (h16)(hv[e] - (float)hi[e]); }
            *(h16x4*)(p.h_hi + (size_t)tok * DM + c) = hi;
            *(h16x4*)(p.h_lo + (size_t)tok * DM + c) = lo;
        }
    }
}

#define LDT 72
template <int BM, class AF, class BF, class SEG>
__device__ __forceinline__ void gemm_kloop_seg(char* smem, int K, const AF& af, const BF& bf, f32x4 (&acc)[BM / 64][4], const SEG& seg) {
    constexpr int MT = BM / 64, WM = BM / 4, NA = BM / 64;
    h16* sA = (h16*)smem; h16* sB = sA + 2 * BM * LDT;
    const int tid = otid(), lane = tid & 63, wave = tid >> 6, wm = wave >> 1, wn = wave & 1;
    const int lrow = tid >> 3, lkc = (tid & 7) * 8;
    u32x4 ra0[NA], rb0[2], ra1[NA], rb1[2];
    const int nk = K / 64;
#define GK_LOAD(RA, RB, KT) do { const int k_ = (KT) * 64 + lkc; \
        _Pragma("unroll") for (int i = 0; i < NA; ++i) RA[i] = *(const u32x4*)af(lrow + i * 64, k_); \
        _Pragma("unroll") for (int i = 0; i < 2; ++i) RB[i] = *(const u32x4*)bf(lrow + i * 64, k_); } while (0)
#define GK_STORE(RA, RB, BUF) do { h16* nA_ = sA + (BUF) * BM * LDT; h16* nB_ = sB + (BUF) * 128 * LDT; \
        _Pragma("unroll") for (int i = 0; i < NA; ++i) *(u32x4*)&nA_[(lrow + i * 64) * LDT + lkc] = RA[i]; \
        _Pragma("unroll") for (int i = 0; i < 2; ++i) *(u32x4*)&nB_[(lrow + i * 64) * LDT + lkc] = RB[i]; } while (0)
#define GK_COMPUTE(BUF) do { const h16* cA = sA + (BUF) * BM * LDT; const h16* cB = sB + (BUF) * 128 * LDT; \
        _Pragma("unroll") for (int ks = 0; ks < 2; ++ks) { h16x8 a[MT], b[4]; \
            _Pragma("unroll") for (int i = 0; i < MT; ++i) a[i] = *(const h16x8*)&cA[(wm * WM + i * 16 + (lane & 15)) * LDT + ks * 32 + (lane >> 4) * 8]; \
            _Pragma("unroll") for (int j = 0; j < 4; ++j) b[j] = *(const h16x8*)&cB[(wn * 64 + j * 16 + (lane & 15)) * LDT + ks * 32 + (lane >> 4) * 8]; \
            _Pragma("unroll") for (int i = 0; i < MT; ++i) _Pragma("unroll") for (int j = 0; j < 4; ++j) acc[i][j] = __builtin_amdgcn_mfma_f32_16x16x32_f16(b[j], a[i], acc[i][j], 0, 0, 0); } } while (0)
    GK_LOAD(ra0, rb0, 0);
    if (nk > 1) GK_LOAD(ra1, rb1, 1);
    GK_STORE(ra0, rb0, 0);
    __syncthreads();
    for (int kt = 0; kt < nk; kt += 2) {
        if (kt + 2 < nk) GK_LOAD(ra0, rb0, kt + 2);
        GK_COMPUTE(0);
        seg(kt);
        if (kt + 1 < nk) GK_STORE(ra1, rb1, 1);
        __syncthreads();
        if (kt + 1 < nk) {
            if (kt + 3 < nk) GK_LOAD(ra1, rb1, kt + 3);
            GK_COMPUTE(1);
            seg(kt + 1);
            if (kt + 2 < nk) GK_STORE(ra0, rb0, 0);
            __syncthreads();
        }
    }
#undef GK_LOAD
#undef GK_STORE
#undef GK_COMPUTE
}
template <int BM, class AF, class BF>
__device__ __forceinline__ void gemm_kloop(char* smem, int K, const AF& af, const BF& bf, f32x4 (&acc)[BM / 64][4]) {
    gemm_kloop_seg<BM>(smem, K, af, bf, acc, [](int) {});
}
template <int BM> __device__ __forceinline__ void zero_acc(f32x4 (&acc)[BM / 64][4]) {
#pragma unroll
    for (int i = 0; i < BM / 64; ++i)
#pragma unroll
        for (int j = 0; j < 4; ++j) acc[i][j] = (f32x4){0.f, 0.f, 0.f, 0.f};
}
template <int BM, class EPI>
__device__ __forceinline__ void gemm_epi(const f32x4 (&acc)[BM / 64][4], const EPI& epi) {
    const int lane = otid() & 63, wave = otid() >> 6, wm = wave >> 1, wn = wave & 1;
#pragma unroll
    for (int i = 0; i < BM / 64; ++i)
#pragma unroll
        for (int j = 0; j < 4; ++j) epi(wm * (BM / 4) + i * 16 + (lane & 15), wn * 64 + j * 16 + 4 * (lane >> 4), acc[i][j]);
}
#define GEMM_LDS(BM) (2 * (BM) * LDT * 2 + 2 * 128 * LDT * 2)


namespace pg8 {
#define PG8_LAS __attribute__((address_space(3)))
constexpr int BM = 256, BK = 64, HALF = 128, HTB = HALF * BK * 2, STAGE_BYTES = 8 * HTB, NXCD = 8, WGM = 8;
__device__ __forceinline__ int lds_byte(int r, int c) { const int st = (r >> 4) * 2 + (c >> 5), rr = r & 15, cc = c & 31, ob = rr * 64 + cc * 2; return st * 1024 + (ob ^ (((ob >> 9) & 1) << 5)); }
__device__ __forceinline__ void stage_rc(int b, int& R, int& C) { const int st = b / 1024, sb = b % 1024, swz = sb ^ (((sb >> 9) & 1) << 5); R = (st >> 1) * 16 + swz / 64; C = (st & 1) * 32 + (swz % 64) / 2; }
__device__ __forceinline__ int perm32(int rho) { const int n = rho >> 4, i = rho & 15; return 8 * (i >> 2) + 4 * n + (i & 3); }
struct Unit { int pm, pn; };
struct Gemm { const h16* A; const h16* Bt; int M, N, K, lda; };
struct StaticOrder {
    int nM, nN, nwg, G, c;
    __device__ void init(int M, int N, int G_, int c_) { nM = M / BM; nN = N / BM; nwg = nM * nN; G = G_; c = c_; }
    __device__ bool next(int i, Unit& u) const {
        const long L = (long)i * G + c; if (L >= nwg) return false;
        int wgid = (int)L; { const int q = nwg / NXCD, r = nwg % NXCD, xcd = wgid % NXCD, off = wgid / NXCD; wgid = (xcd < r ? xcd * (q + 1) : r * (q + 1) + (xcd - r) * q) + off; }
        const int nig = WGM * nN, gid = wgid / nig, fm = gid * WGM, gsz = (nM - fm) < WGM ? (nM - fm) : WGM;
        u.pm = fm + ((wgid % nig) % gsz); u.pn = (wgid % nig) / gsz; return true;
    }
};
template <class Epi, class Sched>
__device__ __forceinline__ void gemm_phase(PG8_LAS unsigned char* lds, const Gemm g, const Sched& S, const Epi& E) {
    const int tid = otid(), wid = __builtin_amdgcn_readfirstlane(tid >> 6), lane = tid & 63, wr = wid >> 2, wc = wid & 3, fr = lane & 15, fq = lane >> 4;
    const int K = g.K, nt = K / BK;
    unsigned voffA[2], voffB[2];
#pragma unroll
    for (int i = 0; i < 2; ++i) { int R, C; stage_rc(tid * 16 + i * 8192, R, C); const int Rb = Epi::PERM ? ((R & ~31) + perm32(R & 31)) : R;
        voffA[i] = (unsigned)(R * g.lda + C) * 2u; voffB[i] = (unsigned)(Rb * K + C) * 2u; }
    const size_t kstep = (size_t)(BK * 2);
    const size_t hsA = (size_t)HALF * g.lda * 2, hsB = (size_t)HALF * K * 2;
    const size_t tsA = 2 * hsA, tsB = 2 * hsB;
    const unsigned ldsw = (unsigned)wid * 1024u;
    const int aoff = lds_byte(wr * 64 + fr, fq * 8), boff = lds_byte(wc * 32 + fr, fq * 8);
#define PG8_SA(b, h) (((b) * 2 + (h)) * HTB)
#define PG8_SB(b, h) ((4 + (b) * 2 + (h)) * HTB)
#define PG8_STAGE(bufoff, gbase, voff) do { _Pragma("unroll") for (int _i = 0; _i < 2; ++_i) \
        __builtin_amdgcn_global_load_lds((const unsigned*)((const char*)(gbase) + (voff)[_i]), (PG8_LAS unsigned*)(lds + (bufoff) + ldsw + _i * 8192), 16, 0, 0); } while (0)
#define PG8_LDA(dst, b, h) do { _Pragma("unroll") for (int m = 0; m < 4; ++m) _Pragma("unroll") for (int k = 0; k < 2; ++k) dst[m][k] = *(const PG8_LAS h16x8*)(lds + PG8_SA(b, h) + aoff + m * 2048 + k * 1024); } while (0)
#define PG8_LDB(dst, b, h) do { _Pragma("unroll") for (int n = 0; n < 2; ++n) _Pragma("unroll") for (int k = 0; k < 2; ++k) dst[n][k] = *(const PG8_LAS h16x8*)(lds + PG8_SB(b, h) + boff + n * 2048 + k * 1024); } while (0)
#define PG8_MMA(ai, bj, At, Bt) do { __builtin_amdgcn_s_setprio(1); _Pragma("unroll") for (int m = 0; m < 4; ++m) _Pragma("unroll") for (int n = 0; n < 2; ++n) _Pragma("unroll") for (int k = 0; k < 2; ++k) \
        acc[ai][bj][m][n] = __builtin_amdgcn_mfma_f32_16x16x32_f16(Bt[n][k], At[m][k], acc[ai][bj][m][n], 0, 0, 0); __builtin_amdgcn_s_setprio(0); } while (0)
#define PG8_WAIT_V(n) asm volatile("s_waitcnt vmcnt(" #n ")" ::: "memory")
#define PG8_WAIT_L(n) asm volatile("s_waitcnt lgkmcnt(" #n ")" ::: "memory")
#define PG8_BAR __builtin_amdgcn_s_barrier()
#define PG8_SCHED __builtin_amdgcn_sched_barrier(0)
    Unit cur, nxt; int ui = 0;
    if (!S.next(0, cur)) return;
    f32x4 acc[2][2][4][2];
#pragma unroll
    for (int a = 0; a < 2; ++a)
#pragma unroll
        for (int b = 0; b < 2; ++b)
#pragma unroll
            for (int m = 0; m < 4; ++m)
#pragma unroll
                for (int n = 0; n < 2; ++n) acc[a][b][m][n] = (f32x4){0.f, 0.f, 0.f, 0.f};
    h16x8 At[4][2], B0[2][2], B1[2][2];
    const char* cA = (const char*)g.A + (size_t)cur.pm * tsA; const char* cB = (const char*)g.Bt + (size_t)cur.pn * tsB;
    PG8_STAGE(PG8_SB(0, 0), cB, voffB); PG8_STAGE(PG8_SA(0, 0), cA, voffA); PG8_STAGE(PG8_SB(0, 1), cB + hsB, voffB); PG8_STAGE(PG8_SA(0, 1), cA + hsA, voffA);
    if (wr == 1) PG8_BAR;
    PG8_WAIT_V(4); PG8_BAR;
    PG8_STAGE(PG8_SB(1, 0), cB + kstep, voffB); PG8_STAGE(PG8_SA(1, 0), cA + kstep, voffA); PG8_STAGE(PG8_SB(1, 1), cB + hsB + kstep, voffB);
    PG8_WAIT_V(6); PG8_BAR;
    for (;;) {
        const bool has_next = S.next(ui + 1, nxt);
        const char* nA = has_next ? (const char*)g.A + (size_t)nxt.pm * tsA : cA; const char* nB = has_next ? (const char*)g.Bt + (size_t)nxt.pn * tsB : cB;
        for (int t = 0; t < nt; t += 2) {
            const bool last = (t == nt - 2);
            const char* a1 = cA + (size_t)(t + 1) * kstep;
            const char* a2 = last ? nA : cA + (size_t)(t + 2) * kstep; const char* b2 = last ? nB : cB + (size_t)(t + 2) * kstep;
            const char* a3 = a2 + kstep; const char* b3 = b2 + kstep;
            PG8_LDB(B0, 0, 0); PG8_SCHED; PG8_LDA(At, 0, 0); PG8_STAGE(PG8_SA(1, 1), a1 + hsA, voffA);
            PG8_WAIT_L(8); PG8_BAR; PG8_WAIT_L(0); PG8_MMA(0, 0, At, B0); PG8_BAR; PG8_SCHED;
            PG8_LDB(B1, 0, 1); PG8_STAGE(PG8_SB(0, 0), b2, voffB);
            PG8_BAR; PG8_WAIT_L(0); PG8_MMA(0, 1, At, B1); PG8_BAR;
            PG8_LDA(At, 0, 1); PG8_STAGE(PG8_SA(0, 0), a2, voffA);
            PG8_BAR; PG8_WAIT_L(0); PG8_MMA(1, 0, At, B0); PG8_BAR; PG8_SCHED;
            PG8_STAGE(PG8_SB(0, 1), b2 + hsB, voffB);
            PG8_WAIT_V(6); PG8_BAR; PG8_MMA(1, 1, At, B1); PG8_BAR;
            PG8_LDB(B0, 1, 0); PG8_SCHED; PG8_LDA(At, 1, 0); PG8_STAGE(PG8_SA(0, 1), a2 + hsA, voffA);
            PG8_WAIT_L(8); PG8_BAR; PG8_WAIT_L(0); PG8_MMA(0, 0, At, B0); PG8_BAR; PG8_SCHED;
            PG8_LDB(B1, 1, 1); PG8_STAGE(PG8_SB(1, 0), b3, voffB);
            PG8_BAR; PG8_WAIT_L(0); PG8_MMA(0, 1, At, B1); PG8_BAR;
            PG8_LDA(At, 1, 1); PG8_STAGE(PG8_SA(1, 0), a3, voffA);
            PG8_BAR; PG8_WAIT_L(0); PG8_MMA(1, 0, At, B0); PG8_BAR; PG8_SCHED;
            PG8_STAGE(PG8_SB(1, 1), b3 + hsB, voffB);
            PG8_WAIT_V(6); PG8_BAR; PG8_MMA(1, 1, At, B1); PG8_BAR;
        }
        E(acc, cur, wr, wc, fr, fq);
        if (!has_next) break;
#pragma unroll
        for (int a = 0; a < 2; ++a)
#pragma unroll
            for (int b = 0; b < 2; ++b)
#pragma unroll
                for (int m = 0; m < 4; ++m)
#pragma unroll
                    for (int n = 0; n < 2; ++n) acc[a][b][m][n] = (f32x4){0.f, 0.f, 0.f, 0.f};
        cur = nxt; cA = nA; cB = nB; ++ui;
    }
    PG8_WAIT_V(0);
    if (wr == 0) PG8_BAR;
    PG8_BAR;
#undef PG8_SA
#undef PG8_SB
#undef PG8_STAGE
#undef PG8_LDA
#undef PG8_LDB
#undef PG8_MMA
#undef PG8_WAIT_V
#undef PG8_WAIT_L
#undef PG8_BAR
#undef PG8_SCHED
}
__device__ __forceinline__ h16x8 pack8(const f32x4& a, const f32x4& b) { h16x8 r; r[0] = (h16)a[0]; r[1] = (h16)a[1]; r[2] = (h16)a[2]; r[3] = (h16)a[3]; r[4] = (h16)b[0]; r[5] = (h16)b[1]; r[6] = (h16)b[2]; r[7] = (h16)b[3]; return r; }
template <int ACT> struct EpiH16 {
    static constexpr bool PERM = true;
    h16* O; int ldc; int ncols; const float* bias;
    __device__ __forceinline__ void operator()(const f32x4 (&acc)[2][2][4][2], const Unit& u, int wr, int wc, int fr, int fq) const {
        const int row0 = u.pm * BM + wr * 64 + fr, col0 = u.pn * BM + wc * 32 + 8 * fq;
#pragma unroll
        for (int bj = 0; bj < 2; ++bj) {
            const int col = col0 + bj * HALF;
            if (col < ncols) {
                f32x4 b0 = {0.f, 0.f, 0.f, 0.f}, b1 = b0;
                if (ACT == 1) { b0 = *(const f32x4*)(bias + col); b1 = *(const f32x4*)(bias + col + 4); }
#pragma unroll
                for (int ai = 0; ai < 2; ++ai)
#pragma unroll
                    for (int m = 0; m < 4; ++m) {
                        f32x4 v0 = acc[ai][bj][m][0] + b0, v1 = acc[ai][bj][m][1] + b1;
                        if (ACT == 1) {
#pragma unroll
                            for (int e = 0; e < 4; ++e) { v0[e] = sigm(v0[e]); v1[e] = sigm(v1[e]); }
                        }
                        *(h16x8*)(O + (size_t)(row0 + ai * HALF + m * 16) * ldc + col) = pack8(v0, v1);
                    }
            }
        }
    }
};
struct EpiResid {
    static constexpr bool PERM = false;
    float* O; const float* X; const float* gate;
    __device__ __forceinline__ void operator()(const f32x4 (&acc)[2][2][4][2], const Unit& u, int wr, int wc, int fr, int fq) const {
        const int row0 = u.pm * BM + wr * 64 + fr, col0 = u.pn * BM + wc * 32 + 4 * fq;
        const float* gr = gate + (size_t)((u.pm * BM) / SEQ) * 6144;
#pragma unroll
        for (int bj = 0; bj < 2; ++bj)
#pragma unroll
            for (int n = 0; n < 2; ++n) {
                const int col = col0 + bj * HALF + n * 16;
                const f32x4 gg = *(const f32x4*)(gr + col);
#pragma unroll
                for (int ai = 0; ai < 2; ++ai)
#pragma unroll
                    for (int m = 0; m < 4; ++m) {
                        const size_t o = (size_t)(row0 + ai * HALF + m * 16) * DM + col;
                        *(f32x4*)(O + o) = *(const f32x4*)(X + o) + gg * acc[ai][bj][m][n];
                    }
            }
    }
};
}

__device__ __forceinline__ void ph_gemm1(CP p, int bid, int nblk, char* smem) {
    {
        pg8::Gemm g; g.A = p.h_hi; g.Bt = p.Wp; g.M = NTOK; g.N = 2560; g.K = DM; g.lda = DM;
        pg8::StaticOrder S; S.init(NTOK, 2560, nblk, bid);
        pg8::EpiH16<0> E; E.O = p.proj; E.ldc = PJ; E.ncols = PJ; E.bias = nullptr;
        pg8::gemm_phase(( PG8_LAS unsigned char*)smem, g, S, E);
    }
    __syncthreads();
    for (int u = bid - 128; u >= 0 && u < 128; u += nblk) {
        f32x4 acc[4][4]; zero_acc<256>(acc);
        const int mt = u >> 1, nt = u & 1, m0 = mt * 256, n0 = nt * 128;
        const h16* Ah = p.h_hi + (size_t)m0 * DM; const h16* Al = p.h_lo + (size_t)m0 * DM; const h16* B = p.Widx + (size_t)n0 * 3072;
        gemm_kloop<256>(smem, 3072, [=](int r, int k) { const h16* base = (k >= 1024 && k < 2048) ? Al : Ah; return base + (size_t)r * DM + (k & 1023); },
                        [=](int r, int k) { return B + (size_t)r * 3072 + k; }, acc);
        float* O = p.idxf + (size_t)m0 * IDXLD + n0;
        gemm_epi<256>(acc, [=](int ml, int nl, f32x4 v) { if (n0 + nl < IDXLD) *(f32x4*)(O + (size_t)ml * IDXLD + nl) = v; });
    }
}

template <int PASS>
__device__ __forceinline__ void ph_s5_scan(CP p, int l, int bid, int nblk) {
    const int lane = otid() & 63, wv = otid() >> 6;
    for (int u = bid * 8 + wv; u < 4096; u += nblk * 8) {
        const int g = u & 15, c = (u >> 4) & 63, b = u >> 10;
        const int pidx = (l * 16 + g) * 64 + lane;
        const float* sc_ = p.s5c + (size_t)pidx * 36;
        float Br[16], Bi[16];
#pragma unroll
        for (int cc = 0; cc < 16; ++cc) { Br[cc] = sc_[4 + cc]; Bi[cc] = sc_[20 + cc]; }
        const float lr = sc_[0], li = sc_[1];
        float hr = 0.f, hi = 0.f;
        float Cr[16], Ci[16];
        if (PASS == 3) {
#pragma unroll
            for (int cc = 0; cc < 16; ++cc) { Cr[cc] = p.in[I_S5CRE][((size_t)(l * 16 + g) * 16 + cc) * 64 + lane]; Ci[cc] = p.in[I_S5CIM][((size_t)(l * 16 + g) * 16 + cc) * 64 + lane]; }
            const size_t hix = ((((size_t)b * 64 + c) * 16 + g) * 64 + lane) * 2;
            hr = p.s5H[hix]; hi = p.s5H[hix + 1];
        }
        const int t0 = b * SEQ + c * 64;
        const int oidx = ((lane >> 5) & 1) * 8 + ((lane >> 4) & 1) * 4 + ((lane >> 3) & 1) * 2 + ((lane >> 2) & 1);
        const float dsk = p.in[I_S5D][l * 256 + g * 16 + oidx];
        for (int t = 0; t < 64; ++t) {
            const h16* up = p.proj + (size_t)(t0 + t) * PJ + P_U + g * 16;
            h16x8 u0 = *(const h16x8*)up, u1 = *(const h16x8*)(up + 8);
            float uu[16];
#pragma unroll
            for (int cc = 0; cc < 8; ++cc) { uu[cc] = (float)u0[cc]; uu[8 + cc] = (float)u1[cc]; }
            float br = 0.f, bi = 0.f;
#pragma unroll
            for (int cc = 0; cc < 16; ++cc) { br += Br[cc] * uu[cc]; bi += Bi[cc] * uu[cc]; }
            const float nhr = lr * hr - li * hi + br, nhi = lr * hi + li * hr + bi;
            hr = nhr; hi = nhi;
            if (PASS == 3) {
                float v[16];
#pragma unroll
                for (int cc = 0; cc < 16; ++cc) v[cc] = Cr[cc] * hr - Ci[cc] * hi;
                float v8[8], v4[4], v2[2], v1;
                const bool b3 = lane & 8, b2 = lane & 4;
#pragma unroll
                for (int i = 0; i < 8; ++i) { auto r = __builtin_amdgcn_permlane32_swap(__float_as_uint(v[i]), __float_as_uint(v[i + 8]), false, false); v8[i] = __uint_as_float(r[0]) + __uint_as_float(r[1]); }
#pragma unroll
                for (int i = 0; i < 4; ++i) { auto r = __builtin_amdgcn_permlane16_swap(__float_as_uint(v8[i]), __float_as_uint(v8[i + 4]), false, false); v4[i] = __uint_as_float(r[0]) + __uint_as_float(r[1]); }
#pragma unroll
                for (int i = 0; i < 2; ++i) { float snd = b3 ? v4[i] : v4[i + 2], keep = b3 ? v4[i + 2] : v4[i]; v2[i] = keep + dppf<0x128>(snd); }
                { float snd = b2 ? v2[0] : v2[1], keep = b2 ? v2[1] : v2[0]; v1 = keep + dppf<0x1B>(dppf<0x141>(snd)); }
                v1 += dppf<0x4E>(v1); v1 += dppf<0xB1>(v1);
                if ((lane & 3) == 0) {
                    const float y = v1 + dsk * uu[oidx];
                    p.ybuf[(size_t)(t0 + t) * 256 + g * 16 + oidx] = (h16)gelu_tanh(y);
                }
            }
        }
        if (PASS == 1) { const size_t eix = ((((size_t)b * 64 + c) * 16 + g) * 64 + lane) * 2; p.s5E[eix] = hr; p.s5E[eix + 1] = hi; }
    }
}
__device__ __forceinline__ void ph_s5_carry(CP p, int l, int bid, int nblk) {
    if (bid >= 8) return;
    const int gid = bid * 512 + otid();
    const int pp = gid & 63, g = (gid >> 6) & 15, b = gid >> 10;
    const int pidx = (l * 16 + g) * 64 + pp;
    const float ar = p.s5c[(size_t)pidx * 36 + 2], ai = p.s5c[(size_t)pidx * 36 + 3];
    float hr = 0.f, hi = 0.f;
    for (int c = 0; c < 64; ++c) {
        const size_t ix = ((((size_t)b * 64 + c) * 16 + g) * 64 + pp) * 2;
        p.s5H[ix] = hr; p.s5H[ix + 1] = hi;
        const float er_ = p.s5E[ix], ei_ = p.s5E[ix + 1];
        const float nr = ar * hr - ai * hi + er_, ni = ar * hi + ai * hr + ei_;
        hr = nr; hi = ni;
    }
}
__device__ __forceinline__ void ph_s5_glu(CP p, int l, int bid, int nblk, char* smem) {
    for (int u = bid; u < 128; u += nblk) {
        const int mt = u >> 1, nt = u & 1, m0 = mt * 256, n0 = nt * 128;
        f32x4 acc[4][4]; zero_acc<256>(acc);
        const h16* A = p.ybuf + (size_t)m0 * 256; const h16* B = p.Wglu + (size_t)n0 * 256;
        gemm_kloop<256>(smem, 256, [=](int r, int k) { return A + (size_t)r * 256 + k; }, [=](int r, int k) { return B + (size_t)r * 256 + k; }, acc);
        const float* gb = p.in[I_S5GB] + l * 256 + n0;
        const h16* Y = p.ybuf + (size_t)m0 * 256 + n0; h16* O = p.branches + (size_t)m0 * DM + n0;
        gemm_epi<256>(acc, [=](int ml, int nl, f32x4 v) {
            h16x4 y = *(const h16x4*)(Y + (size_t)ml * 256 + nl); f32x4 bb = *(const f32x4*)(gb + nl);
            *(h16x4*)(O + (size_t)ml * DM + nl) = pack4((float)y[0] * sigm(v[0] + bb[0]), (float)y[1] * sigm(v[1] + bb[1]), (float)y[2] * sigm(v[2] + bb[2]), (float)y[3] * sigm(v[3] + bb[3])); });
    }
}

__device__ __forceinline__ void ph_rg_a(CP p, int l, int bid, int nblk, char* smem) {
    float* xc = (float*)smem;
    float* aa = xc + 32 * 256;
    float* bx = aa + 32 * 256;
    const int tid = otid();
    for (int u = bid; u < 512; u += nblk) {
        const int b = u >> 7, c = u & 127, t0 = c * 32;
        __syncthreads();
        {
            const int ch = tid & 255;
            const float w0 = p.in[I_RGCW][(l * 4 + 0) * 256 + ch], w1 = p.in[I_RGCW][(l * 4 + 1) * 256 + ch], w2 = p.in[I_RGCW][(l * 4 + 2) * 256 + ch], w3 = p.in[I_RGCW][(l * 4 + 3) * 256 + ch];
            const float cb = p.in[I_RGCB][l * 256 + ch];
            for (int t = tid >> 8; t < 32; t += 2) {
                const int tt = t0 + t;
                const h16* xp = p.proj + (size_t)(b * SEQ + tt) * PJ + P_RGX + ch;
                float s = cb + w3 * (float)xp[0];
                if (tt >= 1) s += w2 * (float)xp[-(long)PJ];
                if (tt >= 2) s += w1 * (float)xp[-2 * (long)PJ];
                if (tt >= 3) s += w0 * (float)xp[-3 * (long)PJ];
                xc[t * 256 + ch] = s;
            }
        }
        __syncthreads();
        const int ch = tid & 255, half = tid >> 8, blk = ch >> 6, d = ch & 63;
        const float* wr = p.in[I_RGWR] + ((size_t)(l * 4 + blk) * 64) * 64 + d;
        const float* wi = p.in[I_RGWI] + ((size_t)(l * 4 + blk) * 64) * 64 + d;
        const float br = p.in[I_RGBR][l * 256 + ch], bi = p.in[I_RGBI][l * 256 + ch];
        const float spl = softplusf_(-p.in[I_RGLAM][l * 256 + ch]);
#pragma unroll 1
        for (int grp = 0; grp < 2; ++grp) {
            float ar[8], ai[8];
#pragma unroll
            for (int q = 0; q < 8; ++q) { ar[q] = br; ai[q] = bi; }
            const int tb = half * 16 + grp * 8;
            for (int cc = 0; cc < 64; ++cc) {
                const float wrv = wr[cc * 64], wiv = wi[cc * 64];
#pragma unroll
                for (int q = 0; q < 8; ++q) { const float xv = xc[(tb + q) * 256 + blk * 64 + cc]; ar[q] += xv * wrv; ai[q] += xv * wiv; }
            }
#pragma unroll
            for (int q = 0; q < 8; ++q) {
                const float r = sigm(ar[q]), ig = sigm(ai[q]);
                const float la = -8.f * r * spl;
                const float a = __expf(la), mult = sqrtf(-expm1f(2.f * la));
                aa[(tb + q) * 256 + ch] = a; bx[(tb + q) * 256 + ch] = mult * ig * xc[(tb + q) * 256 + ch];
            }
        }
        __syncthreads();
        if (tid < 256) {
            float h = 0.f, cp = 1.f;
            float* hl = p.rg_hl + (size_t)(b * SEQ + t0) * 256 + ch; float* cpo = p.rg_cp + (size_t)(b * SEQ + t0) * 256 + ch;
            for (int t = 0; t < 32; ++t) { const float a = aa[t * 256 + ch]; h = a * h + bx[t * 256 + ch]; cp *= a; hl[(size_t)t * 256] = h; cpo[(size_t)t * 256] = cp; }
            p.rg_agg[((size_t)(b * 128 + c) * 256 + ch) * 2] = cp; p.rg_agg[((size_t)(b * 128 + c) * 256 + ch) * 2 + 1] = h;
        }
    }
}
__device__ __forceinline__ void ph_rg_c(CP p, int l, int bid, int nblk, char* smem) {
    float* carry = (float*)smem;
    const int tid = otid();
    for (int u = bid; u < 512; u += nblk) {
        const int b = u >> 7, c = u & 127, t0 = c * 32;
        __syncthreads();
        if (tid < 256) { float h = 0.f; for (int cc = 0; cc < c; ++cc) { const float* ag = p.rg_agg + ((size_t)(b * 128 + cc) * 256 + tid) * 2; h = ag[0] * h + ag[1]; } carry[tid] = h; }
        __syncthreads();
        const int ch = tid & 255;
        for (int t = tid >> 8; t < 32; t += 2) {
            const size_t tok = (size_t)b * SEQ + t0 + t;
            const float h = p.rg_hl[tok * 256 + ch] + p.rg_cp[tok * 256 + ch] * carry[ch];
            const float gt = (float)p.proj[tok * PJ + P_RGG + ch];
            p.branches[tok * DM + 512 + ch] = (h16)(h * gelu_tanh(gt));
        }
    }
}

__device__ __forceinline__ void ph_rw_prep(CP p, int l, int bid, int nblk, char* smem) {
    h16* wup = (h16*)smem;
    h16* aup = wup + 32 * 256;
    h16* gup = aup + 32 * 256;
    float* f = (float*)(gup + 64 * 256);
    const int tid = otid(), lane = tid & 63;
    for (int i = tid; i < 32 * 256; i += 512) { wup[i] = (h16)p.in[I_RWWUP][(size_t)l * 32 * 256 + i]; aup[i] = (h16)p.in[I_RWAUP][(size_t)l * 32 * 256 + i]; }
    for (int i = tid; i < 64 * 256; i += 512) gup[i] = (h16)p.in[I_RWGUP][(size_t)l * 64 * 256 + i];
    const float* mu = p.in[I_RWMU] + l * 896;
    const int ch = tid & 255, tg = tid >> 8;
    const float w0 = p.in[I_RWW0][l * 256 + ch], a0 = p.in[I_RWA0][l * 256 + ch], kkw = p.in[I_RWKK][l * 256 + ch], kaw = p.in[I_RWKA][l * 256 + ch];
    const float rk = p.in[I_RWRK][l * 256 + ch];
    __syncthreads();
    for (int u = bid; u < NTOK / 16; u += nblk) {
        const int tok0 = u * 16;
        __syncthreads();
        for (int i = tid; i < 16 * 896; i += 512) {
            const int t = i / 896, cidx = i % 896; const int tok = tok0 + t;
            const float cur = (float)p.proj[(size_t)tok * PJ + P_RW + cidx];
            const float prv = (tok % SEQ) ? (float)p.proj[(size_t)(tok - 1) * PJ + P_RW + cidx] : 0.f;
            float v = cur + (prv - cur) * mu[cidx];
            if (cidx >= 768 && cidx < 800) v = tanhf(v);
            if (cidx >= 832) v = sigm(v);
            f[i] = v;
        }
        __syncthreads();
        for (int q = 0; q < 8; ++q) {
            const int t = tg * 8 + q; const int tok = tok0 + t;
            const float* ft = f + t * 896;
            float lw = 0.f, la = 0.f, lg = 0.f;
#pragma unroll 8
            for (int j = 0; j < 32; ++j) { lw += ft[768 + j] * (float)wup[j * 256 + ch]; la += ft[800 + j] * (float)aup[j * 256 + ch]; }
#pragma unroll 8
            for (int j = 0; j < 64; ++j) lg += ft[832 + j] * (float)gup[j * 256 + ch];
            const float w = -softplusf_(-(w0 + lw)) - 0.5f;
            const float wl = -__expf(w);
            const float a = sigm(a0 + la);
            const float r = ft[ch], k = ft[256 + ch], v = ft[512 + ch];
            float kk = k * kkw;
            const float nrm = sqrtf(wave_sum(kk * kk));
            kk = kk / fmaxf(nrm, 1e-12f);
            const float k2 = k * (1.f + (a - 1.f) * kaw);
            const float sb = wave_sum(r * k2 * rk);
            const size_t o = (size_t)tok * 256 + ch;
            p.rw_r[o] = (h16)r; p.rw_w[o] = (h16)wl; p.rw_k[o] = (h16)k2; p.rw_kk[o] = (h16)kk; p.rw_b[o] = (h16)(kk * a);
            p.rw_g[o] = (h16)lg; p.rw_bonus[o] = (h16)(sb * v); p.rw_v[o] = (h16)v;
        }
    }
}
__device__ __forceinline__ void ph_rw_scan(CP p, int bid, char* smem) {
    if (bid >= 16 || otid() >= 64) return;
    float (*sv)[64] = (float (*)[64])smem;
    const int b = bid >> 2, h = bid & 3, lane = otid();
    float S[64];
#pragma unroll
    for (int k = 0; k < 64; ++k) S[k] = 0.f;
    for (int t = 0; t < SEQ; ++t) {
        const size_t tok = (size_t)b * SEQ + t; const size_t o = tok * 256 + h * 64 + lane;
        const float vv = (float)p.rw_v[o];
        sv[0][lane] = (float)p.rw_r[o]; sv[1][lane] = __expf((float)p.rw_w[o]); sv[2][lane] = (float)p.rw_k[o]; sv[3][lane] = (float)p.rw_kk[o]; sv[4][lane] = (float)p.rw_b[o];
        __builtin_amdgcn_s_waitcnt(0); __builtin_amdgcn_wave_barrier();
        float skk = 0.f;
#pragma unroll
        for (int k = 0; k < 64; ++k) skk += S[k] * sv[3][k];
        float y = 0.f;
#pragma unroll
        for (int k = 0; k < 64; ++k) { S[k] = S[k] * sv[1][k] - skk * sv[4][k] + vv * sv[2][k]; y += S[k] * sv[0][k]; }
        p.rw_y[o] = y;
        __builtin_amdgcn_s_waitcnt(0); __builtin_amdgcn_wave_barrier();
    }
}
__device__ __forceinline__ void ph_rw_post(CP p, int l, int bid, int nblk) {
    const int lane = otid() & 63, wv = otid() >> 6;
    for (int u = bid * 8 + wv; u < NTOK * 4; u += nblk * 8) {
        const int tok = u >> 2, h = u & 3; const size_t o = (size_t)tok * 256 + h * 64 + lane;
        const float y = p.rw_y[o];
        const float mean = wave_sum(y) * (1.f / 64.f);
        const float dv = y - mean;
        const float var = wave_sum(dv * dv) * (1.f / 64.f);
        float v = dv * rsqrtf(var + 64e-5f) * p.in[I_RWGNW][l * 256 + h * 64 + lane] + p.in[I_RWGNB][l * 256 + h * 64 + lane];
        v += (float)p.rw_bonus[o];
        p.branches[(size_t)tok * DM + 768 + h * 64 + lane] = (h16)(v * (float)p.rw_g[o]);
    }
}

#define RS 68
template <int MODE>
__device__ __forceinline__ void mm_nt(float* out, const float* X, const float* Y, int wave, int nw, int lane) {
    const int g = lane >> 4, c = lane & 15;
    for (int idx = wave; idx < 16; idx += nw) {
        const int ti = idx >> 2, tj = idx & 3;
        f32x4 acc = {0.f, 0.f, 0.f, 0.f};
        if (MODE == 0 || tj <= ti) {
#pragma unroll
            for (int kb = 0; kb < 4; ++kb) {
                const f32x4 a4 = *(const f32x4*)&X[(ti * 16 + c) * RS + kb * 16 + 4 * g];
                const f32x4 b4 = *(const f32x4*)&Y[(tj * 16 + c) * RS + kb * 16 + 4 * g];
#pragma unroll
                for (int i = 0; i < 4; ++i) acc = __builtin_amdgcn_mfma_f32_16x16x4f32(a4[i], b4[i], acc, 0, 0, 0);
            }
        }
#pragma unroll
        for (int r = 0; r < 4; ++r) {
            const int row = ti * 16 + 4 * g + r, col = tj * 16 + c;
            float v = acc[r];
            if (MODE == 1 && col >= row) v = 0.f;
            if (MODE == 2 && col > row) v = 0.f;
            out[row * RS + col] = v;
        }
    }
}
__device__ __forceinline__ f32x4 mm_nn_tile(f32x4 acc, const float* X, const float* Y, int ti, int tj, int lane, float sign) {
    const int g = lane >> 4, c = lane & 15;
#pragma unroll
    for (int kb = 0; kb < 4; ++kb) {
        const f32x4 a4 = *(const f32x4*)&X[(ti * 16 + c) * RS + kb * 16 + 4 * g];
#pragma unroll
        for (int i = 0; i < 4; ++i) acc = __builtin_amdgcn_mfma_f32_16x16x4f32(sign * a4[i], Y[(kb * 16 + 4 * g + i) * RS + tj * 16 + c], acc, 0, 0, 0);
    }
    return acc;
}
template <int T> struct FwdRow {
    static __device__ __forceinline__ void run(float (&x)[64], const float* Nm) {
        FwdRow<T - 1>::run(x, Nm);
        float acc = x[T];
#pragma unroll
        for (int s4 = 0; s4 < (T + 3) / 4; ++s4) {
            const f32x4 n4 = *(const f32x4*)&Nm[T * RS + s4 * 4];
#pragma unroll
            for (int e = 0; e < 4; ++e) if (s4 * 4 + e < T) acc -= n4[e] * x[s4 * 4 + e];
        }
        x[T] = acc;
    }
};
template <> struct FwdRow<0> { static __device__ __forceinline__ void run(float (&)[64], const float*) {} };
#define RWA_LDS (16384 + 8 * 64 * RS * 4)
__device__ __forceinline__ void ph_rw_a(CP p, int l, int bid, int nblk, char* smem) {
    h16* fs = (h16*)smem;
    float* Ah = (float*)(smem + 16384);
    float* Rh = Ah + 64 * RS; float* Bh = Rh + 64 * RS; float* Kh = Bh + 64 * RS; float* Vv = Kh + 64 * RS;
    float* Nm = Vv + 64 * RS; float* Mm = Nm + 64 * RS; float* T1 = Mm + 64 * RS;
    h16* lw_ = (h16*)Nm;
    float* tot = (float*)fs;
    float* egl = tot + 8 * 64;
    for (int u = bid; u < 1024; u += nblk) {
        int tid = otid(), lane = tid & 63, wave = tid >> 6;
        const float* mu = p.in[I_RWMU] + oint(l) * 896;
        const int h = u & 3, c = (u >> 2) & 63, b = u >> 8;
        const int t0 = c * 64; const size_t tok0 = (size_t)b * SEQ + t0;
        __syncthreads();
        for (int i = tid; i < 64 * 128; i += 512) {
            const int t = i >> 7, j = i & 127; const size_t tok = tok0 + t;
            const float cur = (float)p.proj[tok * PJ + P_RW + 768 + j];
            const float prv = (t0 + t) ? (float)p.proj[(tok - 1) * PJ + P_RW + 768 + j] : 0.f;
            float v = cur + (prv - cur) * mu[768 + j];
            if (j < 32) v = tanhf(v); else if (j >= 64) v = sigm(v);
            fs[i] = (h16)v;
        }
        for (int i = tid; i < 128 * 64; i += 512) {
            const int j = i >> 6, cc = i & 63;
            float wv;
            if (j < 32) wv = p.in[I_RWWUP][((size_t)l * 32 + j) * 256 + h * 64 + cc];
            else if (j < 64) wv = p.in[I_RWAUP][((size_t)l * 32 + (j - 32)) * 256 + h * 64 + cc];
            else wv = p.in[I_RWGUP][((size_t)l * 64 + (j - 64)) * 256 + h * 64 + cc];
            lw_[i] = (h16)wv;
        }
        __syncthreads();
        tid = otid(); lane = tid & 63; wave = tid >> 6;
        {
            const int ll = oint(l);
            const int ch = h * 64 + lane;
            const float w0 = p.in[I_RWW0][ll * 256 + ch], a0 = p.in[I_RWA0][ll * 256 + ch], kkw = p.in[I_RWKK][ll * 256 + ch], kaw = p.in[I_RWKA][ll * 256 + ch], rkw = p.in[I_RWRK][ll * 256 + ch];
            const float mur = mu[ch], muk = mu[256 + ch], muv = mu[512 + ch];
            float run = 0.f;
            h16 pr_[9], pk_[9], pv_[9];
#pragma unroll
            for (int q = 0; q < 9; ++q) {
                const int t = wave * 8 + q - 1;
                const bool ok = (t0 + t) >= 0;
                const h16* pc = p.proj + (tok0 + t) * PJ + P_RW + ch;
                pr_[q] = ok ? pc[0] : (h16)0.f; pk_[q] = ok ? pc[256] : (h16)0.f; pv_[q] = ok ? pc[512] : (h16)0.f;
            }
#pragma unroll
            for (int q = 0; q < 8; ++q) {
                const int t = wave * 8 + q; const size_t tok = tok0 + t;
                const h16* ft = fs + t * 128;
                float lw = 0.f, la = 0.f, lg = 0.f;
#pragma unroll 8
                for (int j = 0; j < 32; ++j) { lw += (float)ft[j] * (float)lw_[j * 64 + lane]; la += (float)ft[32 + j] * (float)lw_[(32 + j) * 64 + lane]; }
#pragma unroll 8
                for (int j = 0; j < 64; ++j) lg += (float)ft[64 + j] * (float)lw_[(64 + j) * 64 + lane];
                const float rc = (float)pr_[q + 1], kc = (float)pk_[q + 1], vc = (float)pv_[q + 1];
                const float rp = (float)pr_[q], kp_ = (float)pk_[q], vp = (float)pv_[q];
                const float r = rc + (rp - rc) * mur, k = kc + (kp_ - kc) * muk, v = vc + (vp - vc) * muv;
                const float w = -softplusf_(-(w0 + lw)) - 0.5f;
                const float wl = -__expf(w);
                const float a = sigm(a0 + la);
                float kk = k * kkw;
                const float nrm = sqrtf(wave_sum(kk * kk));
                kk = kk / fmaxf(nrm, 1e-12f);
                const float k2 = k * (1.f + (a - 1.f) * kaw);
                const float sb = wave_sum(r * k2 * rkw);
                p.rw_g[tok * 256 + ch] = (h16)lg; p.rw_bonus[tok * 256 + ch] = (h16)(sb * v);
                run += wl;
                Ah[t * RS + lane] = kk; Rh[t * RS + lane] = r; Bh[t * RS + lane] = kk * a; Kh[t * RS + lane] = k2; Vv[t * RS + lane] = v; T1[t * RS + lane] = run;
            }
            __syncthreads();
            tot[wave * 64 + lane] = run;
            __syncthreads();
            float offs = 0.f, gl = 0.f;
#pragma unroll
            for (int w8 = 0; w8 < 8; ++w8) { const float tv = tot[w8 * 64 + lane]; if (w8 < wave) offs += tv; gl += tv; }
            if (wave == 0) { egl[lane] = __expf(gl); p.rw_gam[(size_t)u * 64 + lane] = __expf(gl); }
            float gprev = offs;
#pragma unroll 1
            for (int q = 0; q < 8; ++q) {
                const int t = wave * 8 + q;
                const float G = offs + T1[t * RS + lane];
                const float eg = __expf(G), egp = __expf(gprev), egi = __expf(-G);
                Ah[t * RS + lane] *= egp; Rh[t * RS + lane] *= eg; Bh[t * RS + lane] *= egi; Kh[t * RS + lane] *= egi;
                gprev = G;
            }
        }
        __syncthreads();
        tid = otid(); lane = tid & 63; wave = tid >> 6;
        mm_nt<1>(Nm, Ah, Bh, wave, 8, lane);
        mm_nt<1>(Mm, Ah, Kh, wave, 8, lane);
        __syncthreads();
        tid = otid(); lane = tid & 63; wave = tid >> 6;
        for (int idx = wave; idx < 16; idx += 8) {
            const int ti = idx >> 2, tj = idx & 3;
            f32x4 acc = {0.f, 0.f, 0.f, 0.f};
            acc = mm_nn_tile(acc, Mm, Vv, ti, tj, lane, 1.f);
#pragma unroll
            for (int r = 0; r < 4; ++r) T1[(ti * 16 + 4 * (lane >> 4) + r) * RS + tj * 16 + (lane & 15)] = acc[r];
        }
        __syncthreads();
        tid = otid(); lane = tid & 63; wave = tid >> 6;
        const size_t ub = (size_t)u * 4096;
        if (wave < 2) {
            float* src = wave == 0 ? Ah : T1;
            h16* og = (wave == 0 ? p.rw_W : p.rw_U0) + ub;
#pragma unroll
            for (int I = 0; I < 4; ++I) {
                float acc[16];
#pragma unroll
                for (int r = 0; r < 16; ++r) acc[r] = src[(16 * I + r) * RS + lane];
#pragma unroll 1
                for (int s4 = 0; s4 < 4 * I; ++s4) {
                    const float x0 = src[(s4 * 4 + 0) * RS + lane], x1 = src[(s4 * 4 + 1) * RS + lane], x2 = src[(s4 * 4 + 2) * RS + lane], x3 = src[(s4 * 4 + 3) * RS + lane];
#pragma unroll
                    for (int r = 0; r < 16; ++r) { const f32x4 n4 = *(const f32x4*)&Nm[(16 * I + r) * RS + s4 * 4]; acc[r] -= n4[0] * x0 + n4[1] * x1 + n4[2] * x2 + n4[3] * x3; }
                }
#pragma unroll
                for (int r = 1; r < 16; ++r) {
#pragma unroll
                    for (int q4 = 0; q4 < 4; ++q4) {
                        if (q4 * 4 < r) {
                            const f32x4 n4 = *(const f32x4*)&Nm[(16 * I + r) * RS + 16 * I + q4 * 4];
#pragma unroll
                            for (int e = 0; e < 4; ++e) if (q4 * 4 + e < r) acc[r] -= n4[e] * acc[q4 * 4 + e];
                        }
                    }
                }
#pragma unroll
                for (int r = 0; r < 16; ++r) { src[(16 * I + r) * RS + lane] = acc[r]; og[(16 * I + r) * 64 + lane] = (h16)acc[r]; }
            }
        } else {
            mm_nt<2>(Mm, Rh, Bh, wave - 2, 6, lane);
            for (int i = tid - 128; i < 4096; i += 384) { const int k = i >> 6, t = i & 63; p.rw_Be[ub + i] = (h16)(-Bh[t * RS + k] * egl_get(egl, k)); }
            for (int idx = wave - 2; idx < 16; idx += 6) {
                const int ti = idx >> 2, tj = idx & 3, g = lane >> 4, cc = lane & 15;
                f32x4 acc = {0.f, 0.f, 0.f, 0.f};
#pragma unroll
                for (int tb = 0; tb < 4; ++tb)
#pragma unroll
                    for (int i = 0; i < 4; ++i) acc = __builtin_amdgcn_mfma_f32_16x16x4f32(Kh[(tb * 16 + 4 * g + i) * RS + ti * 16 + cc], Vv[(tb * 16 + 4 * g + i) * RS + tj * 16 + cc], acc, 0, 0, 0);
#pragma unroll
                for (int r = 0; r < 4; ++r) { const int k = ti * 16 + 4 * g + r; p.rw_VK[ub + k * 64 + tj * 16 + cc] = (h16)(acc[r] * egl_get(egl, k)); }
            }
        }
        __syncthreads();
        tid = otid(); lane = tid & 63; wave = tid >> 6;
        mm_nt<2>(Nm, Rh, Kh, wave, 8, lane);
        __syncthreads();
        tid = otid(); lane = tid & 63; wave = tid >> 6;
        for (int idx = wave; idx < 16; idx += 8) {
            const int ti = idx >> 2, tj = idx & 3, g = lane >> 4, cc = lane & 15;
            f32x4 a1, a2 = {0.f, 0.f, 0.f, 0.f};
#pragma unroll
            for (int r = 0; r < 4; ++r) a1[r] = Rh[(ti * 16 + 4 * g + r) * RS + tj * 16 + cc];
            a1 = mm_nn_tile(a1, Mm, Ah, ti, tj, lane, -1.f);
            a2 = mm_nn_tile(a2, Nm, Vv, ti, tj, lane, 1.f);
            a2 = mm_nn_tile(a2, Mm, T1, ti, tj, lane, -1.f);
#pragma unroll
            for (int r = 0; r < 4; ++r) { const int row = ti * 16 + 4 * g + r, col = tj * 16 + cc; p.rw_Ry[ub + row * 64 + col] = (h16)a1[r]; p.rw_Y0[ub + row * 64 + col] = (h16)a2[r]; }
        }
    }
}
__device__ __forceinline__ void ph_rw_b(CP p, int bid, char* smem) {
    h16* Sh = (h16*)smem;
    h16* Uh = Sh + 64 * 72;
    const int tid = otid(), lane = tid & 63, wave = tid >> 6, g = lane >> 4, cc = lane & 15;
    const int vt = wave >> 1, hf = wave & 1;
    const int b = bid >> 2, h = bid & 3;
    f32x4 S[2];
    S[0] = (f32x4){0.f, 0.f, 0.f, 0.f}; S[1] = S[0];
    h16x8 Wf[2][2], Bf[2][2]; h16x4 U0i[2], VKi[2]; float gam[2];
    auto ld = [&](int c, h16x8 (&W_)[2][2], h16x8 (&B_)[2][2], h16x4 (&U_)[2], h16x4 (&V_)[2], float (&G_)[2]) {
        const size_t ub = ((size_t)(b * 64 + c) * 4 + h) * 4096;
#pragma unroll
        for (int j = 0; j < 2; ++j) {
            const int rowi = (2 * hf + j) * 16 + cc;
#pragma unroll
            for (int ks = 0; ks < 2; ++ks) { W_[j][ks] = *(const h16x8*)(p.rw_W + ub + rowi * 64 + ks * 32 + 8 * g); B_[j][ks] = *(const h16x8*)(p.rw_Be + ub + rowi * 64 + ks * 32 + 8 * g); }
            U_[j] = *(const h16x4*)(p.rw_U0 + ub + rowi * 64 + vt * 16 + 4 * g);
            V_[j] = *(const h16x4*)(p.rw_VK + ub + rowi * 64 + vt * 16 + 4 * g);
            G_[j] = p.rw_gam[((size_t)(b * 64 + c) * 4 + h) * 64 + rowi];
        }
    };
    ld(0, Wf, Bf, U0i, VKi, gam);
    for (int c = 0; c < 64; ++c) {
        h16x8 Wn[2][2], Bn[2][2]; h16x4 Un[2], Vn[2]; float Gn[2];
        if (c + 1 < 64) ld(c + 1, Wn, Bn, Un, Vn, Gn);
#pragma unroll
        for (int j = 0; j < 2; ++j)
#pragma unroll
            for (int r = 0; r < 4; ++r) Sh[(vt * 16 + 4 * g + r) * 72 + (2 * hf + j) * 16 + cc] = (h16)S[j][r];
        __syncthreads();
        { const int row = tid >> 3, kc = (tid & 7) * 8; *(h16x8*)(p.rw_S0 + ((size_t)(b * 64 + c) * 4 + h) * 4096 + row * 64 + kc) = *(const h16x8*)&Sh[row * 72 + kc]; }
        h16x8 Af[2];
#pragma unroll
        for (int ks = 0; ks < 2; ++ks) Af[ks] = *(const h16x8*)&Sh[(vt * 16 + cc) * 72 + ks * 32 + 8 * g];
        f32x4 Ut[2];
#pragma unroll
        for (int j = 0; j < 2; ++j) {
            f32x4 acc = {(float)U0i[j][0], (float)U0i[j][1], (float)U0i[j][2], (float)U0i[j][3]};
            acc = __builtin_amdgcn_mfma_f32_16x16x32_f16(Af[0], Wf[j][0], acc, 0, 0, 0);
            acc = __builtin_amdgcn_mfma_f32_16x16x32_f16(Af[1], Wf[j][1], acc, 0, 0, 0);
            Ut[j] = acc;
        }
#pragma unroll
        for (int j = 0; j < 2; ++j)
#pragma unroll
            for (int r = 0; r < 4; ++r) Uh[(vt * 16 + 4 * g + r) * 72 + (2 * hf + j) * 16 + cc] = (h16)Ut[j][r];
        __syncthreads();
#pragma unroll
        for (int ks = 0; ks < 2; ++ks) Af[ks] = *(const h16x8*)&Uh[(vt * 16 + cc) * 72 + ks * 32 + 8 * g];
#pragma unroll
        for (int j = 0; j < 2; ++j) {
            f32x4 acc;
#pragma unroll
            for (int r = 0; r < 4; ++r) acc[r] = S[j][r] * gam[j] + (float)VKi[j][r];
            acc = __builtin_amdgcn_mfma_f32_16x16x32_f16(Af[0], Bf[j][0], acc, 0, 0, 0);
            acc = __builtin_amdgcn_mfma_f32_16x16x32_f16(Af[1], Bf[j][1], acc, 0, 0, 0);
            S[j] = acc;
        }
        if (c + 1 < 64) {
#pragma unroll
            for (int j = 0; j < 2; ++j) { Wf[j][0] = Wn[j][0]; Wf[j][1] = Wn[j][1]; Bf[j][0] = Bn[j][0]; Bf[j][1] = Bn[j][1]; U0i[j] = Un[j]; VKi[j] = Vn[j]; gam[j] = Gn[j]; }
        }
    }
}
__device__ __forceinline__ void ph_rw_c(CP p, int l, int bid, int nblk) {
    const int tid = otid(), lane = tid & 63, wave = tid >> 6, g = lane >> 4, cc = lane & 15;
    const int h = wave >> 1, th = wave & 1;
    for (int u = bid; u < 256; u += nblk) {
        const int b = u >> 6, c = u & 63;
        const size_t ub = ((size_t)(b * 64 + c) * 4 + h) * 4096;
        h16x8 Af[4][2];
#pragma unroll
        for (int vt = 0; vt < 4; ++vt)
#pragma unroll
            for (int ks = 0; ks < 2; ++ks) Af[vt][ks] = *(const h16x8*)(p.rw_S0 + ub + (vt * 16 + cc) * 64 + ks * 32 + 8 * g);
#pragma unroll
        for (int j = 0; j < 2; ++j) {
            const int t = (2 * th + j) * 16 + cc;
            const h16x8 B0 = *(const h16x8*)(p.rw_Ry + ub + t * 64 + 8 * g), B1 = *(const h16x8*)(p.rw_Ry + ub + t * 64 + 32 + 8 * g);
            f32x4 y[4]; float sum = 0.f;
#pragma unroll
            for (int vt = 0; vt < 4; ++vt) {
                const h16x4 yi = *(const h16x4*)(p.rw_Y0 + ub + t * 64 + vt * 16 + 4 * g);
                f32x4 acc = {(float)yi[0], (float)yi[1], (float)yi[2], (float)yi[3]};
                acc = __builtin_amdgcn_mfma_f32_16x16x32_f16(Af[vt][0], B0, acc, 0, 0, 0);
                acc = __builtin_amdgcn_mfma_f32_16x16x32_f16(Af[vt][1], B1, acc, 0, 0, 0);
                y[vt] = acc; sum += acc[0] + acc[1] + acc[2] + acc[3];
            }
            sum = rows_sum(sum);
            const float mean = sum * (1.f / 64.f);
            float vs = 0.f;
#pragma unroll
            for (int vt = 0; vt < 4; ++vt)
#pragma unroll
                for (int r = 0; r < 4; ++r) { const float d = y[vt][r] - mean; vs += d * d; }
            vs = rows_sum(vs);
            const float rstd = rsqrtf(vs * (1.f / 64.f) + 64e-5f);
            const size_t tok = (size_t)b * SEQ + c * 64 + t;
#pragma unroll
            for (int vt = 0; vt < 4; ++vt) {
                const int ch = h * 64 + vt * 16 + 4 * g;
                const f32x4 gw = *(const f32x4*)(p.in[I_RWGNW] + l * 256 + ch), gb = *(const f32x4*)(p.in[I_RWGNB] + l * 256 + ch);
                const h16x4 bo = *(const h16x4*)(p.rw_bonus + tok * 256 + ch), gg = *(const h16x4*)(p.rw_g + tok * 256 + ch);
                float o[4];
#pragma unroll
                for (int r = 0; r < 4; ++r) o[r] = ((y[vt][r] - mean) * rstd * gw[r] + gb[r] + (float)bo[r]) * (float)gg[r];
                *(h16x4*)(p.branches + tok * DM + 768 + ch) = pack4(o[0], o[1], o[2], o[3]);
            }
        }
    }
}

__device__ __forceinline__ void ph_dsa_pre(CP p, int bid, int nblk) {
    const int lane = otid() & 63, wv = otid() >> 6;
    for (int tok = bid * 8 + wv; tok < NTOK; tok += nblk * 8) {
        const int i = lane & 31;
        const float c = p.ropet[((size_t)tok * 32 + i) * 2], s = p.ropet[((size_t)tok * 32 + i) * 2 + 1];
        const int base = (lane < 32) ? P_Q : P_K;
        h16* dst = p.proj + (size_t)tok * PJ + base;
        const float scl = (lane < 32) ? 0.125f : 1.f;
#pragma unroll
        for (int h = 0; h < 4; ++h) {
            const float x1 = (float)dst[h * 64 + i], x2 = (float)dst[h * 64 + 32 + i];
            dst[h * 64 + i] = (h16)((x1 * c - x2 * s) * scl);
            dst[h * 64 + 32 + i] = (h16)((x2 * c + x1 * s) * scl);
        }
        const int i2 = lane & 15;
        const float c2 = p.ropet[((size_t)tok * 32 + 2 * i2) * 2], s2 = p.ropet[((size_t)tok * 32 + 2 * i2) * 2 + 1];
        float* xf = p.idxf + (size_t)tok * IDXLD;
        if (lane < 16) {
#pragma unroll
            for (int h = 0; h < 4; ++h) {
                const float x1 = xf[h * 32 + i2], x2 = xf[h * 32 + 16 + i2];
                xf[h * 32 + i2] = x1 * c2 - x2 * s2;
                xf[h * 32 + 16 + i2] = x2 * c2 + x1 * s2;
            }
        } else if (lane < 32) {
            const float x1 = xf[128 + i2], x2 = xf[128 + 16 + i2];
            xf[128 + i2] = x1 * c2 - x2 * s2;
            xf[128 + 16 + i2] = x2 * c2 + x1 * s2;
        }
    }
}
__device__ __forceinline__ unsigned f2key(float x) { unsigned u = __float_as_uint(x); return (u & 0x80000000u) ? ~u : (u | 0x80000000u); }
__device__ __forceinline__ void ph_dsa_naive(CP p, int bid, int nblk, char* smem) {
    const int lane = otid() & 63, wv = otid() >> 6;
    unsigned* s_key = (unsigned*)smem + wv * 4096;
    float* s_p = (float*)s_key;
    float* s_iq = (float*)(smem + 8 * 4096 * 4) + wv * 128;
    float* s_q = (float*)(smem + 8 * 4096 * 4 + 8 * 128 * 4) + wv * 256;
    int* s_list = (int*)(smem + 8 * 4096 * 4 + 8 * 128 * 4 + 8 * 256 * 4) + wv * 256;
    const unsigned long long lt_mask = (lane == 0) ? 0ull : (~0ull >> (64 - lane));
    for (int tok = bid * 8 + wv; tok < NTOK; tok += nblk * 8) {
        const int b = tok / SEQ, t = tok % SEQ;
        s_iq[lane] = p.idxf[(size_t)tok * IDXLD + lane]; s_iq[64 + lane] = p.idxf[(size_t)tok * IDXLD + 64 + lane];
        for (int i = 0; i < 4; ++i) s_q[i * 64 + lane] = (float)p.proj[(size_t)tok * PJ + P_Q + i * 64 + lane];
        const float w0 = p.idxf[(size_t)tok * IDXLD + 160], w1 = p.idxf[(size_t)tok * IDXLD + 161], w2 = p.idxf[(size_t)tok * IDXLD + 162], w3 = p.idxf[(size_t)tok * IDXLD + 163];
        __builtin_amdgcn_s_waitcnt(0); __builtin_amdgcn_wave_barrier();
        const int n = t + 1;
        const int nch = (t >> 6) + 1;
#pragma unroll 1
        for (int i = 0; i < nch; ++i) {
            const int s = lane + 64 * i;
            unsigned kv_ = 0u;
            if (s <= t) {
                const float* kp = p.idxf + ((size_t)b * SEQ + s) * IDXLD + 128;
                float d0 = 0.f, d1 = 0.f, d2 = 0.f, d3 = 0.f;
#pragma unroll
                for (int d4 = 0; d4 < 8; ++d4) {
                    const f32x4 kv = *(const f32x4*)(kp + d4 * 4);
#pragma unroll
                    for (int e = 0; e < 4; ++e) { const int d = d4 * 4 + e; d0 += s_iq[d] * kv[e]; d1 += s_iq[32 + d] * kv[e]; d2 += s_iq[64 + d] * kv[e]; d3 += s_iq[96 + d] * kv[e]; }
                }
                const float sc = w0 * fmaxf(d0, 0.f) + w1 * fmaxf(d1, 0.f) + w2 * fmaxf(d2, 0.f) + w3 * fmaxf(d3, 0.f);
                kv_ = f2key(sc + 0.f);
            }
            s_key[s] = kv_;
        }
        __builtin_amdgcn_s_waitcnt(0); __builtin_amdgcn_wave_barrier();
        int cnt_sel;
        if (n <= 256) {
            for (int i = 0; i < 4; ++i) { const int s = lane + 64 * i; if (s <= t) s_list[s] = s; }
            cnt_sel = n;
        } else {
            unsigned v = 0u;
#pragma unroll 1
            for (int bit = 31; bit >= 0; --bit) {
                const unsigned cand = v | (1u << bit);
                int c = 0;
#pragma unroll 4
                for (int i = 0; i < nch; ++i) c += __popcll(__ballot(s_key[lane + 64 * i] >= cand));
                if (c >= 256) v = cand;
            }
            int cgt = 0;
#pragma unroll 4
            for (int i = 0; i < nch; ++i) cgt += __popcll(__ballot(s_key[lane + 64 * i] > v));
            const int need = 256 - cgt;
            int nsel = 0, nties = 0;
#pragma unroll 1
            for (int i = 0; i < nch; ++i) {
                const unsigned kx = s_key[lane + 64 * i];
                const bool gt = kx > v, eq = kx == v;
                const unsigned long long eqm = __ballot(eq);
                const int trank = nties + __popcll(eqm & lt_mask);
                const bool sel = gt || (eq && trank < need);
                const unsigned long long sm = __ballot(sel);
                if (sel) s_list[nsel + __popcll(sm & lt_mask)] = lane + 64 * i;
                nsel += __popcll(sm); nties += __popcll(eqm);
            }
            cnt_sel = nsel;
        }
        __builtin_amdgcn_s_waitcnt(0); __builtin_amdgcn_wave_barrier();
        float lg[4][4];
#pragma unroll
        for (int jj = 0; jj < 4; ++jj) {
            const int j = lane + 64 * jj;
#pragma unroll
            for (int h = 0; h < 4; ++h) lg[jj][h] = -INFINITY;
            if (j < cnt_sel) {
                const int s = s_list[j];
                const h16* kp = p.proj + ((size_t)b * SEQ + s) * PJ + P_K;
#pragma unroll
                for (int h = 0; h < 4; ++h) {
                    float a = 0.f;
#pragma unroll
                    for (int d8 = 0; d8 < 8; ++d8) { const h16x8 kv = *(const h16x8*)(kp + h * 64 + d8 * 8);
#pragma unroll
                        for (int e = 0; e < 8; ++e) a += s_q[h * 64 + d8 * 8 + e] * (float)kv[e]; }
                    lg[jj][h] = a;
                }
            }
        }
        float inv[4];
#pragma unroll
        for (int h = 0; h < 4; ++h) {
            float m = fmaxf(fmaxf(lg[0][h], lg[1][h]), fmaxf(lg[2][h], lg[3][h]));
            m = wave_max(m);
            float sm = 0.f;
#pragma unroll
            for (int jj = 0; jj < 4; ++jj) { const float e = (lane + 64 * jj < cnt_sel) ? __expf(lg[jj][h] - m) : 0.f; s_p[h * 256 + lane + 64 * jj] = e; sm += e; }
            sm = wave_sum(sm);
            inv[h] = 1.f / sm;
        }
        __builtin_amdgcn_s_waitcnt(0); __builtin_amdgcn_wave_barrier();
        const int hh = lane >> 4;
        float o0 = 0.f, o1 = 0.f, o2 = 0.f, o3 = 0.f;
#pragma unroll 4
        for (int j = 0; j < cnt_sel; ++j) {
            const int s = s_list[j]; const float pj = s_p[hh * 256 + j];
            const h16x4 vv = *(const h16x4*)(p.proj + ((size_t)b * SEQ + s) * PJ + P_V + lane * 4);
            o0 += pj * (float)vv[0]; o1 += pj * (float)vv[1]; o2 += pj * (float)vv[2]; o3 += pj * (float)vv[3];
        }
        const float iv = (hh == 0) ? inv[0] : (hh == 1) ? inv[1] : (hh == 2) ? inv[2] : inv[3];
        *(h16x4*)(p.branches + (size_t)tok * DM + 256 + lane * 4) = pack4(o0 * iv, o1 * iv, o2 * iv, o3 * iv);
        __builtin_amdgcn_s_waitcnt(0); __builtin_amdgcn_wave_barrier();
    }
}
#define DSA_NAIVE_LDS (8 * 4096 * 4 + 8 * 128 * 4 + 8 * 256 * 4 + 8 * 256 * 4)

#define IDXH (2 * IDXLD)
__device__ __forceinline__ float idx_score(const f32x4 (&d)[4], const float (&w)[4], int r) {
    float sc = w[0] * fmaxf(d[0][r], 0.f);
    sc = __fmaf_rn(w[1], fmaxf(d[1][r], 0.f), sc);
    sc = __fmaf_rn(w[2], fmaxf(d[2][r], 0.f), sc);
    sc = __fmaf_rn(w[3], fmaxf(d[3][r], 0.f), sc);
    return sc + 0.f;
}
__device__ __forceinline__ f32x4 idx_dot(h16x8 khi, h16x8 klo, h16x8 qhi, h16x8 qlo) {
    f32x4 acc = {0.f, 0.f, 0.f, 0.f};
    acc = __builtin_amdgcn_mfma_f32_16x16x32_f16(khi, qhi, acc, 0, 0, 0);
    acc = __builtin_amdgcn_mfma_f32_16x16x32_f16(klo, qhi, acc, 0, 0, 0);
    acc = __builtin_amdgcn_mfma_f32_16x16x32_f16(khi, qlo, acc, 0, 0, 0);
    return acc;
}
__device__ __forceinline__ void ph_dsa_pre2(CP p, int bid, int nblk, char* smem) {
    h16* vt_s = (h16*)smem;
    for (int u = bid; u < NTOK / 64; u += nblk) {
        const int tid = otid(), lane = tid & 63, wv = tid >> 6;
        const int tok0 = u * 64;
        __syncthreads();
        for (int q = 0; q < 8; ++q) {
            const int tok = tok0 + wv * 8 + q;
            const int i = lane & 31;
            const float c = p.ropet[((size_t)tok * 32 + i) * 2], s = p.ropet[((size_t)tok * 32 + i) * 2 + 1];
            const int base = (lane < 32) ? P_Q : P_K;
            h16* dst = p.proj + (size_t)tok * PJ + base;
            const float scl = (lane < 32) ? 0.125f : 1.f;
#pragma unroll
            for (int h = 0; h < 4; ++h) {
                const float x1 = (float)dst[h * 64 + i], x2 = (float)dst[h * 64 + 32 + i];
                dst[h * 64 + i] = (h16)((x1 * c - x2 * s) * scl);
                dst[h * 64 + 32 + i] = (h16)((x2 * c + x1 * s) * scl);
            }
            const int i2 = lane & 15;
            const float c2 = p.ropet[((size_t)tok * 32 + 2 * i2) * 2], s2 = p.ropet[((size_t)tok * 32 + 2 * i2) * 2 + 1];
            float* xf = p.idxf + (size_t)tok * IDXLD;
            h16* xh = (h16*)xf;
            float o1[4], o2[4];
            if (lane < 16) {
#pragma unroll
                for (int h = 0; h < 4; ++h) { const float x1 = xf[h * 32 + i2], x2 = xf[h * 32 + 16 + i2]; o1[h] = x1 * c2 - x2 * s2; o2[h] = x2 * c2 + x1 * s2; }
            } else if (lane < 32) {
                const float x1 = xf[128 + i2], x2 = xf[128 + 16 + i2]; o1[0] = x1 * c2 - x2 * s2; o2[0] = x2 * c2 + x1 * s2;
            }
            asm volatile("s_waitcnt vmcnt(0)" ::: "memory");
            __builtin_amdgcn_wave_barrier();
            if (lane < 16) {
#pragma unroll
                for (int h = 0; h < 4; ++h) {
                    const h16 h1 = (h16)o1[h], h2 = (h16)o2[h];
                    xh[h * 32 + i2] = h1; xh[h * 32 + 16 + i2] = h2;
                    xh[128 + h * 32 + i2] = (h16)(o1[h] - (float)h1); xh[128 + h * 32 + 16 + i2] = (h16)(o2[h] - (float)h2);
                }
            } else if (lane < 32) {
                const h16 h1 = (h16)o1[0], h2 = (h16)o2[0];
                xh[256 + i2] = h1; xh[256 + 16 + i2] = h2;
                xh[288 + i2] = (h16)(o1[0] - (float)h1); xh[288 + 16 + i2] = (h16)(o2[0] - (float)h2);
            }
            *(h16x4*)&vt_s[(wv * 8 + q) * 264 + lane * 4] = *(const h16x4*)(p.proj + (size_t)tok * PJ + P_V + lane * 4);
        }
        __syncthreads();
        {
            const int dim = tid >> 1, hf = tid & 1, b = tok0 / SEQ, t0 = tok0 % SEQ;
            h16* dst = p.vT + ((size_t)b * 256 + dim) * SEQ + t0 + hf * 32;
#pragma unroll
            for (int k8 = 0; k8 < 4; ++k8) {
                h16x8 v;
#pragma unroll
                for (int e = 0; e < 8; ++e) v[e] = vt_s[(hf * 32 + k8 * 8 + e) * 264 + dim];
                *(h16x8*)(dst + k8 * 8) = v;
            }
        }
    }
}
__device__ __forceinline__ void ph_dsa_a(CP p, int bid, int nblk, char* smem) {
    int* cnts = (int*)smem;
    int* flag = cnts + 256;
    for (int u = bid; u < 1024; u += nblk) {
        const int tid = otid(), lane = tid & 63, wave = tid >> 6, g = lane >> 4, c = lane & 15;
        const int b = u >> 8, qb = u & 255, q0 = qb * 16;
        const size_t tokq = (size_t)b * SEQ + q0 + c;
        if (qb < 16) { if (tid < 16) { p.dthr[(size_t)b * SEQ + q0 + tid] = 0u; p.dcut[(size_t)b * SEQ + q0 + tid] = -1; } continue; }
        __syncthreads();
        const h16* qrow = (const h16*)(p.idxf + tokq * IDXLD);
        h16x8 qh[4], ql[4]; float w[4];
#pragma unroll
        for (int h = 0; h < 4; ++h) { qh[h] = *(const h16x8*)(qrow + h * 32 + 8 * g); ql[h] = *(const h16x8*)(qrow + 128 + h * 32 + 8 * g); w[h] = p.idxf[tokq * IDXLD + 160 + h]; }
        const int ntiles = qb + 1;
        const int nslots = (ntiles - wave + 7) >> 3;
        const int tq = q0 + c;
        unsigned K[32][4];
        {
            h16x8 kh[4], kl[4];
            const h16* kbase = (const h16*)(p.idxf + ((size_t)b * SEQ + c) * IDXLD) + 256 + 8 * g;
#pragma unroll
            for (int q = 0; q < 4; ++q) {
                int j = wave + 8 * q; j = j < ntiles ? j : ntiles - 1;
                kh[q] = *(const h16x8*)(kbase + (size_t)16 * j * IDXH); kl[q] = *(const h16x8*)(kbase + (size_t)16 * j * IDXH + 32);
            }
#pragma unroll
            for (int i = 0; i < 32; ++i) {
                K[i][0] = 0u; K[i][1] = 0u; K[i][2] = 0u; K[i][3] = 0u;
                if (i < nslots) {
                    const int j = wave + 8 * i;
                    f32x4 d[4];
#pragma unroll
                    for (int h = 0; h < 4; ++h) d[h] = idx_dot(kh[i & 3], kl[i & 3], qh[h], ql[h]);
                    if (i + 4 < nslots) { const int j4 = j + 32; kh[i & 3] = *(const h16x8*)(kbase + (size_t)16 * j4 * IDXH); kl[i & 3] = *(const h16x8*)(kbase + (size_t)16 * j4 * IDXH + 32); }
#pragma unroll
                    for (int r = 0; r < 4; ++r) { const int sidx = 16 * j + 4 * g + r; const unsigned kk = f2key(idx_score(d, w, r)); K[i][r] = (sidx <= tq) ? kk : 0u; }
                }
            }
        }
        unsigned v = 0u;
        int par = 0;
#pragma unroll 1
        for (int bit = 31; bit >= 0; --bit) {
            const unsigned cand = v | (1u << bit);
            int cn = 0;
#pragma unroll
            for (int i = 0; i < 32; ++i) if (i < nslots) { cn += (K[i][0] >= cand) + (K[i][1] >= cand) + (K[i][2] >= cand) + (K[i][3] >= cand); }
            cn = rows_isum(cn);
            if (g == 0) cnts[(par * 8 + wave) * 16 + c] = cn;
            __syncthreads();
            int tot = 0;
#pragma unroll
            for (int w8 = 0; w8 < 8; ++w8) tot += cnts[(par * 8 + w8) * 16 + c];
            if (tot >= 256) v = cand;
            par ^= 1;
        }
        int cgt = 0, ceq = 0;
#pragma unroll
        for (int i = 0; i < 32; ++i) if (i < nslots) {
#pragma unroll
            for (int r = 0; r < 4; ++r) { cgt += (K[i][r] > v); ceq += (K[i][r] == v); }
        }
        cgt = rows_isum(cgt); ceq = rows_isum(ceq);
        if (g == 0) { cnts[(par * 8 + wave) * 16 + c] = cgt | (ceq << 16); }
        if (tid == 0) flag[par] = 0;
        __syncthreads();
        int tgt = 0, teq = 0;
#pragma unroll
        for (int w8 = 0; w8 < 8; ++w8) { const int x = cnts[(par * 8 + w8) * 16 + c]; tgt += x & 0xffff; teq += x >> 16; }
        par ^= 1;
        const int need = 256 - tgt;
        const bool has_cut = teq > need;
        if (has_cut) flag[par ^ 1] = 1;
        __syncthreads();
        int cut = 4095;
        if (flag[par ^ 1]) {
            int cc = 0;
#pragma unroll 1
            for (int bit = 11; bit >= 0; --bit) {
                const int cand = cc | (1 << bit);
                int cn = 0;
#pragma unroll
                for (int i = 0; i < 32; ++i) if (i < nslots) {
                    const int sb = 16 * (wave + 8 * i) + 4 * g;
#pragma unroll
                    for (int r = 0; r < 4; ++r) cn += (K[i][r] == v && sb + r < cand);
                }
                cn = rows_isum(cn);
                if (g == 0) cnts[(par * 8 + wave) * 16 + c] = cn;
                __syncthreads();
                int tot = 0;
#pragma unroll
                for (int w8 = 0; w8 < 8; ++w8) tot += cnts[(par * 8 + w8) * 16 + c];
                if (tot < need) cc = cand;
                par ^= 1;
            }
            if (has_cut) cut = cc;
        }
        if (wave == 0 && g == 0) { p.dthr[tokq] = v; p.dcut[tokq] = cut; }
    }
}
#define KS_LD 264
#define VT_LD 72
#define IK_LD 72
#define DSAB_LDS (64 * KS_LD * 2 + 256 * VT_LD * 2 + 64 * IK_LD * 2 + 2 * 64 * KS_LD * 2)
__device__ __forceinline__ void ph_dsa_b(CP p, int bid, int nblk, char* smem) {
    h16* Ks = (h16*)smem;
    h16* Vt = Ks + 64 * KS_LD;
    h16* Ik = Vt + 256 * VT_LD;
    h16* Qs = Ik + 64 * IK_LD;
    h16* IQs = Qs + 64 * KS_LD;
    float* mrg = (float*)smem;
    for (int u = bid; u < 256; u += nblk) {
        const int tid = otid(), lane = tid & 63, wave = tid >> 6, g = lane >> 4, c = lane & 15;
        const int qt = wave & 3, kg = wave >> 2;
        const int b = u >> 6, qblk = 63 - (u & 63), q0 = qblk * 64;
        const int tq = q0 + 16 * qt + c;
        const size_t tokq = (size_t)b * SEQ + tq;
        float w[4];
#pragma unroll
        for (int h = 0; h < 4; ++h) w[h] = p.idxf[tokq * IDXLD + 160 + h];
        __syncthreads();
        for (int i = tid; i < 64 * 32; i += 512) {
            const int row = i >> 5, ch = i & 31; const size_t tk = (size_t)b * SEQ + q0 + row;
            *(u32x4*)&Qs[row * KS_LD + ch * 8] = *(const u32x4*)(p.proj + tk * PJ + P_Q + ch * 8);
            *(u32x4*)&IQs[row * KS_LD + ch * 8] = *(const u32x4*)((const h16*)(p.idxf + tk * IDXLD) + ch * 8);
        }
        const h16* qrow = Qs + (16 * qt + c) * KS_LD;
        const h16* irow = IQs + (16 * qt + c) * KS_LD;
        const unsigned thr = p.dthr[tokq]; const int cut = p.dcut[tokq];
        f32x4 O[4][4];
        float mrun[4], lrun[4];
#pragma unroll
        for (int h = 0; h < 4; ++h) { mrun[h] = -1e30f; lrun[h] = 0.f;
#pragma unroll
            for (int dt = 0; dt < 4; ++dt) O[h][dt] = (f32x4){0.f, 0.f, 0.f, 0.f}; }
        const int nsteps = qblk + 1;
        u32x4 rk[4], rv[4], ri;
#define DSAB_GLOAD(S_) do { const size_t kb_ = (size_t)b * SEQ + 64 * (S_); \
            _Pragma("unroll") for (int i = 0; i < 4; ++i) { const int ch = tid + 512 * i; rk[i] = *(const u32x4*)(p.proj + (kb_ + (ch >> 5)) * PJ + P_K + (ch & 31) * 8); } \
            _Pragma("unroll") for (int i = 0; i < 4; ++i) { const int ch = tid + 512 * i; rv[i] = *(const u32x4*)(p.vT + ((size_t)b * 256 + (ch >> 3)) * SEQ + 64 * (S_) + (ch & 7) * 8); } \
            ri = *(const u32x4*)((const h16*)(p.idxf + (kb_ + (tid >> 3)) * IDXLD) + 256 + (tid & 7) * 8); } while (0)
#define DSAB_LSTORE() do { \
            _Pragma("unroll") for (int i = 0; i < 4; ++i) { const int ch = tid + 512 * i; *(u32x4*)&Ks[(ch >> 5) * KS_LD + (ch & 31) * 8] = rk[i]; } \
            _Pragma("unroll") for (int i = 0; i < 4; ++i) { const int ch = tid + 512 * i; *(u32x4*)&Vt[(ch >> 3) * VT_LD + (ch & 7) * 8] = rv[i]; } \
            *(u32x4*)&Ik[(tid >> 3) * IK_LD + (tid & 7) * 8] = ri; } while (0)
        __syncthreads();
        DSAB_GLOAD(0);
        DSAB_LSTORE();
        __syncthreads();
        for (int s = 0; s < nsteps; ++s) {
            if (s + 1 < nsteps) DSAB_GLOAD(s + 1);
            const int kbase = 64 * s + 32 * kg;
            const h16* qrow_ = qrow; const h16* irow_ = irow;
            asm volatile("" : "+v"(qrow_), "+v"(irow_));
            bool msk[2][4];
#pragma unroll
            for (int jt = 0; jt < 2; ++jt) {
                const int row = 32 * kg + 16 * jt + c;
                const h16x8 kh = *(const h16x8*)&Ik[row * IK_LD + 8 * g], kl = *(const h16x8*)&Ik[row * IK_LD + 32 + 8 * g];
                f32x4 d[4];
#pragma unroll
                for (int h = 0; h < 4; ++h) d[h] = idx_dot(kh, kl, *(const h16x8*)(irow_ + h * 32 + 8 * g), *(const h16x8*)(irow_ + 128 + h * 32 + 8 * g));
#pragma unroll
                for (int r = 0; r < 4; ++r) {
                    const int sidx = kbase + 16 * jt + 4 * g + r;
                    const unsigned kk = f2key(idx_score(d, w, r));
                    msk[jt][r] = (sidx <= tq) && (kk > thr || (kk == thr && sidx <= cut));
                }
            }
#pragma unroll
            for (int h = 0; h < 4; ++h) {
                f32x4 S[2];
#pragma unroll
                for (int jt = 0; jt < 2; ++jt) {
                    const int row = 32 * kg + 16 * jt + c;
                    f32x4 acc = {0.f, 0.f, 0.f, 0.f};
                    acc = __builtin_amdgcn_mfma_f32_16x16x32_f16(*(const h16x8*)&Ks[row * KS_LD + h * 64 + 8 * g], *(const h16x8*)(qrow_ + h * 64 + 8 * g), acc, 0, 0, 0);
                    acc = __builtin_amdgcn_mfma_f32_16x16x32_f16(*(const h16x8*)&Ks[row * KS_LD + h * 64 + 32 + 8 * g], *(const h16x8*)(qrow_ + h * 64 + 32 + 8 * g), acc, 0, 0, 0);
                    S[jt] = acc;
                }
                float mx = -1e30f;
#pragma unroll
                for (int jt = 0; jt < 2; ++jt)
#pragma unroll
                    for (int r = 0; r < 4; ++r) mx = fmaxf(mx, msk[jt][r] ? S[jt][r] : -1e30f);
                mx = rows_max(mx);
                const float mnew = fmaxf(mrun[h], mx);
                const float scale = __expf(mrun[h] - mnew);
                mrun[h] = mnew;
                float ps = 0.f; h16x8 pb;
#pragma unroll
                for (int jt = 0; jt < 2; ++jt)
#pragma unroll
                    for (int r = 0; r < 4; ++r) { const float pe = msk[jt][r] ? __expf(S[jt][r] - mnew) : 0.f; ps += pe; pb[jt * 4 + r] = (h16)pe; }
                lrun[h] = lrun[h] * scale + ps;
#pragma unroll
                for (int dt = 0; dt < 4; ++dt) {
                    f32x4 o = O[h][dt] * scale;
                    const int vrow = h * 64 + 16 * dt + c;
                    const h16x4 va = *(const h16x4*)&Vt[vrow * VT_LD + 32 * kg + 4 * g], vb = *(const h16x4*)&Vt[vrow * VT_LD + 32 * kg + 16 + 4 * g];
                    h16x8 av; av[0] = va[0]; av[1] = va[1]; av[2] = va[2]; av[3] = va[3]; av[4] = vb[0]; av[5] = vb[1]; av[6] = vb[2]; av[7] = vb[3];
                    O[h][dt] = __builtin_amdgcn_mfma_f32_16x16x32_f16(av, pb, o, 0, 0, 0);
                }
            }
            __syncthreads();
            if (s + 1 < nsteps) DSAB_LSTORE();
            __syncthreads();
        }
#pragma unroll
        for (int h = 0; h < 4; ++h) lrun[h] = rows_sum(lrun[h]);
        float* my = mrg + (size_t)(qt * 64 + lane) * 73;
        if (kg == 1) {
#pragma unroll
            for (int h = 0; h < 4; ++h) { my[h] = mrun[h]; my[4 + h] = lrun[h];
#pragma unroll
                for (int dt = 0; dt < 4; ++dt)
#pragma unroll
                    for (int r = 0; r < 4; ++r) my[8 + (h * 4 + dt) * 4 + r] = O[h][dt][r]; }
        }
        __syncthreads();
        if (kg == 0) {
#pragma unroll
            for (int h = 0; h < 4; ++h) {
                const float m1 = my[h], l1 = my[4 + h];
                const float m = fmaxf(mrun[h], m1);
                const float e0 = __expf(mrun[h] - m), e1 = __expf(m1 - m);
                const float inv = 1.f / (lrun[h] * e0 + l1 * e1);
#pragma unroll
                for (int dt = 0; dt < 4; ++dt) {
                    float o[4];
#pragma unroll
                    for (int r = 0; r < 4; ++r) o[r] = (O[h][dt][r] * e0 + my[8 + (h * 4 + dt) * 4 + r] * e1) * inv;
                    *(h16x4*)(p.branches + tokq * DM + 256 + h * 64 + 16 * dt + 4 * g) = pack4(o[0], o[1], o[2], o[3]);
                }
            }
        }
        __syncthreads();
    }
}

__device__ __forceinline__ void ph_gates(CP p, int l, int bid, int nblk, char* smem) {
    pg8::Gemm g; g.A = p.h_hi; g.Bt = p.Wg; g.M = NTOK; g.N = 4096; g.K = DM; g.lda = DM;
    pg8::StaticOrder S; S.init(NTOK, 4096, nblk, bid);
    pg8::EpiH16<1> E; E.O = p.gates; E.ldc = 4096; E.ncols = 4096; E.bias = p.in[I_GATEB] + (size_t)l * 4096;
    pg8::gemm_phase((PG8_LAS unsigned char*)smem, g, S, E);
}
__device__ __forceinline__ void ph_merge(CP p, int l, int bid, int nblk, char* smem) {
    for (int u = bid; u < 128 * 8; u += nblk) {
        const int mt = u >> 3, nt = u & 7, m0 = mt * 128, n0 = nt * 128;
        f32x4 mx[2][4]; zero_acc<128>(mx);
        f32x4 au[2][4]; zero_acc<128>(au);
        const int tid_ = otid(); const int lane = tid_ & 63, wave = tid_ >> 6, wm = wave >> 1, wn = wave & 1;
        const h16* A = p.branches + (size_t)m0 * DM; const h16* B = p.Wb + (size_t)n0 * 256;
        const h16* G = p.gates + (size_t)(m0 + wm * 32 + (lane & 15)) * 4096 + n0 + wn * 64 + 4 * (lane >> 4);
        gemm_kloop_seg<128>(smem, DM, [=](int r, int k) { return A + (size_t)r * DM + k; },
                            [=](int r, int k) { return B + ((size_t)(k >> 8) * 1024 + r) * 256 + (k & 255); }, au,
                            [&](int kt) {
                                if ((kt & 3) == 3) {
                                    const int n = kt >> 2;
#pragma unroll
                                    for (int i = 0; i < 2; ++i)
#pragma unroll
                                        for (int j = 0; j < 4; ++j) {
                                            const h16x4 gg = *(const h16x4*)(G + (size_t)i * 16 * 4096 + n * 1024 + j * 16);
#pragma unroll
                                            for (int e = 0; e < 4; ++e) mx[i][j][e] += (float)gg[e] * au[i][j][e];
                                            au[i][j] = (f32x4){0.f, 0.f, 0.f, 0.f};
                                        }
                                }
                            });
        h16* O = p.mixed + (size_t)m0 * DM + n0;
        gemm_epi<128>(mx, [=](int ml, int nl, f32x4 v) { *(h16x4*)(O + (size_t)ml * DM + nl) = pack4(v[0], v[1], v[2], v[3]); });
    }
}
__device__ __forceinline__ void ph_outproj(CP p, int l, int bid, int nblk, char* smem) {
    pg8::Gemm g; g.A = p.mixed; g.Bt = p.Wo; g.M = NTOK; g.N = DM; g.K = DM; g.lda = DM;
    pg8::StaticOrder S; S.init(NTOK, DM, nblk, bid);
    pg8::EpiResid E; E.O = p.x1; E.X = l == 0 ? p.in[I_X] : p.x1; E.gate = p.mods + (size_t)l * 4 * 6144 + 2 * 1024;
    pg8::gemm_phase((PG8_LAS unsigned char*)smem, g, S, E);
}

__constant__ int c_pair_lo[6] = {0, 0, 0, 1, 1, 2};
__constant__ int c_pair_hi[6] = {1, 2, 3, 2, 3, 3};
__device__ __forceinline__ void ph_norm2_router(CP p, int l, int bid, int nblk, char* smem) {
    float* rw = (float*)smem;
    for (int i = otid(); i < DM * 16; i += 512) rw[i] = p.in[I_ROUTW][i];
    __syncthreads();
    const int lane = otid() & 63, wv = otid() >> 6;
    for (int tok = bid * 8 + wv; tok < NTOK; tok += nblk * 8) {
        const int b = tok / SEQ;
        const float* xr = p.x1 + (size_t)tok * DM;
        f32x4 v[4]; float ss = 0.f;
#pragma unroll
        for (int i = 0; i < 4; ++i) { v[i] = *(const f32x4*)(xr + i * 256 + lane * 4); ss += v[i][0] * v[i][0] + v[i][1] * v[i][1] + v[i][2] * v[i][2] + v[i][3] * v[i][3]; }
        ss = wave_sum(ss);
        const float rs = rsqrtf(ss * (1.f / DM) + 1e-6f);
        const float* g = p.in[I_FNG] + l * DM;
        const float* md = p.mods + ((size_t)l * 4 + b) * 6144;
        float lg[16];
#pragma unroll
        for (int e = 0; e < 16; ++e) lg[e] = 0.f;
#pragma unroll 1
        for (int i = 0; i < 4; ++i) {
            const int c = i * 256 + lane * 4;
            f32x4 gg = *(const f32x4*)(g + c), sh = *(const f32x4*)(md + 3 * 1024 + c), sc = *(const f32x4*)(md + 4 * 1024 + c);
            float hv[4];
#pragma unroll
            for (int e = 0; e < 4; ++e) hv[e] = v[i][e] * rs * gg[e] * (1.f + sc[e]) + sh[e];
            *(h16x4*)(p.h_hi + (size_t)tok * DM + c) = pack4(hv[0], hv[1], hv[2], hv[3]);
#pragma unroll 1
            for (int e = 0; e < 4; ++e) {
                const float* rr = rw + (c + e) * 16;
                const float hve = e == 0 ? hv[0] : e == 1 ? hv[1] : e == 2 ? hv[2] : hv[3];
#pragma unroll
                for (int x4 = 0; x4 < 4; ++x4) { const f32x4 r4 = *(const f32x4*)(rr + x4 * 4); lg[x4 * 4] += hve * r4[0]; lg[x4 * 4 + 1] += hve * r4[1]; lg[x4 * 4 + 2] += hve * r4[2]; lg[x4 * 4 + 3] += hve * r4[3]; }
            }
        }
#pragma unroll
        for (int e = 0; e < 16; ++e) lg[e] = wave_sum(lg[e]);
        if (lane == 0) {
            float sc[16], bi[16];
#pragma unroll
            for (int e = 0; e < 16; ++e) { sc[e] = 1.f / (1.f + expf(-lg[e])); bi[e] = sc[e] + p.in[I_ROUTB][e]; }
            int bg = 0; float bgs = -INFINITY;
#pragma unroll
            for (int gI = 0; gI < 4; ++gI) {
                float m1 = -INFINITY, m2 = -INFINITY;
#pragma unroll
                for (int j = 0; j < 4; ++j) { const float x = bi[gI * 4 + j]; if (x > m1) { m2 = m1; m1 = x; } else if (x > m2) m2 = x; }
                const float gs = m1 + m2;
                if (gs > bgs) { bgs = gs; bg = gI; }
            }
            int e0 = 0; float b0 = -INFINITY;
#pragma unroll
            for (int j = 0; j < 4; ++j) { float x = -INFINITY;
#pragma unroll
                for (int gI = 0; gI < 4; ++gI) if (gI == bg) x = bi[gI * 4 + j];
                if (x > b0) { b0 = x; e0 = j; } }
            int e1 = 0; float b1 = -INFINITY;
#pragma unroll
            for (int j = 0; j < 4; ++j) { float x = -INFINITY;
#pragma unroll
                for (int gI = 0; gI < 4; ++gI) if (gI == bg) x = bi[gI * 4 + j];
                if (j != e0 && x > b1) { b1 = x; e1 = j; } }
            float s0 = 0.f, s1 = 0.f;
#pragma unroll
            for (int e = 0; e < 16; ++e) { if (e == bg * 4 + e0) s0 = sc[e]; if (e == bg * 4 + e1) s1 = sc[e]; }
            const float wsum = s0 + s1; const float wa = s0 / wsum, wb = s1 / wsum;
            const int lo = e0 < e1 ? e0 : e1, hi = e0 < e1 ? e1 : e0;
            const float clo = e0 < e1 ? wa : wb, chi = e0 < e1 ? wb : wa;
            int pr = 0;
#pragma unroll
            for (int q = 0; q < 6; ++q) if (c_pair_lo[q] == lo && c_pair_hi[q] == hi) pr = q;
            const int bucket = bg * 6 + pr;
            const int pos = atomicAdd(&p.bcnt[bucket], 1);
            p.lists[(size_t)bucket * LCAP + pos] = tok;
            p.cw[(size_t)tok * 2] = clo; p.cw[(size_t)tok * 2 + 1] = chi;
        }
    }
}

struct MoeTile { int bucket, i0, cnt, ea, eb; };
__device__ __forceinline__ bool moe_tile(const int* bcnt, int mt, MoeTile& o) {
    int acc = 0;
    for (int b = 0; b < 24; ++b) {
        const int c = bcnt[b]; const int nt = (c + 127) >> 7;
        if (mt < acc + nt) { o.bucket = b; o.i0 = (mt - acc) * 128; o.cnt = c; const int g = b / 6, pr = b % 6; o.ea = g * 4 + c_pair_lo[pr]; o.eb = g * 4 + c_pair_hi[pr]; return true; }
        acc += nt;
    }
    return false;
}
#define MOE_MAXT 152
__device__ __forceinline__ void ph_moe1(CP p, int bid, int nblk, char* smem) {
    for (int u = bid; u < MOE_MAXT * 16; u += nblk) {
        const int mt = u >> 4, nt = u & 15;
        MoeTile T; if (!moe_tile(p.bcnt, mt, T)) break;
        const int* lst = p.lists + (size_t)T.bucket * LCAP; const int i0 = T.i0, cnt = T.cnt;
        const h16* H = p.h_hi;
        const int second = nt >= 8;
        const h16* B = p.We13 + ((size_t)(second ? T.eb : T.ea) * 1024 + (nt & 7) * 128) * DM;
        f32x4 acc[2][4]; zero_acc<128>(acc);
        gemm_kloop<128>(smem, DM, [=](int r, int k) { const int i = i0 + r; const int tok = lst[i < cnt ? i : 0]; return H + (size_t)tok * DM + k; },
                        [=](int r, int k) { return B + (size_t)r * DM + k; }, acc);
        const int lane = otid() & 63, wave = otid() >> 6, wm = wave >> 1, wn = wave & 1;
#pragma unroll
        for (int i = 0; i < 2; ++i) {
            const int ml = wm * 32 + i * 16 + (lane & 15);
            const int ii = i0 + ml; const bool valid = ii < cnt;
            const float cwv = valid ? p.cw[(size_t)lst[ii] * 2 + second] : 0.f;
            h16* O = p.act + ((size_t)mt * 128 + ml) * 1024 + second * 512;
#pragma unroll
            for (int jj = 0; jj < 2; ++jj) {
                const f32x4 a = acc[i][2 * jj], bq = acc[i][2 * jj + 1];
                const int col = ((nt & 7) * 128 + wn * 64 + jj * 32) / 2 + 4 * (lane >> 4);
                float o[4];
#pragma unroll
                for (int e = 0; e < 4; ++e) o[e] = valid ? cwv * (a[e] * sigm(a[e])) * bq[e] : 0.f;
                *(h16x4*)(O + col) = pack4(o[0], o[1], o[2], o[3]);
            }
        }
    }
}
__device__ __forceinline__ void ph_moe2(CP p, int l, int bid, int nblk, char* smem) {
    for (int u = bid; u < MOE_MAXT * 8; u += nblk) {
        const int mt = u >> 3, nt = u & 7, n0 = nt * 128;
        MoeTile T; if (!moe_tile(p.bcnt, mt, T)) break;
        const int* lst = p.lists + (size_t)T.bucket * LCAP; const int i0 = T.i0, cnt = T.cnt;
        const h16* A = p.act + (size_t)mt * 128 * 1024;
        const h16* Ba = p.We2 + ((size_t)T.ea * 1024 + n0) * 512; const h16* Bb = p.We2 + ((size_t)T.eb * 1024 + n0) * 512;
        f32x4 acc[2][4]; zero_acc<128>(acc);
        gemm_kloop<128>(smem, 1024, [=](int r, int k) { return A + (size_t)r * 1024 + k; },
                        [=](int r, int k) { return (k < 512 ? Ba + k : Bb + (k - 512)) + (size_t)r * 512; }, acc);
        const float* md = p.mods + (size_t)l * 4 * 6144 + 5 * 1024 + n0;
        float* X = p.x1;
        gemm_epi<128>(acc, [=](int ml, int nl, f32x4 v) { const int ii = i0 + ml; if (ii < cnt) { const int tok = lst[ii]; const f32x4 gg = *(const f32x4*)(md + (size_t)(tok / SEQ) * 6144 + nl);
                                                          float* xp = X + (size_t)tok * DM + n0 + nl; *(f32x4*)xp = *(const f32x4*)xp + gg * v; } });
    }
}
__device__ __forceinline__ void ph_final(CP p, int bid, int nblk) {
    const int lane = otid() & 63, wv = otid() >> 6;
    for (int tok = bid * 8 + wv; tok < NTOK; tok += nblk * 8) {
        const float* xr = p.x1 + (size_t)tok * DM;
        f32x4 v[4]; float ss = 0.f;
#pragma unroll
        for (int i = 0; i < 4; ++i) { v[i] = *(const f32x4*)(xr + i * 256 + lane * 4); ss += v[i][0] * v[i][0] + v[i][1] * v[i][1] + v[i][2] * v[i][2] + v[i][3] * v[i][3]; }
        ss = wave_sum(ss);
        const float rs = rsqrtf(ss * (1.f / DM) + 1e-6f);
#pragma unroll
        for (int i = 0; i < 4; ++i) { const int c = i * 256 + lane * 4; const f32x4 gg = *(const f32x4*)(p.in[I_FINALG] + c); *(f32x4*)(p.out + (size_t)tok * DM + c) = v[i] * rs * gg; }
    }
}

#define XB_TMO      128
#define XB_XCNT(j)  (256  + 64 * (j))
#define XB_XSUB(j)  (1280 + 64 * (j))
#define XB_XGEN(j)  (2304 + 64 * (j))
#define XB_TOP      3328
#define XB_TOPGEN   3392
#define XCD_BAR_WORDS 3456
#define XB_SPIN_CAP (1u << 24)
#define LAS __attribute__((address_space(3)))

__device__ __forceinline__ unsigned xb_ld(unsigned* p)              { return __hip_atomic_load(p, __ATOMIC_RELAXED, __HIP_MEMORY_SCOPE_AGENT); }
__device__ __forceinline__ unsigned xb_add(unsigned* p, unsigned v) { return __hip_atomic_fetch_add(p, v, __ATOMIC_RELAXED, __HIP_MEMORY_SCOPE_AGENT); }
__device__ __forceinline__ unsigned xb_xcc_id() { return (unsigned)__builtin_amdgcn_s_getreg((3 << 11) | 20) & 0xFu; }
#define XB_SPIN(cond, bar) do { unsigned _sp = 0; while (cond) { __builtin_amdgcn_s_sleep(1); \
    if ((++_sp & 255u) == 0u) { if (xb_ld(&(bar)[XB_TMO])) break; if (_sp > XB_SPIN_CAP) { atomicAdd(&(bar)[XB_TMO], 1u); break; } } } } while (0)

struct XcdBarrier { unsigned* bar; unsigned x; volatile LAS unsigned* st; };

__device__ __forceinline__ XcdBarrier xcd_barrier_post(unsigned* bar, volatile LAS unsigned* st) {
    XcdBarrier b; b.bar = bar; b.x = xb_xcc_id(); b.st = st;
    if (threadIdx.x == 0) (void)xb_add(&bar[XB_XCNT(b.x)], 1u);
    return b;
}
__device__ __forceinline__ void xcd_barrier_complete(unsigned* bar, unsigned x, unsigned& nloc, unsigned& nx) {
    const unsigned G = gridDim.x * gridDim.y * gridDim.z;
    unsigned sum, cnt, mine, sp = 0u;
    for (;;) {
        sum = 0u; cnt = 0u; mine = 0u;
#pragma unroll
        for (unsigned j = 0; j < 16; ++j) { const unsigned c = xb_ld(&bar[XB_XCNT(j)]); sum += c; cnt += (c > 0u) ? 1u : 0u; mine = (j == x) ? c : mine; }
        if (sum == G) break;
        __builtin_amdgcn_s_sleep(1);
        if ((++sp & 255u) == 0u) { if (xb_ld(&bar[XB_TMO])) break; if (sp > XB_SPIN_CAP) { atomicAdd(&bar[XB_TMO], 1u); break; } }
    }
    nloc = mine > 0u ? mine : 1u; nx = cnt > 0u ? cnt : 1u;
}
__device__ __forceinline__ void xcd_barrier(const XcdBarrier& b0) {
    asm volatile("s_waitcnt vmcnt(0)" ::: "memory");
    __syncthreads();
    if (threadIdx.x == 0) {
        unsigned long long ba = (unsigned long long)b0.bar;
        asm volatile("" : "+s"(ba));
        unsigned* bar = (unsigned*)ba;
        const unsigned x = xb_xcc_id();
        volatile LAS unsigned* st = b0.st;
        __builtin_amdgcn_s_waitcnt(0);
        unsigned nloc = st[0], nx = st[1];
        if (nloc == 0u) { xcd_barrier_complete(bar, x, nloc, nx); st[0] = nloc; st[1] = nx; }
        const unsigned old = xb_add(&bar[XB_XSUB(x)], 1u);
        const unsigned gen = old / nloc;
        if (old + 1u == (gen + 1u) * nloc) {
            __builtin_amdgcn_fence(__ATOMIC_RELEASE, "agent");
            asm volatile("s_waitcnt vmcnt(0)" ::: "memory");
            const unsigned og = xb_add(&bar[XB_TOP], 1u);
            const unsigned tg = og / nx;
            if (og + 1u == (tg + 1u) * nx) xb_add(&bar[XB_TOPGEN], 1u);
            else XB_SPIN(xb_ld(&bar[XB_TOPGEN]) == tg, bar);
            __builtin_amdgcn_fence(__ATOMIC_ACQUIRE, "agent");
            xb_add(&bar[XB_XGEN(x)], 1u);
            asm volatile("s_waitcnt vmcnt(0)" ::: "memory");
        } else {
            XB_SPIN(xb_ld(&bar[XB_XGEN(x)]) == gen, bar);
            __builtin_amdgcn_fence(__ATOMIC_ACQUIRE, "agent");
            asm volatile("s_waitcnt vmcnt(0)" ::: "memory");
        }
    }
    __syncthreads();
}

__device__ __forceinline__ const __attribute__((address_space(4))) Params* lp(const __attribute__((address_space(4))) Params* q) { asm volatile("" : "+s"(q)); return q; }
#define MEGA_LDS (155648 + 16)
__global__ void __launch_bounds__(512) k_mega(Params p) {
    extern __shared__ __attribute__((aligned(16))) char smem[];
    volatile LAS unsigned* xbw = (volatile LAS unsigned*)(smem + MEGA_LDS - 16);
    if (threadIdx.x == 0) { xbw[0] = 0u; xbw[1] = 0u; }
    __syncthreads();
    XcdBarrier bar = xcd_barrier_post(p.bar, xbw);
    const int bid0 = blockIdx.x, nblk0 = gridDim.x;
    const __attribute__((address_space(4))) Params* kp = (const __attribute__((address_space(4))) Params*)__builtin_amdgcn_kernarg_segment_ptr();
#define PQ (*lp(kp))
#define BID oint(bid0)
#define NBLK oint(nblk0)
    ph_mods(PQ, BID, NBLK, smem);
    ph_tables(PQ, BID, NBLK);
#if PROBE == 9
    __syncthreads(); ph_mods(PQ, BID, NBLK, smem); ph_tables(PQ, BID, NBLK);
#endif
    ph_convert_mix(PQ, 0, BID, NBLK);
#if PROBE == 1
    ph_convert_mix(PQ, 0, BID, NBLK);
#endif
    xcd_barrier(bar);
    for (int l0 = 0; l0 < 2; ++l0) {
#define LL oint(l0)
        ph_norm1(PQ, LL, BID, NBLK);
        xcd_barrier(bar);
        ph_gemm1(PQ, BID, NBLK, smem);
#if PROBE == 2
        ph_gemm1(PQ, BID, NBLK, smem);
#endif
        xcd_barrier(bar);
        ph_s5_scan<1>(PQ, LL, BID, NBLK);
        __syncthreads();
        ph_rg_a(PQ, LL, BID, NBLK, smem);
        __syncthreads();
        ph_rw_a(PQ, LL, BID, NBLK, smem);
#if PROBE == 13
        __syncthreads(); ph_s5_scan<1>(PQ, LL, BID, NBLK);
#endif
#if PROBE == 14
        __syncthreads(); ph_rg_a(PQ, LL, BID, NBLK, smem);
#endif
#if PROBE == 15
        __syncthreads(); ph_rw_a(PQ, LL, BID, NBLK, smem);
#endif
#if PROBE == 3
        __syncthreads(); ph_s5_scan<1>(PQ, LL, BID, NBLK); __syncthreads(); ph_rg_a(PQ, LL, BID, NBLK, smem); __syncthreads(); ph_rw_a(PQ, LL, BID, NBLK, smem);
#endif
        __syncthreads();
        __syncthreads();
        ph_dsa_pre2(PQ, BID, NBLK, smem);
        xcd_barrier(bar);
        if (BID < 16) ph_rw_b(PQ, BID, smem);
        else {
            ph_s5_carry(PQ, LL, BID - 16, NBLK - 16);
            ph_rg_c(PQ, LL, BID - 16, NBLK - 16, smem);
            __syncthreads();
            ph_dsa_a(PQ, BID - 16, NBLK - 16, smem);
#if PROBE == 4 || PROBE == 12
            __syncthreads(); ph_dsa_a(PQ, BID - 16, NBLK - 16, smem);
#endif
        }
#if PROBE == 4 || PROBE == 11
        if (BID < 16) ph_rw_b(PQ, BID, smem);
#endif
        xcd_barrier(bar);
        ph_dsa_b(PQ, BID, NBLK, smem);
        ph_s5_scan<3>(PQ, LL, BID, NBLK);
        ph_rw_c(PQ, LL, BID, NBLK);
#if PROBE == 5
        __syncthreads(); ph_dsa_b(PQ, BID, NBLK, smem);
#endif
#if PROBE == 17
        ph_s5_scan<3>(PQ, LL, BID, NBLK);
#endif
#if PROBE == 18
        ph_rw_c(PQ, LL, BID, NBLK);
#endif
#if PROBE == 6
        ph_s5_scan<3>(PQ, LL, BID, NBLK); ph_rw_c(PQ, LL, BID, NBLK);
#endif
        xcd_barrier(bar);
        ph_s5_glu(PQ, LL, BID, NBLK, smem);
        xcd_barrier(bar);
        ph_gates(PQ, LL, BID, NBLK, smem);
#if PROBE == 7
        ph_gates(PQ, LL, BID, NBLK, smem);
#endif
        xcd_barrier(bar);
        ph_merge(PQ, LL, BID, NBLK, smem);
#if PROBE == 10
        ph_merge(PQ, LL, BID, NBLK, smem);
#endif
        xcd_barrier(bar);
        ph_outproj(PQ, LL, BID, NBLK, smem);
        ph_convert_moe(PQ, LL, BID, NBLK);
#if PROBE == 1
        ph_convert_moe(PQ, LL, BID, NBLK);
#endif
        xcd_barrier(bar);
        ph_norm2_router(PQ, LL, BID, NBLK, smem);
        if (LL == 0) ph_convert_mix(PQ, 1, BID, NBLK);
#if PROBE == 1
        if (LL == 0) ph_convert_mix(PQ, 1, BID, NBLK);
#endif
        xcd_barrier(bar);
        ph_moe1(PQ, BID, NBLK, smem);
#if PROBE == 8
        ph_moe1(PQ, BID, NBLK, smem);
#endif
        xcd_barrier(bar);
        ph_moe2(PQ, LL, BID, NBLK, smem);
        xcd_barrier(bar);
    }
    ph_final(PQ, BID, NBLK);
}

static inline size_t al(size_t x) { return (x + 255) & ~(size_t)255; }
extern "C" void kernel_launch(void* const* d_in, const int* in_sizes, int n_in, void* d_out, int out_size, void* d_ws, size_t ws_size, hipStream_t stream) {
    Params p{};
    for (int i = 0; i < N_IN; ++i) p.in[i] = (const float*)d_in[i];
    p.pos = (const int*)d_in[I_POS];
    p.out = (float*)d_out;
    char* w = (char*)d_ws; size_t off = 0;
    auto take = [&](size_t bytes) { char* r = w + off; off += al(bytes); return r; };
    p.bar = (unsigned*)take(XCD_BAR_WORDS * 4);
    p.mods = (float*)take(2 * 4 * 6144 * 4);
    p.bcnt = (int*)take(256);
    p.s5c = (float*)take((size_t)2 * 16 * 64 * 36 * 4); p.ropet = (float*)take((size_t)NTOK * 32 * 2 * 4);
    p.Wp = (h16*)take((size_t)2560 * DM * 2); p.Widx = (h16*)take((size_t)256 * 3072 * 2); p.Wg = (h16*)take((size_t)4096 * DM * 2);
    p.Wb = (h16*)take((size_t)4096 * 256 * 2); p.Wo = (h16*)take((size_t)DM * DM * 2); p.Wglu = (h16*)take(256 * 256 * 2);
    p.x1 = (float*)take((size_t)NTOK * DM * 4);
    p.h_hi = (h16*)take((size_t)NTOK * DM * 2); p.h_lo = (h16*)take((size_t)NTOK * DM * 2); p.branches = p.h_lo;
    p.cw = (float*)take((size_t)NTOK * 2 * 4);
    p.lists = (int*)take((size_t)24 * LCAP * 4);
    const size_t offR = off;
    p.proj = (h16*)take((size_t)NTOK * PJ * 2); p.idxf = (float*)take((size_t)NTOK * IDXLD * 4);
    p.vT = (h16*)take((size_t)4 * 256 * SEQ * 2); p.dthr = (unsigned*)take((size_t)NTOK * 4); p.dcut = (int*)take((size_t)NTOK * 4);
    p.ybuf = (h16*)take((size_t)NTOK * 256 * 2); p.s5E = (float*)take((size_t)4 * 64 * 16 * 64 * 2 * 4); p.s5H = (float*)take((size_t)4 * 64 * 16 * 64 * 2 * 4);
    p.rg_hl = (float*)take((size_t)NTOK * 256 * 4); p.rg_cp = (float*)take((size_t)NTOK * 256 * 4); p.rg_agg = (float*)take((size_t)4 * 128 * 256 * 2 * 4);
    p.rw_g = (h16*)take((size_t)NTOK * 256 * 2); p.rw_bonus = (h16*)take((size_t)NTOK * 256 * 2);
    p.rw_W = (h16*)take((size_t)1024 * 4096 * 2); p.rw_U0 = (h16*)take((size_t)1024 * 4096 * 2); p.rw_Ry = (h16*)take((size_t)1024 * 4096 * 2); p.rw_Y0 = (h16*)take((size_t)1024 * 4096 * 2);
    p.rw_Be = (h16*)take((size_t)1024 * 4096 * 2); p.rw_VK = (h16*)take((size_t)1024 * 4096 * 2); p.rw_S0 = (h16*)take((size_t)1024 * 4096 * 2); p.rw_gam = (float*)take((size_t)1024 * 64 * 4);
    const size_t endMix = off;
    p.gates = p.proj;
    p.mixed = p.rw_g;
    if ((char*)p.gates + (size_t)NTOK * 4096 * 2 > (char*)p.mixed) { fprintf(stderr, "gates/mixed overlap\n"); return; }
    off = offR;
    p.We13 = (h16*)take((size_t)16 * 1024 * DM * 2); p.We2 = (h16*)take((size_t)16 * 1024 * 512 * 2); p.act = (h16*)take((size_t)MOE_MAXT * 128 * 1024 * 2);
    const size_t endMoe = off;
    const size_t need = endMix > endMoe ? endMix : endMoe;
    if (need > ws_size || (char*)p.act + (size_t)MOE_MAXT * 128 * 1024 * 2 > (char*)p.ybuf) { fprintf(stderr, "workspace layout problem: need %zu have %zu\n", need, ws_size); return; }

    static int grid = 0;
    if (!grid) {
        (void)hipFuncSetAttribute((const void*)k_mega, hipFuncAttributeMaxDynamicSharedMemorySize, MEGA_LDS);
        int dev = 0, cus = 0, per_cu = 0;
        (void)hipGetDevice(&dev);
        (void)hipDeviceGetAttribute(&cus, hipDeviceAttributeMultiprocessorCount, dev);
        (void)hipOccupancyMaxActiveBlocksPerMultiprocessor(&per_cu, (const void*)k_mega, 512, MEGA_LDS);
        if (per_cu < 1) { fprintf(stderr, "k_mega not launchable (occupancy 0)\n"); return; }
        grid = cus;
        fprintf(stderr, "k_mega: grid %d (cus %d, per_cu %d), ws need %zu have %zu\n", grid, cus, per_cu, need, ws_size);
    }
    (void)hipMemsetAsync(p.bar, 0, XCD_BAR_WORDS * 4, stream);
    k_mega<<<grid, 512, MEGA_LDS, stream>>>(p);
}
```

```cpp
#ifndef PROBE
#define PROBE 0
#endif
#include <hip/hip_runtime.h>
#include <stdint.h>
#include <stdio.h>
#include <math.h>

typedef _Float16 h16;
typedef _Float16 h16x8 __attribute__((ext_vector_type(8)));
typedef _Float16 h16x4 __attribute__((ext_vector_type(4)));
typedef _Float16 h16x2 __attribute__((ext_vector_type(2)));
typedef float f32x4 __attribute__((ext_vector_type(4)));
typedef unsigned u32x4 __attribute__((ext_vector_type(4)));

#define NTOK 16384
#define SEQ 4096
#define NBATCH 4
#define DM 1024
#define DINW 2596
#define PJ 2432
#define IDXLD 192
#define P_U 0
#define P_Q 256
#define P_K 512
#define P_V 768
#define P_RGX 1024
#define P_RGG 1280
#define P_RW 1536
#define LCAP 16384

enum { I_X = 0, I_C, I_POS, I_ADAW, I_ADAB, I_MNG, I_WIN, I_GATEW, I_GATEB, I_BRW, I_OUTW,
       I_S5LRE, I_S5LIM, I_S5LS, I_S5BRE, I_S5BIM, I_S5CRE, I_S5CIM, I_S5D, I_S5GW, I_S5GB,
       I_RGCW, I_RGCB, I_RGWR, I_RGBR, I_RGWI, I_RGBI, I_RGLAM,
       I_RWMU, I_RWW0, I_RWWUP, I_RWA0, I_RWAUP, I_RWGUP, I_RWKK, I_RWKA, I_RWRK, I_RWGNW, I_RWGNB,
       I_FNG, I_ROUTW, I_ROUTB, I_W1, I_W3, I_W2, I_FINALG, N_IN };

struct Params {
    const float* in[N_IN];
    const int* pos;
    float* out;
    unsigned* bar;
    float* mods;
    h16 *Wp, *Widx, *Wg, *Wb, *Wo, *Wglu, *We13, *We2;
    float* x1;
    h16 *h_hi, *h_lo, *branches;
    h16* proj; float* idxf;
    h16* ybuf; float *s5E, *s5H, *s5c, *ropet;
    h16* vT; unsigned* dthr; int* dcut; float* dsa_ml; h16* dsa_op;
    float *rg_hl, *rg_cp, *rg_agg;
    h16 *rw_r, *rw_w, *rw_k, *rw_kk, *rw_b, *rw_g, *rw_bonus, *rw_v; float* rw_y;
    h16 *rw_W, *rw_U0, *rw_Ry, *rw_Y0, *rw_Be, *rw_VK, *rw_S0; float* rw_gam;
    h16* mixed; h16* gates;
    h16* act; int* lists; int* bcnt; float* cw;
};

typedef const __attribute__((address_space(4))) Params& CP;
__device__ __forceinline__ float sigm(float x) { return 1.f / (1.f + __expf(-x)); }
__device__ __forceinline__ float gelu_tanh(float x) { return 0.5f * x * (1.f + tanhf(0.7978845608028654f * (x + 0.044715f * x * x * x))); }
__device__ __forceinline__ float softplusf_(float x) { return fmaxf(x, 0.f) + log1pf(__expf(-fabsf(x))); }
template <int CTRL> __device__ __forceinline__ float dppf(float x) { return __int_as_float(__builtin_amdgcn_update_dpp(0, __float_as_int(x), CTRL, 0xf, 0xf, false)); }
__device__ __forceinline__ float x16_sum(float x) { auto r = __builtin_amdgcn_permlane16_swap(__float_as_uint(x), __float_as_uint(x), false, false); return __uint_as_float(r[0]) + __uint_as_float(r[1]); }
__device__ __forceinline__ float x32_sum(float x) { auto r = __builtin_amdgcn_permlane32_swap(__float_as_uint(x), __float_as_uint(x), false, false); return __uint_as_float(r[0]) + __uint_as_float(r[1]); }
__device__ __forceinline__ float x16_max(float x) { auto r = __builtin_amdgcn_permlane16_swap(__float_as_uint(x), __float_as_uint(x), false, false); return fmaxf(__uint_as_float(r[0]), __uint_as_float(r[1])); }
__device__ __forceinline__ float x32_max(float x) { auto r = __builtin_amdgcn_permlane32_swap(__float_as_uint(x), __float_as_uint(x), false, false); return fmaxf(__uint_as_float(r[0]), __uint_as_float(r[1])); }
__device__ __forceinline__ int x16_isum(int x) { auto r = __builtin_amdgcn_permlane16_swap((unsigned)x, (unsigned)x, false, false); return (int)(r[0] + r[1]); }
__device__ __forceinline__ int x32_isum(int x) { auto r = __builtin_amdgcn_permlane32_swap((unsigned)x, (unsigned)x, false, false); return (int)(r[0] + r[1]); }
__device__ __forceinline__ float rows_sum(float x) { return x32_sum(x16_sum(x)); }
__device__ __forceinline__ float rows_max(float x) { return x32_max(x16_max(x)); }
__device__ __forceinline__ int rows_isum(int x) { return x32_isum(x16_isum(x)); }
template <int CTRL> __device__ __forceinline__ int dppi(int x) { return __builtin_amdgcn_update_dpp(0, x, CTRL, 0xf, 0xf, false); }
__device__ __forceinline__ int wave_isum(int v) { v += dppi<0xB1>(v); v += dppi<0x4E>(v); v += dppi<0x124>(v); v += dppi<0x128>(v); return rows_isum(v); }
__device__ __forceinline__ float wave_sum(float v) { v += dppf<0xB1>(v); v += dppf<0x4E>(v); v += dppf<0x124>(v); v += dppf<0x128>(v); return rows_sum(v); }
__device__ __forceinline__ float wave_max(float v) { v = fmaxf(v, dppf<0xB1>(v)); v = fmaxf(v, dppf<0x4E>(v)); v = fmaxf(v, dppf<0x124>(v)); v = fmaxf(v, dppf<0x128>(v)); return rows_max(v); }
__device__ __forceinline__ float egl_get(const float* egl, int k) { return egl[k]; }
__device__ __forceinline__ h16x4 pack4(float a, float b, float c, float d) { h16x4 r; r[0] = (h16)a; r[1] = (h16)b; r[2] = (h16)c; r[3] = (h16)d; return r; }

__device__ __forceinline__ int oint(int x) { asm volatile("" : "+s"(x)); return x; }
__device__ __forceinline__ int otid() { int t = threadIdx.x; asm volatile("" : "+v"(t)); return t; }
__device__ __forceinline__ void ph_mods(CP p, int bid, int nblk, char* smem) {
    if (bid >= 24) return;
    float* ca = (float*)smem;
    for (int i = otid(); i < 4 * DM; i += 512) { float c = p.in[I_C][i]; ca[i] = c * sigm(c); }
    __syncthreads();
    int gid = bid * 512 + otid();
    int l = gid / 6144, j = gid % 6144;
    const float* w = p.in[I_ADAW] + (size_t)l * DM * 6144 + j;
    float a0 = 0, a1 = 0, a2 = 0, a3 = 0;
    for (int k = 0; k < DM; ++k) { float wv = w[(size_t)k * 6144]; a0 += ca[k] * wv; a1 += ca[DM + k] * wv; a2 += ca[2 * DM + k] * wv; a3 += ca[3 * DM + k] * wv; }
    float bb = p.in[I_ADAB][l * 6144 + j];
    float* m = p.mods + (size_t)l * 4 * 6144;
    m[0 * 6144 + j] = a0 + bb; m[1 * 6144 + j] = a1 + bb; m[2 * 6144 + j] = a2 + bb; m[3 * 6144 + j] = a3 + bb;
}

__device__ __forceinline__ void ph_tables(CP p, int bid, int nblk) {
    const int gt = bid * 512 + otid(), gn = nblk * 512;
    for (int i = gt; i < NTOK * 32; i += gn) {
        const int tok = i >> 5, f = i & 31;
        const double ang = (double)p.pos[tok] * exp(-(double)f * (1.0 / 32.0) * 9.210340371976184);
        double sn, cs; sincos(ang, &sn, &cs);
        p.ropet[(size_t)i * 2] = (float)cs; p.ropet[(size_t)i * 2 + 1] = (float)sn;
    }
    for (int i = gt; i < 2 * 16 * 64; i += gn) {
        const int g = (i >> 6) & 15, l = i >> 10;
        const double lre = p.in[I_S5LRE][i], lim = p.in[I_S5LIM][i], st = exp((double)p.in[I_S5LS][l * 16 + g]);
        const double er = exp(lre * st); double sn, cs; sincos(lim * st, &sn, &cs);
        const double lbr = er * cs, lbi = er * sn;
        const double nr = lbr - 1.0, ni = lbi, den = lre * lre + lim * lim;
        const double fr = (nr * lre + ni * lim) / den, fi = (ni * lre - nr * lim) / den;
        const double e64 = exp(64.0 * lre * st); double s64, c64; sincos(64.0 * lim * st, &s64, &c64);
        float* o = p.s5c + (size_t)i * 36;
        o[0] = (float)lbr; o[1] = (float)lbi; o[2] = (float)(e64 * c64); o[3] = (float)(e64 * s64);
        for (int cc = 0; cc < 16; ++cc) { const double br = p.in[I_S5BRE][(size_t)i * 16 + cc], bi = p.in[I_S5BIM][(size_t)i * 16 + cc];
                                          o[4 + cc] = (float)(fr * br - fi * bi); o[20 + cc] = (float)(fr * bi + fi * br); }
    }
}
template <class SRC>
__device__ __forceinline__ void convT(h16* dst, int dstld, int nrows, int K, int koff, const SRC& src, int gtid, int gthreads) {
    const int kch = K / 8;
    const long total = (long)nrows * kch;
    for (long w = gtid; w < total; w += gthreads) {
        int n = (int)(w % nrows), kc = (int)(w / nrows);
        h16x8 v;
#pragma unroll
        for (int i = 0; i < 8; ++i) v[i] = (h16)src(n, kc * 8 + i);
        *(h16x8*)(dst + (size_t)n * dstld + koff + kc * 8) = v;
    }
}
__device__ __forceinline__ void ph_convert_mix(CP p, int l, int bid, int nblk) {
    const int gt = bid * 512 + otid(), gn = nblk * 512;
    { const float* s = p.in[I_WIN] + (size_t)l * DM * DINW;
      convT(p.Wp, DM, 2560, DM, 0, [=](int n, int k) { return n < PJ ? s[(size_t)k * DINW + (n < 1024 ? n : n + 164)] : 0.f; }, gt, gn);
      convT(p.Widx, 3072, 256, DM, 0, [=](int n, int k) { return n < 164 ? s[(size_t)k * DINW + 1024 + n] : 0.f; }, gt, gn);
      convT(p.Widx, 3072, 256, DM, 1024, [=](int n, int k) { return n < 164 ? s[(size_t)k * DINW + 1024 + n] : 0.f; }, gt, gn);
      convT(p.Widx, 3072, 256, DM, 2048, [=](int n, int k) { float w = n < 164 ? s[(size_t)k * DINW + 1024 + n] : 0.f; float hi = (float)(h16)w; return w - hi; }, gt, gn); }
    { const float* s = p.in[I_GATEW] + (size_t)l * DM * 4096;
      convT(p.Wg, DM, 4096, DM, 0, [=](int n, int k) { return s[(size_t)k * 4096 + n]; }, gt, gn); }
    { const float* s = p.in[I_BRW] + (size_t)l * 4 * 256 * DM;
      convT(p.Wb, 256, 4096, 256, 0, [=](int n, int k) { int br = n >> 10, d = n & 1023; return s[(size_t)br * 256 * DM + (size_t)k * DM + d]; }, gt, gn); }
    { const float* s = p.in[I_OUTW] + (size_t)l * DM * DM;
      convT(p.Wo, DM, DM, DM, 0, [=](int n, int k) { return s[(size_t)k * DM + n]; }, gt, gn); }
    { const float* s = p.in[I_S5GW] + (size_t)l * 256 * 256;
      convT(p.Wglu, 256, 256, 256, 0, [=](int n, int k) { return s[(size_t)k * 256 + n]; }, gt, gn); }
}
__device__ __forceinline__ void ph_convert_moe(CP p, int l, int bid, int nblk) {
    const int gt = bid * 512 + otid(), gn = nblk * 512;
    const float* s1 = p.in[I_W1] + (size_t)l * 16 * DM * 512;
    const float* s3 = p.in[I_W3] + (size_t)l * 16 * DM * 512;
    const float* s2 = p.in[I_W2] + (size_t)l * 16 * 512 * DM;
    convT(p.We13, DM, 16 * 1024, DM, 0, [=](int n, int k) { int e = n >> 10, r = n & 1023; int c = (r >> 5) * 16 + (r & 15); const float* s = ((r >> 4) & 1) ? s3 : s1;
                                                           return s[(size_t)e * DM * 512 + (size_t)k * 512 + c]; }, gt, gn);
    convT(p.We2, 512, 16 * 1024, 512, 0, [=](int n, int k) { int e = n >> 10, c = n & 1023; return s2[(size_t)e * 512 * DM + (size_t)k * DM + c]; }, gt, gn);
}

__device__ __forceinline__ void ph_norm1(CP p, int l, int bid, int nblk) {
    const float* xin = l == 0 ? p.in[I_X] : p.x1;
    const int lane = otid() & 63, wv = otid() >> 6;
    if (bid == 0 && otid() < 24) p.bcnt[otid()] = 0;
    for (int tok = bid * 8 + wv; tok < NTOK; tok += nblk * 8) {
        const int b = tok / SEQ;
        const float* xr = xin + (size_t)tok * DM;
        f32x4 v[4]; float ss = 0.f;
#pragma unroll
        for (int i = 0; i < 4; ++i) { v[i] = *(const f32x4*)(xr + i * 256 + lane * 4); ss += v[i][0] * v[i][0] + v[i][1] * v[i][1] + v[i][2] * v[i][2] + v[i][3] * v[i][3]; }
        ss = wave_sum(ss);
        const float rs = rsqrtf(ss * (1.f / DM) + 1e-6f);
        const float* g = p.in[I_MNG] + l * DM;
        const float* md = p.mods + ((size_t)l * 4 + b) * 6144;
#pragma unroll
        for (int i = 0; i < 4; ++i) {
            const int c = i * 256 + lane * 4;
            f32x4 gg = *(const f32x4*)(g + c), sh = *(const f32x4*)(md + c), sc = *(const f32x4*)(md + 1024 + c);
            float hv[4]; h16x4 hi, lo;
#pragma unroll
            for (int e = 0; e < 4; ++e) { hv[e] = v[i][e] * rs * gg[e] * (1.f + sc[e]) + sh[e]; hi[e] = (h16)hv[e]; lo[e] = (h16)(hv[e] - (float)hi[e]); }
            *(h16x4*)(p.h_hi + (size_t)tok * DM + c) = hi;
            *(h16x4*)(p.h_lo + (size_t)tok * DM + c) = lo;
        }
    }
}

#define LDT 72
template <int BM, class AF, class BF, class SEG>
__device__ __forceinline__ void gemm_kloop_seg(char* smem, int K, const AF& af, const BF& bf, f32x4 (&acc)[BM / 64][4], const SEG& seg) {
    constexpr int MT = BM / 64, WM = BM / 4, NA = BM / 64;
    h16* sA = (h16*)smem; h16* sB = sA + 2 * BM * LDT;
    const int tid = otid(), lane = tid & 63, wave = tid >> 6, wm = wave >> 1, wn = wave & 1;
    const int lrow = tid >> 3, lkc = (tid & 7) * 8;
    u32x4 ra0[NA], rb0[2], ra1[NA], rb1[2];
    const int nk = K / 64;
#define GK_LOAD(RA, RB, KT) do { const int k_ = (KT) * 64 + lkc; \
        _Pragma("unroll") for (int i = 0; i < NA; ++i) RA[i] = *(const u32x4*)af(lrow + i * 64, k_); \
        _Pragma("unroll") for (int i = 0; i < 2; ++i) RB[i] = *(const u32x4*)bf(lrow + i * 64, k_); } while (0)
#define GK_STORE(RA, RB, BUF) do { h16* nA_ = sA + (BUF) * BM * LDT; h16* nB_ = sB + (BUF) * 128 * LDT; \
        _Pragma("unroll") for (int i = 0; i < NA; ++i) *(u32x4*)&nA_[(lrow + i * 64) * LDT + lkc] = RA[i]; \
        _Pragma("unroll") for (int i = 0; i < 2; ++i) *(u32x4*)&nB_[(lrow + i * 64) * LDT + lkc] = RB[i]; } while (0)
#define GK_COMPUTE(BUF) do { const h16* cA = sA + (BUF) * BM * LDT; const h16* cB = sB + (BUF) * 128 * LDT; \
        _Pragma("unroll") for (int ks = 0; ks < 2; ++ks) { h16x8 a[MT], b[4]; \
            _Pragma("unroll") for (int i = 0; i < MT; ++i) a[i] = *(const h16x8*)&cA[(wm * WM + i * 16 + (lane & 15)) * LDT + ks * 32 + (lane >> 4) * 8]; \
            _Pragma("unroll") for (int j = 0; j < 4; ++j) b[j] = *(const h16x8*)&cB[(wn * 64 + j * 16 + (lane & 15)) * LDT + ks * 32 + (lane >> 4) * 8]; \
            _Pragma("unroll") for (int i = 0; i < MT; ++i) _Pragma("unroll") for (int j = 0; j < 4; ++j) acc[i][j] = __builtin_amdgcn_mfma_f32_16x16x32_f16(b[j], a[i], acc[i][j], 0, 0, 0); } } while (0)
    GK_LOAD(ra0, rb0, 0);
    if (nk > 1) GK_LOAD(ra1, rb1, 1);
    GK_STORE(ra0, rb0, 0);
    __syncthreads();
    for (int kt = 0; kt < nk; kt += 2) {
        if (kt + 2 < nk) GK_LOAD(ra0, rb0, kt + 2);
        GK_COMPUTE(0);
        seg(kt);
        if (kt + 1 < nk) GK_STORE(ra1, rb1, 1);
        __syncthreads();
        if (kt + 1 < nk) {
            if (kt + 3 < nk) GK_LOAD(ra1, rb1, kt + 3);
            GK_COMPUTE(1);
            seg(kt + 1);
            if (kt + 2 < nk) GK_STORE(ra0, rb0, 0);
            __syncthreads();
        }
    }
#undef GK_LOAD
#undef GK_STORE
#undef GK_COMPUTE
}
template <int BM, class AF, class BF>
__device__ __forceinline__ void gemm_kloop(char* smem, int K, const AF& af, const BF& bf, f32x4 (&acc)[BM / 64][4]) {
    gemm_kloop_seg<BM>(smem, K, af, bf, acc, [](int) {});
}
template <int BM> __device__ __forceinline__ void zero_acc(f32x4 (&acc)[BM / 64][4]) {
#pragma unroll
    for (int i = 0; i < BM / 64; ++i)
#pragma unroll
        for (int j = 0; j < 4; ++j) acc[i][j] = (f32x4){0.f, 0.f, 0.f, 0.f};
}
template <int BM, class EPI>
__device__ __forceinline__ void gemm_epi(const f32x4 (&acc)[BM / 64][4], const EPI& epi) {
    const int lane = otid() & 63, wave = otid() >> 6, wm = wave >> 1, wn = wave & 1;
#pragma unroll
    for (int i = 0; i < BM / 64; ++i)
#pragma unroll
        for (int j = 0; j < 4; ++j) epi(wm * (BM / 4) + i * 16 + (lane & 15), wn * 64 + j * 16 + 4 * (lane >> 4), acc[i][j]);
}
#define GEMM_LDS(BM) (2 * (BM) * LDT * 2 + 2 * 128 * LDT * 2)


namespace pg8 {
#define PG8_LAS __attribute__((address_space(3)))
constexpr int BM = 256, BK = 64, HALF = 128, HTB = HALF * BK * 2, STAGE_BYTES = 8 * HTB, NXCD = 8, WGM = 8;
__device__ __forceinline__ int lds_byte(int r, int c) { const int st = (r >> 4) * 2 + (c >> 5), rr = r & 15, cc = c & 31, ob = rr * 64 + cc * 2; return st * 1024 + (ob ^ (((ob >> 9) & 1) << 5)); }
__device__ __forceinline__ void stage_rc(int b, int& R, int& C) { const int st = b / 1024, sb = b % 1024, swz = sb ^ (((sb >> 9) & 1) << 5); R = (st >> 1) * 16 + swz / 64; C = (st & 1) * 32 + (swz % 64) / 2; }
__device__ __forceinline__ int perm32(int rho) { const int n = rho >> 4, i = rho & 15; return 8 * (i >> 2) + 4 * n + (i & 3); }
struct Unit { int pm, pn; };
struct Gemm { const h16* A; const h16* Bt; int M, N, K, lda; };
struct StaticOrder {
    int nM, nN, nwg, G, c;
    __device__ void init(int M, int N, int G_, int c_) { nM = M / BM; nN = N / BM; nwg = nM * nN; G = G_; c = c_; }
    __device__ bool next(int i, Unit& u) const {
        const long L = (long)i * G + c; if (L >= nwg) return false;
        int wgid = (int)L; { const int q = nwg / NXCD, r = nwg % NXCD, xcd = wgid % NXCD, off = wgid / NXCD; wgid = (xcd < r ? xcd * (q + 1) : r * (q + 1) + (xcd - r) * q) + off; }
        const int nig = WGM * nN, gid = wgid / nig, fm = gid * WGM, gsz = (nM - fm) < WGM ? (nM - fm) : WGM;
        u.pm = fm + ((wgid % nig) % gsz); u.pn = (wgid % nig) / gsz; return true;
    }
};
template <class Epi, class Sched>
__device__ __forceinline__ void gemm_phase(PG8_LAS unsigned char* lds, const Gemm g, const Sched& S, const Epi& E) {
    const int tid = otid(), wid = __builtin_amdgcn_readfirstlane(tid >> 6), lane = tid & 63, wr = wid >> 2, wc = wid & 3, fr = lane & 15, fq = lane >> 4;
    const int K = g.K, nt = K / BK;
    unsigned voffA[2], voffB[2];
#pragma unroll
    for (int i = 0; i < 2; ++i) { int R, C; stage_rc(tid * 16 + i * 8192, R, C); const int Rb = Epi::PERM ? ((R & ~31) + perm32(R & 31)) : R;
        voffA[i] = (unsigned)(R * g.lda + C) * 2u; voffB[i] = (unsigned)(Rb * K + C) * 2u; }
    const size_t kstep = (size_t)(BK * 2);
    const size_t hsA = (size_t)HALF * g.lda * 2, hsB = (size_t)HALF * K * 2;
    const size_t tsA = 2 * hsA, tsB = 2 * hsB;
    const unsigned ldsw = (unsigned)wid * 1024u;
    const int aoff = lds_byte(wr * 64 + fr, fq * 8), boff = lds_byte(wc * 32 + fr, fq * 8);
#define PG8_SA(b, h) (((b) * 2 + (h)) * HTB)
#define PG8_SB(b, h) ((4 + (b) * 2 + (h)) * HTB)
#define PG8_STAGE(bufoff, gbase, voff) do { _Pragma("unroll") for (int _i = 0; _i < 2; ++_i) \
        __builtin_amdgcn_global_load_lds((const unsigned*)((const char*)(gbase) + (voff)[_i]), (PG8_LAS unsigned*)(lds + (bufoff) + ldsw + _i * 8192), 16, 0, 0); } while (0)
#define PG8_LDA(dst, b, h) do { _Pragma("unroll") for (int m = 0; m < 4; ++m) _Pragma("unroll") for (int k = 0; k < 2; ++k) dst[m][k] = *(const PG8_LAS h16x8*)(lds + PG8_SA(b, h) + aoff + m * 2048 + k * 1024); } while (0)
#define PG8_LDB(dst, b, h) do { _Pragma("unroll") for (int n = 0; n < 2; ++n) _Pragma("unroll") for (int k = 0; k < 2; ++k) dst[n][k] = *(const PG8_LAS h16x8*)(lds + PG8_SB(b, h) + boff + n * 2048 + k * 1024); } while (0)
#define PG8_MMA(ai, bj, At, Bt) do { __builtin_amdgcn_s_setprio(1); _Pragma("unroll") for (int m = 0; m < 4; ++m) _Pragma("unroll") for (int n = 0; n < 2; ++n) _Pragma("unroll") for (int k = 0; k < 2; ++k) \
        acc[ai][bj][m][n] = __builtin_amdgcn_mfma_f32_16x16x32_f16(Bt[n][k], At[m][k], acc[ai][bj][m][n], 0, 0, 0); __builtin_amdgcn_s_setprio(0); } while (0)
#define PG8_WAIT_V(n) asm volatile("s_waitcnt vmcnt(" #n ")" ::: "memory")
#define PG8_WAIT_L(n) asm volatile("s_waitcnt lgkmcnt(" #n ")" ::: "memory")
#define PG8_BAR __builtin_amdgcn_s_barrier()
#define PG8_SCHED __builtin_amdgcn_sched_barrier(0)
    Unit cur, nxt; int ui = 0;
    if (!S.next(0, cur)) return;
    f32x4 acc[2][2][4][2];
#pragma unroll
    for (int a = 0; a < 2; ++a)
#pragma unroll
        for (int b = 0; b < 2; ++b)
#pragma unroll
            for (int m = 0; m < 4; ++m)
#pragma unroll
                for (int n = 0; n < 2; ++n) acc[a][b][m][n] = (f32x4){0.f, 0.f, 0.f, 0.f};
    h16x8 At[4][2], B0[2][2], B1[2][2];
    const char* cA = (const char*)g.A + (size_t)cur.pm * tsA; const char* cB = (const char*)g.Bt + (size_t)cur.pn * tsB;
    PG8_STAGE(PG8_SB(0, 0), cB, voffB); PG8_STAGE(PG8_SA(0, 0), cA, voffA); PG8_STAGE(PG8_SB(0, 1), cB + hsB, voffB); PG8_STAGE(PG8_SA(0, 1), cA + hsA, voffA);
    if (wr == 1) PG8_BAR;
    PG8_WAIT_V(4); PG8_BAR;
    PG8_STAGE(PG8_SB(1, 0), cB + kstep, voffB); PG8_STAGE(PG8_SA(1, 0), cA + kstep, voffA); PG8_STAGE(PG8_SB(1, 1), cB + hsB + kstep, voffB);
    PG8_WAIT_V(6); PG8_BAR;
    for (;;) {
        const bool has_next = S.next(ui + 1, nxt);
        const char* nA = has_next ? (const char*)g.A + (size_t)nxt.pm * tsA : cA; const char* nB = has_next ? (const char*)g.Bt + (size_t)nxt.pn * tsB : cB;
        for (int t = 0; t < nt; t += 2) {
            const bool last = (t == nt - 2);
            const char* a1 = cA + (size_t)(t + 1) * kstep;
            const char* a2 = last ? nA : cA + (size_t)(t + 2) * kstep; const char* b2 = last ? nB : cB + (size_t)(t + 2) * kstep;
            const char* a3 = a2 + kstep; const char* b3 = b2 + kstep;
            PG8_LDB(B0, 0, 0); PG8_SCHED; PG8_LDA(At, 0, 0); PG8_STAGE(PG8_SA(1, 1), a1 + hsA, voffA);
            PG8_WAIT_L(8); PG8_BAR; PG8_WAIT_L(0); PG8_MMA(0, 0, At, B0); PG8_BAR; PG8_SCHED;
            PG8_LDB(B1, 0, 1); PG8_STAGE(PG8_SB(0, 0), b2, voffB);
            PG8_BAR; PG8_WAIT_L(0); PG8_MMA(0, 1, At, B1); PG8_BAR;
            PG8_LDA(At, 0, 1); PG8_STAGE(PG8_SA(0, 0), a2, voffA);
            PG8_BAR; PG8_WAIT_L(0); PG8_MMA(1, 0, At, B0); PG8_BAR; PG8_SCHED;
            PG8_STAGE(PG8_SB(0, 1), b2 + hsB, voffB);
            PG8_WAIT_V(6); PG8_BAR; PG8_MMA(1, 1, At, B1); PG8_BAR;
            PG8_LDB(B0, 1, 0); PG8_SCHED; PG8_LDA(At, 1, 0); PG8_STAGE(PG8_SA(0, 1), a2 + hsA, voffA);
            PG8_WAIT_L(8); PG8_BAR; PG8_WAIT_L(0); PG8_MMA(0, 0, At, B0); PG8_BAR; PG8_SCHED;
            PG8_LDB(B1, 1, 1); PG8_STAGE(PG8_SB(1, 0), b3, voffB);
            PG8_BAR; PG8_WAIT_L(0); PG8_MMA(0, 1, At, B1); PG8_BAR;
            PG8_LDA(At, 1, 1); PG8_STAGE(PG8_SA(1, 0), a3, voffA);
            PG8_BAR; PG8_WAIT_L(0); PG8_MMA(1, 0, At, B0); PG8_BAR; PG8_SCHED;
            PG8_STAGE(PG8_SB(1, 1), b3 + hsB, voffB);
            PG8_WAIT_V(6); PG8_BAR; PG8_MMA(1, 1, At, B1); PG8_BAR;
        }
        E(acc, cur, wr, wc, fr, fq);
        if (!has_next) break;
#pragma unroll
        for (int a = 0; a < 2; ++a)
#pragma unroll
            for (int b = 0; b < 2; ++b)
#pragma unroll
                for (int m = 0; m < 4; ++m)
#pragma unroll
                    for (int n = 0; n < 2; ++n) acc[a][b][m][n] = (f32x4){0.f, 0.f, 0.f, 0.f};
        cur = nxt; cA = nA; cB = nB; ++ui;
    }
    PG8_WAIT_V(0);
    if (wr == 0) PG8_BAR;
    PG8_BAR;
#undef PG8_SA
#undef PG8_SB
#undef PG8_STAGE
#undef PG8_LDA
#undef PG8_LDB
#undef PG8_MMA
#undef PG8_WAIT_V
#undef PG8_WAIT_L
#undef PG8_BAR
#undef PG8_SCHED
}
__device__ __forceinline__ h16x8 pack8(const f32x4& a, const f32x4& b) { h16x8 r; r[0] = (h16)a[0]; r[1] = (h16)a[1]; r[2] = (h16)a[2]; r[3] = (h16)a[3]; r[4] = (h16)b[0]; r[5] = (h16)b[1]; r[6] = (h16)b[2]; r[7] = (h16)b[3]; return r; }
template <int ACT> struct EpiH16 {
    static constexpr bool PERM = true;
    h16* O; int ldc; int ncols; const float* bias;
    __device__ __forceinline__ void operator()(const f32x4 (&acc)[2][2][4][2], const Unit& u, int wr, int wc, int fr, int fq) const {
        const int row0 = u.pm * BM + wr * 64 + fr, col0 = u.pn * BM + wc * 32 + 8 * fq;
#pragma unroll
        for (int bj = 0; bj < 2; ++bj) {
            const int col = col0 + bj * HALF;
            if (col < ncols) {
                f32x4 b0 = {0.f, 0.f, 0.f, 0.f}, b1 = b0;
                if (ACT == 1) { b0 = *(const f32x4*)(bias + col); b1 = *(const f32x4*)(bias + col + 4); }
#pragma unroll
                for (int ai = 0; ai < 2; ++ai)
#pragma unroll
                    for (int m = 0; m < 4; ++m) {
                        f32x4 v0 = acc[ai][bj][m][0] + b0, v1 = acc[ai][bj][m][1] + b1;
                        if (ACT == 1) {
#pragma unroll
                            for (int e = 0; e < 4; ++e) { v0[e] = sigm(v0[e]); v1[e] = sigm(v1[e]); }
                        }
                        *(h16x8*)(O + (size_t)(row0 + ai * HALF + m * 16) * ldc + col) = pack8(v0, v1);
                    }
            }
        }
    }
};
struct EpiResid {
    static constexpr bool PERM = false;
    float* O; const float* X; const float* gate;
    __device__ __forceinline__ void operator()(const f32x4 (&acc)[2][2][4][2], const Unit& u, int wr, int wc, int fr, int fq) const {
        const int row0 = u.pm * BM + wr * 64 + fr, col0 = u.pn * BM + wc * 32 + 4 * fq;
        const float* gr = gate + (size_t)((u.pm * BM) / SEQ) * 6144;
#pragma unroll
        for (int bj = 0; bj < 2; ++bj)
#pragma unroll
            for (int n = 0; n < 2; ++n) {
                const int col = col0 + bj * HALF + n * 16;
                const f32x4 gg = *(const f32x4*)(gr + col);
#pragma unroll
                for (int ai = 0; ai < 2; ++ai)
#pragma unroll
                    for (int m = 0; m < 4; ++m) {
                        const size_t o = (size_t)(row0 + ai * HALF + m * 16) * DM + col;
                        *(f32x4*)(O + o) = *(const f32x4*)(X + o) + gg * acc[ai][bj][m][n];
                    }
            }
    }
};
}

__device__ __forceinline__ void ph_gemm1(CP p, int bid, int nblk, char* smem) {
    {
        pg8::Gemm g; g.A = p.h_hi; g.Bt = p.Wp; g.M = NTOK; g.N = 2560; g.K = DM; g.lda = DM;
        pg8::StaticOrder S; S.init(NTOK, 2560, nblk, bid);
        pg8::EpiH16<0> E; E.O = p.proj; E.ldc = PJ; E.ncols = PJ; E.bias = nullptr;
        pg8::gemm_phase(( PG8_LAS unsigned char*)smem, g, S, E);
    }
    __syncthreads();
    for (int u = bid - 128; u >= 0 && u < 128; u += nblk) {
        f32x4 acc[4][4]; zero_acc<256>(acc);
        const int mt = u >> 1, nt = u & 1, m0 = mt * 256, n0 = nt * 128;
        const h16* Ah = p.h_hi + (size_t)m0 * DM; const h16* Al = p.h_lo + (size_t)m0 * DM; const h16* B = p.Widx + (size_t)n0 * 3072;
        gemm_kloop<256>(smem, 3072, [=](int r, int k) { const h16* base = (k >= 1024 && k < 2048) ? Al : Ah; return base + (size_t)r * DM + (k & 1023); },
                        [=](int r, int k) { return B + (size_t)r * 3072 + k; }, acc);
        float* O = p.idxf + (size_t)m0 * IDXLD + n0;
        gemm_epi<256>(acc, [=](int ml, int nl, f32x4 v) { if (n0 + nl < IDXLD) *(f32x4*)(O + (size_t)ml * IDXLD + nl) = v; });
    }
}

template <int PASS>
__device__ __forceinline__ void ph_s5_scan(CP p, int l, int bid, int nblk, char* smem) {
    const int lane = otid() & 63, wv = otid() >> 6;
    h16* us = (h16*)smem + wv * (64 * 16);
    for (int u = bid * 8 + wv; u < 4096; u += nblk * 8) {
        const int g = u & 15, c = (u >> 4) & 63, b = u >> 10;
        const int pidx = (l * 16 + g) * 64 + lane;
        const float* sc_ = p.s5c + (size_t)pidx * 36;
        float Br[16], Bi[16];
#pragma unroll
        for (int cc = 0; cc < 16; ++cc) { Br[cc] = sc_[4 + cc]; Bi[cc] = sc_[20 + cc]; }
        const float lr = sc_[0], li = sc_[1];
        float hr = 0.f, hi = 0.f;
        float Cr[16], Ci[16];
        if (PASS == 3) {
#pragma unroll
            for (int cc = 0; cc < 16; ++cc) { Cr[cc] = p.in[I_S5CRE][((size_t)(l * 16 + g) * 16 + cc) * 64 + lane]; Ci[cc] = p.in[I_S5CIM][((size_t)(l * 16 + g) * 16 + cc) * 64 + lane]; }
            const size_t hix = ((((size_t)b * 64 + c) * 16 + g) * 64 + lane) * 2;
            hr = p.s5H[hix]; hi = p.s5H[hix + 1];
        }
        const int t0 = b * SEQ + c * 64;
        {
            const h16* up = p.proj + (size_t)(t0 + lane) * PJ + P_U + g * 16;
            const h16x8 a0 = *(const h16x8*)up, a1 = *(const h16x8*)(up + 8);
            __builtin_amdgcn_s_waitcnt(0); __builtin_amdgcn_wave_barrier();
            *(h16x8*)&us[lane * 16] = a0; *(h16x8*)&us[lane * 16 + 8] = a1;
            __builtin_amdgcn_s_waitcnt(0); __builtin_amdgcn_wave_barrier();
        }
        const int oidx = ((lane >> 5) & 1) * 8 + ((lane >> 4) & 1) * 4 + ((lane >> 3) & 1) * 2 + ((lane >> 2) & 1);
        const float dsk = p.in[I_S5D][l * 256 + g * 16 + oidx];
        for (int t = 0; t < 64; ++t) {
            h16x8 u0 = *(const h16x8*)&us[t * 16], u1 = *(const h16x8*)&us[t * 16 + 8];
            float uu[16];
#pragma unroll
            for (int cc = 0; cc < 8; ++cc) { uu[cc] = (float)u0[cc]; uu[8 + cc] = (float)u1[cc]; }
            float br = 0.f, bi = 0.f;
#pragma unroll
            for (int cc = 0; cc < 16; ++cc) { br += Br[cc] * uu[cc]; bi += Bi[cc] * uu[cc]; }
            const float nhr = lr * hr - li * hi + br, nhi = lr * hi + li * hr + bi;
            hr = nhr; hi = nhi;
            if (PASS == 3) {
                float v[16];
#pragma unroll
                for (int cc = 0; cc < 16; ++cc) v[cc] = Cr[cc] * hr - Ci[cc] * hi;
                float v8[8], v4[4], v2[2], v1;
                const bool b3 = lane & 8, b2 = lane & 4;
#pragma unroll
                for (int i = 0; i < 8; ++i) { auto r = __builtin_amdgcn_permlane32_swap(__float_as_uint(v[i]), __float_as_uint(v[i + 8]), false, false); v8[i] = __uint_as_float(r[0]) + __uint_as_float(r[1]); }
#pragma unroll
                for (int i = 0; i < 4; ++i) { auto r = __builtin_amdgcn_permlane16_swap(__float_as_uint(v8[i]), __float_as_uint(v8[i + 4]), false, false); v4[i] = __uint_as_float(r[0]) + __uint_as_float(r[1]); }
#pragma unroll
                for (int i = 0; i < 2; ++i) { float snd = b3 ? v4[i] : v4[i + 2], keep = b3 ? v4[i + 2] : v4[i]; v2[i] = keep + dppf<0x128>(snd); }
                { float snd = b2 ? v2[0] : v2[1], keep = b2 ? v2[1] : v2[0]; v1 = keep + dppf<0x1B>(dppf<0x141>(snd)); }
                v1 += dppf<0x4E>(v1); v1 += dppf<0xB1>(v1);
                if ((lane & 3) == 0) {
                    const float y = v1 + dsk * uu[oidx];
                    p.ybuf[(size_t)(t0 + t) * 256 + g * 16 + oidx] = (h16)gelu_tanh(y);
                }
            }
        }
        if (PASS == 1) { const size_t eix = ((((size_t)b * 64 + c) * 16 + g) * 64 + lane) * 2; p.s5E[eix] = hr; p.s5E[eix + 1] = hi; }
    }
}
__device__ __forceinline__ void ph_s5_carry(CP p, int l, int bid, int nblk) {
    if (bid >= 8) return;
    const int gid = bid * 512 + otid();
    const int pp = gid & 63, g = (gid >> 6) & 15, b = gid >> 10;
    const int pidx = (l * 16 + g) * 64 + pp;
    const float ar = p.s5c[(size_t)pidx * 36 + 2], ai = p.s5c[(size_t)pidx * 36 + 3];
    float hr = 0.f, hi = 0.f;
    for (int c = 0; c < 64; ++c) {
        const size_t ix = ((((size_t)b * 64 + c) * 16 + g) * 64 + pp) * 2;
        p.s5H[ix] = hr; p.s5H[ix + 1] = hi;
        const float er_ = p.s5E[ix], ei_ = p.s5E[ix + 1];
        const float nr = ar * hr - ai * hi + er_, ni = ar * hi + ai * hr + ei_;
        hr = nr; hi = ni;
    }
}
__device__ __forceinline__ void ph_s5_glu(CP p, int l, int bid, int nblk, char* smem) {
    for (int u = bid; u < 128; u += nblk) {
        const int mt = u >> 1, nt = u & 1, m0 = mt * 256, n0 = nt * 128;
        f32x4 acc[4][4]; zero_acc<256>(acc);
        const h16* A = p.ybuf + (size_t)m0 * 256; const h16* B = p.Wglu + (size_t)n0 * 256;
        gemm_kloop<256>(smem, 256, [=](int r, int k) { return A + (size_t)r * 256 + k; }, [=](int r, int k) { return B + (size_t)r * 256 + k; }, acc);
        const float* gb = p.in[I_S5GB] + l * 256 + n0;
        const h16* Y = p.ybuf + (size_t)m0 * 256 + n0; h16* O = p.branches + (size_t)m0 * DM + n0;
        gemm_epi<256>(acc, [=](int ml, int nl, f32x4 v) {
            h16x4 y = *(const h16x4*)(Y + (size_t)ml * 256 + nl); f32x4 bb = *(const f32x4*)(gb + nl);
            *(h16x4*)(O + (size_t)ml * DM + nl) = pack4((float)y[0] * sigm(v[0] + bb[0]), (float)y[1] * sigm(v[1] + bb[1]), (float)y[2] * sigm(v[2] + bb[2]), (float)y[3] * sigm(v[3] + bb[3])); });
    }
}

__device__ __forceinline__ void ph_rg_a(CP p, int l, int bid, int nblk, char* smem) {
    float* xc = (float*)smem;
    float* aa = xc + 32 * 256;
    float* bx = aa + 32 * 256;
    const int tid = otid();
    for (int u = bid; u < 512; u += nblk) {
        const int b = u >> 7, c = u & 127, t0 = c * 32;
        __syncthreads();
        {
            const int ch = tid & 255;
            const float w0 = p.in[I_RGCW][(l * 4 + 0) * 256 + ch], w1 = p.in[I_RGCW][(l * 4 + 1) * 256 + ch], w2 = p.in[I_RGCW][(l * 4 + 2) * 256 + ch], w3 = p.in[I_RGCW][(l * 4 + 3) * 256 + ch];
            const float cb = p.in[I_RGCB][l * 256 + ch];
            const int par = tid >> 8;
            h16 rows[19];
#pragma unroll
            for (int k = 0; k < 19; ++k) { const int tt = t0 + 16 * par - 3 + k; rows[k] = tt >= 0 ? p.proj[(size_t)(b * SEQ + tt) * PJ + P_RGX + ch] : (h16)0.f; }
#pragma unroll
            for (int m = 0; m < 16; ++m)
                xc[(16 * par + m) * 256 + ch] = cb + w3 * (float)rows[m + 3] + w2 * (float)rows[m + 2] + w1 * (float)rows[m + 1] + w0 * (float)rows[m];
        }
        __syncthreads();
        const int ch = tid & 255, half = tid >> 8, blk = ch >> 6, d = ch & 63;
        const float* wr = p.in[I_RGWR] + ((size_t)(l * 4 + blk) * 64) * 64 + d;
        const float* wi = p.in[I_RGWI] + ((size_t)(l * 4 + blk) * 64) * 64 + d;
        const float br = p.in[I_RGBR][l * 256 + ch], bi = p.in[I_RGBI][l * 256 + ch];
        const float spl = softplusf_(-p.in[I_RGLAM][l * 256 + ch]);
#pragma unroll 1
        for (int grp = 0; grp < 2; ++grp) {
            float ar[8], ai[8];
#pragma unroll
            for (int q = 0; q < 8; ++q) { ar[q] = br; ai[q] = bi; }
            const int tb = half * 16 + grp * 8;
            for (int cc = 0; cc < 64; ++cc) {
                const float wrv = wr[cc * 64], wiv = wi[cc * 64];
#pragma unroll
                for (int q = 0; q < 8; ++q) { const float xv = xc[(tb + q) * 256 + blk * 64 + cc]; ar[q] += xv * wrv; ai[q] += xv * wiv; }
            }
#pragma unroll
            for (int q = 0; q < 8; ++q) {
                const float r = sigm(ar[q]), ig = sigm(ai[q]);
                const float la = -8.f * r * spl;
                const float a = __expf(la), mult = sqrtf(-expm1f(2.f * la));
                aa[(tb + q) * 256 + ch] = a; bx[(tb + q) * 256 + ch] = mult * ig * xc[(tb + q) * 256 + ch];
            }
        }
        __syncthreads();
        if (tid < 256) {
            float h = 0.f, cp = 1.f;
            float* hl = p.rg_hl + (size_t)(b * SEQ + t0) * 256 + ch; float* cpo = p.rg_cp + (size_t)(b * SEQ + t0) * 256 + ch;
            for (int t = 0; t < 32; ++t) { const float a = aa[t * 256 + ch]; h = a * h + bx[t * 256 + ch]; cp *= a; hl[(size_t)t * 256] = h; cpo[(size_t)t * 256] = cp; }
            p.rg_agg[((size_t)(b * 128 + c) * 256 + ch) * 2] = cp; p.rg_agg[((size_t)(b * 128 + c) * 256 + ch) * 2 + 1] = h;
        }
    }
}
__device__ __forceinline__ void ph_rg_c(CP p, int l, int bid, int nblk, char* smem) {
    float* carry = (float*)smem;
    const int tid = otid();
    for (int u = bid; u < 512; u += nblk) {
        const int b = u >> 7, c = u & 127, t0 = c * 32;
        __syncthreads();
        if (tid < 256) { float h = 0.f; for (int cc = 0; cc < c; ++cc) { const float* ag = p.rg_agg + ((size_t)(b * 128 + cc) * 256 + tid) * 2; h = ag[0] * h + ag[1]; } carry[tid] = h; }
        __syncthreads();
        const int ch = tid & 255;
        {
            const int par = tid >> 8;
            float hl_[16], cp_[16]; h16 gt_[16];
#pragma unroll
            for (int m = 0; m < 16; ++m) { const size_t tok = (size_t)b * SEQ + t0 + 16 * par + m; hl_[m] = p.rg_hl[tok * 256 + ch]; cp_[m] = p.rg_cp[tok * 256 + ch]; gt_[m] = p.proj[tok * PJ + P_RGG + ch]; }
            const float cr = carry[ch];
#pragma unroll
            for (int m = 0; m < 16; ++m) { const size_t tok = (size_t)b * SEQ + t0 + 16 * par + m; p.branches[tok * DM + 512 + ch] = (h16)((hl_[m] + cp_[m] * cr) * gelu_tanh((float)gt_[m])); }
        }
    }
}

__device__ __forceinline__ void ph_rw_prep(CP p, int l, int bid, int nblk, char* smem) {
    h16* wup = (h16*)smem;
    h16* aup = wup + 32 * 256;
    h16* gup = aup + 32 * 256;
    float* f = (float*)(gup + 64 * 256);
    const int tid = otid(), lane = tid & 63;
    for (int i = tid; i < 32 * 256; i += 512) { wup[i] = (h16)p.in[I_RWWUP][(size_t)l * 32 * 256 + i]; aup[i] = (h16)p.in[I_RWAUP][(size_t)l * 32 * 256 + i]; }
    for (int i = tid; i < 64 * 256; i += 512) gup[i] = (h16)p.in[I_RWGUP][(size_t)l * 64 * 256 + i];
    const float* mu = p.in[I_RWMU] + l * 896;
    const int ch = tid & 255, tg = tid >> 8;
    const float w0 = p.in[I_RWW0][l * 256 + ch], a0 = p.in[I_RWA0][l * 256 + ch], kkw = p.in[I_RWKK][l * 256 + ch], kaw = p.in[I_RWKA][l * 256 + ch];
    const float rk = p.in[I_RWRK][l * 256 + ch];
    __syncthreads();
    for (int u = bid; u < NTOK / 16; u += nblk) {
        const int tok0 = u * 16;
        __syncthreads();
        for (int i = tid; i < 16 * 896; i += 512) {
            const int t = i / 896, cidx = i % 896; const int tok = tok0 + t;
            const float cur = (float)p.proj[(size_t)tok * PJ + P_RW + cidx];
            const float prv = (tok % SEQ) ? (float)p.proj[(size_t)(tok - 1) * PJ + P_RW + cidx] : 0.f;
            float v = cur + (prv - cur) * mu[cidx];
            if (cidx >= 768 && cidx < 800) v = tanhf(v);
            if (cidx >= 832) v = sigm(v);
            f[i] = v;
        }
        __syncthreads();
        for (int q = 0; q < 8; ++q) {
            const int t = tg * 8 + q; const int tok = tok0 + t;
            const float* ft = f + t * 896;
            float lw = 0.f, la = 0.f, lg = 0.f;
#pragma unroll 8
            for (int j = 0; j < 32; ++j) { lw += ft[768 + j] * (float)wup[j * 256 + ch]; la += ft[800 + j] * (float)aup[j * 256 + ch]; }
#pragma unroll 8
            for (int j = 0; j < 64; ++j) lg += ft[832 + j] * (float)gup[j * 256 + ch];
            const float w = -softplusf_(-(w0 + lw)) - 0.5f;
            const float wl = -__expf(w);
            const float a = sigm(a0 + la);
            const float r = ft[ch], k = ft[256 + ch], v = ft[512 + ch];
            float kk = k * kkw;
            const float nrm = sqrtf(wave_sum(kk * kk));
            kk = kk / fmaxf(nrm, 1e-12f);
            const float k2 = k * (1.f + (a - 1.f) * kaw);
            const float sb = wave_sum(r * k2 * rk);
            const size_t o = (size_t)tok * 256 + ch;
            p.rw_r[o] = (h16)r; p.rw_w[o] = (h16)wl; p.rw_k[o] = (h16)k2; p.rw_kk[o] = (h16)kk; p.rw_b[o] = (h16)(kk * a);
            p.rw_g[o] = (h16)lg; p.rw_bonus[o] = (h16)(sb * v); p.rw_v[o] = (h16)v;
        }
    }
}
__device__ __forceinline__ void ph_rw_scan(CP p, int bid, char* smem) {
    if (bid >= 16 || otid() >= 64) return;
    float (*sv)[64] = (float (*)[64])smem;
    const int b = bid >> 2, h = bid & 3, lane = otid();
    float S[64];
#pragma unroll
    for (int k = 0; k < 64; ++k) S[k] = 0.f;
    for (int t = 0; t < SEQ; ++t) {
        const size_t tok = (size_t)b * SEQ + t; const size_t o = tok * 256 + h * 64 + lane;
        const float vv = (float)p.rw_v[o];
        sv[0][lane] = (float)p.rw_r[o]; sv[1][lane] = __expf((float)p.rw_w[o]); sv[2][lane] = (float)p.rw_k[o]; sv[3][lane] = (float)p.rw_kk[o]; sv[4][lane] = (float)p.rw_b[o];
        __builtin_amdgcn_s_waitcnt(0); __builtin_amdgcn_wave_barrier();
        float skk = 0.f;
#pragma unroll
        for (int k = 0; k < 64; ++k) skk += S[k] * sv[3][k];
        float y = 0.f;
#pragma unroll
        for (int k = 0; k < 64; ++k) { S[k] = S[k] * sv[1][k] - skk * sv[4][k] + vv * sv[2][k]; y += S[k] * sv[0][k]; }
        p.rw_y[o] = y;
        __builtin_amdgcn_s_waitcnt(0); __builtin_amdgcn_wave_barrier();
    }
}
__device__ __forceinline__ void ph_rw_post(CP p, int l, int bid, int nblk) {
    const int lane = otid() & 63, wv = otid() >> 6;
    for (int u = bid * 8 + wv; u < NTOK * 4; u += nblk * 8) {
        const int tok = u >> 2, h = u & 3; const size_t o = (size_t)tok * 256 + h * 64 + lane;
        const float y = p.rw_y[o];
        const float mean = wave_sum(y) * (1.f / 64.f);
        const float dv = y - mean;
        const float var = wave_sum(dv * dv) * (1.f / 64.f);
        float v = dv * rsqrtf(var + 64e-5f) * p.in[I_RWGNW][l * 256 + h * 64 + lane] + p.in[I_RWGNB][l * 256 + h * 64 + lane];
        v += (float)p.rw_bonus[o];
        p.branches[(size_t)tok * DM + 768 + h * 64 + lane] = (h16)(v * (float)p.rw_g[o]);
    }
}

#define RS 68
template <int MODE>
__device__ __forceinline__ void mm_nt(float* out, const float* X, const float* Y, int wave, int nw, int lane) {
    const int g = lane >> 4, c = lane & 15;
    for (int idx = wave; idx < 16; idx += nw) {
        const int ti = idx >> 2, tj = idx & 3;
        f32x4 acc = {0.f, 0.f, 0.f, 0.f};
        if (MODE == 0 || tj <= ti) {
#pragma unroll
            for (int kb = 0; kb < 4; ++kb) {
                const f32x4 a4 = *(const f32x4*)&X[(ti * 16 + c) * RS + kb * 16 + 4 * g];
                const f32x4 b4 = *(const f32x4*)&Y[(tj * 16 + c) * RS + kb * 16 + 4 * g];
#pragma unroll
                for (int i = 0; i < 4; ++i) acc = __builtin_amdgcn_mfma_f32_16x16x4f32(a4[i], b4[i], acc, 0, 0, 0);
            }
        }
#pragma unroll
        for (int r = 0; r < 4; ++r) {
            const int row = ti * 16 + 4 * g + r, col = tj * 16 + c;
            float v = acc[r];
            if (MODE == 1 && col >= row) v = 0.f;
            if (MODE == 2 && col > row) v = 0.f;
            out[row * RS + col] = v;
        }
    }
}
__device__ __forceinline__ f32x4 mm_nn_tile(f32x4 acc, const float* X, const float* Y, int ti, int tj, int lane, float sign) {
    const int g = lane >> 4, c = lane & 15;
#pragma unroll
    for (int kb = 0; kb < 4; ++kb) {
        const f32x4 a4 = *(const f32x4*)&X[(ti * 16 + c) * RS + kb * 16 + 4 * g];
#pragma unroll
        for (int i = 0; i < 4; ++i) acc = __builtin_amdgcn_mfma_f32_16x16x4f32(sign * a4[i], Y[(kb * 16 + 4 * g + i) * RS + tj * 16 + c], acc, 0, 0, 0);
    }
    return acc;
}
template <int T> struct FwdRow {
    static __device__ __forceinline__ void run(float (&x)[64], const float* Nm) {
        FwdRow<T - 1>::run(x, Nm);
        float acc = x[T];
#pragma unroll
        for (int s4 = 0; s4 < (T + 3) / 4; ++s4) {
            const f32x4 n4 = *(const f32x4*)&Nm[T * RS + s4 * 4];
#pragma unroll
            for (int e = 0; e < 4; ++e) if (s4 * 4 + e < T) acc -= n4[e] * x[s4 * 4 + e];
        }
        x[T] = acc;
    }
};
template <> struct FwdRow<0> { static __device__ __forceinline__ void run(float (&)[64], const float*) {} };
#define RWA_LDS (16384 + 8 * 64 * RS * 4)
__device__ __forceinline__ void ph_rw_a(CP p, int l, int bid, int nblk, char* smem) {
    h16* fs = (h16*)smem;
    float* Ah = (float*)(smem + 16384);
    float* Rh = Ah + 64 * RS; float* Bh = Rh + 64 * RS; float* Kh = Bh + 64 * RS; float* Vv = Kh + 64 * RS;
    float* Nm = Vv + 64 * RS; float* Mm = Nm + 64 * RS; float* T1 = Mm + 64 * RS;
    float* tot = (float*)fs;
    float* egl = tot + 8 * 64;
    for (int u = bid; u < 1024; u += nblk) {
        int tid = otid(), lane = tid & 63, wave = tid >> 6;
        const float* mu = p.in[I_RWMU] + oint(l) * 896;
        const int h = u & 3, c = (u >> 2) & 63, b = u >> 8;
        const int t0 = c * 64; const size_t tok0 = (size_t)b * SEQ + t0;
        __syncthreads();
        {
            h16 cu_[16], pv_[16];
#pragma unroll
            for (int q = 0; q < 16; ++q) {
                const int i = tid + 512 * q; const int t = i >> 7, j = i & 127; const size_t tok = tok0 + t;
                const h16* pc = p.proj + tok * PJ + P_RW + 768 + j;
                cu_[q] = pc[0];
                pv_[q] = pc[(t0 + t) ? -(long)PJ : 0];
            }
#pragma unroll
            for (int q = 0; q < 16; ++q) {
                const int i = tid + 512 * q; const int t = i >> 7, j = i & 127;
                const float cur = (float)cu_[q]; const float prv = (t0 + t) ? (float)pv_[q] : 0.f;
                float v = cur + (prv - cur) * mu[768 + j];
                if (j < 32) v = tanhf(v); else if (j >= 64) v = sigm(v);
                fs[i] = (h16)v;
            }
        }
        __syncthreads();
        tid = otid(); lane = tid & 63; wave = tid >> 6;
        {
            const int ll = oint(l);
            const int ch = h * 64 + lane;
            const float w0 = p.in[I_RWW0][ll * 256 + ch], a0 = p.in[I_RWA0][ll * 256 + ch], kkw = p.in[I_RWKK][ll * 256 + ch], kaw = p.in[I_RWKA][ll * 256 + ch], rkw = p.in[I_RWRK][ll * 256 + ch];
            const float mur = mu[ch], muk = mu[256 + ch], muv = mu[512 + ch];
            float run = 0.f;
            h16x2 wpk[64];
#pragma unroll
            for (int m = 0; m < 64; ++m) {
                const int j0 = 2 * m;
                const float* src = j0 < 32 ? p.in[I_RWWUP] + ((size_t)ll * 32 + j0) * 256 : j0 < 64 ? p.in[I_RWAUP] + ((size_t)ll * 32 + (j0 - 32)) * 256 : p.in[I_RWGUP] + ((size_t)ll * 64 + (j0 - 64)) * 256;
                h16x2 w2; w2[0] = (h16)src[ch]; w2[1] = (h16)src[256 + ch];
                wpk[m] = w2;
            }
            h16 pr_[9], pk_[9], pv_[9];
#pragma unroll
            for (int q = 0; q < 9; ++q) {
                const int t = wave * 8 + q - 1;
                const bool ok = (t0 + t) >= 0;
                const h16* pc = p.proj + (tok0 + t) * PJ + P_RW + ch;
                pr_[q] = ok ? pc[0] : (h16)0.f; pk_[q] = ok ? pc[256] : (h16)0.f; pv_[q] = ok ? pc[512] : (h16)0.f;
            }
#pragma unroll
            for (int q = 0; q < 8; ++q) {
                const int t = wave * 8 + q; const size_t tok = tok0 + t;
                const h16* ft = fs + t * 128;
                float lw = 0.f, la = 0.f, lg = 0.f;
#pragma unroll
                for (int v8 = 0; v8 < 16; ++v8) {
                    const h16x8 f8 = *(const h16x8*)(ft + v8 * 8);
#pragma unroll
                    for (int e = 0; e < 4; ++e) {
                        h16x2 f2; f2[0] = f8[2 * e]; f2[1] = f8[2 * e + 1];
                        const int m = v8 * 4 + e;
                        if (m < 16) lw = __builtin_amdgcn_fdot2(f2, wpk[m], lw, false);
                        else if (m < 32) la = __builtin_amdgcn_fdot2(f2, wpk[m], la, false);
                        else lg = __builtin_amdgcn_fdot2(f2, wpk[m], lg, false);
                    }
                }
                const float rc = (float)pr_[q + 1], kc = (float)pk_[q + 1], vc = (float)pv_[q + 1];
                const float rp = (float)pr_[q], kp_ = (float)pk_[q], vp = (float)pv_[q];
                const float r = rc + (rp - rc) * mur, k = kc + (kp_ - kc) * muk, v = vc + (vp - vc) * muv;
                const float w = -softplusf_(-(w0 + lw)) - 0.5f;
                const float wl = -__expf(w);
                const float a = sigm(a0 + la);
                float kk = k * kkw;
                const float nrm = sqrtf(wave_sum(kk * kk));
                kk = kk / fmaxf(nrm, 1e-12f);
                const float k2 = k * (1.f + (a - 1.f) * kaw);
                const float sb = wave_sum(r * k2 * rkw);
                p.rw_g[tok * 256 + ch] = (h16)lg; p.rw_bonus[tok * 256 + ch] = (h16)(sb * v);
                run += wl;
                Ah[t * RS + lane] = kk; Rh[t * RS + lane] = r; Bh[t * RS + lane] = kk * a; Kh[t * RS + lane] = k2; Vv[t * RS + lane] = v; T1[t * RS + lane] = run;
            }
            __syncthreads();
            tot[wave * 64 + lane] = run;
            __syncthreads();
            float offs = 0.f, gl = 0.f;
#pragma unroll
            for (int w8 = 0; w8 < 8; ++w8) { const float tv = tot[w8 * 64 + lane]; if (w8 < wave) offs += tv; gl += tv; }
            if (wave == 0) { egl[lane] = __expf(gl); p.rw_gam[(size_t)u * 64 + lane] = __expf(gl); }
            float gprev = offs;
#pragma unroll 1
            for (int q = 0; q < 8; ++q) {
                const int t = wave * 8 + q;
                const float G = offs + T1[t * RS + lane];
                const float eg = __expf(G), egp = __expf(gprev), egi = __expf(-G);
                Ah[t * RS + lane] *= egp; Rh[t * RS + lane] *= eg; Bh[t * RS + lane] *= egi; Kh[t * RS + lane] *= egi;
                gprev = G;
            }
        }
        __syncthreads();
        tid = otid(); lane = tid & 63; wave = tid >> 6;
        mm_nt<1>(Nm, Ah, Bh, wave, 8, lane);
        mm_nt<1>(Mm, Ah, Kh, wave, 8, lane);
        __syncthreads();
        tid = otid(); lane = tid & 63; wave = tid >> 6;
        for (int idx = wave; idx < 16; idx += 8) {
            const int ti = idx >> 2, tj = idx & 3;
            f32x4 acc = {0.f, 0.f, 0.f, 0.f};
            acc = mm_nn_tile(acc, Mm, Vv, ti, tj, lane, 1.f);
#pragma unroll
            for (int r = 0; r < 4; ++r) T1[(ti * 16 + 4 * (lane >> 4) + r) * RS + tj * 16 + (lane & 15)] = acc[r];
        }
        __syncthreads();
        tid = otid(); lane = tid & 63; wave = tid >> 6;
        const size_t ub = (size_t)u * 4096;
        if (wave < 2) {
            float* src = wave == 0 ? Ah : T1;
            h16* og = (wave == 0 ? p.rw_W : p.rw_U0) + ub;
#pragma unroll
            for (int I = 0; I < 4; ++I) {
                float acc[16];
#pragma unroll
                for (int r = 0; r < 16; ++r) acc[r] = src[(16 * I + r) * RS + lane];
#pragma unroll 1
                for (int s4 = 0; s4 < 4 * I; ++s4) {
                    const float x0 = src[(s4 * 4 + 0) * RS + lane], x1 = src[(s4 * 4 + 1) * RS + lane], x2 = src[(s4 * 4 + 2) * RS + lane], x3 = src[(s4 * 4 + 3) * RS + lane];
#pragma unroll
                    for (int r = 0; r < 16; ++r) { const f32x4 n4 = *(const f32x4*)&Nm[(16 * I + r) * RS + s4 * 4]; acc[r] -= n4[0] * x0 + n4[1] * x1 + n4[2] * x2 + n4[3] * x3; }
                }
#pragma unroll
                for (int r = 1; r < 16; ++r) {
#pragma unroll
                    for (int q4 = 0; q4 < 4; ++q4) {
                        if (q4 * 4 < r) {
                            const f32x4 n4 = *(const f32x4*)&Nm[(16 * I + r) * RS + 16 * I + q4 * 4];
#pragma unroll
                            for (int e = 0; e < 4; ++e) if (q4 * 4 + e < r) acc[r] -= n4[e] * acc[q4 * 4 + e];
                        }
                    }
                }
#pragma unroll
                for (int r = 0; r < 16; ++r) { src[(16 * I + r) * RS + lane] = acc[r]; og[(16 * I + r) * 64 + lane] = (h16)acc[r]; }
            }
        } else {
            mm_nt<2>(Mm, Rh, Bh, wave - 2, 6, lane);
            for (int i = tid - 128; i < 4096; i += 384) { const int k = i >> 6, t = i & 63; p.rw_Be[ub + i] = (h16)(-Bh[t * RS + k] * egl_get(egl, k)); }
            for (int idx = wave - 2; idx < 16; idx += 6) {
                const int ti = idx >> 2, tj = idx & 3, g = lane >> 4, cc = lane & 15;
                f32x4 acc = {0.f, 0.f, 0.f, 0.f};
#pragma unroll
                for (int tb = 0; tb < 4; ++tb)
#pragma unroll
                    for (int i = 0; i < 4; ++i) acc = __builtin_amdgcn_mfma_f32_16x16x4f32(Kh[(tb * 16 + 4 * g + i) * RS + ti * 16 + cc], Vv[(tb * 16 + 4 * g + i) * RS + tj * 16 + cc], acc, 0, 0, 0);
#pragma unroll
                for (int r = 0; r < 4; ++r) { const int k = ti * 16 + 4 * g + r; p.rw_VK[ub + k * 64 + tj * 16 + cc] = (h16)(acc[r] * egl_get(egl, k)); }
            }
        }
        __syncthreads();
        tid = otid(); lane = tid & 63; wave = tid >> 6;
        mm_nt<2>(Nm, Rh, Kh, wave, 8, lane);
        __syncthreads();
        tid = otid(); lane = tid & 63; wave = tid >> 6;
        for (int idx = wave; idx < 16; idx += 8) {
            const int ti = idx >> 2, tj = idx & 3, g = lane >> 4, cc = lane & 15;
            f32x4 a1, a2 = {0.f, 0.f, 0.f, 0.f};
#pragma unroll
            for (int r = 0; r < 4; ++r) a1[r] = Rh[(ti * 16 + 4 * g + r) * RS + tj * 16 + cc];
            a1 = mm_nn_tile(a1, Mm, Ah, ti, tj, lane, -1.f);
            a2 = mm_nn_tile(a2, Nm, Vv, ti, tj, lane, 1.f);
            a2 = mm_nn_tile(a2, Mm, T1, ti, tj, lane, -1.f);
#pragma unroll
            for (int r = 0; r < 4; ++r) { const int row = ti * 16 + 4 * g + r, col = tj * 16 + cc; p.rw_Ry[ub + row * 64 + col] = (h16)a1[r]; p.rw_Y0[ub + row * 64 + col] = (h16)a2[r]; }
        }
    }
}
__device__ __forceinline__ void ph_rw_b(CP p, int bid, char* smem) {
    h16* Sh = (h16*)smem;
    h16* Uh = Sh + 64 * 72;
    const int tid = otid(), lane = tid & 63, wave = tid >> 6, g = lane >> 4, cc = lane & 15;
    const int vt = wave >> 1, hf = wave & 1;
    const int b = bid >> 2, h = bid & 3;
    f32x4 S[2];
    S[0] = (f32x4){0.f, 0.f, 0.f, 0.f}; S[1] = S[0];
    h16x8 Wf[2][2], Bf[2][2]; h16x4 U0i[2], VKi[2]; float gam[2];
    auto ld = [&](int c, h16x8 (&W_)[2][2], h16x8 (&B_)[2][2], h16x4 (&U_)[2], h16x4 (&V_)[2], float (&G_)[2]) {
        const size_t ub = ((size_t)(b * 64 + c) * 4 + h) * 4096;
#pragma unroll
        for (int j = 0; j < 2; ++j) {
            const int rowi = (2 * hf + j) * 16 + cc;
#pragma unroll
            for (int ks = 0; ks < 2; ++ks) { W_[j][ks] = *(const h16x8*)(p.rw_W + ub + rowi * 64 + ks * 32 + 8 * g); B_[j][ks] = *(const h16x8*)(p.rw_Be + ub + rowi * 64 + ks * 32 + 8 * g); }
            U_[j] = *(const h16x4*)(p.rw_U0 + ub + rowi * 64 + vt * 16 + 4 * g);
            V_[j] = *(const h16x4*)(p.rw_VK + ub + rowi * 64 + vt * 16 + 4 * g);
            G_[j] = p.rw_gam[((size_t)(b * 64 + c) * 4 + h) * 64 + rowi];
        }
    };
    ld(0, Wf, Bf, U0i, VKi, gam);
    for (int c = 0; c < 64; ++c) {
        h16x8 Wn[2][2], Bn[2][2]; h16x4 Un[2], Vn[2]; float Gn[2];
        if (c + 1 < 64) ld(c + 1, Wn, Bn, Un, Vn, Gn);
#pragma unroll
        for (int j = 0; j < 2; ++j)
#pragma unroll
            for (int r = 0; r < 4; ++r) Sh[(vt * 16 + 4 * g + r) * 72 + (2 * hf + j) * 16 + cc] = (h16)S[j][r];
        __syncthreads();
        { const int row = tid >> 3, kc = (tid & 7) * 8; *(h16x8*)(p.rw_S0 + ((size_t)(b * 64 + c) * 4 + h) * 4096 + row * 64 + kc) = *(const h16x8*)&Sh[row * 72 + kc]; }
        h16x8 Af[2];
#pragma unroll
        for (int ks = 0; ks < 2; ++ks) Af[ks] = *(const h16x8*)&Sh[(vt * 16 + cc) * 72 + ks * 32 + 8 * g];
        f32x4 Ut[2];
#pragma unroll
        for (int j = 0; j < 2; ++j) {
            f32x4 acc = {(float)U0i[j][0], (float)U0i[j][1], (float)U0i[j][2], (float)U0i[j][3]};
            acc = __builtin_amdgcn_mfma_f32_16x16x32_f16(Af[0], Wf[j][0], acc, 0, 0, 0);
            acc = __builtin_amdgcn_mfma_f32_16x16x32_f16(Af[1], Wf[j][1], acc, 0, 0, 0);
            Ut[j] = acc;
        }
#pragma unroll
        for (int j = 0; j < 2; ++j)
#pragma unroll
            for (int r = 0; r < 4; ++r) Uh[(vt * 16 + 4 * g + r) * 72 + (2 * hf + j) * 16 + cc] = (h16)Ut[j][r];
        __syncthreads();
#pragma unroll
        for (int ks = 0; ks < 2; ++ks) Af[ks] = *(const h16x8*)&Uh[(vt * 16 + cc) * 72 + ks * 32 + 8 * g];
#pragma unroll
        for (int j = 0; j < 2; ++j) {
            f32x4 acc;
#pragma unroll
            for (int r = 0; r < 4; ++r) acc[r] = S[j][r] * gam[j] + (float)VKi[j][r];
            acc = __builtin_amdgcn_mfma_f32_16x16x32_f16(Af[0], Bf[j][0], acc, 0, 0, 0);
            acc = __builtin_amdgcn_mfma_f32_16x16x32_f16(Af[1], Bf[j][1], acc, 0, 0, 0);
            S[j] = acc;
        }
        if (c + 1 < 64) {
#pragma unroll
            for (int j = 0; j < 2; ++j) { Wf[j][0] = Wn[j][0]; Wf[j][1] = Wn[j][1]; Bf[j][0] = Bn[j][0]; Bf[j][1] = Bn[j][1]; U0i[j] = Un[j]; VKi[j] = Vn[j]; gam[j] = Gn[j]; }
        }
    }
}
__device__ __forceinline__ void ph_rw_c(CP p, int l, int bid, int nblk) {
    const int tid = otid(), lane = tid & 63, wave = tid >> 6, g = lane >> 4, cc = lane & 15;
    const int h = wave >> 1, th = wave & 1;
    for (int u = bid; u < 256; u += nblk) {
        const int b = u >> 6, c = u & 63;
        const size_t ub = ((size_t)(b * 64 + c) * 4 + h) * 4096;
        h16x8 Af[4][2];
#pragma unroll
        for (int vt = 0; vt < 4; ++vt)
#pragma unroll
            for (int ks = 0; ks < 2; ++ks) Af[vt][ks] = *(const h16x8*)(p.rw_S0 + ub + (vt * 16 + cc) * 64 + ks * 32 + 8 * g);
#pragma unroll
        for (int j = 0; j < 2; ++j) {
            const int t = (2 * th + j) * 16 + cc;
            const h16x8 B0 = *(const h16x8*)(p.rw_Ry + ub + t * 64 + 8 * g), B1 = *(const h16x8*)(p.rw_Ry + ub + t * 64 + 32 + 8 * g);
            f32x4 y[4]; float sum = 0.f;
#pragma unroll
            for (int vt = 0; vt < 4; ++vt) {
                const h16x4 yi = *(const h16x4*)(p.rw_Y0 + ub + t * 64 + vt * 16 + 4 * g);
                f32x4 acc = {(float)yi[0], (float)yi[1], (float)yi[2], (float)yi[3]};
                acc = __builtin_amdgcn_mfma_f32_16x16x32_f16(Af[vt][0], B0, acc, 0, 0, 0);
                acc = __builtin_amdgcn_mfma_f32_16x16x32_f16(Af[vt][1], B1, acc, 0, 0, 0);
                y[vt] = acc; sum += acc[0] + acc[1] + acc[2] + acc[3];
            }
            sum = rows_sum(sum);
            const float mean = sum * (1.f / 64.f);
            float vs = 0.f;
#pragma unroll
            for (int vt = 0; vt < 4; ++vt)
#pragma unroll
                for (int r = 0; r < 4; ++r) { const float d = y[vt][r] - mean; vs += d * d; }
            vs = rows_sum(vs);
            const float rstd = rsqrtf(vs * (1.f / 64.f) + 64e-5f);
            const size_t tok = (size_t)b * SEQ + c * 64 + t;
#pragma unroll
            for (int vt = 0; vt < 4; ++vt) {
                const int ch = h * 64 + vt * 16 + 4 * g;
                const f32x4 gw = *(const f32x4*)(p.in[I_RWGNW] + l * 256 + ch), gb = *(const f32x4*)(p.in[I_RWGNB] + l * 256 + ch);
                const h16x4 bo = *(const h16x4*)(p.rw_bonus + tok * 256 + ch), gg = *(const h16x4*)(p.rw_g + tok * 256 + ch);
                float o[4];
#pragma unroll
                for (int r = 0; r < 4; ++r) o[r] = ((y[vt][r] - mean) * rstd * gw[r] + gb[r] + (float)bo[r]) * (float)gg[r];
                *(h16x4*)(p.branches + tok * DM + 768 + ch) = pack4(o[0], o[1], o[2], o[3]);
            }
        }
    }
}

__device__ __forceinline__ void ph_dsa_pre(CP p, int bid, int nblk) {
    const int lane = otid() & 63, wv = otid() >> 6;
    for (int tok = bid * 8 + wv; tok < NTOK; tok += nblk * 8) {
        const int i = lane & 31;
        const float c = p.ropet[((size_t)tok * 32 + i) * 2], s = p.ropet[((size_t)tok * 32 + i) * 2 + 1];
        const int base = (lane < 32) ? P_Q : P_K;
        h16* dst = p.proj + (size_t)tok * PJ + base;
        const float scl = (lane < 32) ? 0.125f : 1.f;
#pragma unroll
        for (int h = 0; h < 4; ++h) {
            const float x1 = (float)dst[h * 64 + i], x2 = (float)dst[h * 64 + 32 + i];
            dst[h * 64 + i] = (h16)((x1 * c - x2 * s) * scl);
            dst[h * 64 + 32 + i] = (h16)((x2 * c + x1 * s) * scl);
        }
        const int i2 = lane & 15;
        const float c2 = p.ropet[((size_t)tok * 32 + 2 * i2) * 2], s2 = p.ropet[((size_t)tok * 32 + 2 * i2) * 2 + 1];
        float* xf = p.idxf + (size_t)tok * IDXLD;
        if (lane < 16) {
#pragma unroll
            for (int h = 0; h < 4; ++h) {
                const float x1 = xf[h * 32 + i2], x2 = xf[h * 32 + 16 + i2];
                xf[h * 32 + i2] = x1 * c2 - x2 * s2;
                xf[h * 32 + 16 + i2] = x2 * c2 + x1 * s2;
            }
        } else if (lane < 32) {
            const float x1 = xf[128 + i2], x2 = xf[128 + 16 + i2];
            xf[128 + i2] = x1 * c2 - x2 * s2;
            xf[128 + 16 + i2] = x2 * c2 + x1 * s2;
        }
    }
}
__device__ __forceinline__ unsigned f2key(float x) { unsigned u = __float_as_uint(x); return (u & 0x80000000u) ? ~u : (u | 0x80000000u); }
__device__ __forceinline__ void ph_dsa_naive(CP p, int bid, int nblk, char* smem) {
    const int lane = otid() & 63, wv = otid() >> 6;
    unsigned* s_key = (unsigned*)smem + wv * 4096;
    float* s_p = (float*)s_key;
    float* s_iq = (float*)(smem + 8 * 4096 * 4) + wv * 128;
    float* s_q = (float*)(smem + 8 * 4096 * 4 + 8 * 128 * 4) + wv * 256;
    int* s_list = (int*)(smem + 8 * 4096 * 4 + 8 * 128 * 4 + 8 * 256 * 4) + wv * 256;
    const unsigned long long lt_mask = (lane == 0) ? 0ull : (~0ull >> (64 - lane));
    for (int tok = bid * 8 + wv; tok < NTOK; tok += nblk * 8) {
        const int b = tok / SEQ, t = tok % SEQ;
        s_iq[lane] = p.idxf[(size_t)tok * IDXLD + lane]; s_iq[64 + lane] = p.idxf[(size_t)tok * IDXLD + 64 + lane];
        for (int i = 0; i < 4; ++i) s_q[i * 64 + lane] = (float)p.proj[(size_t)tok * PJ + P_Q + i * 64 + lane];
        const float w0 = p.idxf[(size_t)tok * IDXLD + 160], w1 = p.idxf[(size_t)tok * IDXLD + 161], w2 = p.idxf[(size_t)tok * IDXLD + 162], w3 = p.idxf[(size_t)tok * IDXLD + 163];
        __builtin_amdgcn_s_waitcnt(0); __builtin_amdgcn_wave_barrier();
        const int n = t + 1;
        const int nch = (t >> 6) + 1;
#pragma unroll 1
        for (int i = 0; i < nch; ++i) {
            const int s = lane + 64 * i;
            unsigned kv_ = 0u;
            if (s <= t) {
                const float* kp = p.idxf + ((size_t)b * SEQ + s) * IDXLD + 128;
                float d0 = 0.f, d1 = 0.f, d2 = 0.f, d3 = 0.f;
#pragma unroll
                for (int d4 = 0; d4 < 8; ++d4) {
                    const f32x4 kv = *(const f32x4*)(kp + d4 * 4);
#pragma unroll
                    for (int e = 0; e < 4; ++e) { const int d = d4 * 4 + e; d0 += s_iq[d] * kv[e]; d1 += s_iq[32 + d] * kv[e]; d2 += s_iq[64 + d] * kv[e]; d3 += s_iq[96 + d] * kv[e]; }
                }
                const float sc = w0 * fmaxf(d0, 0.f) + w1 * fmaxf(d1, 0.f) + w2 * fmaxf(d2, 0.f) + w3 * fmaxf(d3, 0.f);
                kv_ = f2key(sc + 0.f);
            }
            s_key[s] = kv_;
        }
        __builtin_amdgcn_s_waitcnt(0); __builtin_amdgcn_wave_barrier();
        int cnt_sel;
        if (n <= 256) {
            for (int i = 0; i < 4; ++i) { const int s = lane + 64 * i; if (s <= t) s_list[s] = s; }
            cnt_sel = n;
        } else {
            unsigned v = 0u;
#pragma unroll 1
            for (int bit = 31; bit >= 0; --bit) {
                const unsigned cand = v | (1u << bit);
                int c = 0;
#pragma unroll 4
                for (int i = 0; i < nch; ++i) c += __popcll(__ballot(s_key[lane + 64 * i] >= cand));
                if (c >= 256) v = cand;
            }
            int cgt = 0;
#pragma unroll 4
            for (int i = 0; i < nch; ++i) cgt += __popcll(__ballot(s_key[lane + 64 * i] > v));
            const int need = 256 - cgt;
            int nsel = 0, nties = 0;
#pragma unroll 1
            for (int i = 0; i < nch; ++i) {
                const unsigned kx = s_key[lane + 64 * i];
                const bool gt = kx > v, eq = kx == v;
                const unsigned long long eqm = __ballot(eq);
                const int trank = nties + __popcll(eqm & lt_mask);
                const bool sel = gt || (eq && trank < need);
                const unsigned long long sm = __ballot(sel);
                if (sel) s_list[nsel + __popcll(sm & lt_mask)] = lane + 64 * i;
                nsel += __popcll(sm); nties += __popcll(eqm);
            }
            cnt_sel = nsel;
        }
        __builtin_amdgcn_s_waitcnt(0); __builtin_amdgcn_wave_barrier();
        float lg[4][4];
#pragma unroll
        for (int jj = 0; jj < 4; ++jj) {
            const int j = lane + 64 * jj;
#pragma unroll
            for (int h = 0; h < 4; ++h) lg[jj][h] = -INFINITY;
            if (j < cnt_sel) {
                const int s = s_list[j];
                const h16* kp = p.proj + ((size_t)b * SEQ + s) * PJ + P_K;
#pragma unroll
                for (int h = 0; h < 4; ++h) {
                    float a = 0.f;
#pragma unroll
                    for (int d8 = 0; d8 < 8; ++d8) { const h16x8 kv = *(const h16x8*)(kp + h * 64 + d8 * 8);
#pragma unroll
                        for (int e = 0; e < 8; ++e) a += s_q[h * 64 + d8 * 8 + e] * (float)kv[e]; }
                    lg[jj][h] = a;
                }
            }
        }
        float inv[4];
#pragma unroll
        for (int h = 0; h < 4; ++h) {
            float m = fmaxf(fmaxf(lg[0][h], lg[1][h]), fmaxf(lg[2][h], lg[3][h]));
            m = wave_max(m);
            float sm = 0.f;
#pragma unroll
            for (int jj = 0; jj < 4; ++jj) { const float e = (lane + 64 * jj < cnt_sel) ? __expf(lg[jj][h] - m) : 0.f; s_p[h * 256 + lane + 64 * jj] = e; sm += e; }
            sm = wave_sum(sm);
            inv[h] = 1.f / sm;
        }
        __builtin_amdgcn_s_waitcnt(0); __builtin_amdgcn_wave_barrier();
        const int hh = lane >> 4;
        float o0 = 0.f, o1 = 0.f, o2 = 0.f, o3 = 0.f;
#pragma unroll 4
        for (int j = 0; j < cnt_sel; ++j) {
            const int s = s_list[j]; const float pj = s_p[hh * 256 + j];
            const h16x4 vv = *(const h16x4*)(p.proj + ((size_t)b * SEQ + s) * PJ + P_V + lane * 4);
            o0 += pj * (float)vv[0]; o1 += pj * (float)vv[1]; o2 += pj * (float)vv[2]; o3 += pj * (float)vv[3];
        }
        const float iv = (hh == 0) ? inv[0] : (hh == 1) ? inv[1] : (hh == 2) ? inv[2] : inv[3];
        *(h16x4*)(p.branches + (size_t)tok * DM + 256 + lane * 4) = pack4(o0 * iv, o1 * iv, o2 * iv, o3 * iv);
        __builtin_amdgcn_s_waitcnt(0); __builtin_amdgcn_wave_barrier();
    }
}
#define DSA_NAIVE_LDS (8 * 4096 * 4 + 8 * 128 * 4 + 8 * 256 * 4 + 8 * 256 * 4)

#define IDXH (2 * IDXLD)
__device__ __forceinline__ float idx_score(const f32x4 (&d)[4], const float (&w)[4], int r) {
    float sc = w[0] * fmaxf(d[0][r], 0.f);
    sc = __fmaf_rn(w[1], fmaxf(d[1][r], 0.f), sc);
    sc = __fmaf_rn(w[2], fmaxf(d[2][r], 0.f), sc);
    sc = __fmaf_rn(w[3], fmaxf(d[3][r], 0.f), sc);
    return sc + 0.f;
}
__device__ __forceinline__ f32x4 idx_dot(h16x8 khi, h16x8 klo, h16x8 qhi, h16x8 qlo) {
    f32x4 acc = {0.f, 0.f, 0.f, 0.f};
    acc = __builtin_amdgcn_mfma_f32_16x16x32_f16(khi, qhi, acc, 0, 0, 0);
    acc = __builtin_amdgcn_mfma_f32_16x16x32_f16(klo, qhi, acc, 0, 0, 0);
    acc = __builtin_amdgcn_mfma_f32_16x16x32_f16(khi, qlo, acc, 0, 0, 0);
    return acc;
}
__device__ __forceinline__ void ph_dsa_pre2(CP p, int bid, int nblk, char* smem) {
    h16* vt_s = (h16*)smem;
    for (int u = bid; u < NTOK / 64; u += nblk) {
        const int tid = otid(), lane = tid & 63, wv = tid >> 6;
        const int tok0 = u * 64;
        __syncthreads();
        for (int q = 0; q < 8; ++q) {
            const int tok = tok0 + wv * 8 + q;
            const int i = lane & 31;
            const float c = p.ropet[((size_t)tok * 32 + i) * 2], s = p.ropet[((size_t)tok * 32 + i) * 2 + 1];
            const int base = (lane < 32) ? P_Q : P_K;
            h16* dst = p.proj + (size_t)tok * PJ + base;
            const float scl = (lane < 32) ? 0.125f : 1.f;
#pragma unroll
            for (int h = 0; h < 4; ++h) {
                const float x1 = (float)dst[h * 64 + i], x2 = (float)dst[h * 64 + 32 + i];
                dst[h * 64 + i] = (h16)((x1 * c - x2 * s) * scl);
                dst[h * 64 + 32 + i] = (h16)((x2 * c + x1 * s) * scl);
            }
            const int i2 = lane & 15;
            const float c2 = p.ropet[((size_t)tok * 32 + 2 * i2) * 2], s2 = p.ropet[((size_t)tok * 32 + 2 * i2) * 2 + 1];
            float* xf = p.idxf + (size_t)tok * IDXLD;
            h16* xh = (h16*)xf;
            float o1[4], o2[4];
            if (lane < 16) {
#pragma unroll
                for (int h = 0; h < 4; ++h) { const float x1 = xf[h * 32 + i2], x2 = xf[h * 32 + 16 + i2]; o1[h] = x1 * c2 - x2 * s2; o2[h] = x2 * c2 + x1 * s2; }
            } else if (lane < 32) {
                const float x1 = xf[128 + i2], x2 = xf[128 + 16 + i2]; o1[0] = x1 * c2 - x2 * s2; o2[0] = x2 * c2 + x1 * s2;
            }
            asm volatile("s_waitcnt vmcnt(0)" ::: "memory");
            __builtin_amdgcn_wave_barrier();
            if (lane < 16) {
#pragma unroll
                for (int h = 0; h < 4; ++h) {
                    const h16 h1 = (h16)o1[h], h2 = (h16)o2[h];
                    xh[h * 32 + i2] = h1; xh[h * 32 + 16 + i2] = h2;
                    xh[128 + h * 32 + i2] = (h16)(o1[h] - (float)h1); xh[128 + h * 32 + 16 + i2] = (h16)(o2[h] - (float)h2);
                }
            } else if (lane < 32) {
                const h16 h1 = (h16)o1[0], h2 = (h16)o2[0];
                xh[256 + i2] = h1; xh[256 + 16 + i2] = h2;
                xh[288 + i2] = (h16)(o1[0] - (float)h1); xh[288 + 16 + i2] = (h16)(o2[0] - (float)h2);
            }
            *(h16x4*)&vt_s[(wv * 8 + q) * 264 + lane * 4] = *(const h16x4*)(p.proj + (size_t)tok * PJ + P_V + lane * 4);
        }
        __syncthreads();
        {
            const int dim = tid >> 1, hf = tid & 1, b = tok0 / SEQ, t0 = tok0 % SEQ;
            h16* dst = p.vT + ((size_t)b * 256 + dim) * SEQ + t0 + hf * 32;
#pragma unroll
            for (int k8 = 0; k8 < 4; ++k8) {
                h16x8 v;
#pragma unroll
                for (int e = 0; e < 8; ++e) v[e] = vt_s[(hf * 32 + k8 * 8 + e) * 264 + dim];
                *(h16x8*)(dst + k8 * 8) = v;
            }
        }
    }
}
#define DSAA_LDS (8 * 4096 * 4)
__device__ __forceinline__ void ph_dsa_a(CP p, int bid, int nblk, char* smem) {
    unsigned* Kq = (unsigned*)smem;
    const bool bal = (nblk == 240);
    const int nit = bal ? 5 : (1024 + nblk - 1) / nblk;
    for (int it = 0; it < nit; ++it) {
        int u;
        if (bal) { if (it < 4) u = it * 256 + ((it & 1) ? 255 - bid : 16 + bid); else { if (bid >= 64) break; u = (bid >> 4) * 256 + (bid & 15); } }
        else { u = bid + it * nblk; if (u >= 1024) break; }
        const int tid = otid(), lane = tid & 63, wave = __builtin_amdgcn_readfirstlane(tid >> 6), g = lane >> 4, c = lane & 15;
        const int b = u >> 8, qb = u & 255, q0 = qb * 16;
        if (qb < 16) { if (tid < 16) { p.dthr[(size_t)b * SEQ + q0 + tid] = 0u; p.dcut[(size_t)b * SEQ + q0 + tid] = -1; } continue; }
        const size_t tokq = (size_t)b * SEQ + q0 + c;
        const h16* qrow = (const h16*)(p.idxf + tokq * IDXLD);
        h16x8 qh[4], ql[4]; float w[4];
#pragma unroll
        for (int h = 0; h < 4; ++h) { qh[h] = *(const h16x8*)(qrow + h * 32 + 8 * g); ql[h] = *(const h16x8*)(qrow + 128 + h * 32 + 8 * g); w[h] = p.idxf[tokq * IDXLD + 160 + h]; }
        const int ntiles = qb + 1;
        const int nslots = (ntiles - wave + 7) >> 3;
        const int nch = (16 * ntiles + 63) >> 6;
        const int tq = q0 + c;
        const h16* kbase = (const h16*)(p.idxf + ((size_t)b * SEQ + c) * IDXLD) + 256 + 8 * g;
#pragma unroll 1
        for (int bt = 0; bt < 2; ++bt) {
            __syncthreads();
            {
                h16x8 kh[4], kl[4];
#pragma unroll
                for (int q = 0; q < 4; ++q) {
                    int j = wave + 8 * q; j = j < ntiles ? j : ntiles - 1;
                    kh[q] = *(const h16x8*)(kbase + (size_t)16 * j * IDXH); kl[q] = *(const h16x8*)(kbase + (size_t)16 * j * IDXH + 32);
                }
#pragma unroll 4
                for (int i = 0; i < nslots; ++i) {
                    const int j = wave + 8 * i;
                    h16x8 ckh = kh[0], ckl = kl[0];
                    kh[0] = kh[1]; kl[0] = kl[1]; kh[1] = kh[2]; kl[1] = kl[2]; kh[2] = kh[3]; kl[2] = kl[3];
                    { int j4 = j + 32; j4 = j4 < ntiles ? j4 : ntiles - 1; kh[3] = *(const h16x8*)(kbase + (size_t)16 * j4 * IDXH); kl[3] = *(const h16x8*)(kbase + (size_t)16 * j4 * IDXH + 32); }
                    f32x4 d[4];
#pragma unroll
                    for (int h = 0; h < 4; ++h) d[h] = idx_dot(ckh, ckl, qh[h], ql[h]);
                    u32x4 kk4;
#pragma unroll
                    for (int r = 0; r < 4; ++r) { const int sidx = 16 * j + 4 * g + r; const unsigned kk = f2key(idx_score(d, w, r)); kk4[r] = (sidx <= tq) ? kk : 0u; }
                    if ((c >> 3) == bt) *(u32x4*)&Kq[(c & 7) * 4096 + 16 * j + 4 * g] = kk4;
                }
            }
            __syncthreads();
            {
                const unsigned* myk = Kq + wave * 4096 + lane;
                unsigned kv[64];
#pragma unroll
                for (int m = 0; m < 64; ++m) kv[m] = (m < nch && lane + 64 * m < 16 * ntiles) ? myk[64 * m] : 0u;
                unsigned v = 0u; int cut = 4095; bool done = false;
#pragma unroll 1
                for (int bit = 31; bit >= 0; --bit) {
                    const unsigned cand = v | (1u << bit);
                    int cl = 0;
#pragma unroll
                    for (int m = 0; m < 64; ++m) cl += (kv[m] >= cand) ? 1 : 0;
                    const int cn = __builtin_amdgcn_readfirstlane(wave_isum(cl));
                    if (cn == 256) { v = cand - 1u; cut = -1; done = true; break; }
                    if (cn > 256) v = cand;
                }
                if (!done) {
                    int cgl = 0, cel = 0;
#pragma unroll
                    for (int m = 0; m < 64; ++m) { cgl += (kv[m] > v) ? 1 : 0; cel += (kv[m] == v) ? 1 : 0; }
                    const int cgt = __builtin_amdgcn_readfirstlane(wave_isum(cgl)), ceq = __builtin_amdgcn_readfirstlane(wave_isum(cel));
                    const int need = 256 - cgt;
                    if (ceq > need) {
                        int run = 0; cut = 4095; bool found = false;
#pragma unroll
                        for (int m = 0; m < 64; ++m) {
                            unsigned long long mk = __ballot(kv[m] == v);
                            const int pc = __popcll(mk);
                            if (!found && run + pc >= need) {
                                int kth = need - run;
                                while (kth > 1) { mk &= mk - 1ull; --kth; }
                                cut = (int)__builtin_ctzll(mk) + 64 * m; found = true;
                            }
                            run += pc;
                        }
                    }
                }
                if (lane == 0) { const size_t tk = (size_t)b * SEQ + q0 + bt * 8 + wave; p.dthr[tk] = v; p.dcut[tk] = cut; }
            }
        }
    }
}
#define KS_LD 264
#define VT_LD 72
#define IK_LD 72
#define DSAB_LDS (64 * KS_LD * 2 + 256 * VT_LD * 2 + 64 * IK_LD * 2 + 2 * 64 * KS_LD * 2)
__device__ __forceinline__ void ph_dsa_b(CP p, int bid, int nblk, char* smem) {
    h16* Ks = (h16*)smem;
    h16* Vt = Ks + 64 * KS_LD;
    h16* Ik = Vt + 256 * VT_LD;
    h16* Qs = Ik + 64 * IK_LD;
    h16* IQs = Qs + 64 * KS_LD;
    float* mrg = (float*)smem;
    for (int wi = bid; wi < 512; wi += nblk) {
        const int tid = otid(), lane = tid & 63, wave = tid >> 6, g = lane >> 4, c = lane & 15;
        const int qt = wave & 3, kg = wave >> 2;
        const int half = wi >> 8, b = (wi & 255) >> 6, j_ = wi & 63;
        const int qblk = half ? j_ : 63 - j_, q0 = qblk * 64;
        const int tq = q0 + 16 * qt + c;
        const size_t tokq = (size_t)b * SEQ + tq;
        float w[4];
#pragma unroll
        for (int h = 0; h < 4; ++h) w[h] = p.idxf[tokq * IDXLD + 160 + h];
        __syncthreads();
        for (int i = tid; i < 64 * 32; i += 512) {
            const int row = i >> 5, ch = i & 31; const size_t tk = (size_t)b * SEQ + q0 + row;
            *(u32x4*)&Qs[row * KS_LD + ch * 8] = *(const u32x4*)(p.proj + tk * PJ + P_Q + ch * 8);
            *(u32x4*)&IQs[row * KS_LD + ch * 8] = *(const u32x4*)((const h16*)(p.idxf + tk * IDXLD) + ch * 8);
        }
        const h16* qrow = Qs + (16 * qt + c) * KS_LD;
        const h16* irow = IQs + (16 * qt + c) * KS_LD;
        const unsigned thr = p.dthr[tokq]; const int cut = p.dcut[tokq];
        f32x4 O[4][4];
        float mrun[4], lrun[4];
#pragma unroll
        for (int h = 0; h < 4; ++h) { mrun[h] = -1e30f; lrun[h] = 0.f;
#pragma unroll
            for (int dt = 0; dt < 4; ++dt) O[h][dt] = (f32x4){0.f, 0.f, 0.f, 0.f}; }
        const int nall = qblk + 1, hs_ = (nall + 1) >> 1;
        const int sb = half ? hs_ : 0, nsteps = half ? nall : hs_;
        u32x4 rk[4], rv[4], ri;
#define DSAB_GLOAD(S_) do { const size_t kb_ = (size_t)b * SEQ + 64 * (S_); \
            _Pragma("unroll") for (int i = 0; i < 4; ++i) { const int ch = tid + 512 * i; rk[i] = *(const u32x4*)(p.proj + (kb_ + (ch >> 5)) * PJ + P_K + (ch & 31) * 8); } \
            _Pragma("unroll") for (int i = 0; i < 4; ++i) { const int ch = tid + 512 * i; rv[i] = *(const u32x4*)(p.vT + ((size_t)b * 256 + (ch >> 3)) * SEQ + 64 * (S_) + (ch & 7) * 8); } \
            ri = *(const u32x4*)((const h16*)(p.idxf + (kb_ + (tid >> 3)) * IDXLD) + 256 + (tid & 7) * 8); } while (0)
#define DSAB_LSTORE() do { \
            _Pragma("unroll") for (int i = 0; i < 4; ++i) { const int ch = tid + 512 * i; *(u32x4*)&Ks[(ch >> 5) * KS_LD + (ch & 31) * 8] = rk[i]; } \
            _Pragma("unroll") for (int i = 0; i < 4; ++i) { const int ch = tid + 512 * i; *(u32x4*)&Vt[(ch >> 3) * VT_LD + (ch & 7) * 8] = rv[i]; } \
            *(u32x4*)&Ik[(tid >> 3) * IK_LD + (tid & 7) * 8] = ri; } while (0)
        __syncthreads();
        if (sb < nsteps) { DSAB_GLOAD(sb); DSAB_LSTORE(); }
        __syncthreads();
        for (int s = sb; s < nsteps; ++s) {
            if (s + 1 < nsteps) DSAB_GLOAD(s + 1);
            const int kbase = 64 * s + 32 * kg;
            int qo_ = (16 * qt + c) * KS_LD; asm volatile("" : "+v"(qo_));
            const h16* qrow_ = Qs + qo_; const h16* irow_ = IQs + qo_;
            bool msk[2][4];
            {
                h16x8 kh[2], kl[2];
#pragma unroll
                for (int jt = 0; jt < 2; ++jt) { const int row = 32 * kg + 16 * jt + c; kh[jt] = *(const h16x8*)&Ik[row * IK_LD + 8 * g]; kl[jt] = *(const h16x8*)&Ik[row * IK_LD + 32 + 8 * g]; }
                f32x4 d[2][4];
#pragma unroll
                for (int h = 0; h < 4; ++h) {
                    const h16x8 qh_ = *(const h16x8*)(irow_ + h * 32 + 8 * g), ql_ = *(const h16x8*)(irow_ + 128 + h * 32 + 8 * g);
                    d[0][h] = idx_dot(kh[0], kl[0], qh_, ql_); d[1][h] = idx_dot(kh[1], kl[1], qh_, ql_);
                }
#pragma unroll
                for (int jt = 0; jt < 2; ++jt)
#pragma unroll
                    for (int r = 0; r < 4; ++r) {
                        const int sidx = kbase + 16 * jt + 4 * g + r;
                        const unsigned kk = f2key(idx_score(d[jt], w, r));
                        msk[jt][r] = (sidx <= tq) && (kk > thr || (kk == thr && sidx <= cut));
                    }
            }
#pragma unroll
            for (int h = 0; h < 4; ++h) {
                f32x4 S[2];
                {
                    const h16x8 q0_ = *(const h16x8*)(qrow_ + h * 64 + 8 * g), q1_ = *(const h16x8*)(qrow_ + h * 64 + 32 + 8 * g);
#pragma unroll
                    for (int jt = 0; jt < 2; ++jt) {
                        const int row = 32 * kg + 16 * jt + c;
                        f32x4 acc = {0.f, 0.f, 0.f, 0.f};
                        acc = __builtin_amdgcn_mfma_f32_16x16x32_f16(*(const h16x8*)&Ks[row * KS_LD + h * 64 + 8 * g], q0_, acc, 0, 0, 0);
                        acc = __builtin_amdgcn_mfma_f32_16x16x32_f16(*(const h16x8*)&Ks[row * KS_LD + h * 64 + 32 + 8 * g], q1_, acc, 0, 0, 0);
                        S[jt] = acc;
                    }
                }
                float mx = -1e30f;
#pragma unroll
                for (int jt = 0; jt < 2; ++jt)
#pragma unroll
                    for (int r = 0; r < 4; ++r) mx = fmaxf(mx, msk[jt][r] ? S[jt][r] : -1e30f);
                mx = rows_max(mx);
                const float mnew = fmaxf(mrun[h], mx);
                const float scale = __expf(mrun[h] - mnew);
                mrun[h] = mnew;
                float ps = 0.f; h16x8 pb;
#pragma unroll
                for (int jt = 0; jt < 2; ++jt)
#pragma unroll
                    for (int r = 0; r < 4; ++r) { const float pe = msk[jt][r] ? __expf(S[jt][r] - mnew) : 0.f; ps += pe; pb[jt * 4 + r] = (h16)pe; }
                lrun[h] = lrun[h] * scale + ps;
#pragma unroll
                for (int dt = 0; dt < 4; ++dt) {
                    f32x4 o = O[h][dt] * scale;
                    const int vrow = h * 64 + 16 * dt + c;
                    const h16x4 va = *(const h16x4*)&Vt[vrow * VT_LD + 32 * kg + 4 * g], vb = *(const h16x4*)&Vt[vrow * VT_LD + 32 * kg + 16 + 4 * g];
                    h16x8 av; av[0] = va[0]; av[1] = va[1]; av[2] = va[2]; av[3] = va[3]; av[4] = vb[0]; av[5] = vb[1]; av[6] = vb[2]; av[7] = vb[3];
                    O[h][dt] = __builtin_amdgcn_mfma_f32_16x16x32_f16(av, pb, o, 0, 0, 0);
                }
            }
            __syncthreads();
            if (s + 1 < nsteps) DSAB_LSTORE();
            __syncthreads();
        }
#pragma unroll
        for (int h = 0; h < 4; ++h) lrun[h] = rows_sum(lrun[h]);
        float* my = mrg + (size_t)(qt * 64 + lane) * 73;
        if (kg == 1) {
#pragma unroll
            for (int h = 0; h < 4; ++h) { my[h] = mrun[h]; my[4 + h] = lrun[h];
#pragma unroll
                for (int dt = 0; dt < 4; ++dt)
#pragma unroll
                    for (int r = 0; r < 4; ++r) my[8 + (h * 4 + dt) * 4 + r] = O[h][dt][r]; }
        }
        __syncthreads();
        if (kg == 0) {
            const size_t pq = ((size_t)((b * 64 + qblk) * 2 + half) * 64 + 16 * qt + c);
#pragma unroll
            for (int h = 0; h < 4; ++h) {
                const float m1 = my[h], l1 = my[4 + h];
                const float m = fmaxf(mrun[h], m1);
                const float e0 = __expf(mrun[h] - m), e1 = __expf(m1 - m);
                const float lt = lrun[h] * e0 + l1 * e1;
                const float inv = lt > 0.f ? 1.f / lt : 0.f;
                if (g == 0) { p.dsa_ml[pq * 8 + h * 2] = m; p.dsa_ml[pq * 8 + h * 2 + 1] = lt; }
#pragma unroll
                for (int dt = 0; dt < 4; ++dt) {
                    float o[4];
#pragma unroll
                    for (int r = 0; r < 4; ++r) o[r] = (O[h][dt][r] * e0 + my[8 + (h * 4 + dt) * 4 + r] * e1) * inv;
                    *(h16x4*)(p.dsa_op + pq * 256 + h * 64 + 16 * dt + 4 * g) = pack4(o[0], o[1], o[2], o[3]);
                }
            }
        }
        __syncthreads();
    }
}

__device__ __forceinline__ void ph_dsa_merge(CP p, int bid, int nblk) {
    const int lane = otid() & 63, wv = otid() >> 6;
    for (int tok = bid * 8 + wv; tok < NTOK; tok += nblk * 8) {
        const int b = tok / SEQ, t = tok % SEQ;
        const size_t p0 = ((size_t)((b * 64 + (t >> 6)) * 2) * 64 + (t & 63)), p1 = p0 + 64;
        const int h = lane >> 4;
        const float m0 = p.dsa_ml[p0 * 8 + h * 2], l0 = p.dsa_ml[p0 * 8 + h * 2 + 1], m1 = p.dsa_ml[p1 * 8 + h * 2], l1 = p.dsa_ml[p1 * 8 + h * 2 + 1];
        const h16x4 o0 = *(const h16x4*)(p.dsa_op + p0 * 256 + lane * 4), o1 = *(const h16x4*)(p.dsa_op + p1 * 256 + lane * 4);
        const float m = fmaxf(m0, m1);
        const float w0 = l0 * __expf(m0 - m), w1 = l1 * __expf(m1 - m);
        const float inv = 1.f / (w0 + w1);
        *(h16x4*)(p.branches + (size_t)tok * DM + 256 + lane * 4) = pack4(((float)o0[0] * w0 + (float)o1[0] * w1) * inv, ((float)o0[1] * w0 + (float)o1[1] * w1) * inv,
                                                                         ((float)o0[2] * w0 + (float)o1[2] * w1) * inv, ((float)o0[3] * w0 + (float)o1[3] * w1) * inv);
    }
}
__device__ __forceinline__ void ph_gates(CP p, int l, int bid, int nblk, char* smem) {
    pg8::Gemm g; g.A = p.h_hi; g.Bt = p.Wg; g.M = NTOK; g.N = 4096; g.K = DM; g.lda = DM;
    pg8::StaticOrder S; S.init(NTOK, 4096, nblk, bid);
    pg8::EpiH16<1> E; E.O = p.gates; E.ldc = 4096; E.ncols = 4096; E.bias = p.in[I_GATEB] + (size_t)l * 4096;
    pg8::gemm_phase((PG8_LAS unsigned char*)smem, g, S, E);
}
__device__ __forceinline__ void ph_merge(CP p, int l, int bid, int nblk, char* smem) {
    for (int u = bid; u < 128 * 8; u += nblk) {
        const int mt = u >> 3, nt = u & 7, m0 = mt * 128, n0 = nt * 128;
        f32x4 mx[2][4]; zero_acc<128>(mx);
        f32x4 au[2][4]; zero_acc<128>(au);
        const int tid_ = otid(); const int lane = tid_ & 63, wave = tid_ >> 6, wm = wave >> 1, wn = wave & 1;
        const h16* A = p.branches + (size_t)m0 * DM; const h16* B = p.Wb + (size_t)n0 * 256;
        const h16* G = p.gates + (size_t)(m0 + wm * 32 + (lane & 15)) * 4096 + n0 + wn * 64 + 4 * (lane >> 4);
        gemm_kloop_seg<128>(smem, DM, [=](int r, int k) { return A + (size_t)r * DM + k; },
                            [=](int r, int k) { return B + ((size_t)(k >> 8) * 1024 + r) * 256 + (k & 255); }, au,
                            [&](int kt) {
                                if ((kt & 3) == 3) {
                                    const int n = kt >> 2;
#pragma unroll
                                    for (int i = 0; i < 2; ++i)
#pragma unroll
                                        for (int j = 0; j < 4; ++j) {
                                            const h16x4 gg = *(const h16x4*)(G + (size_t)i * 16 * 4096 + n * 1024 + j * 16);
#pragma unroll
                                            for (int e = 0; e < 4; ++e) mx[i][j][e] += (float)gg[e] * au[i][j][e];
                                            au[i][j] = (f32x4){0.f, 0.f, 0.f, 0.f};
                                        }
                                }
                            });
        h16* O = p.mixed + (size_t)m0 * DM + n0;
        gemm_epi<128>(mx, [=](int ml, int nl, f32x4 v) { *(h16x4*)(O + (size_t)ml * DM + nl) = pack4(v[0], v[1], v[2], v[3]); });
    }
}
__device__ __forceinline__ void ph_outproj(CP p, int l, int bid, int nblk, char* smem) {
    pg8::Gemm g; g.A = p.mixed; g.Bt = p.Wo; g.M = NTOK; g.N = DM; g.K = DM; g.lda = DM;
    pg8::StaticOrder S; S.init(NTOK, DM, nblk, bid);
    pg8::EpiResid E; E.O = p.x1; E.X = l == 0 ? p.in[I_X] : p.x1; E.gate = p.mods + (size_t)l * 4 * 6144 + 2 * 1024;
    pg8::gemm_phase((PG8_LAS unsigned char*)smem, g, S, E);
}

__constant__ int c_pair_lo[6] = {0, 0, 0, 1, 1, 2};
__constant__ int c_pair_hi[6] = {1, 2, 3, 2, 3, 3};
__device__ __forceinline__ void ph_norm2_router(CP p, int l, int bid, int nblk, char* smem) {
    float* rw = (float*)smem;
    for (int i = otid(); i < DM * 16; i += 512) rw[i] = p.in[I_ROUTW][i];
    __syncthreads();
    const int lane = otid() & 63, wv = otid() >> 6;
    for (int tok = bid * 8 + wv; tok < NTOK; tok += nblk * 8) {
        const int b = tok / SEQ;
        const float* xr = p.x1 + (size_t)tok * DM;
        f32x4 v[4]; float ss = 0.f;
#pragma unroll
        for (int i = 0; i < 4; ++i) { v[i] = *(const f32x4*)(xr + i * 256 + lane * 4); ss += v[i][0] * v[i][0] + v[i][1] * v[i][1] + v[i][2] * v[i][2] + v[i][3] * v[i][3]; }
        ss = wave_sum(ss);
        const float rs = rsqrtf(ss * (1.f / DM) + 1e-6f);
        const float* g = p.in[I_FNG] + l * DM;
        const float* md = p.mods + ((size_t)l * 4 + b) * 6144;
        float lg[16];
#pragma unroll
        for (int e = 0; e < 16; ++e) lg[e] = 0.f;
#pragma unroll 1
        for (int i = 0; i < 4; ++i) {
            const int c = i * 256 + lane * 4;
            f32x4 gg = *(const f32x4*)(g + c), sh = *(const f32x4*)(md + 3 * 1024 + c), sc = *(const f32x4*)(md + 4 * 1024 + c);
            float hv[4];
#pragma unroll
            for (int e = 0; e < 4; ++e) hv[e] = v[i][e] * rs * gg[e] * (1.f + sc[e]) + sh[e];
            *(h16x4*)(p.h_hi + (size_t)tok * DM + c) = pack4(hv[0], hv[1], hv[2], hv[3]);
#pragma unroll 1
            for (int e = 0; e < 4; ++e) {
                const float* rr = rw + (c + e) * 16;
                const float hve = e == 0 ? hv[0] : e == 1 ? hv[1] : e == 2 ? hv[2] : hv[3];
#pragma unroll
                for (int x4 = 0; x4 < 4; ++x4) { const f32x4 r4 = *(const f32x4*)(rr + x4 * 4); lg[x4 * 4] += hve * r4[0]; lg[x4 * 4 + 1] += hve * r4[1]; lg[x4 * 4 + 2] += hve * r4[2]; lg[x4 * 4 + 3] += hve * r4[3]; }
            }
        }
#pragma unroll
        for (int e = 0; e < 16; ++e) lg[e] = wave_sum(lg[e]);
        if (lane == 0) {
            float sc[16], bi[16];
#pragma unroll
            for (int e = 0; e < 16; ++e) { sc[e] = 1.f / (1.f + expf(-lg[e])); bi[e] = sc[e] + p.in[I_ROUTB][e]; }
            int bg = 0; float bgs = -INFINITY;
#pragma unroll
            for (int gI = 0; gI < 4; ++gI) {
                float m1 = -INFINITY, m2 = -INFINITY;
#pragma unroll
                for (int j = 0; j < 4; ++j) { const float x = bi[gI * 4 + j]; if (x > m1) { m2 = m1; m1 = x; } else if (x > m2) m2 = x; }
                const float gs = m1 + m2;
                if (gs > bgs) { bgs = gs; bg = gI; }
            }
            int e0 = 0; float b0 = -INFINITY;
#pragma unroll
            for (int j = 0; j < 4; ++j) { float x = -INFINITY;
#pragma unroll
                for (int gI = 0; gI < 4; ++gI) if (gI == bg) x = bi[gI * 4 + j];
                if (x > b0) { b0 = x; e0 = j; } }
            int e1 = 0; float b1 = -INFINITY;
#pragma unroll
            for (int j = 0; j < 4; ++j) { float x = -INFINITY;
#pragma unroll
                for (int gI = 0; gI < 4; ++gI) if (gI == bg) x = bi[gI * 4 + j];
                if (j != e0 && x > b1) { b1 = x; e1 = j; } }
            float s0 = 0.f, s1 = 0.f;
#pragma unroll
            for (int e = 0; e < 16; ++e) { if (e == bg * 4 + e0) s0 = sc[e]; if (e == bg * 4 + e1) s1 = sc[e]; }
            const float wsum = s0 + s1; const float wa = s0 / wsum, wb = s1 / wsum;
            const int lo = e0 < e1 ? e0 : e1, hi = e0 < e1 ? e1 : e0;
            const float clo = e0 < e1 ? wa : wb, chi = e0 < e1 ? wb : wa;
            int pr = 0;
#pragma unroll
            for (int q = 0; q < 6; ++q) if (c_pair_lo[q] == lo && c_pair_hi[q] == hi) pr = q;
            const int bucket = bg * 6 + pr;
            const int pos = atomicAdd(&p.bcnt[bucket], 1);
            p.lists[(size_t)bucket * LCAP + pos] = tok;
            p.cw[(size_t)tok * 2] = clo; p.cw[(size_t)tok * 2 + 1] = chi;
        }
    }
}

struct MoeTile { int bucket, i0, cnt, ea, eb; };
__device__ __forceinline__ bool moe_tile(const int* bcnt, int mt, MoeTile& o) {
    int acc = 0;
    for (int b = 0; b < 24; ++b) {
        const int c = bcnt[b]; const int nt = (c + 127) >> 7;
        if (mt < acc + nt) { o.bucket = b; o.i0 = (mt - acc) * 128; o.cnt = c; const int g = b / 6, pr = b % 6; o.ea = g * 4 + c_pair_lo[pr]; o.eb = g * 4 + c_pair_hi[pr]; return true; }
        acc += nt;
    }
    return false;
}
#define MOE_MAXT 152
__device__ __forceinline__ void ph_moe1(CP p, int bid, int nblk, char* smem) {
    for (int u = bid; u < MOE_MAXT * 16; u += nblk) {
        const int mt = u >> 4, nt = u & 15;
        MoeTile T; if (!moe_tile(p.bcnt, mt, T)) break;
        const int* lst = p.lists + (size_t)T.bucket * LCAP; const int i0 = T.i0, cnt = T.cnt;
        const h16* H = p.h_hi;
        const int second = nt >= 8;
        const h16* B = p.We13 + ((size_t)(second ? T.eb : T.ea) * 1024 + (nt & 7) * 128) * DM;
        f32x4 acc[2][4]; zero_acc<128>(acc);
        gemm_kloop<128>(smem, DM, [=](int r, int k) { const int i = i0 + r; const int tok = lst[i < cnt ? i : 0]; return H + (size_t)tok * DM + k; },
                        [=](int r, int k) { return B + (size_t)r * DM + k; }, acc);
        const int lane = otid() & 63, wave = otid() >> 6, wm = wave >> 1, wn = wave & 1;
#pragma unroll
        for (int i = 0; i < 2; ++i) {
            const int ml = wm * 32 + i * 16 + (lane & 15);
            const int ii = i0 + ml; const bool valid = ii < cnt;
            const float cwv = valid ? p.cw[(size_t)lst[ii] * 2 + second] : 0.f;
            h16* O = p.act + ((size_t)mt * 128 + ml) * 1024 + second * 512;
#pragma unroll
            for (int jj = 0; jj < 2; ++jj) {
                const f32x4 a = acc[i][2 * jj], bq = acc[i][2 * jj + 1];
                const int col = ((nt & 7) * 128 + wn * 64 + jj * 32) / 2 + 4 * (lane >> 4);
                float o[4];
#pragma unroll
                for (int e = 0; e < 4; ++e) o[e] = valid ? cwv * (a[e] * sigm(a[e])) * bq[e] : 0.f;
                *(h16x4*)(O + col) = pack4(o[0], o[1], o[2], o[3]);
            }
        }
    }
}
__device__ __forceinline__ void ph_moe2(CP p, int l, int bid, int nblk, char* smem) {
    for (int u = bid; u < MOE_MAXT * 8; u += nblk) {
        const int mt = u >> 3, nt = u & 7, n0 = nt * 128;
        MoeTile T; if (!moe_tile(p.bcnt, mt, T)) break;
        const int* lst = p.lists + (size_t)T.bucket * LCAP; const int i0 = T.i0, cnt = T.cnt;
        const h16* A = p.act + (size_t)mt * 128 * 1024;
        const h16* Ba = p.We2 + ((size_t)T.ea * 1024 + n0) * 512; const h16* Bb = p.We2 + ((size_t)T.eb * 1024 + n0) * 512;
        f32x4 acc[2][4]; zero_acc<128>(acc);
        gemm_kloop<128>(smem, 1024, [=](int r, int k) { return A + (size_t)r * 1024 + k; },
                        [=](int r, int k) { return (k < 512 ? Ba + k : Bb + (k - 512)) + (size_t)r * 512; }, acc);
        const float* md = p.mods + (size_t)l * 4 * 6144 + 5 * 1024 + n0;
        float* X = p.x1;
        gemm_epi<128>(acc, [=](int ml, int nl, f32x4 v) { const int ii = i0 + ml; if (ii < cnt) { const int tok = lst[ii]; const f32x4 gg = *(const f32x4*)(md + (size_t)(tok / SEQ) * 6144 + nl);
                                                          float* xp = X + (size_t)tok * DM + n0 + nl; *(f32x4*)xp = *(const f32x4*)xp + gg * v; } });
    }
}
__device__ __forceinline__ void ph_final(CP p, int bid, int nblk) {
    const int lane = otid() & 63, wv = otid() >> 6;
    for (int tok = bid * 8 + wv; tok < NTOK; tok += nblk * 8) {
        const float* xr = p.x1 + (size_t)tok * DM;
        f32x4 v[4]; float ss = 0.f;
#pragma unroll
        for (int i = 0; i < 4; ++i) { v[i] = *(const f32x4*)(xr + i * 256 + lane * 4); ss += v[i][0] * v[i][0] + v[i][1] * v[i][1] + v[i][2] * v[i][2] + v[i][3] * v[i][3]; }
        ss = wave_sum(ss);
        const float rs = rsqrtf(ss * (1.f / DM) + 1e-6f);
#pragma unroll
        for (int i = 0; i < 4; ++i) { const int c = i * 256 + lane * 4; const f32x4 gg = *(const f32x4*)(p.in[I_FINALG] + c); *(f32x4*)(p.out + (size_t)tok * DM + c) = v[i] * rs * gg; }
    }
}

#define XB_TMO      128
#define XB_XCNT(j)  (256  + 64 * (j))
#define XB_XSUB(j)  (1280 + 64 * (j))
#define XB_XGEN(j)  (2304 + 64 * (j))
#define XB_TOP      3328
#define XB_TOPGEN   3392
#define XCD_BAR_WORDS 3456
#define XB_SPIN_CAP (1u << 24)
#define LAS __attribute__((address_space(3)))

typedef __attribute__((address_space(1))) unsigned gu32;
__device__ __forceinline__ unsigned xb_ld(gu32* p)              { return __hip_atomic_load(p, __ATOMIC_RELAXED, __HIP_MEMORY_SCOPE_AGENT); }
__device__ __forceinline__ unsigned xb_add(gu32* p, unsigned v) { return __hip_atomic_fetch_add(p, v, __ATOMIC_RELAXED, __HIP_MEMORY_SCOPE_AGENT); }
__device__ __forceinline__ unsigned xb_xcc_id() { return (unsigned)__builtin_amdgcn_s_getreg((3 << 11) | 20) & 0xFu; }
#define XB_SPIN(cond, bar) do { unsigned _sp = 0; while (cond) { __builtin_amdgcn_s_sleep(1); \
    if ((++_sp & 255u) == 0u) { if (xb_ld(&(bar)[XB_TMO])) break; if (_sp > XB_SPIN_CAP) { xb_add(&(bar)[XB_TMO], 1u); break; } } } } while (0)

struct XcdBarrier { unsigned* bar; unsigned x; volatile LAS unsigned* st; };

__device__ __forceinline__ XcdBarrier xcd_barrier_post(unsigned* bar, volatile LAS unsigned* st) {
    XcdBarrier b; b.bar = bar; b.x = xb_xcc_id(); b.st = st;
    if (threadIdx.x == 0) (void)xb_add(&((gu32*)bar)[XB_XCNT(b.x)], 1u);
    return b;
}
__device__ __forceinline__ void xcd_barrier_complete(gu32* bar, unsigned x, unsigned& nloc, unsigned& nx) {
    const unsigned G = gridDim.x * gridDim.y * gridDim.z;
    unsigned sum, cnt, mine, sp = 0u;
    for (;;) {
        sum = 0u; cnt = 0u; mine = 0u;
#pragma unroll
        for (unsigned j = 0; j < 16; ++j) { const unsigned c = xb_ld(&bar[XB_XCNT(j)]); sum += c; cnt += (c > 0u) ? 1u : 0u; mine = (j == x) ? c : mine; }
        if (sum == G) break;
        __builtin_amdgcn_s_sleep(1);
        if ((++sp & 255u) == 0u) { if (xb_ld(&bar[XB_TMO])) break; if (sp > XB_SPIN_CAP) { xb_add(&bar[XB_TMO], 1u); break; } }
    }
    nloc = mine > 0u ? mine : 1u; nx = cnt > 0u ? cnt : 1u;
}
__device__ __forceinline__ void xcd_barrier(const XcdBarrier& b0) {
    asm volatile("s_waitcnt vmcnt(0)" ::: "memory");
    __syncthreads();
    if (threadIdx.x == 0) {
        unsigned long long ba = (unsigned long long)b0.bar;
        asm volatile("" : "+s"(ba));
        gu32* bar = (gu32*)ba;
        const unsigned x = xb_xcc_id();
        volatile LAS unsigned* st = b0.st;
        __builtin_amdgcn_s_waitcnt(0);
        unsigned nloc = st[0], nx = st[1];
        if (nloc == 0u) { xcd_barrier_complete(bar, x, nloc, nx); st[0] = nloc; st[1] = nx; }
        const unsigned old = xb_add(&bar[XB_XSUB(x)], 1u);
        const unsigned gen = old / nloc;
        if (old + 1u == (gen + 1u) * nloc) {
            __builtin_amdgcn_fence(__ATOMIC_RELEASE, "agent");
            asm volatile("s_waitcnt vmcnt(0)" ::: "memory");
            const unsigned og = xb_add(&bar[XB_TOP], 1u);
            const unsigned tg = og / nx;
            if (og + 1u == (tg + 1u) * nx) xb_add(&bar[XB_TOPGEN], 1u);
            else XB_SPIN(xb_ld(&bar[XB_TOPGEN]) == tg, bar);
            __builtin_amdgcn_fence(__ATOMIC_ACQUIRE, "agent");
            xb_add(&bar[XB_XGEN(x)], 1u);
            asm volatile("s_waitcnt vmcnt(0)" ::: "memory");
        } else {
            XB_SPIN(xb_ld(&bar[XB_XGEN(x)]) == gen, bar);
            __builtin_amdgcn_fence(__ATOMIC_ACQUIRE, "agent");
            asm volatile("s_waitcnt vmcnt(0)" ::: "memory");
        }
    }
    __syncthreads();
}

__device__ __forceinline__ const __attribute__((address_space(4))) Params* lp(const __attribute__((address_space(4))) Params* q) { asm volatile("" : "+s"(q)); return q; }
#define MEGA_LDS (155648 + 16)
__global__ void __launch_bounds__(512) k_mega(Params p) {
    extern __shared__ __attribute__((aligned(16))) char smem[];
    volatile LAS unsigned* xbw = (volatile LAS unsigned*)(smem + MEGA_LDS - 16);
    if (threadIdx.x == 0) { xbw[0] = 0u; xbw[1] = 0u; }
    __syncthreads();
    XcdBarrier bar = xcd_barrier_post(p.bar, xbw);
    const int bid0 = blockIdx.x, nblk0 = gridDim.x;
    const __attribute__((address_space(4))) Params* kp = (const __attribute__((address_space(4))) Params*)__builtin_amdgcn_kernarg_segment_ptr();
#define PQ (*lp(kp))
#define BID oint(bid0)
#define NBLK oint(nblk0)
    ph_mods(PQ, BID, NBLK, smem);
    ph_tables(PQ, BID, NBLK);
#if PROBE == 9
    __syncthreads(); ph_mods(PQ, BID, NBLK, smem); ph_tables(PQ, BID, NBLK);
#endif
    ph_convert_mix(PQ, 0, BID, NBLK);
#if PROBE == 1
    ph_convert_mix(PQ, 0, BID, NBLK);
#endif
    xcd_barrier(bar);
    for (int l0 = 0; l0 < 2; ++l0) {
#define LL oint(l0)
        ph_norm1(PQ, LL, BID, NBLK);
        xcd_barrier(bar);
        ph_gemm1(PQ, BID, NBLK, smem);
#if PROBE == 2
        ph_gemm1(PQ, BID, NBLK, smem);
#endif
        xcd_barrier(bar);
        ph_s5_scan<1>(PQ, LL, BID, NBLK, smem);
        __syncthreads();
        ph_rg_a(PQ, LL, BID, NBLK, smem);
        __syncthreads();
        ph_rw_a(PQ, LL, BID, NBLK, smem);
#if PROBE == 13
        __syncthreads(); ph_s5_scan<1>(PQ, LL, BID, NBLK, smem);
#endif
#if PROBE == 14
        __syncthreads(); ph_rg_a(PQ, LL, BID, NBLK, smem);
#endif
#if PROBE == 15
        __syncthreads(); ph_rw_a(PQ, LL, BID, NBLK, smem);
#endif
#if PROBE == 3
        __syncthreads(); ph_s5_scan<1>(PQ, LL, BID, NBLK, smem); __syncthreads(); ph_rg_a(PQ, LL, BID, NBLK, smem); __syncthreads(); ph_rw_a(PQ, LL, BID, NBLK, smem);
#endif
        __syncthreads();
        __syncthreads();
        ph_dsa_pre2(PQ, BID, NBLK, smem);
        xcd_barrier(bar);
        if (BID < 16) ph_rw_b(PQ, BID, smem);
        else {
            ph_s5_carry(PQ, LL, BID - 16, NBLK - 16);
            ph_rg_c(PQ, LL, BID - 16, NBLK - 16, smem);
            __syncthreads();
            ph_dsa_a(PQ, BID - 16, NBLK - 16, smem);
#if PROBE == 4 || PROBE == 12
            __syncthreads(); ph_dsa_a(PQ, BID - 16, NBLK - 16, smem);
#endif
        }
#if PROBE == 4 || PROBE == 11
        if (BID < 16) ph_rw_b(PQ, BID, smem);
#endif
        xcd_barrier(bar);
        ph_dsa_b(PQ, BID, NBLK, smem);
        __syncthreads();
        ph_s5_scan<3>(PQ, LL, BID, NBLK, smem);
        ph_rw_c(PQ, LL, BID, NBLK);
#if PROBE == 5
        __syncthreads(); ph_dsa_b(PQ, BID, NBLK, smem);
#endif
#if PROBE == 17
        ph_s5_scan<3>(PQ, LL, BID, NBLK, smem);
#endif
#if PROBE == 18
        ph_rw_c(PQ, LL, BID, NBLK);
#endif
#if PROBE == 6
        ph_s5_scan<3>(PQ, LL, BID, NBLK, smem); ph_rw_c(PQ, LL, BID, NBLK);
#endif
        xcd_barrier(bar);
        ph_dsa_merge(PQ, BID, NBLK);
        ph_s5_glu(PQ, LL, BID, NBLK, smem);
        xcd_barrier(bar);
        ph_gates(PQ, LL, BID, NBLK, smem);
#if PROBE == 7
        ph_gates(PQ, LL, BID, NBLK, smem);
#endif
        xcd_barrier(bar);
        ph_merge(PQ, LL, BID, NBLK, smem);
#if PROBE == 10
        ph_merge(PQ, LL, BID, NBLK, smem);
#endif
        xcd_barrier(bar);
        ph_outproj(PQ, LL, BID, NBLK, smem);
        ph_convert_moe(PQ, LL, BID, NBLK);
#if PROBE == 1
        ph_convert_moe(PQ, LL, BID, NBLK);
#endif
        xcd_barrier(bar);
        ph_norm2_router(PQ, LL, BID, NBLK, smem);
        if (LL == 0) ph_convert_mix(PQ, 1, BID, NBLK);
#if PROBE == 1
        if (LL == 0) ph_convert_mix(PQ, 1, BID, NBLK);
#endif
        xcd_barrier(bar);
        ph_moe1(PQ, BID, NBLK, smem);
#if PROBE == 8
        ph_moe1(PQ, BID, NBLK, smem);
#endif
        xcd_barrier(bar);
        ph_moe2(PQ, LL, BID, NBLK, smem);
        xcd_barrier(bar);
    }
    ph_final(PQ, BID, NBLK);
}

static inline size_t al(size_t x) { return (x + 255) & ~(size_t)255; }
extern "C" void kernel_launch(void* const* d_in, const int* in_sizes, int n_in, void* d_out, int out_size, void* d_ws, size_t ws_size, hipStream_t stream) {
    Params p{};
    for (int i = 0; i < N_IN; ++i) p.in[i] = (const float*)d_in[i];
    p.pos = (const int*)d_in[I_POS];
    p.out = (float*)d_out;
    char* w = (char*)d_ws; size_t off = 0;
    auto take = [&](size_t bytes) { char* r = w + off; off += al(bytes); return r; };
    p.bar = (unsigned*)take(XCD_BAR_WORDS * 4);
    p.mods = (float*)take(2 * 4 * 6144 * 4);
    p.bcnt = (int*)take(256);
    p.s5c = (float*)take((size_t)2 * 16 * 64 * 36 * 4); p.ropet = (float*)take((size_t)NTOK * 32 * 2 * 4);
    p.Wp = (h16*)take((size_t)2560 * DM * 2); p.Widx = (h16*)take((size_t)256 * 3072 * 2); p.Wg = (h16*)take((size_t)4096 * DM * 2);
    p.Wb = (h16*)take((size_t)4096 * 256 * 2); p.Wo = (h16*)take((size_t)DM * DM * 2); p.Wglu = (h16*)take(256 * 256 * 2);
    p.x1 = (float*)take((size_t)NTOK * DM * 4);
    p.h_hi = (h16*)take((size_t)NTOK * DM * 2); p.h_lo = (h16*)take((size_t)NTOK * DM * 2); p.branches = p.h_lo;
    p.cw = (float*)take((size_t)NTOK * 2 * 4);
    p.lists = (int*)take((size_t)24 * LCAP * 4);
    const size_t offR = off;
    p.proj = (h16*)take((size_t)NTOK * PJ * 2); p.idxf = (float*)take((size_t)NTOK * IDXLD * 4);
    p.vT = (h16*)take((size_t)4 * 256 * SEQ * 2); p.dthr = (unsigned*)take((size_t)NTOK * 4); p.dcut = (int*)take((size_t)NTOK * 4);
    p.ybuf = (h16*)take((size_t)NTOK * 256 * 2); p.s5E = (float*)take((size_t)4 * 64 * 16 * 64 * 2 * 4); p.s5H = (float*)take((size_t)4 * 64 * 16 * 64 * 2 * 4);
    p.rg_hl = (float*)take((size_t)NTOK * 256 * 4); p.rg_cp = (float*)take((size_t)NTOK * 256 * 4); p.rg_agg = (float*)take((size_t)4 * 128 * 256 * 2 * 4);
    p.rw_g = (h16*)take((size_t)NTOK * 256 * 2); p.rw_bonus = (h16*)take((size_t)NTOK * 256 * 2);
    p.rw_W = (h16*)take((size_t)1024 * 4096 * 2); p.rw_U0 = (h16*)take((size_t)1024 * 4096 * 2); p.rw_Ry = (h16*)take((size_t)1024 * 4096 * 2); p.rw_Y0 = (h16*)take((size_t)1024 * 4096 * 2);
    p.rw_Be = (h16*)take((size_t)1024 * 4096 * 2); p.rw_VK = (h16*)take((size_t)1024 * 4096 * 2); p.rw_S0 = (h16*)take((size_t)1024 * 4096 * 2); p.rw_gam = (float*)take((size_t)1024 * 64 * 4);
    const size_t endMix = off;
    p.dsa_op = (h16*)p.rg_hl; p.dsa_ml = p.rg_cp;
    p.gates = p.proj;
    p.mixed = p.rw_g;
    if ((char*)p.gates + (size_t)NTOK * 4096 * 2 > (char*)p.mixed) { fprintf(stderr, "gates/mixed overlap\n"); return; }
    off = offR;
    p.We13 = (h16*)take((size_t)16 * 1024 * DM * 2); p.We2 = (h16*)take((size_t)16 * 1024 * 512 * 2); p.act = (h16*)take((size_t)MOE_MAXT * 128 * 1024 * 2);
    const size_t endMoe = off;
    const size_t need = endMix > endMoe ? endMix : endMoe;
    if (need > ws_size || (char*)p.act + (size_t)MOE_MAXT * 128 * 1024 * 2 > (char*)p.ybuf) { fprintf(stderr, "workspace layout problem: need %zu have %zu\n", need, ws_size); return; }

    static int grid = 0;
    if (!grid) {
        (void)hipFuncSetAttribute((const void*)k_mega, hipFuncAttributeMaxDynamicSharedMemorySize, MEGA_LDS);
        int dev = 0, cus = 0, per_cu = 0;
        (void)hipGetDevice(&dev);
        (void)hipDeviceGetAttribute(&cus, hipDeviceAttributeMultiprocessorCount, dev);
        (void)hipOccupancyMaxActiveBlocksPerMultiprocessor(&per_cu, (const void*)k_mega, 512, MEGA_LDS);
        if (per_cu < 1) { fprintf(stderr, "k_mega not launchable (occupancy 0)\n"); return; }
        grid = cus;
        fprintf(stderr, "k_mega: grid %d (cus %d, per_cu %d), ws need %zu have %zu\n", grid, cus, per_cu, need, ws_size);
    }
    (void)hipMemsetAsync(p.bar, 0, XCD_BAR_WORDS * 4, stream);
    k_mega<<<grid, 512, MEGA_LDS, stream>>>(p);
}
```

```cpp
#ifndef PROBE
#define PROBE 0
#endif
#include <hip/hip_runtime.h>
#include <stdint.h>
#include <stdio.h>
#include <math.h>

typedef _Float16 h16;
typedef _Float16 h16x8 __attribute__((ext_vector_type(8)));
typedef _Float16 h16x4 __attribute__((ext_vector_type(4)));
typedef _Float16 h16x2 __attribute__((ext_vector_type(2)));
typedef float f32x4 __attribute__((ext_vector_type(4)));
typedef unsigned u32x4 __attribute__((ext_vector_type(4)));

#define NTOK 16384
#define SEQ 4096
#define NBATCH 4
#define DM 1024
#define DINW 2596
#define PJ 2432
#define IDXLD 192
#define P_U 0
#define P_Q 256
#define P_K 512
#define P_V 768
#define P_RGX 1024
#define P_RGG 1280
#define P_RW 1536
#define LCAP 16384

enum { I_X = 0, I_C, I_POS, I_ADAW, I_ADAB, I_MNG, I_WIN, I_GATEW, I_GATEB, I_BRW, I_OUTW,
       I_S5LRE, I_S5LIM, I_S5LS, I_S5BRE, I_S5BIM, I_S5CRE, I_S5CIM, I_S5D, I_S5GW, I_S5GB,
       I_RGCW, I_RGCB, I_RGWR, I_RGBR, I_RGWI, I_RGBI, I_RGLAM,
       I_RWMU, I_RWW0, I_RWWUP, I_RWA0, I_RWAUP, I_RWGUP, I_RWKK, I_RWKA, I_RWRK, I_RWGNW, I_RWGNB,
       I_FNG, I_ROUTW, I_ROUTB, I_W1, I_W3, I_W2, I_FINALG, N_IN };

struct Params {
    const float* in[N_IN];
    const int* pos;
    float* out;
    unsigned* bar;
    float* mods;
    h16 *Wp, *Widx, *Wg, *Wb, *Wo, *Wglu, *We13, *We2;
    float* x1;
    h16 *h_hi, *h_lo, *branches;
    h16* proj; float* idxf;
    h16* ybuf; float *s5E, *s5H, *s5c, *ropet;
    h16* vT; unsigned long long* dmask; int* qctr; float* dsa_ml; h16* dsa_op;
    float *rg_hl, *rg_cp, *rg_agg;
    h16 *rw_r, *rw_w, *rw_k, *rw_kk, *rw_b, *rw_g, *rw_bonus, *rw_v; float* rw_y;
    h16 *rw_W, *rw_U0, *rw_Ry, *rw_Y0, *rw_Be, *rw_VK, *rw_S0; float* rw_gam;
    h16* mixed; h16* gates;
    h16* act; h16* h2s; int* lists; int* bcnt; float* cw;
};

typedef const __attribute__((address_space(4))) Params& CP;
__device__ __forceinline__ float sigm(float x) { return 1.f / (1.f + __expf(-x)); }
__device__ __forceinline__ float gelu_tanh(float x) { return 0.5f * x * (1.f + tanhf(0.7978845608028654f * (x + 0.044715f * x * x * x))); }
__device__ __forceinline__ float softplusf_(float x) { return fmaxf(x, 0.f) + log1pf(__expf(-fabsf(x))); }
template <int CTRL> __device__ __forceinline__ float dppf(float x) { return __int_as_float(__builtin_amdgcn_update_dpp(0, __float_as_int(x), CTRL, 0xf, 0xf, false)); }
__device__ __forceinline__ float x16_sum(float x) { auto r = __builtin_amdgcn_permlane16_swap(__float_as_uint(x), __float_as_uint(x), false, false); return __uint_as_float(r[0]) + __uint_as_float(r[1]); }
__device__ __forceinline__ float x32_sum(float x) { auto r = __builtin_amdgcn_permlane32_swap(__float_as_uint(x), __float_as_uint(x), false, false); return __uint_as_float(r[0]) + __uint_as_float(r[1]); }
__device__ __forceinline__ float x16_max(float x) { auto r = __builtin_amdgcn_permlane16_swap(__float_as_uint(x), __float_as_uint(x), false, false); return fmaxf(__uint_as_float(r[0]), __uint_as_float(r[1])); }
__device__ __forceinline__ float x32_max(float x) { auto r = __builtin_amdgcn_permlane32_swap(__float_as_uint(x), __float_as_uint(x), false, false); return fmaxf(__uint_as_float(r[0]), __uint_as_float(r[1])); }
__device__ __forceinline__ int x16_isum(int x) { auto r = __builtin_amdgcn_permlane16_swap((unsigned)x, (unsigned)x, false, false); return (int)(r[0] + r[1]); }
__device__ __forceinline__ int x32_isum(int x) { auto r = __builtin_amdgcn_permlane32_swap((unsigned)x, (unsigned)x, false, false); return (int)(r[0] + r[1]); }
__device__ __forceinline__ float rows_sum(float x) { return x32_sum(x16_sum(x)); }
__device__ __forceinline__ float rows_max(float x) { return x32_max(x16_max(x)); }
__device__ __forceinline__ int rows_isum(int x) { return x32_isum(x16_isum(x)); }
template <int CTRL> __device__ __forceinline__ int dppi(int x) { return __builtin_amdgcn_update_dpp(0, x, CTRL, 0xf, 0xf, false); }
__device__ __forceinline__ int wave_isum(int v) { v += dppi<0xB1>(v); v += dppi<0x4E>(v); v += dppi<0x124>(v); v += dppi<0x128>(v); return rows_isum(v); }
__device__ __forceinline__ float wave_sum(float v) { v += dppf<0xB1>(v); v += dppf<0x4E>(v); v += dppf<0x124>(v); v += dppf<0x128>(v); return rows_sum(v); }
__device__ __forceinline__ float wave_max(float v) { v = fmaxf(v, dppf<0xB1>(v)); v = fmaxf(v, dppf<0x4E>(v)); v = fmaxf(v, dppf<0x124>(v)); v = fmaxf(v, dppf<0x128>(v)); return rows_max(v); }
__device__ __forceinline__ float egl_get(const float* egl, int k) { return egl[k]; }
__device__ __forceinline__ h16x4 pack4(float a, float b, float c, float d) { h16x4 r; r[0] = (h16)a; r[1] = (h16)b; r[2] = (h16)c; r[3] = (h16)d; return r; }

__device__ __forceinline__ int oint(int x) { asm volatile("" : "+s"(x)); return x; }
__device__ __forceinline__ int otid() { int t = threadIdx.x; asm volatile("" : "+v"(t)); return t; }
__device__ __forceinline__ void ph_mods(CP p, int bid, int nblk, char* smem) {
    float* ca = (float*)smem;
    float* part = ca + 4 * DM;
    const int tid = otid();
    __syncthreads();
    for (int i = tid; i < 4 * DM; i += 512) { float c = p.in[I_C][i]; ca[i] = c * sigm(c); }
    __syncthreads();
    for (int u = bid; u < 192; u += nblk) {
        const int l = u / 96, j = (u % 96) * 64 + (tid & 63), ks = tid >> 6;
        const float* w = p.in[I_ADAW] + (size_t)l * DM * 6144 + (size_t)(ks * 128) * 6144 + j;
        float a0 = 0, a1 = 0, a2 = 0, a3 = 0;
#pragma unroll 8
        for (int k = 0; k < 128; ++k) { const float wv = w[(size_t)k * 6144]; const int kk = ks * 128 + k; a0 += ca[kk] * wv; a1 += ca[DM + kk] * wv; a2 += ca[2 * DM + kk] * wv; a3 += ca[3 * DM + kk] * wv; }
        __syncthreads();
        part[(ks * 4 + 0) * 64 + (tid & 63)] = a0; part[(ks * 4 + 1) * 64 + (tid & 63)] = a1; part[(ks * 4 + 2) * 64 + (tid & 63)] = a2; part[(ks * 4 + 3) * 64 + (tid & 63)] = a3;
        __syncthreads();
        if (tid < 256) {
            const int bb = tid >> 6, cc = tid & 63; float sum = p.in[I_ADAB][l * 6144 + (u % 96) * 64 + cc];
#pragma unroll
            for (int q = 0; q < 8; ++q) sum += part[(q * 4 + bb) * 64 + cc];
            p.mods[(size_t)l * 4 * 6144 + (size_t)bb * 6144 + (u % 96) * 64 + cc] = sum;
        }
    }
    __syncthreads();
}
__device__ __forceinline__ void ph_tables(CP p, int bid, int nblk) {
    const int gt = bid * 512 + otid(), gn = nblk * 512;
    if (gt < 2) p.qctr[gt] = 0;
    for (int i = gt; i < NTOK * 32; i += gn) {
        const int tok = i >> 5, f = i & 31;
        const double ang = (double)p.pos[tok] * exp(-(double)f * (1.0 / 32.0) * 9.210340371976184);
        double sn, cs; sincos(ang, &sn, &cs);
        p.ropet[(size_t)i * 2] = (float)cs; p.ropet[(size_t)i * 2 + 1] = (float)sn;
    }
    for (int i = gt; i < 2 * 16 * 64; i += gn) {
        const int g = (i >> 6) & 15, l = i >> 10;
        const double lre = p.in[I_S5LRE][i], lim = p.in[I_S5LIM][i], st = exp((double)p.in[I_S5LS][l * 16 + g]);
        const double er = exp(lre * st); double sn, cs; sincos(lim * st, &sn, &cs);
        const double lbr = er * cs, lbi = er * sn;
        const double nr = lbr - 1.0, ni = lbi, den = lre * lre + lim * lim;
        const double fr = (nr * lre + ni * lim) / den, fi = (ni * lre - nr * lim) / den;
        const double e64 = exp(64.0 * lre * st); double s64, c64; sincos(64.0 * lim * st, &s64, &c64);
        float* o = p.s5c + (size_t)i * 36;
        o[0] = (float)lbr; o[1] = (float)lbi; o[2] = (float)(e64 * c64); o[3] = (float)(e64 * s64);
        for (int cc = 0; cc < 16; ++cc) { const double br = p.in[I_S5BRE][(size_t)i * 16 + cc], bi = p.in[I_S5BIM][(size_t)i * 16 + cc];
                                          o[4 + cc] = (float)(fr * br - fi * bi); o[20 + cc] = (float)(fr * bi + fi * br); }
    }
}
template <class SRC>
__device__ __forceinline__ void convT(h16* dst, int dstld, int nrows, int K, int koff, const SRC& src, int gtid, int gthreads) {
    const int kch = K / 8;
    const long total = (long)nrows * kch;
    for (long w = gtid; w < total; w += gthreads) {
        int n = (int)(w % nrows), kc = (int)(w / nrows);
        h16x8 v;
#pragma unroll
        for (int i = 0; i < 8; ++i) v[i] = (h16)src(n, kc * 8 + i);
        *(h16x8*)(dst + (size_t)n * dstld + koff + kc * 8) = v;
    }
}
__device__ __forceinline__ void ph_convert_mix(CP p, int l, int bid, int nblk) {
    const int gt = bid * 512 + otid(), gn = nblk * 512;
    { const float* s = p.in[I_WIN] + (size_t)l * DM * DINW;
      convT(p.Wp, DM, 2560, DM, 0, [=](int n, int k) { return n < PJ ? s[(size_t)k * DINW + (n < 1024 ? n : n + 164)] : 0.f; }, gt, gn);
      convT(p.Widx, 3072, 256, DM, 0, [=](int n, int k) { return n < 164 ? s[(size_t)k * DINW + 1024 + n] : 0.f; }, gt, gn);
      convT(p.Widx, 3072, 256, DM, 1024, [=](int n, int k) { return n < 164 ? s[(size_t)k * DINW + 1024 + n] : 0.f; }, gt, gn);
      convT(p.Widx, 3072, 256, DM, 2048, [=](int n, int k) { float w = n < 164 ? s[(size_t)k * DINW + 1024 + n] : 0.f; float hi = (float)(h16)w; return w - hi; }, gt, gn); }
    { const float* s = p.in[I_GATEW] + (size_t)l * DM * 4096;
      convT(p.Wg, DM, 4096, DM, 0, [=](int n, int k) { return s[(size_t)k * 4096 + n]; }, gt, gn); }
    { const float* s = p.in[I_BRW] + (size_t)l * 4 * 256 * DM;
      convT(p.Wb, 256, 4096, 256, 0, [=](int n, int k) { int br = n >> 10, d = n & 1023; return s[(size_t)br * 256 * DM + (size_t)k * DM + d]; }, gt, gn); }
    { const float* s = p.in[I_OUTW] + (size_t)l * DM * DM;
      convT(p.Wo, DM, DM, DM, 0, [=](int n, int k) { return s[(size_t)k * DM + n]; }, gt, gn); }
    { const float* s = p.in[I_S5GW] + (size_t)l * 256 * 256;
      convT(p.Wglu, 256, 256, 256, 0, [=](int n, int k) { return s[(size_t)k * 256 + n]; }, gt, gn); }
}
__device__ __forceinline__ void ph_convert_moe(CP p, int l, int bid, int nblk) {
    const int gt = bid * 512 + otid(), gn = nblk * 512;
    const float* s1 = p.in[I_W1] + (size_t)l * 16 * DM * 512;
    const float* s3 = p.in[I_W3] + (size_t)l * 16 * DM * 512;
    const float* s2 = p.in[I_W2] + (size_t)l * 16 * 512 * DM;
    convT(p.We13, DM, 16 * 1024, DM, 0, [=](int n, int k) { int e = n >> 10, r = n & 1023; int c = (r >> 3) * 4 + (r & 3); const float* s = ((r >> 2) & 1) ? s3 : s1;
                                                           return s[(size_t)e * DM * 512 + (size_t)k * 512 + c]; }, gt, gn);
    convT(p.We2, 512, 16 * 1024, 512, 0, [=](int n, int k) { int e = n >> 10, c = n & 1023; return s2[(size_t)e * 512 * DM + (size_t)k * DM + c]; }, gt, gn);
}

__device__ __forceinline__ void ph_norm1(CP p, int l, int bid, int nblk) {
    const float* xin = l == 0 ? p.in[I_X] : p.x1;
    const int lane = otid() & 63, wv = otid() >> 6;
    if (bid == 0 && otid() < 24) p.bcnt[otid()] = 0;
    for (int tok = bid * 8 + wv; tok < NTOK; tok += nblk * 8) {
        const int b = tok / SEQ;
        const float* xr = xin + (size_t)tok * DM;
        f32x4 v[4]; float ss = 0.f;
#pragma unroll
        for (int i = 0; i < 4; ++i) { v[i] = *(const f32x4*)(xr + i * 256 + lane * 4); ss += v[i][0] * v[i][0] + v[i][1] * v[i][1] + v[i][2] * v[i][2] + v[i][3] * v[i][3]; }
        ss = wave_sum(ss);
        const float rs = rsqrtf(ss * (1.f / DM) + 1e-6f);
        const float* g = p.in[I_MNG] + l * DM;
        const float* md = p.mods + ((size_t)l * 4 + b) * 6144;
#pragma unroll
        for (int i = 0; i < 4; ++i) {
            const int c = i * 256 + lane * 4;
            f32x4 gg = *(const f32x4*)(g + c), sh = *(const f32x4*)(md + c), sc = *(const f32x4*)(md + 1024 + c);
            float hv[4]; h16x4 hi, lo;
#pragma unroll
            for (int e = 0; e < 4; ++e) { hv[e] = v[i][e] * rs * gg[e] * (1.f + sc[e]) + sh[e]; hi[e] = (h16)hv[e]; lo[e] = (h16)(hv[e] - (float)hi[e]); }
            *(h16x4*)(p.h_hi + (size_t)tok * DM + c) = hi;
            *(h16x4*)(p.h_lo + (size_t)tok * DM + c) = lo;
        }
    }
}

#define LDT 72
template <int BM, class AF, class BF, class SEG>
__device__ __forceinline__ void gemm_kloop_seg(char* smem, int K, const AF& af, const BF& bf, f32x4 (&acc)[BM / 64][4], const SEG& seg) {
    constexpr int MT = BM / 64, WM = BM / 4, NA = BM / 64;
    h16* sA = (h16*)smem; h16* sB = sA + 2 * BM * LDT;
    const int tid = otid(), lane = tid & 63, wave = tid >> 6, wm = wave >> 1, wn = wave & 1;
    const int lrow = tid >> 3, lkc = (tid & 7) * 8;
    u32x4 ra0[NA], rb0[2], ra1[NA], rb1[2];
    const int nk = K / 64;
#define GK_LOAD(RA, RB, KT) do { const int k_ = (KT) * 64 + lkc; \
        _Pragma("unroll") for (int i = 0; i < NA; ++i) RA[i] = *(const u32x4*)af(lrow + i * 64, k_); \
        _Pragma("unroll") for (int i = 0; i < 2; ++i) RB[i] = *(const u32x4*)bf(lrow + i * 64, k_); } while (0)
#define GK_STORE(RA, RB, BUF) do { h16* nA_ = sA + (BUF) * BM * LDT; h16* nB_ = sB + (BUF) * 128 * LDT; \
        _Pragma("unroll") for (int i = 0; i < NA; ++i) *(u32x4*)&nA_[(lrow + i * 64) * LDT + lkc] = RA[i]; \
        _Pragma("unroll") for (int i = 0; i < 2; ++i) *(u32x4*)&nB_[(lrow + i * 64) * LDT + lkc] = RB[i]; } while (0)
#define GK_COMPUTE(BUF) do { const h16* cA = sA + (BUF) * BM * LDT; const h16* cB = sB + (BUF) * 128 * LDT; \
        _Pragma("unroll") for (int ks = 0; ks < 2; ++ks) { h16x8 a[MT], b[4]; \
            _Pragma("unroll") for (int i = 0; i < MT; ++i) a[i] = *(const h16x8*)&cA[(wm * WM + i * 16 + (lane & 15)) * LDT + ks * 32 + (lane >> 4) * 8]; \
            _Pragma("unroll") for (int j = 0; j < 4; ++j) b[j] = *(const h16x8*)&cB[(wn * 64 + j * 16 + (lane & 15)) * LDT + ks * 32 + (lane >> 4) * 8]; \
            _Pragma("unroll") for (int i = 0; i < MT; ++i) _Pragma("unroll") for (int j = 0; j < 4; ++j) acc[i][j] = __builtin_amdgcn_mfma_f32_16x16x32_f16(b[j], a[i], acc[i][j], 0, 0, 0); } } while (0)
    GK_LOAD(ra0, rb0, 0);
    if (nk > 1) GK_LOAD(ra1, rb1, 1);
    GK_STORE(ra0, rb0, 0);
    __syncthreads();
    for (int kt = 0; kt < nk; kt += 2) {
        if (kt + 2 < nk) GK_LOAD(ra0, rb0, kt + 2);
        GK_COMPUTE(0);
        seg(kt);
        if (kt + 1 < nk) GK_STORE(ra1, rb1, 1);
        __syncthreads();
        if (kt + 1 < nk) {
            if (kt + 3 < nk) GK_LOAD(ra1, rb1, kt + 3);
            GK_COMPUTE(1);
            seg(kt + 1);
            if (kt + 2 < nk) GK_STORE(ra0, rb0, 0);
            __syncthreads();
        }
    }
#undef GK_LOAD
#undef GK_STORE
#undef GK_COMPUTE
}
template <int BM, class AF, class BF>
__device__ __forceinline__ void gemm_kloop(char* smem, int K, const AF& af, const BF& bf, f32x4 (&acc)[BM / 64][4]) {
    gemm_kloop_seg<BM>(smem, K, af, bf, acc, [](int) {});
}
template <int BM> __device__ __forceinline__ void zero_acc(f32x4 (&acc)[BM / 64][4]) {
#pragma unroll
    for (int i = 0; i < BM / 64; ++i)
#pragma unroll
        for (int j = 0; j < 4; ++j) acc[i][j] = (f32x4){0.f, 0.f, 0.f, 0.f};
}
template <int BM, class EPI>
__device__ __forceinline__ void gemm_epi(const f32x4 (&acc)[BM / 64][4], const EPI& epi) {
    const int lane = otid() & 63, wave = otid() >> 6, wm = wave >> 1, wn = wave & 1;
#pragma unroll
    for (int i = 0; i < BM / 64; ++i)
#pragma unroll
        for (int j = 0; j < 4; ++j) epi(wm * (BM / 4) + i * 16 + (lane & 15), wn * 64 + j * 16 + 4 * (lane >> 4), acc[i][j]);
}
#define GEMM_LDS(BM) (2 * (BM) * LDT * 2 + 2 * 128 * LDT * 2)


namespace pg8 {
#define PG8_LAS __attribute__((address_space(3)))
constexpr int BM = 256, BK = 64, HALF = 128, HTB = HALF * BK * 2, STAGE_BYTES = 8 * HTB, NXCD = 8, WGM = 8;
__device__ __forceinline__ int lds_byte(int r, int c) { const int st = (r >> 4) * 2 + (c >> 5), rr = r & 15, cc = c & 31, ob = rr * 64 + cc * 2; return st * 1024 + (ob ^ (((ob >> 9) & 1) << 5)); }
__device__ __forceinline__ void stage_rc(int b, int& R, int& C) { const int st = b / 1024, sb = b % 1024, swz = sb ^ (((sb >> 9) & 1) << 5); R = (st >> 1) * 16 + swz / 64; C = (st & 1) * 32 + (swz % 64) / 2; }
__device__ __forceinline__ int perm32(int rho) { const int n = rho >> 4, i = rho & 15; return 8 * (i >> 2) + 4 * n + (i & 3); }
struct Unit { int pm, pn; int bucket, i0, cnt, ea, eb; };
struct Gemm { const h16* A; const h16* Bt; int M, N, K, lda, ldb; };
struct StaticOrder {
    int nM, nN, nwg, G, c;
    __device__ void init(int M, int N, int G_, int c_) { nM = M / BM; nN = N / BM; nwg = nM * nN; G = G_; c = c_; }
    __device__ bool next(int i, Unit& u) const {
        const long L = (long)i * G + c; if (L >= nwg) return false;
        int wgid = (int)L; { const int q = nwg / NXCD, r = nwg % NXCD, xcd = wgid % NXCD, off = wgid / NXCD; wgid = (xcd < r ? xcd * (q + 1) : r * (q + 1) + (xcd - r) * q) + off; }
        const int nig = WGM * nN, gid = wgid / nig, fm = gid * WGM, gsz = (nM - fm) < WGM ? (nM - fm) : WGM;
        u.pm = fm + ((wgid % nig) % gsz); u.pn = (wgid % nig) / gsz; return true;
    }
    __device__ __forceinline__ int ksplit() const { return 1 << 30; }
    __device__ __forceinline__ void b_ptr(const Gemm& g, const Unit& u, size_t tsB, const char*& lo, const char*& hi) const { lo = hi = (const char*)g.Bt + (size_t)u.pn * tsB; }
};
template <class Epi, class Sched>
__device__ __forceinline__ void gemm_phase(PG8_LAS unsigned char* lds, const Gemm g, const Sched& S, const Epi& E) {
    const int tid = otid(), wid = __builtin_amdgcn_readfirstlane(tid >> 6), lane = tid & 63, wr = wid >> 2, wc = wid & 3, fr = lane & 15, fq = lane >> 4;
    const int K = g.K, nt = K / BK;
    unsigned voffA[2], voffB[2];
#pragma unroll
    for (int i = 0; i < 2; ++i) { int R, C; stage_rc(tid * 16 + i * 8192, R, C); const int Rb = Epi::PERM ? ((R & ~31) + perm32(R & 31)) : R;
        voffA[i] = (unsigned)(R * g.lda + C) * 2u; voffB[i] = (unsigned)(Rb * g.ldb + C) * 2u; }
    const size_t kstep = (size_t)(BK * 2);
    const size_t hsA = (size_t)HALF * g.lda * 2, hsB = (size_t)HALF * g.ldb * 2;
    const int ksp = S.ksplit();
    const size_t tsA = 2 * hsA, tsB = 2 * hsB;
    const unsigned ldsw = (unsigned)wid * 1024u;
    const int aoff = lds_byte(wr * 64 + fr, fq * 8), boff = lds_byte(wc * 32 + fr, fq * 8);
#define PG8_SA(b, h) (((b) * 2 + (h)) * HTB)
#define PG8_SB(b, h) ((4 + (b) * 2 + (h)) * HTB)
#define PG8_STAGE(bufoff, gbase, voff) do { _Pragma("unroll") for (int _i = 0; _i < 2; ++_i) \
        __builtin_amdgcn_global_load_lds((const unsigned*)((const char*)(gbase) + (voff)[_i]), (PG8_LAS unsigned*)(lds + (bufoff) + ldsw + _i * 8192), 16, 0, 0); } while (0)
#define PG8_LDA(dst, b, h) do { _Pragma("unroll") for (int m = 0; m < 4; ++m) _Pragma("unroll") for (int k = 0; k < 2; ++k) dst[m][k] = *(const PG8_LAS h16x8*)(lds + PG8_SA(b, h) + aoff + m * 2048 + k * 1024); } while (0)
#define PG8_LDB(dst, b, h) do { _Pragma("unroll") for (int n = 0; n < 2; ++n) _Pragma("unroll") for (int k = 0; k < 2; ++k) dst[n][k] = *(const PG8_LAS h16x8*)(lds + PG8_SB(b, h) + boff + n * 2048 + k * 1024); } while (0)
#define PG8_MMA(ai, bj, At, Bt) do { __builtin_amdgcn_s_setprio(1); _Pragma("unroll") for (int m = 0; m < 4; ++m) _Pragma("unroll") for (int n = 0; n < 2; ++n) _Pragma("unroll") for (int k = 0; k < 2; ++k) \
        acc[ai][bj][m][n] = __builtin_amdgcn_mfma_f32_16x16x32_f16(Bt[n][k], At[m][k], acc[ai][bj][m][n], 0, 0, 0); __builtin_amdgcn_s_setprio(0); } while (0)
#define PG8_WAIT_V(n) asm volatile("s_waitcnt vmcnt(" #n ")" ::: "memory")
#define PG8_WAIT_L(n) asm volatile("s_waitcnt lgkmcnt(" #n ")" ::: "memory")
#define PG8_BAR __builtin_amdgcn_s_barrier()
#define PG8_SCHED __builtin_amdgcn_sched_barrier(0)
    Unit cur, nxt; int ui = 0;
    if (!S.next(0, cur)) return;
    f32x4 acc[2][2][4][2];
#pragma unroll
    for (int a = 0; a < 2; ++a)
#pragma unroll
        for (int b = 0; b < 2; ++b)
#pragma unroll
            for (int m = 0; m < 4; ++m)
#pragma unroll
                for (int n = 0; n < 2; ++n) acc[a][b][m][n] = (f32x4){0.f, 0.f, 0.f, 0.f};
    h16x8 At[4][2], B0[2][2], B1[2][2];
    const char* cA = (const char*)g.A + (size_t)cur.pm * tsA; const char* cB; const char* cBh; S.b_ptr(g, cur, tsB, cB, cBh);
    PG8_STAGE(PG8_SB(0, 0), cB, voffB); PG8_STAGE(PG8_SA(0, 0), cA, voffA); PG8_STAGE(PG8_SB(0, 1), cB + hsB, voffB); PG8_STAGE(PG8_SA(0, 1), cA + hsA, voffA);
    if (wr == 1) PG8_BAR;
    PG8_WAIT_V(4); PG8_BAR;
    PG8_STAGE(PG8_SB(1, 0), cB + kstep, voffB); PG8_STAGE(PG8_SA(1, 0), cA + kstep, voffA); PG8_STAGE(PG8_SB(1, 1), cB + hsB + kstep, voffB);
    PG8_WAIT_V(6); PG8_BAR;
    for (;;) {
        const bool has_next = S.next(ui + 1, nxt);
        const char* nA = has_next ? (const char*)g.A + (size_t)nxt.pm * tsA : cA; const char* nB = cB; const char* nBh = cBh; if (has_next) S.b_ptr(g, nxt, tsB, nB, nBh);
        for (int t = 0; t < nt; t += 2) {
            const bool last = (t == nt - 2);
            const char* a1 = cA + (size_t)(t + 1) * kstep;
            const char* a2 = last ? nA : cA + (size_t)(t + 2) * kstep; const char* b2 = last ? nB : ((t + 2) < ksp ? cB : cBh) + (size_t)(t + 2) * kstep;
            const char* a3 = a2 + kstep; const char* b3 = b2 + kstep;
            PG8_LDB(B0, 0, 0); PG8_SCHED; PG8_LDA(At, 0, 0); PG8_STAGE(PG8_SA(1, 1), a1 + hsA, voffA);
            PG8_WAIT_L(8); PG8_BAR; PG8_WAIT_L(0); PG8_MMA(0, 0, At, B0); PG8_BAR; PG8_SCHED;
            PG8_LDB(B1, 0, 1); PG8_STAGE(PG8_SB(0, 0), b2, voffB);
            PG8_BAR; PG8_WAIT_L(0); PG8_MMA(0, 1, At, B1); PG8_BAR;
            PG8_LDA(At, 0, 1); PG8_STAGE(PG8_SA(0, 0), a2, voffA);
            PG8_BAR; PG8_WAIT_L(0); PG8_MMA(1, 0, At, B0); PG8_BAR; PG8_SCHED;
            PG8_STAGE(PG8_SB(0, 1), b2 + hsB, voffB);
            PG8_WAIT_V(6); PG8_BAR; PG8_MMA(1, 1, At, B1); PG8_BAR;
            PG8_LDB(B0, 1, 0); PG8_SCHED; PG8_LDA(At, 1, 0); PG8_STAGE(PG8_SA(0, 1), a2 + hsA, voffA);
            PG8_WAIT_L(8); PG8_BAR; PG8_WAIT_L(0); PG8_MMA(0, 0, At, B0); PG8_BAR; PG8_SCHED;
            PG8_LDB(B1, 1, 1); PG8_STAGE(PG8_SB(1, 0), b3, voffB);
            PG8_BAR; PG8_WAIT_L(0); PG8_MMA(0, 1, At, B1); PG8_BAR;
            PG8_LDA(At, 1, 1); PG8_STAGE(PG8_SA(1, 0), a3, voffA);
            PG8_BAR; PG8_WAIT_L(0); PG8_MMA(1, 0, At, B0); PG8_BAR; PG8_SCHED;
            PG8_STAGE(PG8_SB(1, 1), b3 + hsB, voffB);
            PG8_WAIT_V(6); PG8_BAR; PG8_MMA(1, 1, At, B1); PG8_BAR;
        }
        E(acc, cur, wr, wc, fr, fq);
        if (!has_next) break;
#pragma unroll
        for (int a = 0; a < 2; ++a)
#pragma unroll
            for (int b = 0; b < 2; ++b)
#pragma unroll
                for (int m = 0; m < 4; ++m)
#pragma unroll
                    for (int n = 0; n < 2; ++n) acc[a][b][m][n] = (f32x4){0.f, 0.f, 0.f, 0.f};
        cur = nxt; cA = nA; cB = nB; cBh = nBh; ++ui;
    }
    PG8_WAIT_V(0);
    if (wr == 0) PG8_BAR;
    PG8_BAR;
#undef PG8_SA
#undef PG8_SB
#undef PG8_STAGE
#undef PG8_LDA
#undef PG8_LDB
#undef PG8_MMA
#undef PG8_WAIT_V
#undef PG8_WAIT_L
#undef PG8_BAR
#undef PG8_SCHED
}
__device__ __forceinline__ h16x8 pack8(const f32x4& a, const f32x4& b) { h16x8 r; r[0] = (h16)a[0]; r[1] = (h16)a[1]; r[2] = (h16)a[2]; r[3] = (h16)a[3]; r[4] = (h16)b[0]; r[5] = (h16)b[1]; r[6] = (h16)b[2]; r[7] = (h16)b[3]; return r; }
template <int ACT> struct EpiH16 {
    static constexpr bool PERM = true;
    h16* O; int ldc; int ncols; const float* bias;
    __device__ __forceinline__ void operator()(const f32x4 (&acc)[2][2][4][2], const Unit& u, int wr, int wc, int fr, int fq) const {
        const int row0 = u.pm * BM + wr * 64 + fr, col0 = u.pn * BM + wc * 32 + 8 * fq;
#pragma unroll
        for (int bj = 0; bj < 2; ++bj) {
            const int col = col0 + bj * HALF;
            if (col < ncols) {
                f32x4 b0 = {0.f, 0.f, 0.f, 0.f}, b1 = b0;
                if (ACT == 1) { b0 = *(const f32x4*)(bias + col); b1 = *(const f32x4*)(bias + col + 4); }
#pragma unroll
                for (int ai = 0; ai < 2; ++ai)
#pragma unroll
                    for (int m = 0; m < 4; ++m) {
                        f32x4 v0 = acc[ai][bj][m][0] + b0, v1 = acc[ai][bj][m][1] + b1;
                        if (ACT == 1) {
#pragma unroll
                            for (int e = 0; e < 4; ++e) { v0[e] = sigm(v0[e]); v1[e] = sigm(v1[e]); }
                        }
                        *(h16x8*)(O + (size_t)(row0 + ai * HALF + m * 16) * ldc + col) = pack8(v0, v1);
                    }
            }
        }
    }
};
struct EpiResid {
    static constexpr bool PERM = false;
    float* O; const float* X; const float* gate;
    __device__ __forceinline__ void operator()(const f32x4 (&acc)[2][2][4][2], const Unit& u, int wr, int wc, int fr, int fq) const {
        const int row0 = u.pm * BM + wr * 64 + fr, col0 = u.pn * BM + wc * 32 + 4 * fq;
        const float* gr = gate + (size_t)((u.pm * BM) / SEQ) * 6144;
#pragma unroll
        for (int bj = 0; bj < 2; ++bj)
#pragma unroll
            for (int n = 0; n < 2; ++n) {
                const int col = col0 + bj * HALF + n * 16;
                const f32x4 gg = *(const f32x4*)(gr + col);
#pragma unroll
                for (int ai = 0; ai < 2; ++ai)
#pragma unroll
                    for (int m = 0; m < 4; ++m) {
                        const size_t o = (size_t)(row0 + ai * HALF + m * 16) * DM + col;
                        *(f32x4*)(O + o) = *(const f32x4*)(X + o) + gg * acc[ai][bj][m][n];
                    }
            }
    }
};

template <int STAGE> struct MoeOrder {
    const int* bcnt; const h16* W; int G, c;
    static constexpr int NCOL = STAGE == 1 ? 8 : 4;
    __device__ bool next(int i, Unit& u) const {
        const long L = (long)i * G + c; const int mt = (int)(L / NCOL);
        if (mt >= 88) return false;
        int acc = 0, found = 0;
        for (int b = 0; b < 24; ++b) {
            const int cn = bcnt[b]; const int ntl = (cn + 255) >> 8;
            if (!found && mt < acc + ntl) { found = 1; u.bucket = b; u.i0 = (mt - acc) * 256; u.cnt = cn; }
            acc += ntl;
        }
        if (!__builtin_amdgcn_readfirstlane(found)) return false;
        u.bucket = __builtin_amdgcn_readfirstlane(u.bucket); u.i0 = __builtin_amdgcn_readfirstlane(u.i0); u.cnt = __builtin_amdgcn_readfirstlane(u.cnt);
        const int gI = u.bucket / 6, pr = u.bucket % 6;
        u.ea = gI * 4 + (pr < 3 ? 0 : pr < 5 ? 1 : 2); u.eb = gI * 4 + (pr == 0 ? 1 : pr == 1 ? 2 : pr == 2 ? 3 : pr == 3 ? 2 : 3);
        u.pm = mt; u.pn = (int)(L % NCOL); return true;
    }
    __device__ __forceinline__ int ksplit() const { return STAGE == 1 ? (1 << 30) : 8; }
    __device__ __forceinline__ void b_ptr(const Gemm&, const Unit& u, size_t, const char*& lo, const char*& hi) const {
        if (STAGE == 1) { const int e = u.pn < 4 ? u.ea : u.eb; lo = hi = (const char*)(W + ((size_t)e * 1024 + (u.pn & 3) * 256) * 1024); }
        else { lo = (const char*)(W + ((size_t)u.ea * 1024 + u.pn * 256) * 512); hi = (const char*)(W + ((size_t)u.eb * 1024 + u.pn * 256) * 512) - 8 * (size_t)(BK * 2); }
    }
};
struct EpiMoe1 {
    static constexpr bool PERM = true;
    h16* act; const int* lists; const float* cw;
    __device__ __forceinline__ void operator()(const f32x4 (&acc)[2][2][4][2], const Unit& u, int wr, int wc, int fr, int fq) const {
        asm volatile("" : "+v"(fr), "+v"(fq));
        const int* lst = lists + (size_t)u.bucket * LCAP;
        const int second = u.pn >= 4;
        const int colb = ((u.pn & 3) * 256 + wc * 32) / 2 + 4 * fq + second * 512;
#pragma unroll
        for (int ai = 0; ai < 2; ++ai)
#pragma unroll
            for (int m = 0; m < 4; ++m) {
                const int r = ai * HALF + wr * 64 + m * 16 + fr, ii = u.i0 + r; const bool valid = ii < u.cnt;
                const float cwv = valid ? cw[(size_t)lst[valid ? ii : 0] * 2 + second] : 0.f;
                h16* O = act + ((size_t)u.pm * 256 + r) * 1024 + colb;
#pragma unroll
                for (int bj = 0; bj < 2; ++bj) {
                    const f32x4 a = acc[ai][bj][m][0], bq = acc[ai][bj][m][1];
                    *(h16x4*)(O + bj * 64) = pack4(cwv * (a[0] * sigm(a[0])) * bq[0], cwv * (a[1] * sigm(a[1])) * bq[1], cwv * (a[2] * sigm(a[2])) * bq[2], cwv * (a[3] * sigm(a[3])) * bq[3]);
                }
                __builtin_amdgcn_sched_barrier(0);
            }
    }
};
struct EpiMoe2 {
    static constexpr bool PERM = false;
    float* x1; const int* lists; const float* gate;
    __device__ __forceinline__ void operator()(const f32x4 (&acc)[2][2][4][2], const Unit& u, int wr, int wc, int fr, int fq) const {
        asm volatile("" : "+v"(fr), "+v"(fq));
        const int* lst = lists + (size_t)u.bucket * LCAP;
#pragma unroll
        for (int ai = 0; ai < 2; ++ai)
#pragma unroll
            for (int m = 0; m < 4; ++m) {
                const int r = ai * HALF + wr * 64 + m * 16 + fr, ii = u.i0 + r;
                if (ii < u.cnt) {
                    const int tok = lst[ii];
                    const float* gr = gate + (size_t)(tok / SEQ) * 6144;
                    float* xr = x1 + (size_t)tok * DM;
#pragma unroll
                    for (int bj = 0; bj < 2; ++bj)
#pragma unroll
                        for (int n = 0; n < 2; ++n) {
                            const int col = u.pn * 256 + bj * HALF + wc * 32 + n * 16 + 4 * fq;
                            *(f32x4*)(xr + col) = *(const f32x4*)(xr + col) + *(const f32x4*)(gr + col) * acc[ai][bj][m][n];
                        }
                }
            }
    }
};
}

__device__ __forceinline__ void ph_gemm1(CP p, int bid, int nblk, char* smem) {
    {
        pg8::Gemm g; g.A = p.h_hi; g.Bt = p.Wp; g.M = NTOK; g.N = 2560; g.K = DM; g.lda = DM; g.ldb = DM;
        pg8::StaticOrder S; S.init(NTOK, 2560, nblk, bid);
        pg8::EpiH16<0> E; E.O = p.proj; E.ldc = PJ; E.ncols = PJ; E.bias = nullptr;
        pg8::gemm_phase(( PG8_LAS unsigned char*)smem, g, S, E);
    }
    __syncthreads();
    for (int u = bid - 128; u >= 0 && u < 128; u += nblk) {
        f32x4 acc[4][4]; zero_acc<256>(acc);
        const int mt = u >> 1, nt = u & 1, m0 = mt * 256, n0 = nt * 128;
        const h16* Ah = p.h_hi + (size_t)m0 * DM; const h16* Al = p.h_lo + (size_t)m0 * DM; const h16* B = p.Widx + (size_t)n0 * 3072;
        gemm_kloop<256>(smem, 3072, [=](int r, int k) { const h16* base = (k >= 1024 && k < 2048) ? Al : Ah; return base + (size_t)r * DM + (k & 1023); },
                        [=](int r, int k) { return B + (size_t)r * 3072 + k; }, acc);
        float* O = p.idxf + (size_t)m0 * IDXLD + n0;
        gemm_epi<256>(acc, [=](int ml, int nl, f32x4 v) { if (n0 + nl < IDXLD) *(f32x4*)(O + (size_t)ml * IDXLD + nl) = v; });
    }
}

template <int PASS>
__device__ __forceinline__ void ph_s5_scan(CP p, int l, int bid, int nblk, char* smem) {
    const int lane = otid() & 63, wv = otid() >> 6;
    h16* us = (h16*)smem + wv * (64 * 16);
    for (int u = bid * 8 + wv; u < 4096; u += nblk * 8) {
        const int g = u & 15, c = (u >> 4) & 63, b = u >> 10;
        const int pidx = (l * 16 + g) * 64 + lane;
        const float* sc_ = p.s5c + (size_t)pidx * 36;
        float Br[16], Bi[16];
#pragma unroll
        for (int cc = 0; cc < 16; ++cc) { Br[cc] = sc_[4 + cc]; Bi[cc] = sc_[20 + cc]; }
        const float lr = sc_[0], li = sc_[1];
        float hr = 0.f, hi = 0.f;
        h16* Hs = (h16*)(smem + 16384) + wv * (64 * 136);
        if (PASS == 3) {
            const size_t hix = ((((size_t)b * 64 + c) * 16 + g) * 64 + lane) * 2;
            hr = p.s5H[hix]; hi = p.s5H[hix + 1];
        }
        const int t0 = b * SEQ + c * 64;
        {
            const h16* up = p.proj + (size_t)(t0 + lane) * PJ + P_U + g * 16;
            const h16x8 a0 = *(const h16x8*)up, a1 = *(const h16x8*)(up + 8);
            __builtin_amdgcn_s_waitcnt(0); __builtin_amdgcn_wave_barrier();
            *(h16x8*)&us[lane * 16] = a0; *(h16x8*)&us[lane * 16 + 8] = a1;
            __builtin_amdgcn_s_waitcnt(0); __builtin_amdgcn_wave_barrier();
        }
        for (int t = 0; t < 64; ++t) {
            h16x8 u0 = *(const h16x8*)&us[t * 16], u1 = *(const h16x8*)&us[t * 16 + 8];
            float br = 0.f, bi = 0.f;
#pragma unroll
            for (int cc = 0; cc < 8; ++cc) { const float ua = (float)u0[cc], ub = (float)u1[cc]; br += Br[cc] * ua + Br[8 + cc] * ub; bi += Bi[cc] * ua + Bi[8 + cc] * ub; }
            const float nhr = lr * hr - li * hi + br, nhi = lr * hi + li * hr + bi;
            hr = nhr; hi = nhi;
            if (PASS == 3) { Hs[t * 136 + lane] = (h16)hr; Hs[t * 136 + 64 + lane] = (h16)hi; }
        }
        if (PASS == 3) {
            const int cc = lane & 15, gq = lane >> 4;
            const float* cre = p.in[I_S5CRE] + ((size_t)(l * 16 + g) * 16 + cc) * 64 + 8 * gq;
            const float* cim = p.in[I_S5CIM] + ((size_t)(l * 16 + g) * 16 + cc) * 64 + 8 * gq;
            h16x8 bf[4];
#pragma unroll
            for (int ks = 0; ks < 2; ++ks)
#pragma unroll
                for (int j = 0; j < 8; ++j) { bf[ks][j] = (h16)cre[ks * 32 + j]; bf[2 + ks][j] = (h16)(-cim[ks * 32 + j]); }
            const float dsk = p.in[I_S5D][l * 256 + g * 16 + cc];
            __builtin_amdgcn_s_waitcnt(0); __builtin_amdgcn_wave_barrier();
#pragma unroll
            for (int tt = 0; tt < 4; ++tt) {
                f32x4 acc = {0.f, 0.f, 0.f, 0.f};
#pragma unroll
                for (int ks = 0; ks < 4; ++ks) acc = __builtin_amdgcn_mfma_f32_16x16x32_f16(*(const h16x8*)&Hs[(16 * tt + cc) * 136 + ks * 32 + 8 * gq], bf[ks], acc, 0, 0, 0);
#pragma unroll
                for (int r = 0; r < 4; ++r) {
                    const int t = 16 * tt + 4 * gq + r;
                    const float y = acc[r] + dsk * (float)us[t * 16 + cc];
                    p.ybuf[(size_t)(t0 + t) * 256 + g * 16 + cc] = (h16)gelu_tanh(y);
                }
            }
            __builtin_amdgcn_s_waitcnt(0); __builtin_amdgcn_wave_barrier();
        }
        if (PASS == 1) { const size_t eix = ((((size_t)b * 64 + c) * 16 + g) * 64 + lane) * 2; p.s5E[eix] = hr; p.s5E[eix + 1] = hi; }
    }
}
__device__ __forceinline__ void ph_s5_carry(CP p, int l, int bid, int nblk) {
    if (bid >= 8) return;
    const int gid = bid * 512 + otid();
    const int pp = gid & 63, g = (gid >> 6) & 15, b = gid >> 10;
    const int pidx = (l * 16 + g) * 64 + pp;
    const float ar = p.s5c[(size_t)pidx * 36 + 2], ai = p.s5c[(size_t)pidx * 36 + 3];
    float hr = 0.f, hi = 0.f;
    for (int c = 0; c < 64; ++c) {
        const size_t ix = ((((size_t)b * 64 + c) * 16 + g) * 64 + pp) * 2;
        p.s5H[ix] = hr; p.s5H[ix + 1] = hi;
        const float er_ = p.s5E[ix], ei_ = p.s5E[ix + 1];
        const float nr = ar * hr - ai * hi + er_, ni = ar * hi + ai * hr + ei_;
        hr = nr; hi = ni;
    }
}
__device__ __forceinline__ void ph_s5_glu(CP p, int l, int bid, int nblk, char* smem) {
    for (int u = bid; u < 128; u += nblk) {
        const int mt = u >> 1, nt = u & 1, m0 = mt * 256, n0 = nt * 128;
        f32x4 acc[4][4]; zero_acc<256>(acc);
        const h16* A = p.ybuf + (size_t)m0 * 256; const h16* B = p.Wglu + (size_t)n0 * 256;
        gemm_kloop<256>(smem, 256, [=](int r, int k) { return A + (size_t)r * 256 + k; }, [=](int r, int k) { return B + (size_t)r * 256 + k; }, acc);
        const float* gb = p.in[I_S5GB] + l * 256 + n0;
        const h16* Y = p.ybuf + (size_t)m0 * 256 + n0; h16* O = p.branches + (size_t)m0 * DM + n0;
        gemm_epi<256>(acc, [=](int ml, int nl, f32x4 v) {
            h16x4 y = *(const h16x4*)(Y + (size_t)ml * 256 + nl); f32x4 bb = *(const f32x4*)(gb + nl);
            *(h16x4*)(O + (size_t)ml * DM + nl) = pack4((float)y[0] * sigm(v[0] + bb[0]), (float)y[1] * sigm(v[1] + bb[1]), (float)y[2] * sigm(v[2] + bb[2]), (float)y[3] * sigm(v[3] + bb[3])); });
    }
}

__device__ __forceinline__ void ph_rg_a(CP p, int l, int bid, int nblk, char* smem) {
    float* xc = (float*)smem;
    float* aa = xc + 32 * 256;
    float* bx = aa + 32 * 256;
    const int tid = otid();
    for (int u = bid; u < 512; u += nblk) {
        const int b = u >> 7, c = u & 127, t0 = c * 32;
        __syncthreads();
        {
            const int ch = tid & 255;
            const float w0 = p.in[I_RGCW][(l * 4 + 0) * 256 + ch], w1 = p.in[I_RGCW][(l * 4 + 1) * 256 + ch], w2 = p.in[I_RGCW][(l * 4 + 2) * 256 + ch], w3 = p.in[I_RGCW][(l * 4 + 3) * 256 + ch];
            const float cb = p.in[I_RGCB][l * 256 + ch];
            const int par = tid >> 8;
            h16 rows[19];
#pragma unroll
            for (int k = 0; k < 19; ++k) { const int tt = t0 + 16 * par - 3 + k; rows[k] = tt >= 0 ? p.proj[(size_t)(b * SEQ + tt) * PJ + P_RGX + ch] : (h16)0.f; }
#pragma unroll
            for (int m = 0; m < 16; ++m)
                xc[(16 * par + m) * 256 + ch] = cb + w3 * (float)rows[m + 3] + w2 * (float)rows[m + 2] + w1 * (float)rows[m + 1] + w0 * (float)rows[m];
        }
        __syncthreads();
        const int ch = tid & 255, half = tid >> 8, blk = ch >> 6, d = ch & 63;
        const float* wr = p.in[I_RGWR] + ((size_t)(l * 4 + blk) * 64) * 64 + d;
        const float* wi = p.in[I_RGWI] + ((size_t)(l * 4 + blk) * 64) * 64 + d;
        const float br = p.in[I_RGBR][l * 256 + ch], bi = p.in[I_RGBI][l * 256 + ch];
        const float spl = softplusf_(-p.in[I_RGLAM][l * 256 + ch]);
#pragma unroll 1
        for (int grp = 0; grp < 2; ++grp) {
            float ar[8], ai[8];
#pragma unroll
            for (int q = 0; q < 8; ++q) { ar[q] = br; ai[q] = bi; }
            const int tb = half * 16 + grp * 8;
            for (int cc = 0; cc < 64; ++cc) {
                const float wrv = wr[cc * 64], wiv = wi[cc * 64];
#pragma unroll
                for (int q = 0; q < 8; ++q) { const float xv = xc[(tb + q) * 256 + blk * 64 + cc]; ar[q] += xv * wrv; ai[q] += xv * wiv; }
            }
#pragma unroll
            for (int q = 0; q < 8; ++q) {
                const float r = sigm(ar[q]), ig = sigm(ai[q]);
                const float la = -8.f * r * spl;
                const float a = __expf(la), mult = sqrtf(-expm1f(2.f * la));
                aa[(tb + q) * 256 + ch] = a; bx[(tb + q) * 256 + ch] = mult * ig * xc[(tb + q) * 256 + ch];
            }
        }
        __syncthreads();
        if (tid < 256) {
            float h = 0.f, cp = 1.f;
            float* hl = p.rg_hl + (size_t)(b * SEQ + t0) * 256 + ch; float* cpo = p.rg_cp + (size_t)(b * SEQ + t0) * 256 + ch;
            for (int t = 0; t < 32; ++t) { const float a = aa[t * 256 + ch]; h = a * h + bx[t * 256 + ch]; cp *= a; hl[(size_t)t * 256] = h; cpo[(size_t)t * 256] = cp; }
            p.rg_agg[((size_t)(b * 128 + c) * 256 + ch) * 2] = cp; p.rg_agg[((size_t)(b * 128 + c) * 256 + ch) * 2 + 1] = h;
        }
    }
}
__device__ __forceinline__ void ph_rg_c(CP p, int l, int bid, int nblk, char* smem) {
    float* carry = (float*)smem;
    const int tid = otid();
    for (int u = bid; u < 512; u += nblk) {
        const int b = u >> 7, c = u & 127, t0 = c * 32;
        __syncthreads();
        if (tid < 256) {
            float h = 0.f;
            const float2* ag = (const float2*)p.rg_agg + (size_t)b * 128 * 256 + tid;
            int cc = 0;
            for (; cc + 8 <= c; cc += 8) {
                float2 v[8];
#pragma unroll
                for (int q = 0; q < 8; ++q) v[q] = ag[(size_t)(cc + q) * 256];
#pragma unroll
                for (int q = 0; q < 8; ++q) h = v[q].x * h + v[q].y;
            }
            for (; cc < c; ++cc) { const float2 v = ag[(size_t)cc * 256]; h = v.x * h + v.y; }
            carry[tid] = h;
        }
        __syncthreads();
        const int ch = tid & 255;
        {
            const int par = tid >> 8;
            float hl_[16], cp_[16]; h16 gt_[16];
#pragma unroll
            for (int m = 0; m < 16; ++m) { const size_t tok = (size_t)b * SEQ + t0 + 16 * par + m; hl_[m] = p.rg_hl[tok * 256 + ch]; cp_[m] = p.rg_cp[tok * 256 + ch]; gt_[m] = p.proj[tok * PJ + P_RGG + ch]; }
            const float cr = carry[ch];
#pragma unroll
            for (int m = 0; m < 16; ++m) { const size_t tok = (size_t)b * SEQ + t0 + 16 * par + m; p.branches[tok * DM + 512 + ch] = (h16)((hl_[m] + cp_[m] * cr) * gelu_tanh((float)gt_[m])); }
        }
    }
}

__device__ __forceinline__ void ph_rw_prep(CP p, int l, int bid, int nblk, char* smem) {
    h16* wup = (h16*)smem;
    h16* aup = wup + 32 * 256;
    h16* gup = aup + 32 * 256;
    float* f = (float*)(gup + 64 * 256);
    const int tid = otid(), lane = tid & 63;
    for (int i = tid; i < 32 * 256; i += 512) { wup[i] = (h16)p.in[I_RWWUP][(size_t)l * 32 * 256 + i]; aup[i] = (h16)p.in[I_RWAUP][(size_t)l * 32 * 256 + i]; }
    for (int i = tid; i < 64 * 256; i += 512) gup[i] = (h16)p.in[I_RWGUP][(size_t)l * 64 * 256 + i];
    const float* mu = p.in[I_RWMU] + l * 896;
    const int ch = tid & 255, tg = tid >> 8;
    const float w0 = p.in[I_RWW0][l * 256 + ch], a0 = p.in[I_RWA0][l * 256 + ch], kkw = p.in[I_RWKK][l * 256 + ch], kaw = p.in[I_RWKA][l * 256 + ch];
    const float rk = p.in[I_RWRK][l * 256 + ch];
    __syncthreads();
    for (int u = bid; u < NTOK / 16; u += nblk) {
        const int tok0 = u * 16;
        __syncthreads();
        for (int i = tid; i < 16 * 896; i += 512) {
            const int t = i / 896, cidx = i % 896; const int tok = tok0 + t;
            const float cur = (float)p.proj[(size_t)tok * PJ + P_RW + cidx];
            const float prv = (tok % SEQ) ? (float)p.proj[(size_t)(tok - 1) * PJ + P_RW + cidx] : 0.f;
            float v = cur + (prv - cur) * mu[cidx];
            if (cidx >= 768 && cidx < 800) v = tanhf(v);
            if (cidx >= 832) v = sigm(v);
            f[i] = v;
        }
        __syncthreads();
        for (int q = 0; q < 8; ++q) {
            const int t = tg * 8 + q; const int tok = tok0 + t;
            const float* ft = f + t * 896;
            float lw = 0.f, la = 0.f, lg = 0.f;
#pragma unroll 8
            for (int j = 0; j < 32; ++j) { lw += ft[768 + j] * (float)wup[j * 256 + ch]; la += ft[800 + j] * (float)aup[j * 256 + ch]; }
#pragma unroll 8
            for (int j = 0; j < 64; ++j) lg += ft[832 + j] * (float)gup[j * 256 + ch];
            const float w = -softplusf_(-(w0 + lw)) - 0.5f;
            const float wl = -__expf(w);
            const float a = sigm(a0 + la);
            const float r = ft[ch], k = ft[256 + ch], v = ft[512 + ch];
            float kk = k * kkw;
            const float nrm = sqrtf(wave_sum(kk * kk));
            kk = kk / fmaxf(nrm, 1e-12f);
            const float k2 = k * (1.f + (a - 1.f) * kaw);
            const float sb = wave_sum(r * k2 * rk);
            const size_t o = (size_t)tok * 256 + ch;
            p.rw_r[o] = (h16)r; p.rw_w[o] = (h16)wl; p.rw_k[o] = (h16)k2; p.rw_kk[o] = (h16)kk; p.rw_b[o] = (h16)(kk * a);
            p.rw_g[o] = (h16)lg; p.rw_bonus[o] = (h16)(sb * v); p.rw_v[o] = (h16)v;
        }
    }
}
__device__ __forceinline__ void ph_rw_scan(CP p, int bid, char* smem) {
    if (bid >= 16 || otid() >= 64) return;
    float (*sv)[64] = (float (*)[64])smem;
    const int b = bid >> 2, h = bid & 3, lane = otid();
    float S[64];
#pragma unroll
    for (int k = 0; k < 64; ++k) S[k] = 0.f;
    for (int t = 0; t < SEQ; ++t) {
        const size_t tok = (size_t)b * SEQ + t; const size_t o = tok * 256 + h * 64 + lane;
        const float vv = (float)p.rw_v[o];
        sv[0][lane] = (float)p.rw_r[o]; sv[1][lane] = __expf((float)p.rw_w[o]); sv[2][lane] = (float)p.rw_k[o]; sv[3][lane] = (float)p.rw_kk[o]; sv[4][lane] = (float)p.rw_b[o];
        __builtin_amdgcn_s_waitcnt(0); __builtin_amdgcn_wave_barrier();
        float skk = 0.f;
#pragma unroll
        for (int k = 0; k < 64; ++k) skk += S[k] * sv[3][k];
        float y = 0.f;
#pragma unroll
        for (int k = 0; k < 64; ++k) { S[k] = S[k] * sv[1][k] - skk * sv[4][k] + vv * sv[2][k]; y += S[k] * sv[0][k]; }
        p.rw_y[o] = y;
        __builtin_amdgcn_s_waitcnt(0); __builtin_amdgcn_wave_barrier();
    }
}
__device__ __forceinline__ void ph_rw_post(CP p, int l, int bid, int nblk) {
    const int lane = otid() & 63, wv = otid() >> 6;
    for (int u = bid * 8 + wv; u < NTOK * 4; u += nblk * 8) {
        const int tok = u >> 2, h = u & 3; const size_t o = (size_t)tok * 256 + h * 64 + lane;
        const float y = p.rw_y[o];
        const float mean = wave_sum(y) * (1.f / 64.f);
        const float dv = y - mean;
        const float var = wave_sum(dv * dv) * (1.f / 64.f);
        float v = dv * rsqrtf(var + 64e-5f) * p.in[I_RWGNW][l * 256 + h * 64 + lane] + p.in[I_RWGNB][l * 256 + h * 64 + lane];
        v += (float)p.rw_bonus[o];
        p.branches[(size_t)tok * DM + 768 + h * 64 + lane] = (h16)(v * (float)p.rw_g[o]);
    }
}

#define RS 68
template <int MODE>
__device__ __forceinline__ void mm_nt(float* out, const float* X, const float* Y, int wave, int nw, int lane) {
    const int g = lane >> 4, c = lane & 15;
    for (int idx = wave; idx < 16; idx += nw) {
        const int ti = idx >> 2, tj = idx & 3;
        f32x4 acc = {0.f, 0.f, 0.f, 0.f};
        if (MODE == 0 || tj <= ti) {
#pragma unroll
            for (int kb = 0; kb < 4; ++kb) {
                const f32x4 a4 = *(const f32x4*)&X[(ti * 16 + c) * RS + kb * 16 + 4 * g];
                const f32x4 b4 = *(const f32x4*)&Y[(tj * 16 + c) * RS + kb * 16 + 4 * g];
#pragma unroll
                for (int i = 0; i < 4; ++i) acc = __builtin_amdgcn_mfma_f32_16x16x4f32(a4[i], b4[i], acc, 0, 0, 0);
            }
        }
#pragma unroll
        for (int r = 0; r < 4; ++r) {
            const int row = ti * 16 + 4 * g + r, col = tj * 16 + c;
            float v = acc[r];
            if (MODE == 1 && col >= row) v = 0.f;
            if (MODE == 2 && col > row) v = 0.f;
            out[row * RS + col] = v;
        }
    }
}
__device__ __forceinline__ f32x4 mm_nn_tile(f32x4 acc, const float* X, const float* Y, int ti, int tj, int lane, float sign) {
    const int g = lane >> 4, c = lane & 15;
#pragma unroll
    for (int kb = 0; kb < 4; ++kb) {
        const f32x4 a4 = *(const f32x4*)&X[(ti * 16 + c) * RS + kb * 16 + 4 * g];
#pragma unroll
        for (int i = 0; i < 4; ++i) acc = __builtin_amdgcn_mfma_f32_16x16x4f32(sign * a4[i], Y[(kb * 16 + 4 * g + i) * RS + tj * 16 + c], acc, 0, 0, 0);
    }
    return acc;
}
template <int T> struct FwdRow {
    static __device__ __forceinline__ void run(float (&x)[64], const float* Nm) {
        FwdRow<T - 1>::run(x, Nm);
        float acc = x[T];
#pragma unroll
        for (int s4 = 0; s4 < (T + 3) / 4; ++s4) {
            const f32x4 n4 = *(const f32x4*)&Nm[T * RS + s4 * 4];
#pragma unroll
            for (int e = 0; e < 4; ++e) if (s4 * 4 + e < T) acc -= n4[e] * x[s4 * 4 + e];
        }
        x[T] = acc;
    }
};
template <> struct FwdRow<0> { static __device__ __forceinline__ void run(float (&)[64], const float*) {} };
#define RWA_LDS (16384 + 8 * 64 * RS * 4)
__device__ __forceinline__ void ph_rw_a(CP p, int l, int bid, int nblk, char* smem) {
    h16* fs = (h16*)smem;
    float* Ah = (float*)(smem + 16384);
    float* Rh = Ah + 64 * RS; float* Bh = Rh + 64 * RS; float* Kh = Bh + 64 * RS; float* Vv = Kh + 64 * RS;
    float* Nm = Vv + 64 * RS; float* Mm = Nm + 64 * RS; float* T1 = Mm + 64 * RS;
    float* tot = (float*)(smem + RWA_LDS);
    float* egl = tot + 8 * 64;
    for (int u4 = bid * 4; u4 < 1024; u4 += (nblk & ~0) * 4)
    for (int u = u4; u < u4 + 4; ++u) {
        int tid = otid(), lane = tid & 63, wave = tid >> 6;
        const float* mu = p.in[I_RWMU] + oint(l) * 896;
        const int h = u & 3, c = (u >> 2) & 63, b = u >> 8;
        const int t0 = c * 64; const size_t tok0 = (size_t)b * SEQ + t0;
        __syncthreads();
        if (h == 0)
        {
            h16 cu_[16], pv_[16];
#pragma unroll
            for (int q = 0; q < 16; ++q) {
                const int i = tid + 512 * q; const int t = i >> 7, j = i & 127; const size_t tok = tok0 + t;
                const h16* pc = p.proj + tok * PJ + P_RW + 768 + j;
                cu_[q] = pc[0];
                pv_[q] = pc[(t0 + t) ? -(long)PJ : 0];
            }
#pragma unroll
            for (int q = 0; q < 16; ++q) {
                const int i = tid + 512 * q; const int t = i >> 7, j = i & 127;
                const float cur = (float)cu_[q]; const float prv = (t0 + t) ? (float)pv_[q] : 0.f;
                float v = cur + (prv - cur) * mu[768 + j];
                if (j < 32) v = tanhf(v); else if (j >= 64) v = sigm(v);
                fs[i] = (h16)v;
            }
        }
        __syncthreads();
        tid = otid(); lane = tid & 63; wave = tid >> 6;
        {
            const int ll = oint(l);
            const int ch = h * 64 + lane;
            const float w0 = p.in[I_RWW0][ll * 256 + ch], a0 = p.in[I_RWA0][ll * 256 + ch], kkw = p.in[I_RWKK][ll * 256 + ch], kaw = p.in[I_RWKA][ll * 256 + ch], rkw = p.in[I_RWRK][ll * 256 + ch];
            const float mur = mu[ch], muk = mu[256 + ch], muv = mu[512 + ch];
            float run = 0.f;
            h16x2 wpk[64];
#pragma unroll
            for (int m = 0; m < 64; ++m) {
                const int j0 = 2 * m;
                const float* src = j0 < 32 ? p.in[I_RWWUP] + ((size_t)ll * 32 + j0) * 256 : j0 < 64 ? p.in[I_RWAUP] + ((size_t)ll * 32 + (j0 - 32)) * 256 : p.in[I_RWGUP] + ((size_t)ll * 64 + (j0 - 64)) * 256;
                h16x2 w2; w2[0] = (h16)src[ch]; w2[1] = (h16)src[256 + ch];
                wpk[m] = w2;
            }
            h16 pr_[9], pk_[9], pv_[9];
#pragma unroll
            for (int q = 0; q < 9; ++q) {
                const int t = wave * 8 + q - 1;
                const bool ok = (t0 + t) >= 0;
                const h16* pc = p.proj + (tok0 + t) * PJ + P_RW + ch;
                pr_[q] = ok ? pc[0] : (h16)0.f; pk_[q] = ok ? pc[256] : (h16)0.f; pv_[q] = ok ? pc[512] : (h16)0.f;
            }
#pragma unroll
            for (int q = 0; q < 8; ++q) {
                const int t = wave * 8 + q; const size_t tok = tok0 + t;
                const h16* ft = fs + t * 128;
                float lw = 0.f, la = 0.f, lg = 0.f;
#pragma unroll
                for (int v8 = 0; v8 < 16; ++v8) {
                    const h16x8 f8 = *(const h16x8*)(ft + v8 * 8);
#pragma unroll
                    for (int e = 0; e < 4; ++e) {
                        h16x2 f2; f2[0] = f8[2 * e]; f2[1] = f8[2 * e + 1];
                        const int m = v8 * 4 + e;
                        if (m < 16) lw = __builtin_amdgcn_fdot2(f2, wpk[m], lw, false);
                        else if (m < 32) la = __builtin_amdgcn_fdot2(f2, wpk[m], la, false);
                        else lg = __builtin_amdgcn_fdot2(f2, wpk[m], lg, false);
                    }
                }
                const float rc = (float)pr_[q + 1], kc = (float)pk_[q + 1], vc = (float)pv_[q + 1];
                const float rp = (float)pr_[q], kp_ = (float)pk_[q], vp = (float)pv_[q];
                const float r = rc + (rp - rc) * mur, k = kc + (kp_ - kc) * muk, v = vc + (vp - vc) * muv;
                const float w = -softplusf_(-(w0 + lw)) - 0.5f;
                const float wl = -__expf(w);
                const float a = sigm(a0 + la);
                float kk = k * kkw;
                const float nrm = sqrtf(wave_sum(kk * kk));
                kk = kk / fmaxf(nrm, 1e-12f);
                const float k2 = k * (1.f + (a - 1.f) * kaw);
                const float sb = wave_sum(r * k2 * rkw);
                p.rw_g[tok * 256 + ch] = (h16)lg; p.rw_bonus[tok * 256 + ch] = (h16)(sb * v);
                run += wl;
                Ah[t * RS + lane] = kk; Rh[t * RS + lane] = r; Bh[t * RS + lane] = kk * a; Kh[t * RS + lane] = k2; Vv[t * RS + lane] = v; T1[t * RS + lane] = run;
            }
            __syncthreads();
            tot[wave * 64 + lane] = run;
            __syncthreads();
            float offs = 0.f, gl = 0.f;
#pragma unroll
            for (int w8 = 0; w8 < 8; ++w8) { const float tv = tot[w8 * 64 + lane]; if (w8 < wave) offs += tv; gl += tv; }
            if (wave == 0) { egl[lane] = __expf(gl); p.rw_gam[(size_t)u * 64 + lane] = __expf(gl); }
            float gprev = offs;
#pragma unroll 1
            for (int q = 0; q < 8; ++q) {
                const int t = wave * 8 + q;
                const float G = offs + T1[t * RS + lane];
                const float eg = __expf(G), egp = __expf(gprev), egi = __expf(-G);
                Ah[t * RS + lane] *= egp; Rh[t * RS + lane] *= eg; Bh[t * RS + lane] *= egi; Kh[t * RS + lane] *= egi;
                gprev = G;
            }
        }
        __syncthreads();
        tid = otid(); lane = tid & 63; wave = tid >> 6;
        mm_nt<1>(Nm, Ah, Bh, wave, 8, lane);
        mm_nt<1>(Mm, Ah, Kh, wave, 8, lane);
        __syncthreads();
        tid = otid(); lane = tid & 63; wave = tid >> 6;
        for (int idx = wave; idx < 16; idx += 8) {
            const int ti = idx >> 2, tj = idx & 3;
            f32x4 acc = {0.f, 0.f, 0.f, 0.f};
            acc = mm_nn_tile(acc, Mm, Vv, ti, tj, lane, 1.f);
#pragma unroll
            for (int r = 0; r < 4; ++r) T1[(ti * 16 + 4 * (lane >> 4) + r) * RS + tj * 16 + (lane & 15)] = acc[r];
        }
        __syncthreads();
        tid = otid(); lane = tid & 63; wave = tid >> 6;
        const size_t ub = (size_t)u * 4096;
        if (wave < 2) {
            float* src = wave == 0 ? Ah : T1;
            h16* og = (wave == 0 ? p.rw_W : p.rw_U0) + ub;
#pragma unroll
            for (int I = 0; I < 4; ++I) {
                float acc[16];
#pragma unroll
                for (int r = 0; r < 16; ++r) acc[r] = src[(16 * I + r) * RS + lane];
#pragma unroll 1
                for (int s4 = 0; s4 < 4 * I; ++s4) {
                    const float x0 = src[(s4 * 4 + 0) * RS + lane], x1 = src[(s4 * 4 + 1) * RS + lane], x2 = src[(s4 * 4 + 2) * RS + lane], x3 = src[(s4 * 4 + 3) * RS + lane];
#pragma unroll
                    for (int r = 0; r < 16; ++r) { const f32x4 n4 = *(const f32x4*)&Nm[(16 * I + r) * RS + s4 * 4]; acc[r] -= n4[0] * x0 + n4[1] * x1 + n4[2] * x2 + n4[3] * x3; }
                }
#pragma unroll
                for (int r = 1; r < 16; ++r) {
#pragma unroll
                    for (int q4 = 0; q4 < 4; ++q4) {
                        if (q4 * 4 < r) {
                            const f32x4 n4 = *(const f32x4*)&Nm[(16 * I + r) * RS + 16 * I + q4 * 4];
#pragma unroll
                            for (int e = 0; e < 4; ++e) if (q4 * 4 + e < r) acc[r] -= n4[e] * acc[q4 * 4 + e];
                        }
                    }
                }
#pragma unroll
                for (int r = 0; r < 16; ++r) { src[(16 * I + r) * RS + lane] = acc[r]; og[(16 * I + r) * 64 + lane] = (h16)acc[r]; }
            }
        } else {
            mm_nt<2>(Mm, Rh, Bh, wave - 2, 6, lane);
            for (int i = tid - 128; i < 4096; i += 384) { const int k = i >> 6, t = i & 63; p.rw_Be[ub + i] = (h16)(-Bh[t * RS + k] * egl_get(egl, k)); }
            for (int idx = wave - 2; idx < 16; idx += 6) {
                const int ti = idx >> 2, tj = idx & 3, g = lane >> 4, cc = lane & 15;
                f32x4 acc = {0.f, 0.f, 0.f, 0.f};
#pragma unroll
                for (int tb = 0; tb < 4; ++tb)
#pragma unroll
                    for (int i = 0; i < 4; ++i) acc = __builtin_amdgcn_mfma_f32_16x16x4f32(Kh[(tb * 16 + 4 * g + i) * RS + ti * 16 + cc], Vv[(tb * 16 + 4 * g + i) * RS + tj * 16 + cc], acc, 0, 0, 0);
#pragma unroll
                for (int r = 0; r < 4; ++r) { const int k = ti * 16 + 4 * g + r; p.rw_VK[ub + k * 64 + tj * 16 + cc] = (h16)(acc[r] * egl_get(egl, k)); }
            }
        }
        __syncthreads();
        tid = otid(); lane = tid & 63; wave = tid >> 6;
        mm_nt<2>(Nm, Rh, Kh, wave, 8, lane);
        __syncthreads();
        tid = otid(); lane = tid & 63; wave = tid >> 6;
        for (int idx = wave; idx < 16; idx += 8) {
            const int ti = idx >> 2, tj = idx & 3, g = lane >> 4, cc = lane & 15;
            f32x4 a1, a2 = {0.f, 0.f, 0.f, 0.f};
#pragma unroll
            for (int r = 0; r < 4; ++r) a1[r] = Rh[(ti * 16 + 4 * g + r) * RS + tj * 16 + cc];
            a1 = mm_nn_tile(a1, Mm, Ah, ti, tj, lane, -1.f);
            a2 = mm_nn_tile(a2, Nm, Vv, ti, tj, lane, 1.f);
            a2 = mm_nn_tile(a2, Mm, T1, ti, tj, lane, -1.f);
#pragma unroll
            for (int r = 0; r < 4; ++r) { const int row = ti * 16 + 4 * g + r, col = tj * 16 + cc; p.rw_Ry[ub + row * 64 + col] = (h16)a1[r]; p.rw_Y0[ub + row * 64 + col] = (h16)a2[r]; }
        }
    }
}
__device__ __forceinline__ void ph_rw_b(CP p, int bid, char* smem) {
    h16* Sh = (h16*)smem;
    h16* Uh = Sh + 64 * 72;
    const int tid = otid(), lane = tid & 63, wave = tid >> 6, g = lane >> 4, cc = lane & 15;
    const int vt = wave >> 1, hf = wave & 1;
    const int b = bid >> 2, h = bid & 3;
    f32x4 S[2];
    S[0] = (f32x4){0.f, 0.f, 0.f, 0.f}; S[1] = S[0];
    h16x8 Wf[2][2], Bf[2][2]; h16x4 U0i[2], VKi[2]; float gam[2];
    auto ld = [&](int c, h16x8 (&W_)[2][2], h16x8 (&B_)[2][2], h16x4 (&U_)[2], h16x4 (&V_)[2], float (&G_)[2]) {
        const size_t ub = ((size_t)(b * 64 + c) * 4 + h) * 4096;
#pragma unroll
        for (int j = 0; j < 2; ++j) {
            const int rowi = (2 * hf + j) * 16 + cc;
#pragma unroll
            for (int ks = 0; ks < 2; ++ks) { W_[j][ks] = *(const h16x8*)(p.rw_W + ub + rowi * 64 + ks * 32 + 8 * g); B_[j][ks] = *(const h16x8*)(p.rw_Be + ub + rowi * 64 + ks * 32 + 8 * g); }
            U_[j] = *(const h16x4*)(p.rw_U0 + ub + rowi * 64 + vt * 16 + 4 * g);
            V_[j] = *(const h16x4*)(p.rw_VK + ub + rowi * 64 + vt * 16 + 4 * g);
            G_[j] = p.rw_gam[((size_t)(b * 64 + c) * 4 + h) * 64 + rowi];
        }
    };
    ld(0, Wf, Bf, U0i, VKi, gam);
    for (int c = 0; c < 64; ++c) {
        h16x8 Wn[2][2], Bn[2][2]; h16x4 Un[2], Vn[2]; float Gn[2];
        if (c + 1 < 64) ld(c + 1, Wn, Bn, Un, Vn, Gn);
#pragma unroll
        for (int j = 0; j < 2; ++j)
#pragma unroll
            for (int r = 0; r < 4; ++r) Sh[(vt * 16 + 4 * g + r) * 72 + (2 * hf + j) * 16 + cc] = (h16)S[j][r];
        __syncthreads();
        { const int row = tid >> 3, kc = (tid & 7) * 8; *(h16x8*)(p.rw_S0 + ((size_t)(b * 64 + c) * 4 + h) * 4096 + row * 64 + kc) = *(const h16x8*)&Sh[row * 72 + kc]; }
        h16x8 Af[2];
#pragma unroll
        for (int ks = 0; ks < 2; ++ks) Af[ks] = *(const h16x8*)&Sh[(vt * 16 + cc) * 72 + ks * 32 + 8 * g];
        f32x4 Ut[2];
#pragma unroll
        for (int j = 0; j < 2; ++j) {
            f32x4 acc = {(float)U0i[j][0], (float)U0i[j][1], (float)U0i[j][2], (float)U0i[j][3]};
            acc = __builtin_amdgcn_mfma_f32_16x16x32_f16(Af[0], Wf[j][0], acc, 0, 0, 0);
            acc = __builtin_amdgcn_mfma_f32_16x16x32_f16(Af[1], Wf[j][1], acc, 0, 0, 0);
            Ut[j] = acc;
        }
#pragma unroll
        for (int j = 0; j < 2; ++j)
#pragma unroll
            for (int r = 0; r < 4; ++r) Uh[(vt * 16 + 4 * g + r) * 72 + (2 * hf + j) * 16 + cc] = (h16)Ut[j][r];
        __syncthreads();
#pragma unroll
        for (int ks = 0; ks < 2; ++ks) Af[ks] = *(const h16x8*)&Uh[(vt * 16 + cc) * 72 + ks * 32 + 8 * g];
#pragma unroll
        for (int j = 0; j < 2; ++j) {
            f32x4 acc;
#pragma unroll
            for (int r = 0; r < 4; ++r) acc[r] = S[j][r] * gam[j] + (float)VKi[j][r];
            acc = __builtin_amdgcn_mfma_f32_16x16x32_f16(Af[0], Bf[j][0], acc, 0, 0, 0);
            acc = __builtin_amdgcn_mfma_f32_16x16x32_f16(Af[1], Bf[j][1], acc, 0, 0, 0);
            S[j] = acc;
        }
        if (c + 1 < 64) {
#pragma unroll
            for (int j = 0; j < 2; ++j) { Wf[j][0] = Wn[j][0]; Wf[j][1] = Wn[j][1]; Bf[j][0] = Bn[j][0]; Bf[j][1] = Bn[j][1]; U0i[j] = Un[j]; VKi[j] = Vn[j]; gam[j] = Gn[j]; }
        }
    }
}
__device__ __forceinline__ void ph_rw_c(CP p, int l, int bid, int nblk) {
    const int tid = otid(), lane = tid & 63, wave = tid >> 6, g = lane >> 4, cc = lane & 15;
    const int h = wave >> 1, th = wave & 1;
    for (int u = bid; u < 256; u += nblk) {
        const int b = u >> 6, c = u & 63;
        const size_t ub = ((size_t)(b * 64 + c) * 4 + h) * 4096;
        h16x8 Af[4][2];
#pragma unroll
        for (int vt = 0; vt < 4; ++vt)
#pragma unroll
            for (int ks = 0; ks < 2; ++ks) Af[vt][ks] = *(const h16x8*)(p.rw_S0 + ub + (vt * 16 + cc) * 64 + ks * 32 + 8 * g);
#pragma unroll
        for (int j = 0; j < 2; ++j) {
            const int t = (2 * th + j) * 16 + cc;
            const h16x8 B0 = *(const h16x8*)(p.rw_Ry + ub + t * 64 + 8 * g), B1 = *(const h16x8*)(p.rw_Ry + ub + t * 64 + 32 + 8 * g);
            f32x4 y[4]; float sum = 0.f;
#pragma unroll
            for (int vt = 0; vt < 4; ++vt) {
                const h16x4 yi = *(const h16x4*)(p.rw_Y0 + ub + t * 64 + vt * 16 + 4 * g);
                f32x4 acc = {(float)yi[0], (float)yi[1], (float)yi[2], (float)yi[3]};
                acc = __builtin_amdgcn_mfma_f32_16x16x32_f16(Af[vt][0], B0, acc, 0, 0, 0);
                acc = __builtin_amdgcn_mfma_f32_16x16x32_f16(Af[vt][1], B1, acc, 0, 0, 0);
                y[vt] = acc; sum += acc[0] + acc[1] + acc[2] + acc[3];
            }
            sum = rows_sum(sum);
            const float mean = sum * (1.f / 64.f);
            float vs = 0.f;
#pragma unroll
            for (int vt = 0; vt < 4; ++vt)
#pragma unroll
                for (int r = 0; r < 4; ++r) { const float d = y[vt][r] - mean; vs += d * d; }
            vs = rows_sum(vs);
            const float rstd = rsqrtf(vs * (1.f / 64.f) + 64e-5f);
            const size_t tok = (size_t)b * SEQ + c * 64 + t;
#pragma unroll
            for (int vt = 0; vt < 4; ++vt) {
                const int ch = h * 64 + vt * 16 + 4 * g;
                const f32x4 gw = *(const f32x4*)(p.in[I_RWGNW] + l * 256 + ch), gb = *(const f32x4*)(p.in[I_RWGNB] + l * 256 + ch);
                const h16x4 bo = *(const h16x4*)(p.rw_bonus + tok * 256 + ch), gg = *(const h16x4*)(p.rw_g + tok * 256 + ch);
                float o[4];
#pragma unroll
                for (int r = 0; r < 4; ++r) o[r] = ((y[vt][r] - mean) * rstd * gw[r] + gb[r] + (float)bo[r]) * (float)gg[r];
                *(h16x4*)(p.branches + tok * DM + 768 + ch) = pack4(o[0], o[1], o[2], o[3]);
            }
        }
    }
}

__device__ __forceinline__ void ph_dsa_pre(CP p, int bid, int nblk) {
    const int lane = otid() & 63, wv = otid() >> 6;
    for (int tok = bid * 8 + wv; tok < NTOK; tok += nblk * 8) {
        const int i = lane & 31;
        const float c = p.ropet[((size_t)tok * 32 + i) * 2], s = p.ropet[((size_t)tok * 32 + i) * 2 + 1];
        const int base = (lane < 32) ? P_Q : P_K;
        h16* dst = p.proj + (size_t)tok * PJ + base;
        const float scl = (lane < 32) ? 0.125f : 1.f;
#pragma unroll
        for (int h = 0; h < 4; ++h) {
            const float x1 = (float)dst[h * 64 + i], x2 = (float)dst[h * 64 + 32 + i];
            dst[h * 64 + i] = (h16)((x1 * c - x2 * s) * scl);
            dst[h * 64 + 32 + i] = (h16)((x2 * c + x1 * s) * scl);
        }
        const int i2 = lane & 15;
        const float c2 = p.ropet[((size_t)tok * 32 + 2 * i2) * 2], s2 = p.ropet[((size_t)tok * 32 + 2 * i2) * 2 + 1];
        float* xf = p.idxf + (size_t)tok * IDXLD;
        if (lane < 16) {
#pragma unroll
            for (int h = 0; h < 4; ++h) {
                const float x1 = xf[h * 32 + i2], x2 = xf[h * 32 + 16 + i2];
                xf[h * 32 + i2] = x1 * c2 - x2 * s2;
                xf[h * 32 + 16 + i2] = x2 * c2 + x1 * s2;
            }
        } else if (lane < 32) {
            const float x1 = xf[128 + i2], x2 = xf[128 + 16 + i2];
            xf[128 + i2] = x1 * c2 - x2 * s2;
            xf[128 + 16 + i2] = x2 * c2 + x1 * s2;
        }
    }
}
__device__ __forceinline__ unsigned f2key(float x) { unsigned u = __float_as_uint(x); return (u & 0x80000000u) ? ~u : (u | 0x80000000u); }
__device__ __forceinline__ void ph_dsa_naive(CP p, int bid, int nblk, char* smem) {
    const int lane = otid() & 63, wv = otid() >> 6;
    unsigned* s_key = (unsigned*)smem + wv * 4096;
    float* s_p = (float*)s_key;
    float* s_iq = (float*)(smem + 8 * 4096 * 4) + wv * 128;
    float* s_q = (float*)(smem + 8 * 4096 * 4 + 8 * 128 * 4) + wv * 256;
    int* s_list = (int*)(smem + 8 * 4096 * 4 + 8 * 128 * 4 + 8 * 256 * 4) + wv * 256;
    const unsigned long long lt_mask = (lane == 0) ? 0ull : (~0ull >> (64 - lane));
    for (int tok = bid * 8 + wv; tok < NTOK; tok += nblk * 8) {
        const int b = tok / SEQ, t = tok % SEQ;
        s_iq[lane] = p.idxf[(size_t)tok * IDXLD + lane]; s_iq[64 + lane] = p.idxf[(size_t)tok * IDXLD + 64 + lane];
        for (int i = 0; i < 4; ++i) s_q[i * 64 + lane] = (float)p.proj[(size_t)tok * PJ + P_Q + i * 64 + lane];
        const float w0 = p.idxf[(size_t)tok * IDXLD + 160], w1 = p.idxf[(size_t)tok * IDXLD + 161], w2 = p.idxf[(size_t)tok * IDXLD + 162], w3 = p.idxf[(size_t)tok * IDXLD + 163];
        __builtin_amdgcn_s_waitcnt(0); __builtin_amdgcn_wave_barrier();
        const int n = t + 1;
        const int nch = (t >> 6) + 1;
#pragma unroll 1
        for (int i = 0; i < nch; ++i) {
            const int s = lane + 64 * i;
            unsigned kv_ = 0u;
            if (s <= t) {
                const float* kp = p.idxf + ((size_t)b * SEQ + s) * IDXLD + 128;
                float d0 = 0.f, d1 = 0.f, d2 = 0.f, d3 = 0.f;
#pragma unroll
                for (int d4 = 0; d4 < 8; ++d4) {
                    const f32x4 kv = *(const f32x4*)(kp + d4 * 4);
#pragma unroll
                    for (int e = 0; e < 4; ++e) { const int d = d4 * 4 + e; d0 += s_iq[d] * kv[e]; d1 += s_iq[32 + d] * kv[e]; d2 += s_iq[64 + d] * kv[e]; d3 += s_iq[96 + d] * kv[e]; }
                }
                const float sc = w0 * fmaxf(d0, 0.f) + w1 * fmaxf(d1, 0.f) + w2 * fmaxf(d2, 0.f) + w3 * fmaxf(d3, 0.f);
                kv_ = f2key(sc + 0.f);
            }
            s_key[s] = kv_;
        }
        __builtin_amdgcn_s_waitcnt(0); __builtin_amdgcn_wave_barrier();
        int cnt_sel;
        if (n <= 256) {
            for (int i = 0; i < 4; ++i) { const int s = lane + 64 * i; if (s <= t) s_list[s] = s; }
            cnt_sel = n;
        } else {
            unsigned v = 0u;
#pragma unroll 1
            for (int bit = 31; bit >= 0; --bit) {
                const unsigned cand = v | (1u << bit);
                int c = 0;
#pragma unroll 4
                for (int i = 0; i < nch; ++i) c += __popcll(__ballot(s_key[lane + 64 * i] >= cand));
                if (c >= 256) v = cand;
            }
            int cgt = 0;
#pragma unroll 4
            for (int i = 0; i < nch; ++i) cgt += __popcll(__ballot(s_key[lane + 64 * i] > v));
            const int need = 256 - cgt;
            int nsel = 0, nties = 0;
#pragma unroll 1
            for (int i = 0; i < nch; ++i) {
                const unsigned kx = s_key[lane + 64 * i];
                const bool gt = kx > v, eq = kx == v;
                const unsigned long long eqm = __ballot(eq);
                const int trank = nties + __popcll(eqm & lt_mask);
                const bool sel = gt || (eq && trank < need);
                const unsigned long long sm = __ballot(sel);
                if (sel) s_list[nsel + __popcll(sm & lt_mask)] = lane + 64 * i;
                nsel += __popcll(sm); nties += __popcll(eqm);
            }
            cnt_sel = nsel;
        }
        __builtin_amdgcn_s_waitcnt(0); __builtin_amdgcn_wave_barrier();
        float lg[4][4];
#pragma unroll
        for (int jj = 0; jj < 4; ++jj) {
            const int j = lane + 64 * jj;
#pragma unroll
            for (int h = 0; h < 4; ++h) lg[jj][h] = -INFINITY;
            if (j < cnt_sel) {
                const int s = s_list[j];
                const h16* kp = p.proj + ((size_t)b * SEQ + s) * PJ + P_K;
#pragma unroll
                for (int h = 0; h < 4; ++h) {
                    float a = 0.f;
#pragma unroll
                    for (int d8 = 0; d8 < 8; ++d8) { const h16x8 kv = *(const h16x8*)(kp + h * 64 + d8 * 8);
#pragma unroll
                        for (int e = 0; e < 8; ++e) a += s_q[h * 64 + d8 * 8 + e] * (float)kv[e]; }
                    lg[jj][h] = a;
                }
            }
        }
        float inv[4];
#pragma unroll
        for (int h = 0; h < 4; ++h) {
            float m = fmaxf(fmaxf(lg[0][h], lg[1][h]), fmaxf(lg[2][h], lg[3][h]));
            m = wave_max(m);
            float sm = 0.f;
#pragma unroll
            for (int jj = 0; jj < 4; ++jj) { const float e = (lane + 64 * jj < cnt_sel) ? __expf(lg[jj][h] - m) : 0.f; s_p[h * 256 + lane + 64 * jj] = e; sm += e; }
            sm = wave_sum(sm);
            inv[h] = 1.f / sm;
        }
        __builtin_amdgcn_s_waitcnt(0); __builtin_amdgcn_wave_barrier();
        const int hh = lane >> 4;
        float o0 = 0.f, o1 = 0.f, o2 = 0.f, o3 = 0.f;
#pragma unroll 4
        for (int j = 0; j < cnt_sel; ++j) {
            const int s = s_list[j]; const float pj = s_p[hh * 256 + j];
            const h16x4 vv = *(const h16x4*)(p.proj + ((size_t)b * SEQ + s) * PJ + P_V + lane * 4);
            o0 += pj * (float)vv[0]; o1 += pj * (float)vv[1]; o2 += pj * (float)vv[2]; o3 += pj * (float)vv[3];
        }
        const float iv = (hh == 0) ? inv[0] : (hh == 1) ? inv[1] : (hh == 2) ? inv[2] : inv[3];
        *(h16x4*)(p.branches + (size_t)tok * DM + 256 + lane * 4) = pack4(o0 * iv, o1 * iv, o2 * iv, o3 * iv);
        __builtin_amdgcn_s_waitcnt(0); __builtin_amdgcn_wave_barrier();
    }
}
#define DSA_NAIVE_LDS (8 * 4096 * 4 + 8 * 128 * 4 + 8 * 256 * 4 + 8 * 256 * 4)

#define IDXH (2 * IDXLD)
__device__ __forceinline__ float idx_score(const f32x4 (&d)[4], const float (&w)[4], int r) {
    float sc = w[0] * fmaxf(d[0][r], 0.f);
    sc = __fmaf_rn(w[1], fmaxf(d[1][r], 0.f), sc);
    sc = __fmaf_rn(w[2], fmaxf(d[2][r], 0.f), sc);
    sc = __fmaf_rn(w[3], fmaxf(d[3][r], 0.f), sc);
    return sc + 0.f;
}
__device__ __forceinline__ f32x4 idx_dot(h16x8 khi, h16x8 klo, h16x8 qhi, h16x8 qlo) {
    f32x4 acc = {0.f, 0.f, 0.f, 0.f};
    acc = __builtin_amdgcn_mfma_f32_16x16x32_f16(khi, qhi, acc, 0, 0, 0);
    acc = __builtin_amdgcn_mfma_f32_16x16x32_f16(klo, qhi, acc, 0, 0, 0);
    acc = __builtin_amdgcn_mfma_f32_16x16x32_f16(khi, qlo, acc, 0, 0, 0);
    return acc;
}
__device__ __forceinline__ void ph_dsa_pre2(CP p, int bid, int nblk, char* smem) {
    h16* vt_s = (h16*)smem;
    for (int u = bid; u < NTOK / 64; u += nblk) {
        const int tid = otid(), lane = tid & 63, wv = tid >> 6;
        const int tok0 = u * 64;
        __syncthreads();
        for (int q = 0; q < 8; ++q) {
            const int tok = tok0 + wv * 8 + q;
            const int i = lane & 31;
            const float c = p.ropet[((size_t)tok * 32 + i) * 2], s = p.ropet[((size_t)tok * 32 + i) * 2 + 1];
            const int base = (lane < 32) ? P_Q : P_K;
            h16* dst = p.proj + (size_t)tok * PJ + base;
            const float scl = (lane < 32) ? 0.125f : 1.f;
#pragma unroll
            for (int h = 0; h < 4; ++h) {
                const float x1 = (float)dst[h * 64 + i], x2 = (float)dst[h * 64 + 32 + i];
                dst[h * 64 + i] = (h16)((x1 * c - x2 * s) * scl);
                dst[h * 64 + 32 + i] = (h16)((x2 * c + x1 * s) * scl);
            }
            const int i2 = lane & 15;
            const float c2 = p.ropet[((size_t)tok * 32 + 2 * i2) * 2], s2 = p.ropet[((size_t)tok * 32 + 2 * i2) * 2 + 1];
            float* xf = p.idxf + (size_t)tok * IDXLD;
            h16* xh = (h16*)xf;
            float o1[4], o2[4];
            if (lane < 16) {
#pragma unroll
                for (int h = 0; h < 4; ++h) { const float x1 = xf[h * 32 + i2], x2 = xf[h * 32 + 16 + i2]; o1[h] = x1 * c2 - x2 * s2; o2[h] = x2 * c2 + x1 * s2; }
            } else if (lane < 32) {
                const float x1 = xf[128 + i2], x2 = xf[128 + 16 + i2]; o1[0] = x1 * c2 - x2 * s2; o2[0] = x2 * c2 + x1 * s2;
            }
            asm volatile("s_waitcnt vmcnt(0)" ::: "memory");
            __builtin_amdgcn_wave_barrier();
            if (lane < 16) {
#pragma unroll
                for (int h = 0; h < 4; ++h) {
                    const h16 h1 = (h16)o1[h], h2 = (h16)o2[h];
                    xh[h * 32 + i2] = h1; xh[h * 32 + 16 + i2] = h2;
                    xh[128 + h * 32 + i2] = (h16)(o1[h] - (float)h1); xh[128 + h * 32 + 16 + i2] = (h16)(o2[h] - (float)h2);
                }
            } else if (lane < 32) {
                const h16 h1 = (h16)o1[0], h2 = (h16)o2[0];
                xh[256 + i2] = h1; xh[256 + 16 + i2] = h2;
                xh[288 + i2] = (h16)(o1[0] - (float)h1); xh[288 + 16 + i2] = (h16)(o2[0] - (float)h2);
            }
            *(h16x4*)&vt_s[(wv * 8 + q) * 264 + lane * 4] = *(const h16x4*)(p.proj + (size_t)tok * PJ + P_V + lane * 4);
        }
        __syncthreads();
        {
            const int dim = tid >> 1, hf = tid & 1, b = tok0 / SEQ, t0 = tok0 % SEQ;
            h16* dst = p.vT + ((size_t)b * 256 + dim) * SEQ + t0 + hf * 32;
#pragma unroll
            for (int k8 = 0; k8 < 4; ++k8) {
                h16x8 v;
#pragma unroll
                for (int e = 0; e < 8; ++e) v[e] = vt_s[(hf * 32 + k8 * 8 + e) * 264 + dim];
                *(h16x8*)(dst + k8 * 8) = v;
            }
        }
    }
}
#define DSAA_LDS (8 * 4096 * 4)
__device__ __forceinline__ size_t dmask_off(int b, int t) { const int a = t >> 6, r = t & 63; return (size_t)b * 133120 + (size_t)32 * a * (a + 1) + (size_t)r * (a + 1); }
__device__ __forceinline__ void ph_dsa_a(CP p, int l, char* smem) {
    unsigned* Kq = (unsigned*)smem;
    int* qslot = (int*)(smem + DSAA_LDS + 2048);
    for (;;) {
        const int tid = otid(), lane = tid & 63, wave = __builtin_amdgcn_readfirstlane(tid >> 6), g = lane >> 4, c = lane & 15;
        __syncthreads();
        if (tid == 0) *qslot = atomicAdd(&p.qctr[l], 1);
        __syncthreads();
        const int kq = __builtin_amdgcn_readfirstlane(*qslot);
        if (kq >= 1024) break;
        const int b = kq < 960 ? (kq & 3) : ((kq - 960) >> 4), qb = kq < 960 ? 255 - (kq >> 2) : ((kq - 960) & 15), q0 = qb * 16;
        if (qb < 16) {
            if (tid < 64) { const int t = q0 + (tid >> 2), wd = tid & 3, a = t >> 6;
                if (wd <= a) p.dmask[dmask_off(b, t) + wd] = (wd < a) ? ~0ull : (~0ull >> (63 - (t & 63))); }
            continue; }
        const size_t tokq = (size_t)b * SEQ + q0 + c;
        const h16* qrow = (const h16*)(p.idxf + tokq * IDXLD);
        h16x8 qh[4], ql[4]; float w[4];
#pragma unroll
        for (int h = 0; h < 4; ++h) { qh[h] = *(const h16x8*)(qrow + h * 32 + 8 * g); ql[h] = *(const h16x8*)(qrow + 128 + h * 32 + 8 * g); w[h] = p.idxf[tokq * IDXLD + 160 + h]; }
        const int ntiles = qb + 1;
        const int nslots = (ntiles - wave + 7) >> 3;
        const int nch = (16 * ntiles + 63) >> 6;
        const int tq = q0 + c;
        const h16* kbase = (const h16*)(p.idxf + ((size_t)b * SEQ + c) * IDXLD) + 256 + 8 * g;
        u32x4 K4[32];
        {
            h16x8 kh[2], kl[2];
#pragma unroll
            for (int q = 0; q < 2; ++q) {
                int j = wave + 8 * q; j = j < ntiles ? j : ntiles - 1;
                kh[q] = *(const h16x8*)(kbase + (size_t)16 * j * IDXH); kl[q] = *(const h16x8*)(kbase + (size_t)16 * j * IDXH + 32);
            }
#pragma unroll
            for (int i = 0; i < 32; ++i) {
                K4[i] = (u32x4){0u, 0u, 0u, 0u};
                if (i < nslots) {
                    const int j = wave + 8 * i;
                    f32x4 d[4];
#pragma unroll
                    for (int h = 0; h < 4; ++h) d[h] = idx_dot(kh[i & 1], kl[i & 1], qh[h], ql[h]);
                    if (i + 2 < nslots) { const int j2 = j + 16; kh[i & 1] = *(const h16x8*)(kbase + (size_t)16 * j2 * IDXH); kl[i & 1] = *(const h16x8*)(kbase + (size_t)16 * j2 * IDXH + 32); }
#pragma unroll
                    for (int r = 0; r < 4; ++r) { const int sidx = 16 * j + 4 * g + r; const unsigned kk = f2key(idx_score(d, w, r)); K4[i][r] = (sidx <= tq) ? kk : 0u; }
                }
            }
        }
#pragma unroll 1
        for (int bt = 0; bt < 2; ++bt) {
            __syncthreads();
            if ((c >> 3) == bt) {
#pragma unroll
                for (int i = 0; i < 32; ++i) if (i < nslots) *(u32x4*)&Kq[(c & 7) * 4096 + 16 * (wave + 8 * i) + 4 * g] = K4[i];
            }
            __syncthreads();
            {
                const unsigned* myk = Kq + wave * 4096 + lane;
                unsigned kv[64];
#pragma unroll
                for (int m = 0; m < 64; ++m) kv[m] = (m < nch && lane + 64 * m < 16 * ntiles) ? myk[64 * m] : 0u;
                unsigned v = 0u; int cut = 4095; bool done = false;
#pragma unroll 1
                for (int bit = 31; bit >= 0; --bit) {
                    const unsigned cand = v | (1u << bit);
                    int cl = 0;
#pragma unroll
                    for (int m = 0; m < 64; ++m) cl += (kv[m] >= cand) ? 1 : 0;
                    const int cn = __builtin_amdgcn_readfirstlane(wave_isum(cl));
                    if (cn == 256) { v = cand - 1u; cut = -1; done = true; break; }
                    if (cn > 256) v = cand;
                }
                if (!done) {
                    int cgl = 0, cel = 0;
#pragma unroll
                    for (int m = 0; m < 64; ++m) { cgl += (kv[m] > v) ? 1 : 0; cel += (kv[m] == v) ? 1 : 0; }
                    const int cgt = __builtin_amdgcn_readfirstlane(wave_isum(cgl)), ceq = __builtin_amdgcn_readfirstlane(wave_isum(cel));
                    const int need = 256 - cgt;
                    if (ceq > need) {
                        int run = 0; cut = 4095; bool found = false;
#pragma unroll
                        for (int m = 0; m < 64; ++m) {
                            unsigned long long mk = __ballot(kv[m] == v);
                            const int pc = __popcll(mk);
                            if (!found && run + pc >= need) {
                                int kth = need - run;
                                while (kth > 1) { mk &= mk - 1ull; --kth; }
                                cut = (int)__builtin_ctzll(mk) + 64 * m; found = true;
                            }
                            run += pc;
                        }
                    }
                }
                {
                    unsigned long long* sm = (unsigned long long*)(smem + DSAA_LDS + 4096) + wave * 64;
#pragma unroll 1
                    for (int m = 0; m < nch; ++m) {
                        const unsigned kx = (lane + 64 * m < 16 * ntiles) ? myk[64 * m] : 0u;
                        const int cm_ = cut - 64 * m;
                        const unsigned long long mk = __ballot(kx > v || (kx == v && lane <= cm_));
                        sm[m] = mk;
                    }
                    __builtin_amdgcn_s_waitcnt(0); __builtin_amdgcn_wave_barrier();
                    if (lane < nch) p.dmask[dmask_off(b, q0 + bt * 8 + wave) + lane] = sm[lane];
                }
            }
        }
    }
}
#define KS_LD 264
#define VT_LD 72
#define IK_LD 72
#define DSAB_LDS (64 * KS_LD * 2 + 256 * VT_LD * 2 + 64 * KS_LD * 2)
__device__ __forceinline__ void ph_dsa_b(CP p, int bid, int nblk, char* smem) {
    h16* Ks = (h16*)smem;
    h16* Vt = Ks + 64 * KS_LD;
    h16* Qs = Vt + 256 * VT_LD;
    float* mrg = (float*)smem;
    for (int wi = bid; wi < 512; wi += nblk) {
        const int tid = otid(), lane = tid & 63, wave = tid >> 6, g = lane >> 4, c = lane & 15;
        const int qt = wave & 3, kg = wave >> 2;
        const int half = wi >> 8;
        const int x_ = wi & 7, r_ = (wi & 255) >> 3;
        const int b = (nblk == 256) ? (x_ >> 1) : ((wi & 255) >> 6), j_ = (nblk == 256) ? ((x_ & 1) * 32 + r_) : (wi & 63);
        const int qblk = half ? j_ : 63 - j_, q0 = qblk * 64;
        const int tq = q0 + 16 * qt + c;
        const size_t tokq = (size_t)b * SEQ + tq;
        __syncthreads();
        for (int i = tid; i < 64 * 32; i += 512) {
            const int row = i >> 5, ch = i & 31; const size_t tk = (size_t)b * SEQ + q0 + row;
            *(u32x4*)&Qs[row * KS_LD + ch * 8] = *(const u32x4*)(p.proj + tk * PJ + P_Q + ch * 8);
        }
        const unsigned long long* mrow = p.dmask + dmask_off(b, tq);
        f32x4 O[4][4];
        float mrun[4], lrun[4];
#pragma unroll
        for (int h = 0; h < 4; ++h) { mrun[h] = -1e30f; lrun[h] = 0.f;
#pragma unroll
            for (int dt = 0; dt < 4; ++dt) O[h][dt] = (f32x4){0.f, 0.f, 0.f, 0.f}; }
        const int nall = qblk + 1, hs_ = (nall + 1) >> 1;
        const int sb = half ? hs_ : 0, nsteps = half ? nall : hs_;
        u32x4 rk[4], rv[4]; unsigned long long mw, mwn = 0ull;
#define DSAB_GLOAD(S_) do { const size_t kb_ = (size_t)b * SEQ + 64 * (S_); \
            _Pragma("unroll") for (int i = 0; i < 4; ++i) { const int ch = tid + 512 * i; rk[i] = *(const u32x4*)(p.proj + (kb_ + (ch >> 5)) * PJ + P_K + (ch & 31) * 8); } \
            _Pragma("unroll") for (int i = 0; i < 4; ++i) { const int ch = tid + 512 * i; rv[i] = *(const u32x4*)(p.vT + ((size_t)b * 256 + (ch >> 3)) * SEQ + 64 * (S_) + (ch & 7) * 8); } \
            mwn = mrow[(S_)]; } while (0)
#define DSAB_LSTORE() do { \
            _Pragma("unroll") for (int i = 0; i < 4; ++i) { const int ch = tid + 512 * i; *(u32x4*)&Ks[(ch >> 5) * KS_LD + (ch & 31) * 8] = rk[i]; } \
            _Pragma("unroll") for (int i = 0; i < 4; ++i) { const int ch = tid + 512 * i; *(u32x4*)&Vt[(ch >> 3) * VT_LD + (ch & 7) * 8] = rv[i]; } \
            } while (0)
        __syncthreads();
        if (sb < nsteps) { DSAB_GLOAD(sb); DSAB_LSTORE(); }
        __syncthreads();
        for (int s = sb; s < nsteps; ++s) {
            mw = mwn;
            if (s + 1 < nsteps) DSAB_GLOAD(s + 1);
            int qo_ = (16 * qt + c) * KS_LD; asm volatile("" : "+v"(qo_));
            const h16* qrow_ = Qs + qo_;
            bool msk[2][4];
            {
                const unsigned w32 = (unsigned)(mw >> (32 * kg));
#pragma unroll
                for (int jt = 0; jt < 2; ++jt)
#pragma unroll
                    for (int r = 0; r < 4; ++r) msk[jt][r] = (w32 >> (16 * jt + 4 * g + r)) & 1u;
            }
#pragma unroll
            for (int h = 0; h < 4; ++h) {
                f32x4 S[2];
                {
                    const h16x8 q0_ = *(const h16x8*)(qrow_ + h * 64 + 8 * g), q1_ = *(const h16x8*)(qrow_ + h * 64 + 32 + 8 * g);
#pragma unroll
                    for (int jt = 0; jt < 2; ++jt) {
                        const int row = 32 * kg + 16 * jt + c;
                        f32x4 acc = {0.f, 0.f, 0.f, 0.f};
                        acc = __builtin_amdgcn_mfma_f32_16x16x32_f16(*(const h16x8*)&Ks[row * KS_LD + h * 64 + 8 * g], q0_, acc, 0, 0, 0);
                        acc = __builtin_amdgcn_mfma_f32_16x16x32_f16(*(const h16x8*)&Ks[row * KS_LD + h * 64 + 32 + 8 * g], q1_, acc, 0, 0, 0);
                        S[jt] = acc;
                    }
                }
                float mx = -1e30f;
#pragma unroll
                for (int jt = 0; jt < 2; ++jt)
#pragma unroll
                    for (int r = 0; r < 4; ++r) mx = fmaxf(mx, msk[jt][r] ? S[jt][r] : -1e30f);
                mx = rows_max(mx);
                const float mnew = fmaxf(mrun[h], mx);
                const float scale = __expf(mrun[h] - mnew);
                mrun[h] = mnew;
                float ps = 0.f; h16x8 pb;
#pragma unroll
                for (int jt = 0; jt < 2; ++jt)
#pragma unroll
                    for (int r = 0; r < 4; ++r) { const float pe = msk[jt][r] ? __expf(S[jt][r] - mnew) : 0.f; ps += pe; pb[jt * 4 + r] = (h16)pe; }
                lrun[h] = lrun[h] * scale + ps;
#pragma unroll
                for (int dt = 0; dt < 4; ++dt) {
                    f32x4 o = O[h][dt] * scale;
                    const int vrow = h * 64 + 16 * dt + c;
                    const h16x4 va = *(const h16x4*)&Vt[vrow * VT_LD + 32 * kg + 4 * g], vb = *(const h16x4*)&Vt[vrow * VT_LD + 32 * kg + 16 + 4 * g];
                    h16x8 av; av[0] = va[0]; av[1] = va[1]; av[2] = va[2]; av[3] = va[3]; av[4] = vb[0]; av[5] = vb[1]; av[6] = vb[2]; av[7] = vb[3];
                    O[h][dt] = __builtin_amdgcn_mfma_f32_16x16x32_f16(av, pb, o, 0, 0, 0);
                }
            }
            __syncthreads();
            if (s + 1 < nsteps) DSAB_LSTORE();
            __syncthreads();
        }
#pragma unroll
        for (int h = 0; h < 4; ++h) lrun[h] = rows_sum(lrun[h]);
        float* my = mrg + (size_t)(qt * 64 + lane) * 73;
        if (kg == 1) {
#pragma unroll
            for (int h = 0; h < 4; ++h) { my[h] = mrun[h]; my[4 + h] = lrun[h];
#pragma unroll
                for (int dt = 0; dt < 4; ++dt)
#pragma unroll
                    for (int r = 0; r < 4; ++r) my[8 + (h * 4 + dt) * 4 + r] = O[h][dt][r]; }
        }
        __syncthreads();
        if (kg == 0) {
            const size_t pq = ((size_t)((b * 64 + qblk) * 2 + half) * 64 + 16 * qt + c);
#pragma unroll
            for (int h = 0; h < 4; ++h) {
                const float m1 = my[h], l1 = my[4 + h];
                const float m = fmaxf(mrun[h], m1);
                const float e0 = __expf(mrun[h] - m), e1 = __expf(m1 - m);
                const float lt = lrun[h] * e0 + l1 * e1;
                const float inv = lt > 0.f ? 1.f / lt : 0.f;
                if (g == 0) { p.dsa_ml[pq * 8 + h * 2] = m; p.dsa_ml[pq * 8 + h * 2 + 1] = lt; }
#pragma unroll
                for (int dt = 0; dt < 4; ++dt) {
                    float o[4];
#pragma unroll
                    for (int r = 0; r < 4; ++r) o[r] = (O[h][dt][r] * e0 + my[8 + (h * 4 + dt) * 4 + r] * e1) * inv;
                    *(h16x4*)(p.dsa_op + pq * 256 + h * 64 + 16 * dt + 4 * g) = pack4(o[0], o[1], o[2], o[3]);
                }
            }
        }
        __syncthreads();
    }
}

__device__ __forceinline__ void ph_dsa_merge(CP p, int bid, int nblk) {
    const int lane = otid() & 63, wv = otid() >> 6;
    for (int tok = bid * 8 + wv; tok < NTOK; tok += nblk * 8) {
        const int b = tok / SEQ, t = tok % SEQ;
        const size_t p0 = ((size_t)((b * 64 + (t >> 6)) * 2) * 64 + (t & 63)), p1 = p0 + 64;
        const int h = lane >> 4;
        const float m0 = p.dsa_ml[p0 * 8 + h * 2], l0 = p.dsa_ml[p0 * 8 + h * 2 + 1], m1 = p.dsa_ml[p1 * 8 + h * 2], l1 = p.dsa_ml[p1 * 8 + h * 2 + 1];
        const h16x4 o0 = *(const h16x4*)(p.dsa_op + p0 * 256 + lane * 4), o1 = *(const h16x4*)(p.dsa_op + p1 * 256 + lane * 4);
        const float m = fmaxf(m0, m1);
        const float w0 = l0 * __expf(m0 - m), w1 = l1 * __expf(m1 - m);
        const float inv = 1.f / (w0 + w1);
        *(h16x4*)(p.branches + (size_t)tok * DM + 256 + lane * 4) = pack4(((float)o0[0] * w0 + (float)o1[0] * w1) * inv, ((float)o0[1] * w0 + (float)o1[1] * w1) * inv,
                                                                         ((float)o0[2] * w0 + (float)o1[2] * w1) * inv, ((float)o0[3] * w0 + (float)o1[3] * w1) * inv);
    }
}
__device__ __forceinline__ void ph_gates(CP p, int l, int bid, int nblk, char* smem) {
    pg8::Gemm g; g.A = p.h_hi; g.Bt = p.Wg; g.M = NTOK; g.N = 4096; g.K = DM; g.lda = DM; g.ldb = DM;
    pg8::StaticOrder S; S.init(NTOK, 4096, nblk, bid);
    pg8::EpiH16<1> E; E.O = p.gates; E.ldc = 4096; E.ncols = 4096; E.bias = p.in[I_GATEB] + (size_t)l * 4096;
    pg8::gemm_phase((PG8_LAS unsigned char*)smem, g, S, E);
}
__device__ __forceinline__ void ph_merge(CP p, int l, int bid, int nblk, char* smem) {
    for (int u = bid; u < 128 * 8; u += nblk) {
        const int mt = u >> 3, nt = u & 7, m0 = mt * 128, n0 = nt * 128;
        f32x4 mx[2][4]; zero_acc<128>(mx);
        f32x4 au[2][4]; zero_acc<128>(au);
        const int tid_ = otid(); const int lane = tid_ & 63, wave = tid_ >> 6, wm = wave >> 1, wn = wave & 1;
        const h16* A = p.branches + (size_t)m0 * DM; const h16* B = p.Wb + (size_t)n0 * 256;
        const h16* G = p.gates + (size_t)(m0 + wm * 32 + (lane & 15)) * 4096 + n0 + wn * 64 + 4 * (lane >> 4);
        gemm_kloop_seg<128>(smem, DM, [=](int r, int k) { return A + (size_t)r * DM + k; },
                            [=](int r, int k) { return B + ((size_t)(k >> 8) * 1024 + r) * 256 + (k & 255); }, au,
                            [&](int kt) {
                                if ((kt & 3) == 3) {
                                    const int n = kt >> 2;
#pragma unroll
                                    for (int i = 0; i < 2; ++i)
#pragma unroll
                                        for (int j = 0; j < 4; ++j) {
                                            const h16x4 gg = *(const h16x4*)(G + (size_t)i * 16 * 4096 + n * 1024 + j * 16);
#pragma unroll
                                            for (int e = 0; e < 4; ++e) mx[i][j][e] += (float)gg[e] * au[i][j][e];
                                            au[i][j] = (f32x4){0.f, 0.f, 0.f, 0.f};
                                        }
                                }
                            });
        h16* O = p.mixed + (size_t)m0 * DM + n0;
        gemm_epi<128>(mx, [=](int ml, int nl, f32x4 v) { *(h16x4*)(O + (size_t)ml * DM + nl) = pack4(v[0], v[1], v[2], v[3]); });
    }
}
__device__ __forceinline__ void ph_outproj(CP p, int l, int bid, int nblk, char* smem) {
    pg8::Gemm g; g.A = p.mixed; g.Bt = p.Wo; g.M = NTOK; g.N = DM; g.K = DM; g.lda = DM; g.ldb = DM;
    pg8::StaticOrder S; S.init(NTOK, DM, nblk, bid);
    pg8::EpiResid E; E.O = p.x1; E.X = l == 0 ? p.in[I_X] : p.x1; E.gate = p.mods + (size_t)l * 4 * 6144 + 2 * 1024;
    pg8::gemm_phase((PG8_LAS unsigned char*)smem, g, S, E);
}

__constant__ int c_pair_lo[6] = {0, 0, 0, 1, 1, 2};
__constant__ int c_pair_hi[6] = {1, 2, 3, 2, 3, 3};
__device__ __forceinline__ void ph_norm2_router(CP p, int l, int bid, int nblk, char* smem) {
    float* rw = (float*)smem;
    for (int i = otid(); i < DM * 16; i += 512) rw[i] = p.in[I_ROUTW][i];
    __syncthreads();
    const int lane = otid() & 63, wv = otid() >> 6;
    for (int tok = bid * 8 + wv; tok < NTOK; tok += nblk * 8) {
        const int b = tok / SEQ;
        const float* xr = p.x1 + (size_t)tok * DM;
        f32x4 v[4]; float ss = 0.f;
#pragma unroll
        for (int i = 0; i < 4; ++i) { v[i] = *(const f32x4*)(xr + i * 256 + lane * 4); ss += v[i][0] * v[i][0] + v[i][1] * v[i][1] + v[i][2] * v[i][2] + v[i][3] * v[i][3]; }
        ss = wave_sum(ss);
        const float rs = rsqrtf(ss * (1.f / DM) + 1e-6f);
        const float* g = p.in[I_FNG] + l * DM;
        const float* md = p.mods + ((size_t)l * 4 + b) * 6144;
        float lg[16];
#pragma unroll
        for (int e = 0; e < 16; ++e) lg[e] = 0.f;
#pragma unroll 1
        for (int i = 0; i < 4; ++i) {
            const int c = i * 256 + lane * 4;
            f32x4 gg = *(const f32x4*)(g + c), sh = *(const f32x4*)(md + 3 * 1024 + c), sc = *(const f32x4*)(md + 4 * 1024 + c);
            float hv[4];
#pragma unroll
            for (int e = 0; e < 4; ++e) hv[e] = v[i][e] * rs * gg[e] * (1.f + sc[e]) + sh[e];
            *(h16x4*)(p.h_hi + (size_t)tok * DM + c) = pack4(hv[0], hv[1], hv[2], hv[3]);
#pragma unroll 1
            for (int e = 0; e < 4; ++e) {
                const float* rr = rw + (c + e) * 16;
                const float hve = e == 0 ? hv[0] : e == 1 ? hv[1] : e == 2 ? hv[2] : hv[3];
#pragma unroll
                for (int x4 = 0; x4 < 4; ++x4) { const f32x4 r4 = *(const f32x4*)(rr + x4 * 4); lg[x4 * 4] += hve * r4[0]; lg[x4 * 4 + 1] += hve * r4[1]; lg[x4 * 4 + 2] += hve * r4[2]; lg[x4 * 4 + 3] += hve * r4[3]; }
            }
        }
#pragma unroll
        for (int e = 0; e < 16; ++e) lg[e] = wave_sum(lg[e]);
        if (lane == 0) {
            float sc[16], bi[16];
#pragma unroll
            for (int e = 0; e < 16; ++e) { sc[e] = 1.f / (1.f + expf(-lg[e])); bi[e] = sc[e] + p.in[I_ROUTB][e]; }
            int bg = 0; float bgs = -INFINITY;
#pragma unroll
            for (int gI = 0; gI < 4; ++gI) {
                float m1 = -INFINITY, m2 = -INFINITY;
#pragma unroll
                for (int j = 0; j < 4; ++j) { const float x = bi[gI * 4 + j]; if (x > m1) { m2 = m1; m1 = x; } else if (x > m2) m2 = x; }
                const float gs = m1 + m2;
                if (gs > bgs) { bgs = gs; bg = gI; }
            }
            int e0 = 0; float b0 = -INFINITY;
#pragma unroll
            for (int j = 0; j < 4; ++j) { float x = -INFINITY;
#pragma unroll
                for (int gI = 0; gI < 4; ++gI) if (gI == bg) x = bi[gI * 4 + j];
                if (x > b0) { b0 = x; e0 = j; } }
            int e1 = 0; float b1 = -INFINITY;
#pragma unroll
            for (int j = 0; j < 4; ++j) { float x = -INFINITY;
#pragma unroll
                for (int gI = 0; gI < 4; ++gI) if (gI == bg) x = bi[gI * 4 + j];
                if (j != e0 && x > b1) { b1 = x; e1 = j; } }
            float s0 = 0.f, s1 = 0.f;
#pragma unroll
            for (int e = 0; e < 16; ++e) { if (e == bg * 4 + e0) s0 = sc[e]; if (e == bg * 4 + e1) s1 = sc[e]; }
            const float wsum = s0 + s1; const float wa = s0 / wsum, wb = s1 / wsum;
            const int lo = e0 < e1 ? e0 : e1, hi = e0 < e1 ? e1 : e0;
            const float clo = e0 < e1 ? wa : wb, chi = e0 < e1 ? wb : wa;
            int pr = 0;
#pragma unroll
            for (int q = 0; q < 6; ++q) if (c_pair_lo[q] == lo && c_pair_hi[q] == hi) pr = q;
            const int bucket = bg * 6 + pr;
            const int pos = atomicAdd(&p.bcnt[bucket], 1);
            p.lists[(size_t)bucket * LCAP + pos] = tok;
            p.cw[(size_t)tok * 2] = clo; p.cw[(size_t)tok * 2 + 1] = chi;
        }
    }
}

struct MoeTile { int bucket, i0, cnt, ea, eb; };
__device__ __forceinline__ bool moe_tile(const int* bcnt, int mt, MoeTile& o) {
    int acc = 0;
    for (int b = 0; b < 24; ++b) {
        const int c = bcnt[b]; const int nt = (c + 127) >> 7;
        if (mt < acc + nt) { o.bucket = b; o.i0 = (mt - acc) * 128; o.cnt = c; const int g = b / 6, pr = b % 6; o.ea = g * 4 + c_pair_lo[pr]; o.eb = g * 4 + c_pair_hi[pr]; return true; }
        acc += nt;
    }
    return false;
}
#define MOE_MAXT 152
__device__ __forceinline__ void ph_moe1(CP p, int bid, int nblk, char* smem) {
    for (int u = bid; u < MOE_MAXT * 16; u += nblk) {
        const int mt = u >> 4, nt = u & 15;
        MoeTile T; if (!moe_tile(p.bcnt, mt, T)) break;
        const int* lst = p.lists + (size_t)T.bucket * LCAP; const int i0 = T.i0, cnt = T.cnt;
        const h16* H = p.h_hi;
        const int second = nt >= 8;
        const h16* B = p.We13 + ((size_t)(second ? T.eb : T.ea) * 1024 + (nt & 7) * 128) * DM;
        f32x4 acc[2][4]; zero_acc<128>(acc);
        gemm_kloop<128>(smem, DM, [=](int r, int k) { const int i = i0 + r; const int tok = lst[i < cnt ? i : 0]; return H + (size_t)tok * DM + k; },
                        [=](int r, int k) { return B + (size_t)r * DM + k; }, acc);
        const int lane = otid() & 63, wave = otid() >> 6, wm = wave >> 1, wn = wave & 1;
#pragma unroll
        for (int i = 0; i < 2; ++i) {
            const int ml = wm * 32 + i * 16 + (lane & 15);
            const int ii = i0 + ml; const bool valid = ii < cnt;
            const float cwv = valid ? p.cw[(size_t)lst[ii] * 2 + second] : 0.f;
            h16* O = p.act + ((size_t)mt * 128 + ml) * 1024 + second * 512;
#pragma unroll
            for (int jj = 0; jj < 2; ++jj) {
                const f32x4 a = acc[i][2 * jj], bq = acc[i][2 * jj + 1];
                const int col = ((nt & 7) * 128 + wn * 64 + jj * 32) / 2 + 4 * (lane >> 4);
                float o[4];
#pragma unroll
                for (int e = 0; e < 4; ++e) o[e] = valid ? cwv * (a[e] * sigm(a[e])) * bq[e] : 0.f;
                *(h16x4*)(O + col) = pack4(o[0], o[1], o[2], o[3]);
            }
        }
    }
}
__device__ __forceinline__ void ph_moe2(CP p, int l, int bid, int nblk, char* smem) {
    for (int u = bid; u < MOE_MAXT * 8; u += nblk) {
        const int mt = u >> 3, nt = u & 7, n0 = nt * 128;
        MoeTile T; if (!moe_tile(p.bcnt, mt, T)) break;
        const int* lst = p.lists + (size_t)T.bucket * LCAP; const int i0 = T.i0, cnt = T.cnt;
        const h16* A = p.act + (size_t)mt * 128 * 1024;
        const h16* Ba = p.We2 + ((size_t)T.ea * 1024 + n0) * 512; const h16* Bb = p.We2 + ((size_t)T.eb * 1024 + n0) * 512;
        f32x4 acc[2][4]; zero_acc<128>(acc);
        gemm_kloop<128>(smem, 1024, [=](int r, int k) { return A + (size_t)r * 1024 + k; },
                        [=](int r, int k) { return (k < 512 ? Ba + k : Bb + (k - 512)) + (size_t)r * 512; }, acc);
        const float* md = p.mods + (size_t)l * 4 * 6144 + 5 * 1024 + n0;
        float* X = p.x1;
        gemm_epi<128>(acc, [=](int ml, int nl, f32x4 v) { const int ii = i0 + ml; if (ii < cnt) { const int tok = lst[ii]; const f32x4 gg = *(const f32x4*)(md + (size_t)(tok / SEQ) * 6144 + nl);
                                                          float* xp = X + (size_t)tok * DM + n0 + nl; *(f32x4*)xp = *(const f32x4*)xp + gg * v; } });
    }
}

__device__ __forceinline__ void ph_moe_gather(CP p, int bid, int nblk, char* smem) {
    int* tb = (int*)smem;
    const int tid = otid(), lane = tid & 63, wv = tid >> 6;
    __syncthreads();
    if (tid == 0) { int acc = 0; for (int b = 0; b < 24; ++b) { tb[b] = acc; acc += (p.bcnt[b] + 255) >> 8; } tb[24] = acc; }
    __syncthreads();
    const int nrows = tb[24] * 256;
    for (int R = bid * 8 + wv; R < nrows; R += nblk * 8) {
        const int mt = R >> 8, r = R & 255;
        int b = 0;
#pragma unroll 1
        for (int q = 1; q < 24; ++q) if (tb[q] <= mt) b = q;
        const int ii = (mt - tb[b]) * 256 + r;
        u32x4 v0 = {0u, 0u, 0u, 0u}, v1 = v0;
        if (ii < p.bcnt[b]) { const int tok = p.lists[(size_t)b * LCAP + ii]; const u32x4* src = (const u32x4*)(p.h_hi + (size_t)tok * DM); v0 = src[lane]; v1 = src[64 + lane]; }
        u32x4* dst = (u32x4*)(p.h2s + (size_t)R * DM); dst[lane] = v0; dst[64 + lane] = v1;
    }
}
__device__ __forceinline__ void ph_moe1b(CP p, int bid, int nblk, char* smem) {
    pg8::Gemm g; g.A = p.h2s; g.Bt = p.We13; g.M = 0; g.N = 0; g.K = DM; g.lda = DM; g.ldb = DM;
    pg8::MoeOrder<1> S; S.bcnt = p.bcnt; S.W = p.We13; S.G = nblk; S.c = bid;
    pg8::EpiMoe1 E; E.act = p.act; E.lists = p.lists; E.cw = p.cw;
    pg8::gemm_phase((PG8_LAS unsigned char*)smem, g, S, E);
}
__device__ __forceinline__ void ph_moe2b(CP p, int l, int bid, int nblk, char* smem) {
    pg8::Gemm g; g.A = p.act; g.Bt = p.We2; g.M = 0; g.N = 0; g.K = DM; g.lda = DM; g.ldb = 512;
    pg8::MoeOrder<2> S; S.bcnt = p.bcnt; S.W = p.We2; S.G = nblk; S.c = bid;
    pg8::EpiMoe2 E; E.x1 = p.x1; E.lists = p.lists; E.gate = p.mods + (size_t)l * 4 * 6144 + 5 * 1024;
    pg8::gemm_phase((PG8_LAS unsigned char*)smem, g, S, E);
}

__device__ __forceinline__ void ph_final(CP p, int bid, int nblk) {
    const int lane = otid() & 63, wv = otid() >> 6;
    for (int tok = bid * 8 + wv; tok < NTOK; tok += nblk * 8) {
        const float* xr = p.x1 + (size_t)tok * DM;
        f32x4 v[4]; float ss = 0.f;
#pragma unroll
        for (int i = 0; i < 4; ++i) { v[i] = *(const f32x4*)(xr + i * 256 + lane * 4); ss += v[i][0] * v[i][0] + v[i][1] * v[i][1] + v[i][2] * v[i][2] + v[i][3] * v[i][3]; }
        ss = wave_sum(ss);
        const float rs = rsqrtf(ss * (1.f / DM) + 1e-6f);
#pragma unroll
        for (int i = 0; i < 4; ++i) { const int c = i * 256 + lane * 4; const f32x4 gg = *(const f32x4*)(p.in[I_FINALG] + c); *(f32x4*)(p.out + (size_t)tok * DM + c) = v[i] * rs * gg; }
    }
}

#define XB_TMO      128
#define XB_XCNT(j)  (256  + 64 * (j))
#define XB_XSUB(j)  (1280 + 64 * (j))
#define XB_XGEN(j)  (2304 + 64 * (j))
#define XB_TOP      3328
#define XB_TOPGEN   3392
#define XCD_BAR_WORDS 3456
#define XB_SPIN_CAP (1u << 24)
#define LAS __attribute__((address_space(3)))

typedef __attribute__((address_space(1))) unsigned gu32;
__device__ __forceinline__ unsigned xb_ld(gu32* p)              { return __hip_atomic_load(p, __ATOMIC_RELAXED, __HIP_MEMORY_SCOPE_AGENT); }
__device__ __forceinline__ unsigned xb_add(gu32* p, unsigned v) { return __hip_atomic_fetch_add(p, v, __ATOMIC_RELAXED, __HIP_MEMORY_SCOPE_AGENT); }
__device__ __forceinline__ unsigned xb_xcc_id() { return (unsigned)__builtin_amdgcn_s_getreg((3 << 11) | 20) & 0xFu; }
#define XB_SPIN(cond, bar) do { unsigned _sp = 0; while (cond) { __builtin_amdgcn_s_sleep(1); \
    if ((++_sp & 255u) == 0u) { if (xb_ld(&(bar)[XB_TMO])) break; if (_sp > XB_SPIN_CAP) { xb_add(&(bar)[XB_TMO], 1u); break; } } } } while (0)

struct XcdBarrier { unsigned* bar; unsigned x; volatile LAS unsigned* st; };

__device__ __forceinline__ XcdBarrier xcd_barrier_post(unsigned* bar, volatile LAS unsigned* st) {
    XcdBarrier b; b.bar = bar; b.x = xb_xcc_id(); b.st = st;
    if (threadIdx.x == 0) (void)xb_add(&((gu32*)bar)[XB_XCNT(b.x)], 1u);
    return b;
}
__device__ __forceinline__ void xcd_barrier_complete(gu32* bar, unsigned x, unsigned& nloc, unsigned& nx) {
    const unsigned G = gridDim.x * gridDim.y * gridDim.z;
    unsigned sum, cnt, mine, sp = 0u;
    for (;;) {
        sum = 0u; cnt = 0u; mine = 0u;
#pragma unroll
        for (unsigned j = 0; j < 16; ++j) { const unsigned c = xb_ld(&bar[XB_XCNT(j)]); sum += c; cnt += (c > 0u) ? 1u : 0u; mine = (j == x) ? c : mine; }
        if (sum == G) break;
        __builtin_amdgcn_s_sleep(1);
        if ((++sp & 255u) == 0u) { if (xb_ld(&bar[XB_TMO])) break; if (sp > XB_SPIN_CAP) { xb_add(&bar[XB_TMO], 1u); break; } }
    }
    nloc = mine > 0u ? mine : 1u; nx = cnt > 0u ? cnt : 1u;
}
__device__ __forceinline__ void xcd_barrier(const XcdBarrier& b0) {
    asm volatile("s_waitcnt vmcnt(0)" ::: "memory");
    __syncthreads();
    if (threadIdx.x == 0) {
        unsigned long long ba = (unsigned long long)b0.bar;
        asm volatile("" : "+s"(ba));
        gu32* bar = (gu32*)ba;
        const unsigned x = xb_xcc_id();
        volatile LAS unsigned* st = b0.st;
        __builtin_amdgcn_s_waitcnt(0);
        unsigned nloc = st[0], nx = st[1];
        if (nloc == 0u) { xcd_barrier_complete(bar, x, nloc, nx); st[0] = nloc; st[1] = nx; }
        const unsigned old = xb_add(&bar[XB_XSUB(x)], 1u);
        const unsigned gen = old / nloc;
        if (old + 1u == (gen + 1u) * nloc) {
            __builtin_amdgcn_fence(__ATOMIC_RELEASE, "agent");
            asm volatile("s_waitcnt vmcnt(0)" ::: "memory");
            const unsigned og = xb_add(&bar[XB_TOP], 1u);
            const unsigned tg = og / nx;
            if (og + 1u == (tg + 1u) * nx) xb_add(&bar[XB_TOPGEN], 1u);
            else XB_SPIN(xb_ld(&bar[XB_TOPGEN]) == tg, bar);
            __builtin_amdgcn_fence(__ATOMIC_ACQUIRE, "agent");
            xb_add(&bar[XB_XGEN(x)], 1u);
            asm volatile("s_waitcnt vmcnt(0)" ::: "memory");
        } else {
            XB_SPIN(xb_ld(&bar[XB_XGEN(x)]) == gen, bar);
            __builtin_amdgcn_fence(__ATOMIC_ACQUIRE, "agent");
            asm volatile("s_waitcnt vmcnt(0)" ::: "memory");
        }
    }
    __syncthreads();
}

__device__ __forceinline__ const __attribute__((address_space(4))) Params* lp(const __attribute__((address_space(4))) Params* q) { asm volatile("" : "+s"(q)); return q; }
#define MEGA_LDS (155648 + 2560 + 16)
__global__ void __launch_bounds__(512) k_mega(Params p) {
    extern __shared__ __attribute__((aligned(16))) char smem[];
    volatile LAS unsigned* xbw = (volatile LAS unsigned*)(smem + MEGA_LDS - 16);
    if (threadIdx.x == 0) { xbw[0] = 0u; xbw[1] = 0u; }
    __syncthreads();
    XcdBarrier bar = xcd_barrier_post(p.bar, xbw);
    const int bid0 = blockIdx.x, nblk0 = gridDim.x;
    const __attribute__((address_space(4))) Params* kp = (const __attribute__((address_space(4))) Params*)__builtin_amdgcn_kernarg_segment_ptr();
#define PQ (*lp(kp))
#define BID oint(bid0)
#define NBLK oint(nblk0)
    ph_mods(PQ, BID, NBLK, smem);
    ph_tables(PQ, BID, NBLK);
#if PROBE == 9
    __syncthreads(); ph_mods(PQ, BID, NBLK, smem); ph_tables(PQ, BID, NBLK);
#endif
    ph_convert_mix(PQ, 0, BID, NBLK);
#if PROBE == 1
    ph_convert_mix(PQ, 0, BID, NBLK);
#endif
    xcd_barrier(bar);
    for (int l0 = 0; l0 < 2; ++l0) {
#define LL oint(l0)
        ph_norm1(PQ, LL, BID, NBLK);
        xcd_barrier(bar);
        ph_gemm1(PQ, BID, NBLK, smem);
#if PROBE == 2
        ph_gemm1(PQ, BID, NBLK, smem);
#endif
        xcd_barrier(bar);
        ph_s5_scan<1>(PQ, LL, BID, NBLK, smem);
        __syncthreads();
        ph_rg_a(PQ, LL, BID, NBLK, smem);
        __syncthreads();
        ph_rw_a(PQ, LL, BID, NBLK, smem);
#if PROBE == 13
        __syncthreads(); ph_s5_scan<1>(PQ, LL, BID, NBLK, smem);
#endif
#if PROBE == 14
        __syncthreads(); ph_rg_a(PQ, LL, BID, NBLK, smem);
#endif
#if PROBE == 15
        __syncthreads(); ph_rw_a(PQ, LL, BID, NBLK, smem);
#endif
#if PROBE == 3
        __syncthreads(); ph_s5_scan<1>(PQ, LL, BID, NBLK, smem); __syncthreads(); ph_rg_a(PQ, LL, BID, NBLK, smem); __syncthreads(); ph_rw_a(PQ, LL, BID, NBLK, smem);
#endif
        __syncthreads();
        __syncthreads();
        ph_dsa_pre2(PQ, BID, NBLK, smem);
        xcd_barrier(bar);
        if (BID < 16) ph_rw_b(PQ, BID, smem);
        else {
            ph_s5_carry(PQ, LL, BID - 16, NBLK - 16);
            ph_rg_c(PQ, LL, BID - 16, NBLK - 16, smem);
            __syncthreads();
        }
#if PROBE == 4 || PROBE == 11
        if (BID < 16) ph_rw_b(PQ, BID, smem);
#endif
        __syncthreads();
        ph_dsa_a(PQ, LL, smem);
        xcd_barrier(bar);
        ph_dsa_b(PQ, BID, NBLK, smem);
        __syncthreads();
        ph_s5_scan<3>(PQ, LL, BID, NBLK, smem);
        ph_rw_c(PQ, LL, BID, NBLK);
#if PROBE == 5
        __syncthreads(); ph_dsa_b(PQ, BID, NBLK, smem);
#endif
#if PROBE == 17
        ph_s5_scan<3>(PQ, LL, BID, NBLK, smem);
#endif
#if PROBE == 18
        ph_rw_c(PQ, LL, BID, NBLK);
#endif
#if PROBE == 6
        ph_s5_scan<3>(PQ, LL, BID, NBLK, smem); ph_rw_c(PQ, LL, BID, NBLK);
#endif
        xcd_barrier(bar);
        ph_dsa_merge(PQ, BID, NBLK);
        ph_s5_glu(PQ, LL, BID, NBLK, smem);
        xcd_barrier(bar);
        ph_gates(PQ, LL, BID, NBLK, smem);
#if PROBE == 7
        ph_gates(PQ, LL, BID, NBLK, smem);
#endif
        xcd_barrier(bar);
        ph_merge(PQ, LL, BID, NBLK, smem);
#if PROBE == 10
        ph_merge(PQ, LL, BID, NBLK, smem);
#endif
        xcd_barrier(bar);
        ph_outproj(PQ, LL, BID, NBLK, smem);
        ph_convert_moe(PQ, LL, BID, NBLK);
#if PROBE == 1
        ph_convert_moe(PQ, LL, BID, NBLK);
#endif
        xcd_barrier(bar);
        ph_norm2_router(PQ, LL, BID, NBLK, smem);
        xcd_barrier(bar);
        ph_moe_gather(PQ, BID, NBLK, smem);
        xcd_barrier(bar);
        ph_moe1b(PQ, BID, NBLK, smem);
#if PROBE == 8
        ph_moe1b(PQ, BID, NBLK, smem);
#endif
        xcd_barrier(bar);
        ph_moe2b(PQ, LL, BID, NBLK, smem);
        if (LL == 0 && BID >= 64) ph_convert_mix(PQ, 1, BID - 64, NBLK - 64);
        xcd_barrier(bar);
    }
    ph_final(PQ, BID, NBLK);
}

static inline size_t al(size_t x) { return (x + 255) & ~(size_t)255; }
extern "C" void kernel_launch(void* const* d_in, const int* in_sizes, int n_in, void* d_out, int out_size, void* d_ws, size_t ws_size, hipStream_t stream) {
    Params p{};
    for (int i = 0; i < N_IN; ++i) p.in[i] = (const float*)d_in[i];
    p.pos = (const int*)d_in[I_POS];
    p.out = (float*)d_out;
    char* w = (char*)d_ws; size_t off = 0;
    auto take = [&](size_t bytes) { char* r = w + off; off += al(bytes); return r; };
    p.bar = (unsigned*)take(XCD_BAR_WORDS * 4);
    p.mods = (float*)take(2 * 4 * 6144 * 4);
    p.bcnt = (int*)take(256); p.qctr = (int*)take(256);
    p.s5c = (float*)take((size_t)2 * 16 * 64 * 36 * 4); p.ropet = (float*)take((size_t)NTOK * 32 * 2 * 4);
    p.Wp = (h16*)take((size_t)2560 * DM * 2); p.Widx = (h16*)take((size_t)256 * 3072 * 2); p.Wg = (h16*)take((size_t)4096 * DM * 2);
    p.Wb = (h16*)take((size_t)4096 * 256 * 2); p.Wo = (h16*)take((size_t)DM * DM * 2); p.Wglu = (h16*)take(256 * 256 * 2);
    p.x1 = (float*)take((size_t)NTOK * DM * 4);
    p.h_hi = (h16*)take((size_t)NTOK * DM * 2); p.h_lo = (h16*)take((size_t)NTOK * DM * 2); p.branches = p.h_lo;
    p.cw = (float*)take((size_t)NTOK * 2 * 4);
    p.lists = (int*)take((size_t)24 * LCAP * 4);
    const size_t offR = off;
    p.proj = (h16*)take((size_t)NTOK * PJ * 2); p.idxf = (float*)take((size_t)NTOK * IDXLD * 4);
    p.vT = (h16*)take((size_t)4 * 256 * SEQ * 2); p.dmask = (unsigned long long*)take((size_t)4 * 133120 * 8);
    p.ybuf = (h16*)take((size_t)NTOK * 256 * 2); p.s5E = (float*)take((size_t)4 * 64 * 16 * 64 * 2 * 4); p.s5H = (float*)take((size_t)4 * 64 * 16 * 64 * 2 * 4);
    p.rg_hl = (float*)take((size_t)NTOK * 256 * 4); p.rg_cp = (float*)take((size_t)NTOK * 256 * 4); p.rg_agg = (float*)take((size_t)4 * 128 * 256 * 2 * 4);
    p.rw_g = (h16*)take((size_t)NTOK * 256 * 2); p.rw_bonus = (h16*)take((size_t)NTOK * 256 * 2);
    p.rw_W = (h16*)take((size_t)1024 * 4096 * 2); p.rw_U0 = (h16*)take((size_t)1024 * 4096 * 2); p.rw_Ry = (h16*)take((size_t)1024 * 4096 * 2); p.rw_Y0 = (h16*)take((size_t)1024 * 4096 * 2);
    p.rw_Be = (h16*)take((size_t)1024 * 4096 * 2); p.rw_VK = (h16*)take((size_t)1024 * 4096 * 2); p.rw_S0 = (h16*)take((size_t)1024 * 4096 * 2); p.rw_gam = (float*)take((size_t)1024 * 64 * 4);
    const size_t endMix = off;
    p.dsa_op = (h16*)p.rg_hl; p.dsa_ml = p.rg_cp;
    p.gates = p.proj;
    p.mixed = p.rw_g;
    if ((char*)p.gates + (size_t)NTOK * 4096 * 2 > (char*)p.mixed) { fprintf(stderr, "gates/mixed overlap\n"); return; }
    off = offR;
    p.We13 = (h16*)take((size_t)16 * 1024 * DM * 2); p.We2 = (h16*)take((size_t)16 * 1024 * 512 * 2); p.act = (h16*)take((size_t)88 * 256 * 1024 * 2); p.h2s = (h16*)take((size_t)88 * 256 * 1024 * 2);
    const size_t endMoe = off;
    const size_t need = endMix > endMoe ? endMix : endMoe;
    if (need > ws_size || (char*)p.h2s + (size_t)88 * 256 * 1024 * 2 > (char*)p.mixed) { fprintf(stderr, "workspace layout problem: need %zu have %zu\n", need, ws_size); return; }

    static int grid = 0;
    if (!grid) {
        (void)hipFuncSetAttribute((const void*)k_mega, hipFuncAttributeMaxDynamicSharedMemorySize, MEGA_LDS);
        int dev = 0, cus = 0, per_cu = 0;
        (void)hipGetDevice(&dev);
        (void)hipDeviceGetAttribute(&cus, hipDeviceAttributeMultiprocessorCount, dev);
        (void)hipOccupancyMaxActiveBlocksPerMultiprocessor(&per_cu, (const void*)k_mega, 512, MEGA_LDS);
        if (per_cu < 1) { fprintf(stderr, "k_mega not launchable (occupancy 0)\n"); return; }
        grid = cus;
        fprintf(stderr, "k_mega: grid %d (cus %d, per_cu %d), ws need %zu have %zu\n", grid, cus, per_cu, need, ws_size);
    }
    (void)hipMemsetAsync(p.bar, 0, XCD_BAR_WORDS * 4, stream);
    k_mega<<<grid, 512, MEGA_LDS, stream>>>(p);
}
```

```cpp
#ifndef PROBE
#define PROBE 0
#endif
#include <hip/hip_runtime.h>
#include <stdint.h>
#include <stdio.h>
#include <math.h>

typedef _Float16 h16;
typedef _Float16 h16x8 __attribute__((ext_vector_type(8)));
typedef _Float16 h16x4 __attribute__((ext_vector_type(4)));
typedef _Float16 h16x2 __attribute__((ext_vector_type(2)));
typedef float f32x4 __attribute__((ext_vector_type(4)));
typedef unsigned u32x4 __attribute__((ext_vector_type(4)));

#define NTOK 16384
#define SEQ 4096
#define NBATCH 4
#define DM 1024
#define DINW 2596
#define PJ 2432
#define IDXLD 192
#define P_U 0
#define P_Q 256
#define P_K 512
#define P_V 768
#define P_RGX 1024
#define P_RGG 1280
#define P_RW 1536
#define LCAP 16384

enum { I_X = 0, I_C, I_POS, I_ADAW, I_ADAB, I_MNG, I_WIN, I_GATEW, I_GATEB, I_BRW, I_OUTW,
       I_S5LRE, I_S5LIM, I_S5LS, I_S5BRE, I_S5BIM, I_S5CRE, I_S5CIM, I_S5D, I_S5GW, I_S5GB,
       I_RGCW, I_RGCB, I_RGWR, I_RGBR, I_RGWI, I_RGBI, I_RGLAM,
       I_RWMU, I_RWW0, I_RWWUP, I_RWA0, I_RWAUP, I_RWGUP, I_RWKK, I_RWKA, I_RWRK, I_RWGNW, I_RWGNB,
       I_FNG, I_ROUTW, I_ROUTB, I_W1, I_W3, I_W2, I_FINALG, N_IN };

struct Params {
    const float* in[N_IN];
    const int* pos;
    float* out;
    unsigned* bar;
    float* mods;
    h16 *Wp, *Widx, *Wg, *Wb, *Wo, *Wglu, *We13, *We2;
    float* x1;
    h16 *h_hi, *h_lo, *branches;
    h16* proj; float* idxf;
    h16* ybuf; float *s5E, *s5H, *s5c, *ropet;
    h16* vT; unsigned long long* dmask; int* qctr; float* dsa_ml; h16* dsa_op;
    float *rg_hl, *rg_cp, *rg_agg;
    h16 *rw_r, *rw_w, *rw_k, *rw_kk, *rw_b, *rw_g, *rw_bonus, *rw_v; float* rw_y;
    h16 *rw_W, *rw_U0, *rw_Ry, *rw_Y0, *rw_Be, *rw_VK, *rw_S0; float* rw_gam;
    h16* mixed; h16* gates;
    h16* act; h16* h2s; int* lists; int* bcnt; float* cw;
};

typedef const __attribute__((address_space(4))) Params& CP;
__device__ __forceinline__ float sigm(float x) { return __builtin_amdgcn_rcpf(1.f + __expf(-x)); }
__device__ __forceinline__ float tanh_fast(float x) { return 1.f - 2.f * __builtin_amdgcn_rcpf(1.f + __expf(2.f * x)); }
__device__ __forceinline__ float gelu_tanh(float x) { return 0.5f * x * (1.f + tanh_fast(0.7978845608028654f * (x + 0.044715f * x * x * x))); }
__device__ __forceinline__ float softplusf_(float x) { return fmaxf(x, 0.f) + __logf(1.f + __expf(-fabsf(x))); }
template <int CTRL> __device__ __forceinline__ float dppf(float x) { return __int_as_float(__builtin_amdgcn_update_dpp(0, __float_as_int(x), CTRL, 0xf, 0xf, false)); }
__device__ __forceinline__ float x16_sum(float x) { auto r = __builtin_amdgcn_permlane16_swap(__float_as_uint(x), __float_as_uint(x), false, false); return __uint_as_float(r[0]) + __uint_as_float(r[1]); }
__device__ __forceinline__ float x32_sum(float x) { auto r = __builtin_amdgcn_permlane32_swap(__float_as_uint(x), __float_as_uint(x), false, false); return __uint_as_float(r[0]) + __uint_as_float(r[1]); }
__device__ __forceinline__ float x16_max(float x) { auto r = __builtin_amdgcn_permlane16_swap(__float_as_uint(x), __float_as_uint(x), false, false); return fmaxf(__uint_as_float(r[0]), __uint_as_float(r[1])); }
__device__ __forceinline__ float x32_max(float x) { auto r = __builtin_amdgcn_permlane32_swap(__float_as_uint(x), __float_as_uint(x), false, false); return fmaxf(__uint_as_float(r[0]), __uint_as_float(r[1])); }
__device__ __forceinline__ int x16_isum(int x) { auto r = __builtin_amdgcn_permlane16_swap((unsigned)x, (unsigned)x, false, false); return (int)(r[0] + r[1]); }
__device__ __forceinline__ int x32_isum(int x) { auto r = __builtin_amdgcn_permlane32_swap((unsigned)x, (unsigned)x, false, false); return (int)(r[0] + r[1]); }
__device__ __forceinline__ float rows_sum(float x) { return x32_sum(x16_sum(x)); }
__device__ __forceinline__ float rows_max(float x) { return x32_max(x16_max(x)); }
__device__ __forceinline__ int rows_isum(int x) { return x32_isum(x16_isum(x)); }
template <int CTRL> __device__ __forceinline__ int dppi(int x) { return __builtin_amdgcn_update_dpp(0, x, CTRL, 0xf, 0xf, false); }
__device__ __forceinline__ int wave_isum(int v) { v += dppi<0xB1>(v); v += dppi<0x4E>(v); v += dppi<0x124>(v); v += dppi<0x128>(v); return rows_isum(v); }
__device__ __forceinline__ float wave_sum(float v) { v += dppf<0xB1>(v); v += dppf<0x4E>(v); v += dppf<0x124>(v); v += dppf<0x128>(v); return rows_sum(v); }
__device__ __forceinline__ float wave_max(float v) { v = fmaxf(v, dppf<0xB1>(v)); v = fmaxf(v, dppf<0x4E>(v)); v = fmaxf(v, dppf<0x124>(v)); v = fmaxf(v, dppf<0x128>(v)); return rows_max(v); }
__device__ __forceinline__ float egl_get(const float* egl, int k) { return egl[k]; }
__device__ __forceinline__ h16x4 pack4(float a, float b, float c, float d) { h16x4 r; r[0] = (h16)a; r[1] = (h16)b; r[2] = (h16)c; r[3] = (h16)d; return r; }

__device__ __forceinline__ int oint(int x) { asm volatile("" : "+s"(x)); return x; }
__device__ __forceinline__ int otid() { int t = threadIdx.x; asm volatile("" : "+v"(t)); return t; }
__device__ __forceinline__ void st16_wt(void* ptr, h16x8 v) { asm volatile("global_store_dwordx4 %0, %1, off sc1\n\ts_nop 1" :: "v"(ptr), "v"(__builtin_bit_cast(u32x4, v)) : "memory"); }
__device__ __forceinline__ void lds_barrier() { asm volatile("s_waitcnt lgkmcnt(0)\n\ts_barrier" ::: "memory"); }
__device__ __forceinline__ void ph_mods(CP p, int bid, int nblk, char* smem) {
    float* ca = (float*)smem;
    float* part = ca + 4 * DM;
    const int tid = otid();
    __syncthreads();
    for (int i = tid; i < 4 * DM; i += 512) { float c = p.in[I_C][i]; ca[i] = c * sigm(c); }
    __syncthreads();
    for (int u = bid; u < 192; u += nblk) {
        const int l = u / 96, j = (u % 96) * 64 + (tid & 63), ks = tid >> 6;
        const float* w = p.in[I_ADAW] + (size_t)l * DM * 6144 + (size_t)(ks * 128) * 6144 + j;
        float a0 = 0, a1 = 0, a2 = 0, a3 = 0;
#pragma unroll 8
        for (int k = 0; k < 128; ++k) { const float wv = w[(size_t)k * 6144]; const int kk = ks * 128 + k; a0 += ca[kk] * wv; a1 += ca[DM + kk] * wv; a2 += ca[2 * DM + kk] * wv; a3 += ca[3 * DM + kk] * wv; }
        __syncthreads();
        part[(ks * 4 + 0) * 64 + (tid & 63)] = a0; part[(ks * 4 + 1) * 64 + (tid & 63)] = a1; part[(ks * 4 + 2) * 64 + (tid & 63)] = a2; part[(ks * 4 + 3) * 64 + (tid & 63)] = a3;
        __syncthreads();
        if (tid < 256) {
            const int bb = tid >> 6, cc = tid & 63; float sum = p.in[I_ADAB][l * 6144 + (u % 96) * 64 + cc];
#pragma unroll
            for (int q = 0; q < 8; ++q) sum += part[(q * 4 + bb) * 64 + cc];
            p.mods[(size_t)l * 4 * 6144 + (size_t)bb * 6144 + (u % 96) * 64 + cc] = sum;
        }
    }
    __syncthreads();
}
__device__ __forceinline__ void ph_tables(CP p, int bid, int nblk) {
    const int gt = bid * 512 + otid(), gn = nblk * 512;
    if (gt < 2) p.qctr[gt] = 0;
    for (int i = gt; i < NTOK * 32; i += gn) {
        const int tok = i >> 5, f = i & 31;
        const double ang = (double)p.pos[tok] * exp(-(double)f * (1.0 / 32.0) * 9.210340371976184);
        double sn, cs; sincos(ang, &sn, &cs);
        p.ropet[(size_t)i * 2] = (float)cs; p.ropet[(size_t)i * 2 + 1] = (float)sn;
    }
    for (int i = gt; i < 2 * 16 * 64; i += gn) {
        const int g = (i >> 6) & 15, l = i >> 10;
        const double lre = p.in[I_S5LRE][i], lim = p.in[I_S5LIM][i], st = exp((double)p.in[I_S5LS][l * 16 + g]);
        const double er = exp(lre * st); double sn, cs; sincos(lim * st, &sn, &cs);
        const double lbr = er * cs, lbi = er * sn;
        const double nr = lbr - 1.0, ni = lbi, den = lre * lre + lim * lim;
        const double fr = (nr * lre + ni * lim) / den, fi = (ni * lre - nr * lim) / den;
        const double e64 = exp(64.0 * lre * st); double s64, c64; sincos(64.0 * lim * st, &s64, &c64);
        float* o = p.s5c + (size_t)i * 36;
        o[0] = (float)lbr; o[1] = (float)lbi; o[2] = (float)(e64 * c64); o[3] = (float)(e64 * s64);
        for (int cc = 0; cc < 16; ++cc) { const double br = p.in[I_S5BRE][(size_t)i * 16 + cc], bi = p.in[I_S5BIM][(size_t)i * 16 + cc];
                                          o[4 + cc] = (float)(fr * br - fi * bi); o[20 + cc] = (float)(fr * bi + fi * br); }
    }
}
template <class SRC>
__device__ __forceinline__ void convT(h16* dst, int dstld, int nrows, int K, int koff, const SRC& src, int bid, int nblk, char* smem) {
    h16* tl = (h16*)smem;
    const int tid = otid();
    const int ntn = nrows >> 6, ntk = K >> 6;
    for (int t = bid; t < ntn * ntk; t += nblk) {
        const int n0 = (t % ntn) * 64, k0 = (t / ntn) * 64;
        float v[8];
#pragma unroll
        for (int q = 0; q < 8; ++q) v[q] = src(n0 + (tid & 63), k0 + (tid >> 6) + 8 * q);
        __syncthreads();
#pragma unroll
        for (int q = 0; q < 8; ++q) tl[(tid & 63) * 72 + (tid >> 6) + 8 * q] = (h16)v[q];
        __syncthreads();
        *(h16x8*)(dst + (size_t)(n0 + (tid >> 3)) * dstld + koff + k0 + (tid & 7) * 8) = *(const h16x8*)&tl[(tid >> 3) * 72 + (tid & 7) * 8];
    }
    __syncthreads();
}
__device__ __forceinline__ void ph_convert_mix(CP p, int l, int bid, int nblk, char* smem) {
    { const float* s = p.in[I_WIN] + (size_t)l * DM * DINW;
      convT(p.Wp, DM, 2560, DM, 0, [=](int n, int k) { return n < PJ ? s[(size_t)k * DINW + (n < 1024 ? n : n + 164)] : 0.f; }, bid, nblk, smem);
      convT(p.Widx, 3072, 256, DM, 0, [=](int n, int k) { return n < 164 ? s[(size_t)k * DINW + 1024 + n] : 0.f; }, bid, nblk, smem);
      convT(p.Widx, 3072, 256, DM, 1024, [=](int n, int k) { return n < 164 ? s[(size_t)k * DINW + 1024 + n] : 0.f; }, bid, nblk, smem);
      convT(p.Widx, 3072, 256, DM, 2048, [=](int n, int k) { float w = n < 164 ? s[(size_t)k * DINW + 1024 + n] : 0.f; float hi = (float)(h16)w; return w - hi; }, bid, nblk, smem); }
    { const float* s = p.in[I_GATEW] + (size_t)l * DM * 4096;
      convT(p.Wg, DM, 4096, DM, 0, [=](int n, int k) { return s[(size_t)k * 4096 + n]; }, bid, nblk, smem); }
    { const float* s = p.in[I_BRW] + (size_t)l * 4 * 256 * DM;
      convT(p.Wb, 256, 4096, 256, 0, [=](int n, int k) { int br = n >> 10, d = n & 1023; return s[(size_t)br * 256 * DM + (size_t)k * DM + d]; }, bid, nblk, smem); }
    { const float* s = p.in[I_OUTW] + (size_t)l * DM * DM;
      convT(p.Wo, DM, DM, DM, 0, [=](int n, int k) { return s[(size_t)k * DM + n]; }, bid, nblk, smem); }
    { const float* s = p.in[I_S5GW] + (size_t)l * 256 * 256;
      convT(p.Wglu, 256, 256, 256, 0, [=](int n, int k) { return s[(size_t)k * 256 + n]; }, bid, nblk, smem); }
}
__device__ __forceinline__ void ph_convert_moe(CP p, int l, int bid, int nblk, char* smem) {
    const float* s1 = p.in[I_W1] + (size_t)l * 16 * DM * 512;
    const float* s3 = p.in[I_W3] + (size_t)l * 16 * DM * 512;
    const float* s2 = p.in[I_W2] + (size_t)l * 16 * 512 * DM;
    convT(p.We13, DM, 16 * 1024, DM, 0, [=](int n, int k) { int e = n >> 10, r = n & 1023; int c = (r >> 3) * 4 + (r & 3); const float* s = ((r >> 2) & 1) ? s3 : s1;
                                                           return s[(size_t)e * DM * 512 + (size_t)k * 512 + c]; }, bid, nblk, smem);
    convT(p.We2, 512, 16 * 1024, 512, 0, [=](int n, int k) { int e = n >> 10, c = n & 1023; return s2[(size_t)e * 512 * DM + (size_t)k * DM + c]; }, bid, nblk, smem);
}

__device__ __forceinline__ void ph_norm1(CP p, int l, int bid, int nblk) {
    const float* xin = l == 0 ? p.in[I_X] : p.x1;
    const int lane = otid() & 63, wv = otid() >> 6;
    if (bid == 0 && otid() < 24) p.bcnt[otid()] = 0;
    for (int tok = bid * 8 + wv; tok < NTOK; tok += nblk * 8) {
        const int b = tok / SEQ;
        const float* xr = xin + (size_t)tok * DM;
        f32x4 v[4]; float ss = 0.f;
#pragma unroll
        for (int i = 0; i < 4; ++i) { v[i] = *(const f32x4*)(xr + i * 256 + lane * 4); ss += v[i][0] * v[i][0] + v[i][1] * v[i][1] + v[i][2] * v[i][2] + v[i][3] * v[i][3]; }
        ss = wave_sum(ss);
        const float rs = rsqrtf(ss * (1.f / DM) + 1e-6f);
        const float* g = p.in[I_MNG] + l * DM;
        const float* md = p.mods + ((size_t)l * 4 + b) * 6144;
#pragma unroll
        for (int i = 0; i < 4; ++i) {
            const int c = i * 256 + lane * 4;
            f32x4 gg = *(const f32x4*)(g + c), sh = *(const f32x4*)(md + c), sc = *(const f32x4*)(md + 1024 + c);
            float hv[4]; h16x4 hi, lo;
#pragma unroll
            for (int e = 0; e < 4; ++e) { hv[e] = v[i][e] * rs * gg[e] * (1.f + sc[e]) + sh[e]; hi[e] = (h16)hv[e]; lo[e] = (h16)(hv[e] - (float)hi[e]); }
            *(h16x4*)(p.h_hi + (size_t)tok * DM + c) = hi;
            *(h16x4*)(p.h_lo + (size_t)tok * DM + c) = lo;
        }
    }
}

#define LDT 72
template <int BM, class AF, class BF, class SEG>
__device__ __forceinline__ void gemm_kloop_seg(char* smem, int K, const AF& af, const BF& bf, f32x4 (&acc)[BM / 64][4], const SEG& seg) {
    constexpr int MT = BM / 64, WM = BM / 4, NA = BM / 64;
    h16* sA = (h16*)smem; h16* sB = sA + 2 * BM * LDT;
    const int tid = otid(), lane = tid & 63, wave = tid >> 6, wm = wave >> 1, wn = wave & 1;
    const int lrow = tid >> 3, lkc = (tid & 7) * 8;
    u32x4 ra0[NA], rb0[2], ra1[NA], rb1[2];
    const int nk = K / 64;
#define GK_LOAD(RA, RB, KT) do { const int k_ = (KT) * 64 + lkc; \
        _Pragma("unroll") for (int i = 0; i < NA; ++i) RA[i] = *(const u32x4*)af(lrow + i * 64, k_); \
        _Pragma("unroll") for (int i = 0; i < 2; ++i) RB[i] = *(const u32x4*)bf(lrow + i * 64, k_); } while (0)
#define GK_STORE(RA, RB, BUF) do { h16* nA_ = sA + (BUF) * BM * LDT; h16* nB_ = sB + (BUF) * 128 * LDT; \
        _Pragma("unroll") for (int i = 0; i < NA; ++i) *(u32x4*)&nA_[(lrow + i * 64) * LDT + lkc] = RA[i]; \
        _Pragma("unroll") for (int i = 0; i < 2; ++i) *(u32x4*)&nB_[(lrow + i * 64) * LDT + lkc] = RB[i]; } while (0)
#define GK_COMPUTE(BUF) do { const h16* cA = sA + (BUF) * BM * LDT; const h16* cB = sB + (BUF) * 128 * LDT; \
        _Pragma("unroll") for (int ks = 0; ks < 2; ++ks) { h16x8 a[MT], b[4]; \
            _Pragma("unroll") for (int i = 0; i < MT; ++i) a[i] = *(const h16x8*)&cA[(wm * WM + i * 16 + (lane & 15)) * LDT + ks * 32 + (lane >> 4) * 8]; \
            _Pragma("unroll") for (int j = 0; j < 4; ++j) b[j] = *(const h16x8*)&cB[(wn * 64 + j * 16 + (lane & 15)) * LDT + ks * 32 + (lane >> 4) * 8]; \
            _Pragma("unroll") for (int i = 0; i < MT; ++i) _Pragma("unroll") for (int j = 0; j < 4; ++j) acc[i][j] = __builtin_amdgcn_mfma_f32_16x16x32_f16(b[j], a[i], acc[i][j], 0, 0, 0); } } while (0)
    GK_LOAD(ra0, rb0, 0);
    if (nk > 1) GK_LOAD(ra1, rb1, 1);
    GK_STORE(ra0, rb0, 0);
    lds_barrier();
    for (int kt = 0; kt < nk; kt += 2) {
        if (kt + 2 < nk) GK_LOAD(ra0, rb0, kt + 2);
        GK_COMPUTE(0);
        seg(kt);
        if (kt + 1 < nk) GK_STORE(ra1, rb1, 1);
        lds_barrier();
        if (kt + 1 < nk) {
            if (kt + 3 < nk) GK_LOAD(ra1, rb1, kt + 3);
            GK_COMPUTE(1);
            seg(kt + 1);
            if (kt + 2 < nk) GK_STORE(ra0, rb0, 0);
            lds_barrier();
        }
    }
#undef GK_LOAD
#undef GK_STORE
#undef GK_COMPUTE
}
template <int BM, class AF, class BF>
__device__ __forceinline__ void gemm_kloop(char* smem, int K, const AF& af, const BF& bf, f32x4 (&acc)[BM / 64][4]) {
    gemm_kloop_seg<BM>(smem, K, af, bf, acc, [](int) {});
}
template <int BM> __device__ __forceinline__ void zero_acc(f32x4 (&acc)[BM / 64][4]) {
#pragma unroll
    for (int i = 0; i < BM / 64; ++i)
#pragma unroll
        for (int j = 0; j < 4; ++j) acc[i][j] = (f32x4){0.f, 0.f, 0.f, 0.f};
}
template <int BM, class EPI>
__device__ __forceinline__ void gemm_epi(const f32x4 (&acc)[BM / 64][4], const EPI& epi) {
    const int lane = otid() & 63, wave = otid() >> 6, wm = wave >> 1, wn = wave & 1;
#pragma unroll
    for (int i = 0; i < BM / 64; ++i)
#pragma unroll
        for (int j = 0; j < 4; ++j) epi(wm * (BM / 4) + i * 16 + (lane & 15), wn * 64 + j * 16 + 4 * (lane >> 4), acc[i][j]);
}
#define GEMM_LDS(BM) (2 * (BM) * LDT * 2 + 2 * 128 * LDT * 2)


namespace pg8 {
#define PG8_LAS __attribute__((address_space(3)))
constexpr int BM = 256, BK = 64, HALF = 128, HTB = HALF * BK * 2, STAGE_BYTES = 8 * HTB, NXCD = 8, WGM = 8;
__device__ __forceinline__ int lds_byte(int r, int c) { const int st = (r >> 4) * 2 + (c >> 5), rr = r & 15, cc = c & 31, ob = rr * 64 + cc * 2; return st * 1024 + (ob ^ (((ob >> 9) & 1) << 5)); }
__device__ __forceinline__ void stage_rc(int b, int& R, int& C) { const int st = b / 1024, sb = b % 1024, swz = sb ^ (((sb >> 9) & 1) << 5); R = (st >> 1) * 16 + swz / 64; C = (st & 1) * 32 + (swz % 64) / 2; }
__device__ __forceinline__ int perm32(int rho) { const int n = rho >> 4, i = rho & 15; return 8 * (i >> 2) + 4 * n + (i & 3); }
struct Unit { int pm, pn; int bucket, i0, cnt, ea, eb; };
struct Gemm { const h16* A; const h16* Bt; int M, N, K, lda, ldb; };
struct StaticOrder {
    int nM, nN, nwg, G, c;
    __device__ void init(int M, int N, int G_, int c_) { nM = M / BM; nN = N / BM; nwg = nM * nN; G = G_; c = c_; }
    __device__ bool next(int i, Unit& u) const {
        const long L = (long)i * G + c; if (L >= nwg) return false;
        int wgid = (int)L; { const int q = nwg / NXCD, r = nwg % NXCD, xcd = wgid % NXCD, off = wgid / NXCD; wgid = (xcd < r ? xcd * (q + 1) : r * (q + 1) + (xcd - r) * q) + off; }
        const int nig = WGM * nN, gid = wgid / nig, fm = gid * WGM, gsz = (nM - fm) < WGM ? (nM - fm) : WGM;
        u.pm = fm + ((wgid % nig) % gsz); u.pn = (wgid % nig) / gsz; return true;
    }
    __device__ __forceinline__ int ksplit() const { return 1 << 30; }
    __device__ __forceinline__ void b_ptr(const Gemm& g, const Unit& u, size_t tsB, const char*& lo, const char*& hi) const { lo = hi = (const char*)g.Bt + (size_t)u.pn * tsB; }
};
template <class Epi, class Sched>
__device__ __forceinline__ void gemm_phase(PG8_LAS unsigned char* lds, const Gemm g, const Sched& S, const Epi& E) {
    const int tid = otid(), wid = __builtin_amdgcn_readfirstlane(tid >> 6), lane = tid & 63, wr = wid >> 2, wc = wid & 3, fr = lane & 15, fq = lane >> 4;
    const int K = g.K, nt = K / BK;
    unsigned voffA[2], voffB[2];
#pragma unroll
    for (int i = 0; i < 2; ++i) { int R, C; stage_rc(tid * 16 + i * 8192, R, C); const int Rb = Epi::PERM ? ((R & ~31) + perm32(R & 31)) : R;
        voffA[i] = (unsigned)(R * g.lda + C) * 2u; voffB[i] = (unsigned)(Rb * g.ldb + C) * 2u; }
    const size_t kstep = (size_t)(BK * 2);
    const size_t hsA = (size_t)HALF * g.lda * 2, hsB = (size_t)HALF * g.ldb * 2;
    const int ksp = S.ksplit();
    const size_t tsA = 2 * hsA, tsB = 2 * hsB;
    const unsigned ldsw = (unsigned)wid * 1024u;
    const int aoff = lds_byte(wr * 64 + fr, fq * 8), boff = lds_byte(wc * 32 + fr, fq * 8);
#define PG8_SA(b, h) (((b) * 2 + (h)) * HTB)
#define PG8_SB(b, h) ((4 + (b) * 2 + (h)) * HTB)
#define PG8_STAGE(bufoff, gbase, voff) do { _Pragma("unroll") for (int _i = 0; _i < 2; ++_i) \
        __builtin_amdgcn_global_load_lds((const unsigned*)((const char*)(gbase) + (voff)[_i]), (PG8_LAS unsigned*)(lds + (bufoff) + ldsw + _i * 8192), 16, 0, 0); } while (0)
#define PG8_LDA(dst, b, h) do { _Pragma("unroll") for (int m = 0; m < 4; ++m) _Pragma("unroll") for (int k = 0; k < 2; ++k) dst[m][k] = *(const PG8_LAS h16x8*)(lds + PG8_SA(b, h) + aoff + m * 2048 + k * 1024); } while (0)
#define PG8_LDB(dst, b, h) do { _Pragma("unroll") for (int n = 0; n < 2; ++n) _Pragma("unroll") for (int k = 0; k < 2; ++k) dst[n][k] = *(const PG8_LAS h16x8*)(lds + PG8_SB(b, h) + boff + n * 2048 + k * 1024); } while (0)
#define PG8_MMA(ai, bj, At, Bt) do { __builtin_amdgcn_s_setprio(1); _Pragma("unroll") for (int m = 0; m < 4; ++m) _Pragma("unroll") for (int n = 0; n < 2; ++n) _Pragma("unroll") for (int k = 0; k < 2; ++k) \
        acc[ai][bj][m][n] = __builtin_amdgcn_mfma_f32_16x16x32_f16(Bt[n][k], At[m][k], acc[ai][bj][m][n], 0, 0, 0); __builtin_amdgcn_s_setprio(0); } while (0)
#define PG8_WAIT_V(n) asm volatile("s_waitcnt vmcnt(" #n ")" ::: "memory")
#define PG8_WAIT_L(n) asm volatile("s_waitcnt lgkmcnt(" #n ")" ::: "memory")
#define PG8_BAR __builtin_amdgcn_s_barrier()
#define PG8_SCHED __builtin_amdgcn_sched_barrier(0)
    Unit cur, nxt; int ui = 0;
    if (!S.next(0, cur)) return;
    f32x4 acc[2][2][4][2];
#pragma unroll
    for (int a = 0; a < 2; ++a)
#pragma unroll
        for (int b = 0; b < 2; ++b)
#pragma unroll
            for (int m = 0; m < 4; ++m)
#pragma unroll
                for (int n = 0; n < 2; ++n) acc[a][b][m][n] = (f32x4){0.f, 0.f, 0.f, 0.f};
    h16x8 At[4][2], B0[2][2], B1[2][2];
    const char* cA = (const char*)g.A + (size_t)cur.pm * tsA; const char* cB; const char* cBh; S.b_ptr(g, cur, tsB, cB, cBh);
    PG8_STAGE(PG8_SB(0, 0), cB, voffB); PG8_STAGE(PG8_SA(0, 0), cA, voffA); PG8_STAGE(PG8_SB(0, 1), cB + hsB, voffB); PG8_STAGE(PG8_SA(0, 1), cA + hsA, voffA);
    if (wr == 1) PG8_BAR;
    PG8_WAIT_V(4); PG8_BAR;
    PG8_STAGE(PG8_SB(1, 0), cB + kstep, voffB); PG8_STAGE(PG8_SA(1, 0), cA + kstep, voffA); PG8_STAGE(PG8_SB(1, 1), cB + hsB + kstep, voffB);
    PG8_WAIT_V(6); PG8_BAR;
    for (;;) {
        const bool has_next = S.next(ui + 1, nxt);
        const char* nA = has_next ? (const char*)g.A + (size_t)nxt.pm * tsA : cA; const char* nB = cB; const char* nBh = cBh; if (has_next) S.b_ptr(g, nxt, tsB, nB, nBh);
        for (int t = 0; t < nt; t += 2) {
            const bool last = (t == nt - 2);
            const char* a1 = cA + (size_t)(t + 1) * kstep;
            const char* a2 = last ? nA : cA + (size_t)(t + 2) * kstep; const char* b2 = last ? nB : ((t + 2) < ksp ? cB : cBh) + (size_t)(t + 2) * kstep;
            const char* a3 = a2 + kstep; const char* b3 = b2 + kstep;
            PG8_LDB(B0, 0, 0); PG8_SCHED; PG8_LDA(At, 0, 0); PG8_STAGE(PG8_SA(1, 1), a1 + hsA, voffA);
            PG8_WAIT_L(8); PG8_BAR; PG8_WAIT_L(0); PG8_MMA(0, 0, At, B0); PG8_BAR; PG8_SCHED;
            PG8_LDB(B1, 0, 1); PG8_STAGE(PG8_SB(0, 0), b2, voffB);
            PG8_BAR; PG8_WAIT_L(0); PG8_MMA(0, 1, At, B1); PG8_BAR;
            PG8_LDA(At, 0, 1); PG8_STAGE(PG8_SA(0, 0), a2, voffA);
            PG8_BAR; PG8_WAIT_L(0); PG8_MMA(1, 0, At, B0); PG8_BAR; PG8_SCHED;
            PG8_STAGE(PG8_SB(0, 1), b2 + hsB, voffB);
            PG8_WAIT_V(6); PG8_BAR; PG8_MMA(1, 1, At, B1); PG8_BAR;
            PG8_LDB(B0, 1, 0); PG8_SCHED; PG8_LDA(At, 1, 0); PG8_STAGE(PG8_SA(0, 1), a2 + hsA, voffA);
            PG8_WAIT_L(8); PG8_BAR; PG8_WAIT_L(0); PG8_MMA(0, 0, At, B0); PG8_BAR; PG8_SCHED;
            PG8_LDB(B1, 1, 1); PG8_STAGE(PG8_SB(1, 0), b3, voffB);
            PG8_BAR; PG8_WAIT_L(0); PG8_MMA(0, 1, At, B1); PG8_BAR;
            PG8_LDA(At, 1, 1); PG8_STAGE(PG8_SA(1, 0), a3, voffA);
            PG8_BAR; PG8_WAIT_L(0); PG8_MMA(1, 0, At, B0); PG8_BAR; PG8_SCHED;
            PG8_STAGE(PG8_SB(1, 1), b3 + hsB, voffB);
            PG8_WAIT_V(6); PG8_BAR; PG8_MMA(1, 1, At, B1); PG8_BAR;
        }
        E(acc, cur, wr, wc, fr, fq);
        if (!has_next) break;
#pragma unroll
        for (int a = 0; a < 2; ++a)
#pragma unroll
            for (int b = 0; b < 2; ++b)
#pragma unroll
                for (int m = 0; m < 4; ++m)
#pragma unroll
                    for (int n = 0; n < 2; ++n) acc[a][b][m][n] = (f32x4){0.f, 0.f, 0.f, 0.f};
        cur = nxt; cA = nA; cB = nB; cBh = nBh; ++ui;
    }
    PG8_WAIT_V(0);
    if (wr == 0) PG8_BAR;
    PG8_BAR;
#undef PG8_SA
#undef PG8_SB
#undef PG8_STAGE
#undef PG8_LDA
#undef PG8_LDB
#undef PG8_MMA
#undef PG8_WAIT_V
#undef PG8_WAIT_L
#undef PG8_BAR
#undef PG8_SCHED
}
__device__ __forceinline__ h16x8 pack8(const f32x4& a, const f32x4& b) { h16x8 r; r[0] = (h16)a[0]; r[1] = (h16)a[1]; r[2] = (h16)a[2]; r[3] = (h16)a[3]; r[4] = (h16)b[0]; r[5] = (h16)b[1]; r[6] = (h16)b[2]; r[7] = (h16)b[3]; return r; }
template <int ACT> struct EpiH16 {
    static constexpr bool PERM = true;
    h16* O; int ldc; int ncols; const float* bias;
    __device__ __forceinline__ void operator()(const f32x4 (&acc)[2][2][4][2], const Unit& u, int wr, int wc, int fr, int fq) const {
        const int row0 = u.pm * BM + wr * 64 + fr, col0 = u.pn * BM + wc * 32 + 8 * fq;
#pragma unroll
        for (int bj = 0; bj < 2; ++bj) {
            const int col = col0 + bj * HALF;
            if (col < ncols) {
                f32x4 b0 = {0.f, 0.f, 0.f, 0.f}, b1 = b0;
                if (ACT == 1) { b0 = *(const f32x4*)(bias + col); b1 = *(const f32x4*)(bias + col + 4); }
#pragma unroll
                for (int ai = 0; ai < 2; ++ai)
#pragma unroll
                    for (int m = 0; m < 4; ++m) {
                        f32x4 v0 = acc[ai][bj][m][0] + b0, v1 = acc[ai][bj][m][1] + b1;
                        if (ACT == 1) {
#pragma unroll
                            for (int e = 0; e < 4; ++e) { v0[e] = sigm(v0[e]); v1[e] = sigm(v1[e]); }
                        }
                        st16_wt(O + (size_t)(row0 + ai * HALF + m * 16) * ldc + col, pack8(v0, v1));
                    }
            }
        }
    }
};
struct EpiResid {
    static constexpr bool PERM = false;
    float* O; const float* X; const float* gate;
    __device__ __forceinline__ void operator()(const f32x4 (&acc)[2][2][4][2], const Unit& u, int wr, int wc, int fr, int fq) const {
        const int row0 = u.pm * BM + wr * 64 + fr, col0 = u.pn * BM + wc * 32 + 4 * fq;
        const float* gr = gate + (size_t)((u.pm * BM) / SEQ) * 6144;
#pragma unroll
        for (int bj = 0; bj < 2; ++bj)
#pragma unroll
            for (int n = 0; n < 2; ++n) {
                const int col = col0 + bj * HALF + n * 16;
                const f32x4 gg = *(const f32x4*)(gr + col);
#pragma unroll
                for (int ai = 0; ai < 2; ++ai)
#pragma unroll
                    for (int m = 0; m < 4; ++m) {
                        const size_t o = (size_t)(row0 + ai * HALF + m * 16) * DM + col;
                        *(f32x4*)(O + o) = *(const f32x4*)(X + o) + gg * acc[ai][bj][m][n];
                    }
            }
    }
};

template <int STAGE> struct MoeOrder {
    const int* bcnt; const h16* W; int G, c;
    static constexpr int NCOL = STAGE == 1 ? 8 : 4;
    __device__ bool next(int i, Unit& u) const {
        const long L = (long)i * G + c; const int mt = (int)(L / NCOL);
        if (mt >= 88) return false;
        int acc = 0, found = 0;
        for (int b = 0; b < 24; ++b) {
            const int cn = bcnt[b]; const int ntl = (cn + 255) >> 8;
            if (!found && mt < acc + ntl) { found = 1; u.bucket = b; u.i0 = (mt - acc) * 256; u.cnt = cn; }
            acc += ntl;
        }
        if (!__builtin_amdgcn_readfirstlane(found)) return false;
        u.bucket = __builtin_amdgcn_readfirstlane(u.bucket); u.i0 = __builtin_amdgcn_readfirstlane(u.i0); u.cnt = __builtin_amdgcn_readfirstlane(u.cnt);
        const int gI = u.bucket / 6, pr = u.bucket % 6;
        u.ea = gI * 4 + (pr < 3 ? 0 : pr < 5 ? 1 : 2); u.eb = gI * 4 + (pr == 0 ? 1 : pr == 1 ? 2 : pr == 2 ? 3 : pr == 3 ? 2 : 3);
        u.pm = mt; u.pn = (int)(L % NCOL); return true;
    }
    __device__ __forceinline__ int ksplit() const { return STAGE == 1 ? (1 << 30) : 8; }
    __device__ __forceinline__ void b_ptr(const Gemm&, const Unit& u, size_t, const char*& lo, const char*& hi) const {
        if (STAGE == 1) { const int e = u.pn < 4 ? u.ea : u.eb; lo = hi = (const char*)(W + ((size_t)e * 1024 + (u.pn & 3) * 256) * 1024); }
        else { lo = (const char*)(W + ((size_t)u.ea * 1024 + u.pn * 256) * 512); hi = (const char*)(W + ((size_t)u.eb * 1024 + u.pn * 256) * 512) - 8 * (size_t)(BK * 2); }
    }
};
struct EpiMoe1 {
    static constexpr bool PERM = true;
    h16* act; const int* lists; const float* cw;
    __device__ __forceinline__ void operator()(const f32x4 (&acc)[2][2][4][2], const Unit& u, int wr, int wc, int fr, int fq) const {
        asm volatile("" : "+v"(fr), "+v"(fq));
        const int* lst = lists + (size_t)u.bucket * LCAP;
        const int second = u.pn >= 4;
        const int colb = ((u.pn & 3) * 256 + wc * 32) / 2 + 4 * fq + second * 512;
#pragma unroll
        for (int ai = 0; ai < 2; ++ai)
#pragma unroll
            for (int m = 0; m < 4; ++m) {
                const int r = ai * HALF + wr * 64 + m * 16 + fr, ii = u.i0 + r; const bool valid = ii < u.cnt;
                const float cwv = valid ? cw[(size_t)lst[valid ? ii : 0] * 2 + second] : 0.f;
                h16* O = act + ((size_t)u.pm * 256 + r) * 1024 + colb;
#pragma unroll
                for (int bj = 0; bj < 2; ++bj) {
                    const f32x4 a = acc[ai][bj][m][0], bq = acc[ai][bj][m][1];
                    *(h16x4*)(O + bj * 64) = pack4(cwv * (a[0] * sigm(a[0])) * bq[0], cwv * (a[1] * sigm(a[1])) * bq[1], cwv * (a[2] * sigm(a[2])) * bq[2], cwv * (a[3] * sigm(a[3])) * bq[3]);
                }
                __builtin_amdgcn_sched_barrier(0);
            }
    }
};
struct EpiMoe2 {
    static constexpr bool PERM = false;
    float* x1; const int* lists; const float* gate;
    __device__ __forceinline__ void operator()(const f32x4 (&acc)[2][2][4][2], const Unit& u, int wr, int wc, int fr, int fq) const {
        asm volatile("" : "+v"(fr), "+v"(fq));
        const int* lst = lists + (size_t)u.bucket * LCAP;
#pragma unroll
        for (int ai = 0; ai < 2; ++ai)
#pragma unroll
            for (int m = 0; m < 4; ++m) {
                const int r = ai * HALF + wr * 64 + m * 16 + fr, ii = u.i0 + r;
                if (ii < u.cnt) {
                    const int tok = lst[ii];
                    const float* gr = gate + (size_t)(tok / SEQ) * 6144;
                    float* xr = x1 + (size_t)tok * DM;
#pragma unroll
                    for (int bj = 0; bj < 2; ++bj)
#pragma unroll
                        for (int n = 0; n < 2; ++n) {
                            const int col = u.pn * 256 + bj * HALF + wc * 32 + n * 16 + 4 * fq;
                            *(f32x4*)(xr + col) = *(const f32x4*)(xr + col) + *(const f32x4*)(gr + col) * acc[ai][bj][m][n];
                        }
                }
            }
    }
};
}

__device__ __forceinline__ void ph_gemm1(CP p, int bid, int nblk, char* smem) {
    {
        pg8::Gemm g; g.A = p.h_hi; g.Bt = p.Wp; g.M = NTOK; g.N = 2560; g.K = DM; g.lda = DM; g.ldb = DM;
        pg8::StaticOrder S; S.init(NTOK, 2560, nblk, bid);
        pg8::EpiH16<0> E; E.O = p.proj; E.ldc = PJ; E.ncols = PJ; E.bias = nullptr;
        pg8::gemm_phase(( PG8_LAS unsigned char*)smem, g, S, E);
    }
    __syncthreads();
    for (int u = bid - 128; u >= 0 && u < 128; u += nblk) {
        f32x4 acc[4][4]; zero_acc<256>(acc);
        const int mt = u >> 1, nt = u & 1, m0 = mt * 256, n0 = nt * 128;
        const h16* Ah = p.h_hi + (size_t)m0 * DM; const h16* Al = p.h_lo + (size_t)m0 * DM; const h16* B = p.Widx + (size_t)n0 * 3072;
        gemm_kloop<256>(smem, 3072, [=](int r, int k) { const h16* base = (k >= 1024 && k < 2048) ? Al : Ah; return base + (size_t)r * DM + (k & 1023); },
                        [=](int r, int k) { return B + (size_t)r * 3072 + k; }, acc);
        float* O = p.idxf + (size_t)m0 * IDXLD + n0;
        gemm_epi<256>(acc, [=](int ml, int nl, f32x4 v) { if (n0 + nl < IDXLD) *(f32x4*)(O + (size_t)ml * IDXLD + nl) = v; });
    }
}

template <int PASS>
__device__ __forceinline__ void ph_s5_scan(CP p, int l, int bid, int nblk, char* smem) {
    const int lane = otid() & 63, wv = otid() >> 6;
    h16* us = (h16*)smem + wv * (64 * 16);
    for (int u = bid * 8 + wv; u < 4096; u += nblk * 8) {
        const int g = u & 15, c = (u >> 4) & 63, b = u >> 10;
        const int pidx = (l * 16 + g) * 64 + lane;
        const float* sc_ = p.s5c + (size_t)pidx * 36;
        float Br[16], Bi[16];
#pragma unroll
        for (int cc = 0; cc < 16; ++cc) { Br[cc] = sc_[4 + cc]; Bi[cc] = sc_[20 + cc]; }
        const float lr = sc_[0], li = sc_[1];
        float hr = 0.f, hi = 0.f;
        h16* Hs = (h16*)(smem + 16384) + wv * (64 * 136);
        if (PASS == 3) {
            const size_t hix = ((((size_t)b * 64 + c) * 16 + g) * 64 + lane) * 2;
            hr = p.s5H[hix]; hi = p.s5H[hix + 1];
        }
        const int t0 = b * SEQ + c * 64;
        {
            const h16* up = p.proj + (size_t)(t0 + lane) * PJ + P_U + g * 16;
            const h16x8 a0 = *(const h16x8*)up, a1 = *(const h16x8*)(up + 8);
            __builtin_amdgcn_s_waitcnt(0); __builtin_amdgcn_wave_barrier();
            *(h16x8*)&us[lane * 16] = a0; *(h16x8*)&us[lane * 16 + 8] = a1;
            __builtin_amdgcn_s_waitcnt(0); __builtin_amdgcn_wave_barrier();
        }
        for (int t = 0; t < 64; ++t) {
            h16x8 u0 = *(const h16x8*)&us[t * 16], u1 = *(const h16x8*)&us[t * 16 + 8];
            float br = 0.f, bi = 0.f;
#pragma unroll
            for (int cc = 0; cc < 8; ++cc) { const float ua = (float)u0[cc], ub = (float)u1[cc]; br += Br[cc] * ua + Br[8 + cc] * ub; bi += Bi[cc] * ua + Bi[8 + cc] * ub; }
            const float nhr = lr * hr - li * hi + br, nhi = lr * hi + li * hr + bi;
            hr = nhr; hi = nhi;
            if (PASS == 3) { Hs[t * 136 + lane] = (h16)hr; Hs[t * 136 + 64 + lane] = (h16)hi; }
        }
        if (PASS == 3) {
            const int cc = lane & 15, gq = lane >> 4;
            const float* cre = p.in[I_S5CRE] + ((size_t)(l * 16 + g) * 16 + cc) * 64 + 8 * gq;
            const float* cim = p.in[I_S5CIM] + ((size_t)(l * 16 + g) * 16 + cc) * 64 + 8 * gq;
            h16x8 bf[4];
#pragma unroll
            for (int ks = 0; ks < 2; ++ks)
#pragma unroll
                for (int j = 0; j < 8; ++j) { bf[ks][j] = (h16)cre[ks * 32 + j]; bf[2 + ks][j] = (h16)(-cim[ks * 32 + j]); }
            const float dsk = p.in[I_S5D][l * 256 + g * 16 + cc];
            __builtin_amdgcn_s_waitcnt(0); __builtin_amdgcn_wave_barrier();
#pragma unroll
            for (int tt = 0; tt < 4; ++tt) {
                f32x4 acc = {0.f, 0.f, 0.f, 0.f};
#pragma unroll
                for (int ks = 0; ks < 4; ++ks) acc = __builtin_amdgcn_mfma_f32_16x16x32_f16(*(const h16x8*)&Hs[(16 * tt + cc) * 136 + ks * 32 + 8 * gq], bf[ks], acc, 0, 0, 0);
#pragma unroll
                for (int r = 0; r < 4; ++r) {
                    const int t = 16 * tt + 4 * gq + r;
                    const float y = acc[r] + dsk * (float)us[t * 16 + cc];
                    p.ybuf[(size_t)(t0 + t) * 256 + g * 16 + cc] = (h16)gelu_tanh(y);
                }
            }
            __builtin_amdgcn_s_waitcnt(0); __builtin_amdgcn_wave_barrier();
        }
        if (PASS == 1) { const size_t eix = ((((size_t)b * 64 + c) * 16 + g) * 64 + lane) * 2; p.s5E[eix] = hr; p.s5E[eix + 1] = hi; }
    }
}
__device__ __forceinline__ void ph_s5_carry(CP p, int l, int bid, int nblk) {
    if (bid >= 8) return;
    const int gid = bid * 512 + otid();
    const int pp = gid & 63, g = (gid >> 6) & 15, b = gid >> 10;
    const int pidx = (l * 16 + g) * 64 + pp;
    const float ar = p.s5c[(size_t)pidx * 36 + 2], ai = p.s5c[(size_t)pidx * 36 + 3];
    float hr = 0.f, hi = 0.f;
    for (int c = 0; c < 64; ++c) {
        const size_t ix = ((((size_t)b * 64 + c) * 16 + g) * 64 + pp) * 2;
        p.s5H[ix] = hr; p.s5H[ix + 1] = hi;
        const float er_ = p.s5E[ix], ei_ = p.s5E[ix + 1];
        const float nr = ar * hr - ai * hi + er_, ni = ar * hi + ai * hr + ei_;
        hr = nr; hi = ni;
    }
}
__device__ __forceinline__ void ph_s5_glu(CP p, int l, int bid, int nblk, char* smem) {
    for (int u = bid; u < 128; u += nblk) {
        const int mt = u >> 1, nt = u & 1, m0 = mt * 256, n0 = nt * 128;
        f32x4 acc[4][4]; zero_acc<256>(acc);
        const h16* A = p.ybuf + (size_t)m0 * 256; const h16* B = p.Wglu + (size_t)n0 * 256;
        gemm_kloop<256>(smem, 256, [=](int r, int k) { return A + (size_t)r * 256 + k; }, [=](int r, int k) { return B + (size_t)r * 256 + k; }, acc);
        const float* gb = p.in[I_S5GB] + l * 256 + n0;
        const h16* Y = p.ybuf + (size_t)m0 * 256 + n0; h16* O = p.branches + (size_t)m0 * DM + n0;
        gemm_epi<256>(acc, [=](int ml, int nl, f32x4 v) {
            h16x4 y = *(const h16x4*)(Y + (size_t)ml * 256 + nl); f32x4 bb = *(const f32x4*)(gb + nl);
            *(h16x4*)(O + (size_t)ml * DM + nl) = pack4((float)y[0] * sigm(v[0] + bb[0]), (float)y[1] * sigm(v[1] + bb[1]), (float)y[2] * sigm(v[2] + bb[2]), (float)y[3] * sigm(v[3] + bb[3])); });
    }
}

__device__ __forceinline__ void ph_rg_a(CP p, int l, int bid, int nblk, char* smem) {
    float* xc = (float*)smem;
    float* aa = xc + 32 * 256;
    float* bx = aa + 32 * 256;
    const int tid = otid();
    for (int u = bid; u < 512; u += nblk) {
        const int b = u >> 7, c = u & 127, t0 = c * 32;
        __syncthreads();
        {
            const int ch = tid & 255;
            const float w0 = p.in[I_RGCW][(l * 4 + 0) * 256 + ch], w1 = p.in[I_RGCW][(l * 4 + 1) * 256 + ch], w2 = p.in[I_RGCW][(l * 4 + 2) * 256 + ch], w3 = p.in[I_RGCW][(l * 4 + 3) * 256 + ch];
            const float cb = p.in[I_RGCB][l * 256 + ch];
            const int par = tid >> 8;
            h16 rows[19];
#pragma unroll
            for (int k = 0; k < 19; ++k) { const int tt = t0 + 16 * par - 3 + k; rows[k] = tt >= 0 ? p.proj[(size_t)(b * SEQ + tt) * PJ + P_RGX + ch] : (h16)0.f; }
#pragma unroll
            for (int m = 0; m < 16; ++m)
                xc[(16 * par + m) * 256 + ch] = cb + w3 * (float)rows[m + 3] + w2 * (float)rows[m + 2] + w1 * (float)rows[m + 1] + w0 * (float)rows[m];
        }
        __syncthreads();
        const int ch = tid & 255, half = tid >> 8, blk = ch >> 6, d = ch & 63;
        const float* wr = p.in[I_RGWR] + ((size_t)(l * 4 + blk) * 64) * 64 + d;
        const float* wi = p.in[I_RGWI] + ((size_t)(l * 4 + blk) * 64) * 64 + d;
        const float br = p.in[I_RGBR][l * 256 + ch], bi = p.in[I_RGBI][l * 256 + ch];
        const float spl = softplusf_(-p.in[I_RGLAM][l * 256 + ch]);
#pragma unroll 1
        for (int grp = 0; grp < 2; ++grp) {
            float ar[8], ai[8];
#pragma unroll
            for (int q = 0; q < 8; ++q) { ar[q] = br; ai[q] = bi; }
            const int tb = half * 16 + grp * 8;
            for (int cc = 0; cc < 64; ++cc) {
                const float wrv = wr[cc * 64], wiv = wi[cc * 64];
#pragma unroll
                for (int q = 0; q < 8; ++q) { const float xv = xc[(tb + q) * 256 + blk * 64 + cc]; ar[q] += xv * wrv; ai[q] += xv * wiv; }
            }
#pragma unroll
            for (int q = 0; q < 8; ++q) {
                const float r = sigm(ar[q]), ig = sigm(ai[q]);
                const float la = -8.f * r * spl;
                const float a = __expf(la), mult = sqrtf(fmaxf(1.f - __expf(2.f * la), 0.f));
                aa[(tb + q) * 256 + ch] = a; bx[(tb + q) * 256 + ch] = mult * ig * xc[(tb + q) * 256 + ch];
            }
        }
        __syncthreads();
        if (tid < 256) {
            float h = 0.f, cp = 1.f;
            float* hl = p.rg_hl + (size_t)(b * SEQ + t0) * 256 + ch; float* cpo = p.rg_cp + (size_t)(b * SEQ + t0) * 256 + ch;
            for (int t = 0; t < 32; ++t) { const float a = aa[t * 256 + ch]; h = a * h + bx[t * 256 + ch]; cp *= a; hl[(size_t)t * 256] = h; cpo[(size_t)t * 256] = cp; }
            p.rg_agg[((size_t)(b * 128 + c) * 256 + ch) * 2] = cp; p.rg_agg[((size_t)(b * 128 + c) * 256 + ch) * 2 + 1] = h;
        }
    }
}
__device__ __forceinline__ void ph_rg_c(CP p, int l, int bid, int nblk, char* smem) {
    float* carry = (float*)smem;
    const int tid = otid();
    for (int u = bid; u < 512; u += nblk) {
        const int b = u >> 7, c = u & 127, t0 = c * 32;
        __syncthreads();
        if (tid < 256) {
            float h = 0.f;
            const float2* ag = (const float2*)p.rg_agg + (size_t)b * 128 * 256 + tid;
            int cc = 0;
            for (; cc + 8 <= c; cc += 8) {
                float2 v[8];
#pragma unroll
                for (int q = 0; q < 8; ++q) v[q] = ag[(size_t)(cc + q) * 256];
#pragma unroll
                for (int q = 0; q < 8; ++q) h = v[q].x * h + v[q].y;
            }
            for (; cc < c; ++cc) { const float2 v = ag[(size_t)cc * 256]; h = v.x * h + v.y; }
            carry[tid] = h;
        }
        __syncthreads();
        const int ch = tid & 255;
        {
            const int par = tid >> 8;
            float hl_[16], cp_[16]; h16 gt_[16];
#pragma unroll
            for (int m = 0; m < 16; ++m) { const size_t tok = (size_t)b * SEQ + t0 + 16 * par + m; hl_[m] = p.rg_hl[tok * 256 + ch]; cp_[m] = p.rg_cp[tok * 256 + ch]; gt_[m] = p.proj[tok * PJ + P_RGG + ch]; }
            const float cr = carry[ch];
#pragma unroll
            for (int m = 0; m < 16; ++m) { const size_t tok = (size_t)b * SEQ + t0 + 16 * par + m; p.branches[tok * DM + 512 + ch] = (h16)((hl_[m] + cp_[m] * cr) * gelu_tanh((float)gt_[m])); }
        }
    }
}

__device__ __forceinline__ void ph_rw_prep(CP p, int l, int bid, int nblk, char* smem) {
    h16* wup = (h16*)smem;
    h16* aup = wup + 32 * 256;
    h16* gup = aup + 32 * 256;
    float* f = (float*)(gup + 64 * 256);
    const int tid = otid(), lane = tid & 63;
    for (int i = tid; i < 32 * 256; i += 512) { wup[i] = (h16)p.in[I_RWWUP][(size_t)l * 32 * 256 + i]; aup[i] = (h16)p.in[I_RWAUP][(size_t)l * 32 * 256 + i]; }
    for (int i = tid; i < 64 * 256; i += 512) gup[i] = (h16)p.in[I_RWGUP][(size_t)l * 64 * 256 + i];
    const float* mu = p.in[I_RWMU] + l * 896;
    const int ch = tid & 255, tg = tid >> 8;
    const float w0 = p.in[I_RWW0][l * 256 + ch], a0 = p.in[I_RWA0][l * 256 + ch], kkw = p.in[I_RWKK][l * 256 + ch], kaw = p.in[I_RWKA][l * 256 + ch];
    const float rk = p.in[I_RWRK][l * 256 + ch];
    __syncthreads();
    for (int u = bid; u < NTOK / 16; u += nblk) {
        const int tok0 = u * 16;
        __syncthreads();
        for (int i = tid; i < 16 * 896; i += 512) {
            const int t = i / 896, cidx = i % 896; const int tok = tok0 + t;
            const float cur = (float)p.proj[(size_t)tok * PJ + P_RW + cidx];
            const float prv = (tok % SEQ) ? (float)p.proj[(size_t)(tok - 1) * PJ + P_RW + cidx] : 0.f;
            float v = cur + (prv - cur) * mu[cidx];
            if (cidx >= 768 && cidx < 800) v = tanhf(v);
            if (cidx >= 832) v = sigm(v);
            f[i] = v;
        }
        __syncthreads();
        for (int q = 0; q < 8; ++q) {
            const int t = tg * 8 + q; const int tok = tok0 + t;
            const float* ft = f + t * 896;
            float lw = 0.f, la = 0.f, lg = 0.f;
#pragma unroll 8
            for (int j = 0; j < 32; ++j) { lw += ft[768 + j] * (float)wup[j * 256 + ch]; la += ft[800 + j] * (float)aup[j * 256 + ch]; }
#pragma unroll 8
            for (int j = 0; j < 64; ++j) lg += ft[832 + j] * (float)gup[j * 256 + ch];
            const float w = -softplusf_(-(w0 + lw)) - 0.5f;
            const float wl = -__expf(w);
            const float a = sigm(a0 + la);
            const float r = ft[ch], k = ft[256 + ch], v = ft[512 + ch];
            float kk = k * kkw;
            const float nrm = sqrtf(wave_sum(kk * kk));
            kk = kk / fmaxf(nrm, 1e-12f);
            const float k2 = k * (1.f + (a - 1.f) * kaw);
            const float sb = wave_sum(r * k2 * rk);
            const size_t o = (size_t)tok * 256 + ch;
            p.rw_r[o] = (h16)r; p.rw_w[o] = (h16)wl; p.rw_k[o] = (h16)k2; p.rw_kk[o] = (h16)kk; p.rw_b[o] = (h16)(kk * a);
            p.rw_g[o] = (h16)lg; p.rw_bonus[o] = (h16)(sb * v); p.rw_v[o] = (h16)v;
        }
    }
}
__device__ __forceinline__ void ph_rw_scan(CP p, int bid, char* smem) {
    if (bid >= 16 || otid() >= 64) return;
    float (*sv)[64] = (float (*)[64])smem;
    const int b = bid >> 2, h = bid & 3, lane = otid();
    float S[64];
#pragma unroll
    for (int k = 0; k < 64; ++k) S[k] = 0.f;
    for (int t = 0; t < SEQ; ++t) {
        const size_t tok = (size_t)b * SEQ + t; const size_t o = tok * 256 + h * 64 + lane;
        const float vv = (float)p.rw_v[o];
        sv[0][lane] = (float)p.rw_r[o]; sv[1][lane] = __expf((float)p.rw_w[o]); sv[2][lane] = (float)p.rw_k[o]; sv[3][lane] = (float)p.rw_kk[o]; sv[4][lane] = (float)p.rw_b[o];
        __builtin_amdgcn_s_waitcnt(0); __builtin_amdgcn_wave_barrier();
        float skk = 0.f;
#pragma unroll
        for (int k = 0; k < 64; ++k) skk += S[k] * sv[3][k];
        float y = 0.f;
#pragma unroll
        for (int k = 0; k < 64; ++k) { S[k] = S[k] * sv[1][k] - skk * sv[4][k] + vv * sv[2][k]; y += S[k] * sv[0][k]; }
        p.rw_y[o] = y;
        __builtin_amdgcn_s_waitcnt(0); __builtin_amdgcn_wave_barrier();
    }
}
__device__ __forceinline__ void ph_rw_post(CP p, int l, int bid, int nblk) {
    const int lane = otid() & 63, wv = otid() >> 6;
    for (int u = bid * 8 + wv; u < NTOK * 4; u += nblk * 8) {
        const int tok = u >> 2, h = u & 3; const size_t o = (size_t)tok * 256 + h * 64 + lane;
        const float y = p.rw_y[o];
        const float mean = wave_sum(y) * (1.f / 64.f);
        const float dv = y - mean;
        const float var = wave_sum(dv * dv) * (1.f / 64.f);
        float v = dv * rsqrtf(var + 64e-5f) * p.in[I_RWGNW][l * 256 + h * 64 + lane] + p.in[I_RWGNB][l * 256 + h * 64 + lane];
        v += (float)p.rw_bonus[o];
        p.branches[(size_t)tok * DM + 768 + h * 64 + lane] = (h16)(v * (float)p.rw_g[o]);
    }
}

#define RS 68
template <int MODE>
__device__ __forceinline__ void mm_nt(float* out, const float* X, const float* Y, int wave, int nw, int lane) {
    const int g = lane >> 4, c = lane & 15;
    for (int idx = wave; idx < 16; idx += nw) {
        const int ti = idx >> 2, tj = idx & 3;
        f32x4 acc = {0.f, 0.f, 0.f, 0.f};
        if (MODE == 0 || tj <= ti) {
#pragma unroll
            for (int kb = 0; kb < 4; ++kb) {
                const f32x4 a4 = *(const f32x4*)&X[(ti * 16 + c) * RS + kb * 16 + 4 * g];
                const f32x4 b4 = *(const f32x4*)&Y[(tj * 16 + c) * RS + kb * 16 + 4 * g];
#pragma unroll
                for (int i = 0; i < 4; ++i) acc = __builtin_amdgcn_mfma_f32_16x16x4f32(a4[i], b4[i], acc, 0, 0, 0);
            }
        }
#pragma unroll
        for (int r = 0; r < 4; ++r) {
            const int row = ti * 16 + 4 * g + r, col = tj * 16 + c;
            float v = acc[r];
            if (MODE == 1 && col >= row) v = 0.f;
            if (MODE == 2 && col > row) v = 0.f;
            out[row * RS + col] = v;
        }
    }
}
__device__ __forceinline__ f32x4 mm_nn_tile(f32x4 acc, const float* X, const float* Y, int ti, int tj, int lane, float sign) {
    const int g = lane >> 4, c = lane & 15;
#pragma unroll
    for (int kb = 0; kb < 4; ++kb) {
        const f32x4 a4 = *(const f32x4*)&X[(ti * 16 + c) * RS + kb * 16 + 4 * g];
#pragma unroll
        for (int i = 0; i < 4; ++i) acc = __builtin_amdgcn_mfma_f32_16x16x4f32(sign * a4[i], Y[(kb * 16 + 4 * g + i) * RS + tj * 16 + c], acc, 0, 0, 0);
    }
    return acc;
}
template <int T> struct FwdRow {
    static __device__ __forceinline__ void run(float (&x)[64], const float* Nm) {
        FwdRow<T - 1>::run(x, Nm);
        float acc = x[T];
#pragma unroll
        for (int s4 = 0; s4 < (T + 3) / 4; ++s4) {
            const f32x4 n4 = *(const f32x4*)&Nm[T * RS + s4 * 4];
#pragma unroll
            for (int e = 0; e < 4; ++e) if (s4 * 4 + e < T) acc -= n4[e] * x[s4 * 4 + e];
        }
        x[T] = acc;
    }
};
template <> struct FwdRow<0> { static __device__ __forceinline__ void run(float (&)[64], const float*) {} };
#define RWA_LDS (16384 + 8 * 64 * RS * 4)
__device__ __forceinline__ void ph_rw_a(CP p, int l, int bid, int nblk, char* smem) {
    h16* fs = (h16*)smem;
    float* Ah = (float*)(smem + 16384);
    float* Rh = Ah + 64 * RS; float* Bh = Rh + 64 * RS; float* Kh = Bh + 64 * RS; float* Vv = Kh + 64 * RS;
    float* Nm = Vv + 64 * RS; float* Mm = Nm + 64 * RS; float* T1 = Mm + 64 * RS;
    float* tot = (float*)(smem + RWA_LDS);
    float* egl = tot + 8 * 64;
    for (int u4 = bid * 4; u4 < 1024; u4 += (nblk & ~0) * 4)
    for (int u = u4; u < u4 + 4; ++u) {
        int tid = otid(), lane = tid & 63, wave = tid >> 6;
        const float* mu = p.in[I_RWMU] + oint(l) * 896;
        const int h = u & 3, c = (u >> 2) & 63, b = u >> 8;
        const int t0 = c * 64; const size_t tok0 = (size_t)b * SEQ + t0;
        __syncthreads();
        if (h == 0)
        {
            h16 cu_[16], pv_[16];
#pragma unroll
            for (int q = 0; q < 16; ++q) {
                const int i = tid + 512 * q; const int t = i >> 7, j = i & 127; const size_t tok = tok0 + t;
                const h16* pc = p.proj + tok * PJ + P_RW + 768 + j;
                cu_[q] = pc[0];
                pv_[q] = pc[(t0 + t) ? -(long)PJ : 0];
            }
#pragma unroll
            for (int q = 0; q < 16; ++q) {
                const int i = tid + 512 * q; const int t = i >> 7, j = i & 127;
                const float cur = (float)cu_[q]; const float prv = (t0 + t) ? (float)pv_[q] : 0.f;
                float v = cur + (prv - cur) * mu[768 + j];
                if (j < 32) v = tanh_fast(v); else if (j >= 64) v = sigm(v);
                fs[i] = (h16)v;
            }
        }
        __syncthreads();
        tid = otid(); lane = tid & 63; wave = tid >> 6;
        {
            const int ll = oint(l);
            const int ch = h * 64 + lane;
            const float w0 = p.in[I_RWW0][ll * 256 + ch], a0 = p.in[I_RWA0][ll * 256 + ch], kkw = p.in[I_RWKK][ll * 256 + ch], kaw = p.in[I_RWKA][ll * 256 + ch], rkw = p.in[I_RWRK][ll * 256 + ch];
            const float mur = mu[ch], muk = mu[256 + ch], muv = mu[512 + ch];
            float run = 0.f;
            h16x2 wpk[64];
#pragma unroll
            for (int m = 0; m < 64; ++m) {
                const int j0 = 2 * m;
                const float* src = j0 < 32 ? p.in[I_RWWUP] + ((size_t)ll * 32 + j0) * 256 : j0 < 64 ? p.in[I_RWAUP] + ((size_t)ll * 32 + (j0 - 32)) * 256 : p.in[I_RWGUP] + ((size_t)ll * 64 + (j0 - 64)) * 256;
                h16x2 w2; w2[0] = (h16)src[ch]; w2[1] = (h16)src[256 + ch];
                wpk[m] = w2;
            }
            h16 pr_[9], pk_[9], pv_[9];
#pragma unroll
            for (int q = 0; q < 9; ++q) {
                const int t = wave * 8 + q - 1;
                const bool ok = (t0 + t) >= 0;
                const h16* pc = p.proj + (tok0 + t) * PJ + P_RW + ch;
                pr_[q] = ok ? pc[0] : (h16)0.f; pk_[q] = ok ? pc[256] : (h16)0.f; pv_[q] = ok ? pc[512] : (h16)0.f;
            }
#pragma unroll
            for (int q = 0; q < 8; ++q) {
                const int t = wave * 8 + q; const size_t tok = tok0 + t;
                const h16* ft = fs + t * 128;
                float lw = 0.f, la = 0.f, lg = 0.f;
#pragma unroll
                for (int v8 = 0; v8 < 16; ++v8) {
                    const h16x8 f8 = *(const h16x8*)(ft + v8 * 8);
#pragma unroll
                    for (int e = 0; e < 4; ++e) {
                        h16x2 f2; f2[0] = f8[2 * e]; f2[1] = f8[2 * e + 1];
                        const int m = v8 * 4 + e;
                        if (m < 16) lw = __builtin_amdgcn_fdot2(f2, wpk[m], lw, false);
                        else if (m < 32) la = __builtin_amdgcn_fdot2(f2, wpk[m], la, false);
                        else lg = __builtin_amdgcn_fdot2(f2, wpk[m], lg, false);
                    }
                }
                const float rc = (float)pr_[q + 1], kc = (float)pk_[q + 1], vc = (float)pv_[q + 1];
                const float rp = (float)pr_[q], kp_ = (float)pk_[q], vp = (float)pv_[q];
                const float r = rc + (rp - rc) * mur, k = kc + (kp_ - kc) * muk, v = vc + (vp - vc) * muv;
                const float w = -softplusf_(-(w0 + lw)) - 0.5f;
                const float wl = -__expf(w);
                const float a = sigm(a0 + la);
                float kk = k * kkw;
                const float nrm = sqrtf(wave_sum(kk * kk));
                kk = kk * __builtin_amdgcn_rcpf(fmaxf(nrm, 1e-12f));
                const float k2 = k * (1.f + (a - 1.f) * kaw);
                const float sb = wave_sum(r * k2 * rkw);
                p.rw_g[tok * 256 + ch] = (h16)lg; p.rw_bonus[tok * 256 + ch] = (h16)(sb * v);
                run += wl;
                Ah[t * RS + lane] = kk; Rh[t * RS + lane] = r; Bh[t * RS + lane] = kk * a; Kh[t * RS + lane] = k2; Vv[t * RS + lane] = v; T1[t * RS + lane] = run;
            }
            __syncthreads();
            tot[wave * 64 + lane] = run;
            __syncthreads();
            float offs = 0.f, gl = 0.f;
#pragma unroll
            for (int w8 = 0; w8 < 8; ++w8) { const float tv = tot[w8 * 64 + lane]; if (w8 < wave) offs += tv; gl += tv; }
            if (wave == 0) { egl[lane] = __expf(gl); p.rw_gam[(size_t)u * 64 + lane] = __expf(gl); }
            float gprev = offs;
#pragma unroll 1
            for (int q = 0; q < 8; ++q) {
                const int t = wave * 8 + q;
                const float G = offs + T1[t * RS + lane];
                const float eg = __expf(G), egp = __expf(gprev), egi = __expf(-G);
                Ah[t * RS + lane] *= egp; Rh[t * RS + lane] *= eg; Bh[t * RS + lane] *= egi; Kh[t * RS + lane] *= egi;
                gprev = G;
            }
        }
        __syncthreads();
        tid = otid(); lane = tid & 63; wave = tid >> 6;
        mm_nt<1>(Nm, Ah, Bh, wave, 8, lane);
        mm_nt<1>(Mm, Ah, Kh, wave, 8, lane);
        __syncthreads();
        tid = otid(); lane = tid & 63; wave = tid >> 6;
        for (int idx = wave; idx < 16; idx += 8) {
            const int ti = idx >> 2, tj = idx & 3;
            f32x4 acc = {0.f, 0.f, 0.f, 0.f};
            acc = mm_nn_tile(acc, Mm, Vv, ti, tj, lane, 1.f);
#pragma unroll
            for (int r = 0; r < 4; ++r) T1[(ti * 16 + 4 * (lane >> 4) + r) * RS + tj * 16 + (lane & 15)] = acc[r];
        }
        __syncthreads();
        tid = otid(); lane = tid & 63; wave = tid >> 6;
        const size_t ub = (size_t)u * 4096;
        {
            mm_nt<2>(Mm, Rh, Bh, wave, 8, lane);
            for (int i = tid; i < 4096; i += 512) { const int k = i >> 6, t = i & 63; p.rw_Be[ub + i] = (h16)(-Bh[t * RS + k] * egl_get(egl, k)); }
            for (int idx = wave; idx < 16; idx += 8) {
                const int ti = idx >> 2, tj = idx & 3, g = lane >> 4, cc = lane & 15;
                f32x4 acc = {0.f, 0.f, 0.f, 0.f};
#pragma unroll
                for (int tb = 0; tb < 4; ++tb)
#pragma unroll
                    for (int i = 0; i < 4; ++i) acc = __builtin_amdgcn_mfma_f32_16x16x4f32(Kh[(tb * 16 + 4 * g + i) * RS + ti * 16 + cc], Vv[(tb * 16 + 4 * g + i) * RS + tj * 16 + cc], acc, 0, 0, 0);
#pragma unroll
                for (int r = 0; r < 4; ++r) { const int k = ti * 16 + 4 * g + r; p.rw_VK[ub + k * 64 + tj * 16 + cc] = (h16)(acc[r] * egl_get(egl, k)); }
            }
        }
        {
            float* src = wave < 4 ? Ah : T1;
            h16* og = (wave < 4 ? p.rw_W : p.rw_U0) + ub;
            const int col0 = (wave & 3) * 16, g = lane >> 4, cc = lane & 15;
#pragma unroll
            for (int I = 0; I < 4; ++I) {
                if (I > 0) {
                    f32x4 acc;
#pragma unroll
                    for (int r = 0; r < 4; ++r) acc[r] = src[(16 * I + 4 * g + r) * RS + col0 + cc];
#pragma unroll
                    for (int kb = 0; kb < I; ++kb) {
                        const f32x4 a4 = *(const f32x4*)&Nm[(16 * I + cc) * RS + kb * 16 + 4 * g];
#pragma unroll
                        for (int i = 0; i < 4; ++i) acc = __builtin_amdgcn_mfma_f32_16x16x4f32(-a4[i], src[(kb * 16 + 4 * g + i) * RS + col0 + cc], acc, 0, 0, 0);
                    }
#pragma unroll
                    for (int r = 0; r < 4; ++r) src[(16 * I + 4 * g + r) * RS + col0 + cc] = acc[r];
                    __builtin_amdgcn_s_waitcnt(0); __builtin_amdgcn_wave_barrier();
                }
                if (lane < 16) {
                    float x[16];
#pragma unroll
                    for (int r = 0; r < 16; ++r) x[r] = src[(16 * I + r) * RS + col0 + lane];
#pragma unroll
                    for (int r = 1; r < 16; ++r) {
#pragma unroll
                        for (int q4 = 0; q4 < 4; ++q4) {
                            if (q4 * 4 < r) {
                                const f32x4 n4 = *(const f32x4*)&Nm[(16 * I + r) * RS + 16 * I + q4 * 4];
#pragma unroll
                                for (int e = 0; e < 4; ++e) if (q4 * 4 + e < r) x[r] -= n4[e] * x[q4 * 4 + e];
                            }
                        }
                    }
#pragma unroll
                    for (int r = 0; r < 16; ++r) { src[(16 * I + r) * RS + col0 + lane] = x[r]; og[(16 * I + r) * 64 + col0 + lane] = (h16)x[r]; }
                }
                __builtin_amdgcn_s_waitcnt(0); __builtin_amdgcn_wave_barrier();
            }
        }
        __syncthreads();
        tid = otid(); lane = tid & 63; wave = tid >> 6;
        mm_nt<2>(Nm, Rh, Kh, wave, 8, lane);
        __syncthreads();
        tid = otid(); lane = tid & 63; wave = tid >> 6;
        for (int idx = wave; idx < 16; idx += 8) {
            const int ti = idx >> 2, tj = idx & 3, g = lane >> 4, cc = lane & 15;
            f32x4 a1, a2 = {0.f, 0.f, 0.f, 0.f};
#pragma unroll
            for (int r = 0; r < 4; ++r) a1[r] = Rh[(ti * 16 + 4 * g + r) * RS + tj * 16 + cc];
            a1 = mm_nn_tile(a1, Mm, Ah, ti, tj, lane, -1.f);
            a2 = mm_nn_tile(a2, Nm, Vv, ti, tj, lane, 1.f);
            a2 = mm_nn_tile(a2, Mm, T1, ti, tj, lane, -1.f);
#pragma unroll
            for (int r = 0; r < 4; ++r) { const int row = ti * 16 + 4 * g + r, col = tj * 16 + cc; p.rw_Ry[ub + row * 64 + col] = (h16)a1[r]; p.rw_Y0[ub + row * 64 + col] = (h16)a2[r]; }
        }
    }
}
__device__ __forceinline__ void ph_rw_b(CP p, int bid, char* smem) {
    h16* Sh = (h16*)smem;
    h16* Uh = Sh + 64 * 72;
    const int tid = otid(), lane = tid & 63, wave = tid >> 6, g = lane >> 4, cc = lane & 15;
    const int vt = wave >> 1, hf = wave & 1;
    const int b = bid >> 2, h = bid & 3;
    f32x4 S[2];
    S[0] = (f32x4){0.f, 0.f, 0.f, 0.f}; S[1] = S[0];
#define RWB_DECL(X) h16x8 X##W00, X##W01, X##W10, X##W11, X##B00, X##B01, X##B10, X##B11; h16x4 X##U0, X##U1, X##V0, X##V1; float X##G0 = 0.f, X##G1 = 0.f
#define RWB_LD(X, C_) do { const int c_ = (C_) < 64 ? (C_) : 63; const size_t ub = ((size_t)(b * 64 + c_) * 4 + h) * 4096; \
        const int r0 = (2 * hf) * 16 + cc, r1 = (2 * hf + 1) * 16 + cc; \
        X##W00 = *(const h16x8*)(p.rw_W + ub + r0 * 64 + 8 * g); X##W01 = *(const h16x8*)(p.rw_W + ub + r0 * 64 + 32 + 8 * g); \
        X##W10 = *(const h16x8*)(p.rw_W + ub + r1 * 64 + 8 * g); X##W11 = *(const h16x8*)(p.rw_W + ub + r1 * 64 + 32 + 8 * g); \
        X##B00 = *(const h16x8*)(p.rw_Be + ub + r0 * 64 + 8 * g); X##B01 = *(const h16x8*)(p.rw_Be + ub + r0 * 64 + 32 + 8 * g); \
        X##B10 = *(const h16x8*)(p.rw_Be + ub + r1 * 64 + 8 * g); X##B11 = *(const h16x8*)(p.rw_Be + ub + r1 * 64 + 32 + 8 * g); \
        X##U0 = *(const h16x4*)(p.rw_U0 + ub + r0 * 64 + vt * 16 + 4 * g); X##U1 = *(const h16x4*)(p.rw_U0 + ub + r1 * 64 + vt * 16 + 4 * g); \
        X##V0 = *(const h16x4*)(p.rw_VK + ub + r0 * 64 + vt * 16 + 4 * g); X##V1 = *(const h16x4*)(p.rw_VK + ub + r1 * 64 + vt * 16 + 4 * g); \
        X##G0 = p.rw_gam[((size_t)(b * 64 + c_) * 4 + h) * 64 + r0]; X##G1 = p.rw_gam[((size_t)(b * 64 + c_) * 4 + h) * 64 + r1]; } while (0)
#define RWB_BODY(X, C_) do { \
        _Pragma("unroll") for (int j = 0; j < 2; ++j) _Pragma("unroll") for (int r = 0; r < 4; ++r) Sh[(vt * 16 + 4 * g + r) * 72 + (2 * hf + j) * 16 + cc] = (h16)S[j][r]; \
        lds_barrier(); \
          \
        { const int row = tid >> 3, kc = (tid & 7) * 8; if ((C_) >= 3) *(h16x8*)(p.rw_S0 + ((size_t)(b * 64 + (C_) - 3) * 4 + h) * 4096 + row * 64 + kc) = pd0; pd0 = pd1; pd1 = pd2; pd2 = *(const h16x8*)&Sh[row * 72 + kc]; } \
        h16x8 Af0 = *(const h16x8*)&Sh[(vt * 16 + cc) * 72 + 8 * g], Af1 = *(const h16x8*)&Sh[(vt * 16 + cc) * 72 + 32 + 8 * g]; \
        f32x4 Ut0 = {(float)X##U0[0], (float)X##U0[1], (float)X##U0[2], (float)X##U0[3]}, Ut1 = {(float)X##U1[0], (float)X##U1[1], (float)X##U1[2], (float)X##U1[3]}; \
        Ut0 = __builtin_amdgcn_mfma_f32_16x16x32_f16(Af0, X##W00, Ut0, 0, 0, 0); Ut1 = __builtin_amdgcn_mfma_f32_16x16x32_f16(Af0, X##W10, Ut1, 0, 0, 0); \
        Ut0 = __builtin_amdgcn_mfma_f32_16x16x32_f16(Af1, X##W01, Ut0, 0, 0, 0); Ut1 = __builtin_amdgcn_mfma_f32_16x16x32_f16(Af1, X##W11, Ut1, 0, 0, 0); \
        _Pragma("unroll") for (int r = 0; r < 4; ++r) { Uh[(vt * 16 + 4 * g + r) * 72 + (2 * hf) * 16 + cc] = (h16)Ut0[r]; Uh[(vt * 16 + 4 * g + r) * 72 + (2 * hf + 1) * 16 + cc] = (h16)Ut1[r]; } \
        lds_barrier(); \
        Af0 = *(const h16x8*)&Uh[(vt * 16 + cc) * 72 + 8 * g]; Af1 = *(const h16x8*)&Uh[(vt * 16 + cc) * 72 + 32 + 8 * g]; \
        f32x4 a0, a1; \
        _Pragma("unroll") for (int r = 0; r < 4; ++r) { a0[r] = S[0][r] * X##G0 + (float)X##V0[r]; a1[r] = S[1][r] * X##G1 + (float)X##V1[r]; } \
        a0 = __builtin_amdgcn_mfma_f32_16x16x32_f16(Af0, X##B00, a0, 0, 0, 0); a1 = __builtin_amdgcn_mfma_f32_16x16x32_f16(Af0, X##B10, a1, 0, 0, 0); \
        a0 = __builtin_amdgcn_mfma_f32_16x16x32_f16(Af1, X##B01, a0, 0, 0, 0); a1 = __builtin_amdgcn_mfma_f32_16x16x32_f16(Af1, X##B11, a1, 0, 0, 0); \
        S[0] = a0; S[1] = a1; } while (0)
    RWB_DECL(x_); RWB_DECL(y_); RWB_DECL(z_);
    h16x8 pd0 = {}, pd1 = {}, pd2 = {};
    RWB_LD(x_, 0); RWB_LD(y_, 1);
    for (int c = 0; c < 66; c += 3) {
        RWB_LD(z_, c + 2);
        if (c < 64) RWB_BODY(x_, c);
        RWB_LD(x_, c + 3);
        if (c + 1 < 64) RWB_BODY(y_, c + 1);
        RWB_LD(y_, c + 4);
        if (c + 2 < 64) RWB_BODY(z_, c + 2);
    }
    { const int row = tid >> 3, kc = (tid & 7) * 8;
      *(h16x8*)(p.rw_S0 + ((size_t)(b * 64 + 61) * 4 + h) * 4096 + row * 64 + kc) = pd0; *(h16x8*)(p.rw_S0 + ((size_t)(b * 64 + 62) * 4 + h) * 4096 + row * 64 + kc) = pd1; *(h16x8*)(p.rw_S0 + ((size_t)(b * 64 + 63) * 4 + h) * 4096 + row * 64 + kc) = pd2; }
#undef RWB_DECL
#undef RWB_LD
#undef RWB_BODY
}
__device__ __forceinline__ void ph_rw_c(CP p, int l, int bid, int nblk) {
    const int tid = otid(), lane = tid & 63, wave = tid >> 6, g = lane >> 4, cc = lane & 15;
    const int h = wave >> 1, th = wave & 1;
    for (int u = bid; u < 256; u += nblk) {
        const int b = u >> 6, c = u & 63;
        const size_t ub = ((size_t)(b * 64 + c) * 4 + h) * 4096;
        h16x8 Af[4][2];
#pragma unroll
        for (int vt = 0; vt < 4; ++vt)
#pragma unroll
            for (int ks = 0; ks < 2; ++ks) Af[vt][ks] = *(const h16x8*)(p.rw_S0 + ub + (vt * 16 + cc) * 64 + ks * 32 + 8 * g);
#pragma unroll
        for (int j = 0; j < 2; ++j) {
            const int t = (2 * th + j) * 16 + cc;
            const h16x8 B0 = *(const h16x8*)(p.rw_Ry + ub + t * 64 + 8 * g), B1 = *(const h16x8*)(p.rw_Ry + ub + t * 64 + 32 + 8 * g);
            f32x4 y[4]; float sum = 0.f;
#pragma unroll
            for (int vt = 0; vt < 4; ++vt) {
                const h16x4 yi = *(const h16x4*)(p.rw_Y0 + ub + t * 64 + vt * 16 + 4 * g);
                f32x4 acc = {(float)yi[0], (float)yi[1], (float)yi[2], (float)yi[3]};
                acc = __builtin_amdgcn_mfma_f32_16x16x32_f16(Af[vt][0], B0, acc, 0, 0, 0);
                acc = __builtin_amdgcn_mfma_f32_16x16x32_f16(Af[vt][1], B1, acc, 0, 0, 0);
                y[vt] = acc; sum += acc[0] + acc[1] + acc[2] + acc[3];
            }
            sum = rows_sum(sum);
            const float mean = sum * (1.f / 64.f);
            float vs = 0.f;
#pragma unroll
            for (int vt = 0; vt < 4; ++vt)
#pragma unroll
                for (int r = 0; r < 4; ++r) { const float d = y[vt][r] - mean; vs += d * d; }
            vs = rows_sum(vs);
            const float rstd = rsqrtf(vs * (1.f / 64.f) + 64e-5f);
            const size_t tok = (size_t)b * SEQ + c * 64 + t;
#pragma unroll
            for (int vt = 0; vt < 4; ++vt) {
                const int ch = h * 64 + vt * 16 + 4 * g;
                const f32x4 gw = *(const f32x4*)(p.in[I_RWGNW] + l * 256 + ch), gb = *(const f32x4*)(p.in[I_RWGNB] + l * 256 + ch);
                const h16x4 bo = *(const h16x4*)(p.rw_bonus + tok * 256 + ch), gg = *(const h16x4*)(p.rw_g + tok * 256 + ch);
                float o[4];
#pragma unroll
                for (int r = 0; r < 4; ++r) o[r] = ((y[vt][r] - mean) * rstd * gw[r] + gb[r] + (float)bo[r]) * (float)gg[r];
                *(h16x4*)(p.branches + tok * DM + 768 + ch) = pack4(o[0], o[1], o[2], o[3]);
            }
        }
    }
}

__device__ __forceinline__ void ph_dsa_pre(CP p, int bid, int nblk) {
    const int lane = otid() & 63, wv = otid() >> 6;
    for (int tok = bid * 8 + wv; tok < NTOK; tok += nblk * 8) {
        const int i = lane & 31;
        const float c = p.ropet[((size_t)tok * 32 + i) * 2], s = p.ropet[((size_t)tok * 32 + i) * 2 + 1];
        const int base = (lane < 32) ? P_Q : P_K;
        h16* dst = p.proj + (size_t)tok * PJ + base;
        const float scl = (lane < 32) ? 0.125f : 1.f;
#pragma unroll
        for (int h = 0; h < 4; ++h) {
            const float x1 = (float)dst[h * 64 + i], x2 = (float)dst[h * 64 + 32 + i];
            dst[h * 64 + i] = (h16)((x1 * c - x2 * s) * scl);
            dst[h * 64 + 32 + i] = (h16)((x2 * c + x1 * s) * scl);
        }
        const int i2 = lane & 15;
        const float c2 = p.ropet[((size_t)tok * 32 + 2 * i2) * 2], s2 = p.ropet[((size_t)tok * 32 + 2 * i2) * 2 + 1];
        float* xf = p.idxf + (size_t)tok * IDXLD;
        if (lane < 16) {
#pragma unroll
            for (int h = 0; h < 4; ++h) {
                const float x1 = xf[h * 32 + i2], x2 = xf[h * 32 + 16 + i2];
                xf[h * 32 + i2] = x1 * c2 - x2 * s2;
                xf[h * 32 + 16 + i2] = x2 * c2 + x1 * s2;
            }
        } else if (lane < 32) {
            const float x1 = xf[128 + i2], x2 = xf[128 + 16 + i2];
            xf[128 + i2] = x1 * c2 - x2 * s2;
            xf[128 + 16 + i2] = x2 * c2 + x1 * s2;
        }
    }
}
__device__ __forceinline__ unsigned f2key(float x) { unsigned u = __float_as_uint(x); return (u & 0x80000000u) ? ~u : (u | 0x80000000u); }
__device__ __forceinline__ void ph_dsa_naive(CP p, int bid, int nblk, char* smem) {
    const int lane = otid() & 63, wv = otid() >> 6;
    unsigned* s_key = (unsigned*)smem + wv * 4096;
    float* s_p = (float*)s_key;
    float* s_iq = (float*)(smem + 8 * 4096 * 4) + wv * 128;
    float* s_q = (float*)(smem + 8 * 4096 * 4 + 8 * 128 * 4) + wv * 256;
    int* s_list = (int*)(smem + 8 * 4096 * 4 + 8 * 128 * 4 + 8 * 256 * 4) + wv * 256;
    const unsigned long long lt_mask = (lane == 0) ? 0ull : (~0ull >> (64 - lane));
    for (int tok = bid * 8 + wv; tok < NTOK; tok += nblk * 8) {
        const int b = tok / SEQ, t = tok % SEQ;
        s_iq[lane] = p.idxf[(size_t)tok * IDXLD + lane]; s_iq[64 + lane] = p.idxf[(size_t)tok * IDXLD + 64 + lane];
        for (int i = 0; i < 4; ++i) s_q[i * 64 + lane] = (float)p.proj[(size_t)tok * PJ + P_Q + i * 64 + lane];
        const float w0 = p.idxf[(size_t)tok * IDXLD + 160], w1 = p.idxf[(size_t)tok * IDXLD + 161], w2 = p.idxf[(size_t)tok * IDXLD + 162], w3 = p.idxf[(size_t)tok * IDXLD + 163];
        __builtin_amdgcn_s_waitcnt(0); __builtin_amdgcn_wave_barrier();
        const int n = t + 1;
        const int nch = (t >> 6) + 1;
#pragma unroll 1
        for (int i = 0; i < nch; ++i) {
            const int s = lane + 64 * i;
            unsigned kv_ = 0u;
            if (s <= t) {
                const float* kp = p.idxf + ((size_t)b * SEQ + s) * IDXLD + 128;
                float d0 = 0.f, d1 = 0.f, d2 = 0.f, d3 = 0.f;
#pragma unroll
                for (int d4 = 0; d4 < 8; ++d4) {
                    const f32x4 kv = *(const f32x4*)(kp + d4 * 4);
#pragma unroll
                    for (int e = 0; e < 4; ++e) { const int d = d4 * 4 + e; d0 += s_iq[d] * kv[e]; d1 += s_iq[32 + d] * kv[e]; d2 += s_iq[64 + d] * kv[e]; d3 += s_iq[96 + d] * kv[e]; }
                }
                const float sc = w0 * fmaxf(d0, 0.f) + w1 * fmaxf(d1, 0.f) + w2 * fmaxf(d2, 0.f) + w3 * fmaxf(d3, 0.f);
                kv_ = f2key(sc + 0.f);
            }
            s_key[s] = kv_;
        }
        __builtin_amdgcn_s_waitcnt(0); __builtin_amdgcn_wave_barrier();
        int cnt_sel;
        if (n <= 256) {
            for (int i = 0; i < 4; ++i) { const int s = lane + 64 * i; if (s <= t) s_list[s] = s; }
            cnt_sel = n;
        } else {
            unsigned v = 0u;
#pragma unroll 1
            for (int bit = 31; bit >= 0; --bit) {
                const unsigned cand = v | (1u << bit);
                int c = 0;
#pragma unroll 4
                for (int i = 0; i < nch; ++i) c += __popcll(__ballot(s_key[lane + 64 * i] >= cand));
                if (c >= 256) v = cand;
            }
            int cgt = 0;
#pragma unroll 4
            for (int i = 0; i < nch; ++i) cgt += __popcll(__ballot(s_key[lane + 64 * i] > v));
            const int need = 256 - cgt;
            int nsel = 0, nties = 0;
#pragma unroll 1
            for (int i = 0; i < nch; ++i) {
                const unsigned kx = s_key[lane + 64 * i];
                const bool gt = kx > v, eq = kx == v;
                const unsigned long long eqm = __ballot(eq);
                const int trank = nties + __popcll(eqm & lt_mask);
                const bool sel = gt || (eq && trank < need);
                const unsigned long long sm = __ballot(sel);
                if (sel) s_list[nsel + __popcll(sm & lt_mask)] = lane + 64 * i;
                nsel += __popcll(sm); nties += __popcll(eqm);
            }
            cnt_sel = nsel;
        }
        __builtin_amdgcn_s_waitcnt(0); __builtin_amdgcn_wave_barrier();
        float lg[4][4];
#pragma unroll
        for (int jj = 0; jj < 4; ++jj) {
            const int j = lane + 64 * jj;
#pragma unroll
            for (int h = 0; h < 4; ++h) lg[jj][h] = -INFINITY;
            if (j < cnt_sel) {
                const int s = s_list[j];
                const h16* kp = p.proj + ((size_t)b * SEQ + s) * PJ + P_K;
#pragma unroll
                for (int h = 0; h < 4; ++h) {
                    float a = 0.f;
#pragma unroll
                    for (int d8 = 0; d8 < 8; ++d8) { const h16x8 kv = *(const h16x8*)(kp + h * 64 + d8 * 8);
#pragma unroll
                        for (int e = 0; e < 8; ++e) a += s_q[h * 64 + d8 * 8 + e] * (float)kv[e]; }
                    lg[jj][h] = a;
                }
            }
        }
        float inv[4];
#pragma unroll
        for (int h = 0; h < 4; ++h) {
            float m = fmaxf(fmaxf(lg[0][h], lg[1][h]), fmaxf(lg[2][h], lg[3][h]));
            m = wave_max(m);
            float sm = 0.f;
#pragma unroll
            for (int jj = 0; jj < 4; ++jj) { const float e = (lane + 64 * jj < cnt_sel) ? __expf(lg[jj][h] - m) : 0.f; s_p[h * 256 + lane + 64 * jj] = e; sm += e; }
            sm = wave_sum(sm);
            inv[h] = 1.f / sm;
        }
        __builtin_amdgcn_s_waitcnt(0); __builtin_amdgcn_wave_barrier();
        const int hh = lane >> 4;
        float o0 = 0.f, o1 = 0.f, o2 = 0.f, o3 = 0.f;
#pragma unroll 4
        for (int j = 0; j < cnt_sel; ++j) {
            const int s = s_list[j]; const float pj = s_p[hh * 256 + j];
            const h16x4 vv = *(const h16x4*)(p.proj + ((size_t)b * SEQ + s) * PJ + P_V + lane * 4);
            o0 += pj * (float)vv[0]; o1 += pj * (float)vv[1]; o2 += pj * (float)vv[2]; o3 += pj * (float)vv[3];
        }
        const float iv = (hh == 0) ? inv[0] : (hh == 1) ? inv[1] : (hh == 2) ? inv[2] : inv[3];
        *(h16x4*)(p.branches + (size_t)tok * DM + 256 + lane * 4) = pack4(o0 * iv, o1 * iv, o2 * iv, o3 * iv);
        __builtin_amdgcn_s_waitcnt(0); __builtin_amdgcn_wave_barrier();
    }
}
#define DSA_NAIVE_LDS (8 * 4096 * 4 + 8 * 128 * 4 + 8 * 256 * 4 + 8 * 256 * 4)

#define IDXH (2 * IDXLD)
__device__ __forceinline__ float idx_score(const f32x4 (&d)[4], const float (&w)[4], int r) {
    float sc = w[0] * fmaxf(d[0][r], 0.f);
    sc = __fmaf_rn(w[1], fmaxf(d[1][r], 0.f), sc);
    sc = __fmaf_rn(w[2], fmaxf(d[2][r], 0.f), sc);
    sc = __fmaf_rn(w[3], fmaxf(d[3][r], 0.f), sc);
    return sc + 0.f;
}
__device__ __forceinline__ f32x4 idx_dot(h16x8 khi, h16x8 klo, h16x8 qhi, h16x8 qlo) {
    f32x4 acc = {0.f, 0.f, 0.f, 0.f};
    acc = __builtin_amdgcn_mfma_f32_16x16x32_f16(khi, qhi, acc, 0, 0, 0);
    acc = __builtin_amdgcn_mfma_f32_16x16x32_f16(klo, qhi, acc, 0, 0, 0);
    acc = __builtin_amdgcn_mfma_f32_16x16x32_f16(khi, qlo, acc, 0, 0, 0);
    return acc;
}
__device__ __forceinline__ void ph_dsa_pre2(CP p, int bid, int nblk, char* smem) {
    h16* vt_s = (h16*)smem;
    for (int u = bid; u < NTOK / 64; u += nblk) {
        const int tid = otid(), lane = tid & 63, wv = tid >> 6;
        const int tok0 = u * 64;
        __syncthreads();
        for (int q = 0; q < 8; ++q) {
            const int tok = tok0 + wv * 8 + q;
            const int i = lane & 31;
            const float c = p.ropet[((size_t)tok * 32 + i) * 2], s = p.ropet[((size_t)tok * 32 + i) * 2 + 1];
            const int base = (lane < 32) ? P_Q : P_K;
            h16* dst = p.proj + (size_t)tok * PJ + base;
            const float scl = (lane < 32) ? 0.125f : 1.f;
#pragma unroll
            for (int h = 0; h < 4; ++h) {
                const float x1 = (float)dst[h * 64 + i], x2 = (float)dst[h * 64 + 32 + i];
                dst[h * 64 + i] = (h16)((x1 * c - x2 * s) * scl);
                dst[h * 64 + 32 + i] = (h16)((x2 * c + x1 * s) * scl);
            }
            const int i2 = lane & 15;
            const float c2 = p.ropet[((size_t)tok * 32 + 2 * i2) * 2], s2 = p.ropet[((size_t)tok * 32 + 2 * i2) * 2 + 1];
            float* xf = p.idxf + (size_t)tok * IDXLD;
            h16* xh = (h16*)xf;
            float o1[4], o2[4];
            if (lane < 16) {
#pragma unroll
                for (int h = 0; h < 4; ++h) { const float x1 = xf[h * 32 + i2], x2 = xf[h * 32 + 16 + i2]; o1[h] = x1 * c2 - x2 * s2; o2[h] = x2 * c2 + x1 * s2; }
            } else if (lane < 32) {
                const float x1 = xf[128 + i2], x2 = xf[128 + 16 + i2]; o1[0] = x1 * c2 - x2 * s2; o2[0] = x2 * c2 + x1 * s2;
            }
            asm volatile("s_waitcnt vmcnt(0)" ::: "memory");
            __builtin_amdgcn_wave_barrier();
            if (lane < 16) {
#pragma unroll
                for (int h = 0; h < 4; ++h) {
                    const h16 h1 = (h16)o1[h], h2 = (h16)o2[h];
                    xh[h * 32 + i2] = h1; xh[h * 32 + 16 + i2] = h2;
                    xh[128 + h * 32 + i2] = (h16)(o1[h] - (float)h1); xh[128 + h * 32 + 16 + i2] = (h16)(o2[h] - (float)h2);
                }
            } else if (lane < 32) {
                const h16 h1 = (h16)o1[0], h2 = (h16)o2[0];
                xh[256 + i2] = h1; xh[256 + 16 + i2] = h2;
                xh[288 + i2] = (h16)(o1[0] - (float)h1); xh[288 + 16 + i2] = (h16)(o2[0] - (float)h2);
            }
            *(h16x4*)&vt_s[(wv * 8 + q) * 264 + lane * 4] = *(const h16x4*)(p.proj + (size_t)tok * PJ + P_V + lane * 4);
        }
        __syncthreads();
        {
            const int dim = tid >> 1, hf = tid & 1, b = tok0 / SEQ, t0 = tok0 % SEQ;
            h16* dst = p.vT + ((size_t)b * 256 + dim) * SEQ + t0 + hf * 32;
#pragma unroll
            for (int k8 = 0; k8 < 4; ++k8) {
                h16x8 v;
#pragma unroll
                for (int e = 0; e < 8; ++e) v[e] = vt_s[(hf * 32 + k8 * 8 + e) * 264 + dim];
                *(h16x8*)(dst + k8 * 8) = v;
            }
        }
    }
}
#define DSAA_LDS (8 * 4096 * 4)
__device__ __forceinline__ size_t dmask_off(int b, int t) { const int a = t >> 6, r = t & 63; return (size_t)b * 133120 + (size_t)32 * a * (a + 1) + (size_t)r * (a + 1); }
__device__ __forceinline__ void ph_dsa_a(CP p, int l, char* smem) {
    unsigned* Kq = (unsigned*)smem;
    int* qslot = (int*)(smem + DSAA_LDS + 2048);
    for (;;) {
        const int tid = otid(), lane = tid & 63, wave = __builtin_amdgcn_readfirstlane(tid >> 6), g = lane >> 4, c = lane & 15;
        __syncthreads();
        if (tid == 0) *qslot = atomicAdd(&p.qctr[l], 1);
        __syncthreads();
        const int kq = __builtin_amdgcn_readfirstlane(*qslot);
        if (kq >= 1024) break;
        const int b = kq < 960 ? (kq & 3) : ((kq - 960) >> 4), qb = kq < 960 ? 255 - (kq >> 2) : ((kq - 960) & 15), q0 = qb * 16;
        if (qb < 16) {
            if (tid < 64) { const int t = q0 + (tid >> 2), wd = tid & 3, a = t >> 6;
                if (wd <= a) p.dmask[dmask_off(b, t) + wd] = (wd < a) ? ~0ull : (~0ull >> (63 - (t & 63))); }
            continue; }
        const size_t tokq = (size_t)b * SEQ + q0 + c;
        const h16* qrow = (const h16*)(p.idxf + tokq * IDXLD);
        h16x8 qh[4], ql[4]; float w[4];
#pragma unroll
        for (int h = 0; h < 4; ++h) { qh[h] = *(const h16x8*)(qrow + h * 32 + 8 * g); ql[h] = *(const h16x8*)(qrow + 128 + h * 32 + 8 * g); w[h] = p.idxf[tokq * IDXLD + 160 + h]; }
        const int ntiles = qb + 1;
        const int nslots = (ntiles - wave + 7) >> 3;
        const int nch = (16 * ntiles + 63) >> 6;
        const int tq = q0 + c;
        const h16* kbase = (const h16*)(p.idxf + ((size_t)b * SEQ + c) * IDXLD) + 256 + 8 * g;
        u32x4 K4[32];
        {
            h16x8 kh[2], kl[2];
#pragma unroll
            for (int q = 0; q < 2; ++q) {
                int j = wave + 8 * q; j = j < ntiles ? j : ntiles - 1;
                kh[q] = *(const h16x8*)(kbase + (size_t)16 * j * IDXH); kl[q] = *(const h16x8*)(kbase + (size_t)16 * j * IDXH + 32);
            }
#pragma unroll
            for (int i = 0; i < 32; ++i) {
                K4[i] = (u32x4){0u, 0u, 0u, 0u};
                if (i < nslots) {
                    const int j = wave + 8 * i;
                    f32x4 d[4];
#pragma unroll
                    for (int h = 0; h < 4; ++h) d[h] = idx_dot(kh[i & 1], kl[i & 1], qh[h], ql[h]);
                    if (i + 2 < nslots) { const int j2 = j + 16; kh[i & 1] = *(const h16x8*)(kbase + (size_t)16 * j2 * IDXH); kl[i & 1] = *(const h16x8*)(kbase + (size_t)16 * j2 * IDXH + 32); }
#pragma unroll
                    for (int r = 0; r < 4; ++r) { const int sidx = 16 * j + 4 * g + r; const unsigned kk = f2key(idx_score(d, w, r)); K4[i][r] = (sidx <= tq) ? kk : 0u; }
                }
            }
        }
#pragma unroll 1
        for (int bt = 0; bt < 2; ++bt) {
            __syncthreads();
            if ((c >> 3) == bt) {
#pragma unroll
                for (int i = 0; i < 32; ++i) if (i < nslots) *(u32x4*)&Kq[(c & 7) * 4096 + 16 * (wave + 8 * i) + 4 * g] = K4[i];
            }
            __syncthreads();
            {
                const unsigned* myk = Kq + wave * 4096 + lane;
                unsigned kv[64];
#pragma unroll
                for (int m = 0; m < 64; ++m) kv[m] = (m < nch && lane + 64 * m < 16 * ntiles) ? myk[64 * m] : 0u;
                unsigned v = 0u; int cut = 4095; bool done = false;
#pragma unroll 1
                for (int bit = 31; bit >= 0; --bit) {
                    const unsigned cand = v | (1u << bit);
                    int cl = 0;
#pragma unroll
                    for (int m = 0; m < 64; ++m) cl += (kv[m] >= cand) ? 1 : 0;
                    const int cn = __builtin_amdgcn_readfirstlane(wave_isum(cl));
                    if (cn == 256) { v = cand - 1u; cut = -1; done = true; break; }
                    if (cn > 256) v = cand;
                }
                if (!done) {
                    int cgl = 0, cel = 0;
#pragma unroll
                    for (int m = 0; m < 64; ++m) { cgl += (kv[m] > v) ? 1 : 0; cel += (kv[m] == v) ? 1 : 0; }
                    const int cgt = __builtin_amdgcn_readfirstlane(wave_isum(cgl)), ceq = __builtin_amdgcn_readfirstlane(wave_isum(cel));
                    const int need = 256 - cgt;
                    if (ceq > need) {
                        int run = 0; cut = 4095; bool found = false;
#pragma unroll
                        for (int m = 0; m < 64; ++m) {
                            unsigned long long mk = __ballot(kv[m] == v);
                            const int pc = __popcll(mk);
                            if (!found && run + pc >= need) {
                                int kth = need - run;
                                while (kth > 1) { mk &= mk - 1ull; --kth; }
                                cut = (int)__builtin_ctzll(mk) + 64 * m; found = true;
                            }
                            run += pc;
                        }
                    }
                }
                {
                    unsigned long long* sm = (unsigned long long*)(smem + DSAA_LDS + 4096) + wave * 64;
#pragma unroll 1
                    for (int m = 0; m < nch; ++m) {
                        const unsigned kx = (lane + 64 * m < 16 * ntiles) ? myk[64 * m] : 0u;
                        const int cm_ = cut - 64 * m;
                        const unsigned long long mk = __ballot(kx > v || (kx == v && lane <= cm_));
                        sm[m] = mk;
                    }
                    __builtin_amdgcn_s_waitcnt(0); __builtin_amdgcn_wave_barrier();
                    if (lane < nch) p.dmask[dmask_off(b, q0 + bt * 8 + wave) + lane] = sm[lane];
                }
            }
        }
    }
}
#define KS_LD 264
#define VT_LD 72
#define IK_LD 72
#define DSAB_LDS (64 * KS_LD * 2 + 256 * VT_LD * 2 + 64 * KS_LD * 2)
__device__ __forceinline__ void ph_dsa_b(CP p, int bid, int nblk, char* smem) {
    h16* Ks = (h16*)smem;
    h16* Vt = Ks + 64 * KS_LD;
    h16* Qs = Vt + 256 * VT_LD;
    float* mrg = (float*)smem;
    for (int wi = bid; wi < 512; wi += nblk) {
        const int tid = otid(), lane = tid & 63, wave = tid >> 6, g = lane >> 4, c = lane & 15;
        const int qt = wave & 3, kg = wave >> 2;
        const int half = wi >> 8;
        const int x_ = wi & 7, r_ = (wi & 255) >> 3;
        const int b = (nblk == 256) ? (x_ >> 1) : ((wi & 255) >> 6), j_ = (nblk == 256) ? ((x_ & 1) * 32 + r_) : (wi & 63);
        const int qblk = half ? j_ : 63 - j_, q0 = qblk * 64;
        const int tq = q0 + 16 * qt + c;
        const size_t tokq = (size_t)b * SEQ + tq;
        __syncthreads();
        for (int i = tid; i < 64 * 32; i += 512) {
            const int row = i >> 5, ch = i & 31; const size_t tk = (size_t)b * SEQ + q0 + row;
            *(u32x4*)&Qs[row * KS_LD + ch * 8] = *(const u32x4*)(p.proj + tk * PJ + P_Q + ch * 8);
        }
        const unsigned long long* mrow = p.dmask + dmask_off(b, tq);
        f32x4 O[4][4];
        float mrun[4], lrun[4];
#pragma unroll
        for (int h = 0; h < 4; ++h) { mrun[h] = -1e30f; lrun[h] = 0.f;
#pragma unroll
            for (int dt = 0; dt < 4; ++dt) O[h][dt] = (f32x4){0.f, 0.f, 0.f, 0.f}; }
        const int nall = qblk + 1, hs_ = (nall + 1) >> 1;
        const int sb = half ? hs_ : 0, nsteps = half ? nall : hs_;
        u32x4 rk[4], rv[4]; unsigned long long mw, mwn = 0ull;
#define DSAB_GLOAD(S_) do { const size_t kb_ = (size_t)b * SEQ + 64 * (S_); \
            _Pragma("unroll") for (int i = 0; i < 4; ++i) { const int ch = tid + 512 * i; rk[i] = *(const u32x4*)(p.proj + (kb_ + (ch >> 5)) * PJ + P_K + (ch & 31) * 8); } \
            _Pragma("unroll") for (int i = 0; i < 4; ++i) { const int ch = tid + 512 * i; rv[i] = *(const u32x4*)(p.vT + ((size_t)b * 256 + (ch >> 3)) * SEQ + 64 * (S_) + (ch & 7) * 8); } \
            mwn = mrow[(S_)]; } while (0)
#define DSAB_LSTORE() do { \
            _Pragma("unroll") for (int i = 0; i < 4; ++i) { const int ch = tid + 512 * i; *(u32x4*)&Ks[(ch >> 5) * KS_LD + (ch & 31) * 8] = rk[i]; } \
            _Pragma("unroll") for (int i = 0; i < 4; ++i) { const int ch = tid + 512 * i; *(u32x4*)&Vt[(ch >> 3) * VT_LD + (ch & 7) * 8] = rv[i]; } \
            } while (0)
        __syncthreads();
        if (sb < nsteps) { DSAB_GLOAD(sb); DSAB_LSTORE(); }
        __syncthreads();
        for (int s = sb; s < nsteps; ++s) {
            mw = mwn;
            if (s + 1 < nsteps) DSAB_GLOAD(s + 1);
            int qo_ = (16 * qt + c) * KS_LD; asm volatile("" : "+v"(qo_));
            const h16* qrow_ = Qs + qo_;
            bool msk[2][4];
            {
                const unsigned w32 = (unsigned)(mw >> (32 * kg));
#pragma unroll
                for (int jt = 0; jt < 2; ++jt)
#pragma unroll
                    for (int r = 0; r < 4; ++r) msk[jt][r] = (w32 >> (16 * jt + 4 * g + r)) & 1u;
            }
#pragma unroll
            for (int h = 0; h < 4; ++h) {
                f32x4 S[2];
                {
                    const h16x8 q0_ = *(const h16x8*)(qrow_ + h * 64 + 8 * g), q1_ = *(const h16x8*)(qrow_ + h * 64 + 32 + 8 * g);
#pragma unroll
                    for (int jt = 0; jt < 2; ++jt) {
                        const int row = 32 * kg + 16 * jt + c;
                        f32x4 acc = {0.f, 0.f, 0.f, 0.f};
                        acc = __builtin_amdgcn_mfma_f32_16x16x32_f16(*(const h16x8*)&Ks[row * KS_LD + h * 64 + 8 * g], q0_, acc, 0, 0, 0);
                        acc = __builtin_amdgcn_mfma_f32_16x16x32_f16(*(const h16x8*)&Ks[row * KS_LD + h * 64 + 32 + 8 * g], q1_, acc, 0, 0, 0);
                        S[jt] = acc;
                    }
                }
                float mx = -1e30f;
#pragma unroll
                for (int jt = 0; jt < 2; ++jt)
#pragma unroll
                    for (int r = 0; r < 4; ++r) mx = fmaxf(mx, msk[jt][r] ? S[jt][r] : -1e30f);
                mx = rows_max(mx);
                const float mnew = fmaxf(mrun[h], mx);
                const float scale = __expf(mrun[h] - mnew);
                mrun[h] = mnew;
                float ps = 0.f; h16x8 pb;
#pragma unroll
                for (int jt = 0; jt < 2; ++jt)
#pragma unroll
                    for (int r = 0; r < 4; ++r) { const float pe = msk[jt][r] ? __expf(S[jt][r] - mnew) : 0.f; ps += pe; pb[jt * 4 + r] = (h16)pe; }
                lrun[h] = lrun[h] * scale + ps;
#pragma unroll
                for (int dt = 0; dt < 4; ++dt) {
                    f32x4 o = O[h][dt] * scale;
                    const int vrow = h * 64 + 16 * dt + c;
                    const h16x4 va = *(const h16x4*)&Vt[vrow * VT_LD + 32 * kg + 4 * g], vb = *(const h16x4*)&Vt[vrow * VT_LD + 32 * kg + 16 + 4 * g];
                    h16x8 av; av[0] = va[0]; av[1] = va[1]; av[2] = va[2]; av[3] = va[3]; av[4] = vb[0]; av[5] = vb[1]; av[6] = vb[2]; av[7] = vb[3];
                    O[h][dt] = __builtin_amdgcn_mfma_f32_16x16x32_f16(av, pb, o, 0, 0, 0);
                }
            }
            lds_barrier();
            if (s + 1 < nsteps) DSAB_LSTORE();
            lds_barrier();
        }
#pragma unroll
        for (int h = 0; h < 4; ++h) lrun[h] = rows_sum(lrun[h]);
        float* my = mrg + (size_t)(qt * 64 + lane) * 73;
        if (kg == 1) {
#pragma unroll
            for (int h = 0; h < 4; ++h) { my[h] = mrun[h]; my[4 + h] = lrun[h];
#pragma unroll
                for (int dt = 0; dt < 4; ++dt)
#pragma unroll
                    for (int r = 0; r < 4; ++r) my[8 + (h * 4 + dt) * 4 + r] = O[h][dt][r]; }
        }
        __syncthreads();
        if (kg == 0) {
            const size_t pq = ((size_t)((b * 64 + qblk) * 2 + half) * 64 + 16 * qt + c);
#pragma unroll
            for (int h = 0; h < 4; ++h) {
                const float m1 = my[h], l1 = my[4 + h];
                const float m = fmaxf(mrun[h], m1);
                const float e0 = __expf(mrun[h] - m), e1 = __expf(m1 - m);
                const float lt = lrun[h] * e0 + l1 * e1;
                const float inv = lt > 0.f ? 1.f / lt : 0.f;
                if (g == 0) { p.dsa_ml[pq * 8 + h * 2] = m; p.dsa_ml[pq * 8 + h * 2 + 1] = lt; }
#pragma unroll
                for (int dt = 0; dt < 4; ++dt) {
                    float o[4];
#pragma unroll
                    for (int r = 0; r < 4; ++r) o[r] = (O[h][dt][r] * e0 + my[8 + (h * 4 + dt) * 4 + r] * e1) * inv;
                    *(h16x4*)(p.dsa_op + pq * 256 + h * 64 + 16 * dt + 4 * g) = pack4(o[0], o[1], o[2], o[3]);
                }
            }
        }
        __syncthreads();
    }
}

__device__ __forceinline__ void ph_dsa_merge(CP p, int bid, int nblk) {
    const int lane = otid() & 63, wv = otid() >> 6;
    for (int tok = bid * 8 + wv; tok < NTOK; tok += nblk * 8) {
        const int b = tok / SEQ, t = tok % SEQ;
        const size_t p0 = ((size_t)((b * 64 + (t >> 6)) * 2) * 64 + (t & 63)), p1 = p0 + 64;
        const int h = lane >> 4;
        const float m0 = p.dsa_ml[p0 * 8 + h * 2], l0 = p.dsa_ml[p0 * 8 + h * 2 + 1], m1 = p.dsa_ml[p1 * 8 + h * 2], l1 = p.dsa_ml[p1 * 8 + h * 2 + 1];
        const h16x4 o0 = *(const h16x4*)(p.dsa_op + p0 * 256 + lane * 4), o1 = *(const h16x4*)(p.dsa_op + p1 * 256 + lane * 4);
        const float m = fmaxf(m0, m1);
        const float w0 = l0 * __expf(m0 - m), w1 = l1 * __expf(m1 - m);
        const float inv = 1.f / (w0 + w1);
        *(h16x4*)(p.branches + (size_t)tok * DM + 256 + lane * 4) = pack4(((float)o0[0] * w0 + (float)o1[0] * w1) * inv, ((float)o0[1] * w0 + (float)o1[1] * w1) * inv,
                                                                         ((float)o0[2] * w0 + (float)o1[2] * w1) * inv, ((float)o0[3] * w0 + (float)o1[3] * w1) * inv);
    }
}
__device__ __forceinline__ void ph_gates(CP p, int l, int bid, int nblk, char* smem) {
    pg8::Gemm g; g.A = p.h_hi; g.Bt = p.Wg; g.M = NTOK; g.N = 4096; g.K = DM; g.lda = DM; g.ldb = DM;
    pg8::StaticOrder S; S.init(NTOK, 4096, nblk, bid);
    pg8::EpiH16<1> E; E.O = p.gates; E.ldc = 4096; E.ncols = 4096; E.bias = p.in[I_GATEB] + (size_t)l * 4096;
    pg8::gemm_phase((PG8_LAS unsigned char*)smem, g, S, E);
}
__device__ __forceinline__ void ph_merge(CP p, int l, int bid, int nblk, char* smem) {
    for (int u = bid; u < 128 * 8; u += nblk) {
        const int mt = u >> 3, nt = u & 7, m0 = mt * 128, n0 = nt * 128;
        f32x4 mx[2][4]; zero_acc<128>(mx);
        f32x4 au[2][4]; zero_acc<128>(au);
        const int tid_ = otid(); const int lane = tid_ & 63, wave = tid_ >> 6, wm = wave >> 1, wn = wave & 1;
        const h16* A = p.branches + (size_t)m0 * DM; const h16* B = p.Wb + (size_t)n0 * 256;
        const h16* G = p.gates + (size_t)(m0 + wm * 32 + (lane & 15)) * 4096 + n0 + wn * 64 + 4 * (lane >> 4);
        gemm_kloop_seg<128>(smem, DM, [=](int r, int k) { return A + (size_t)r * DM + k; },
                            [=](int r, int k) { return B + ((size_t)(k >> 8) * 1024 + r) * 256 + (k & 255); }, au,
                            [&](int kt) {
                                if ((kt & 3) == 3) {
                                    const int n = kt >> 2;
#pragma unroll
                                    for (int i = 0; i < 2; ++i)
#pragma unroll
                                        for (int j = 0; j < 4; ++j) {
                                            const h16x4 gg = *(const h16x4*)(G + (size_t)i * 16 * 4096 + n * 1024 + j * 16);
#pragma unroll
                                            for (int e = 0; e < 4; ++e) mx[i][j][e] += (float)gg[e] * au[i][j][e];
                                            au[i][j] = (f32x4){0.f, 0.f, 0.f, 0.f};
                                        }
                                }
                            });
        h16* O = p.mixed + (size_t)m0 * DM + n0;
        gemm_epi<128>(mx, [=](int ml, int nl, f32x4 v) { *(h16x4*)(O + (size_t)ml * DM + nl) = pack4(v[0], v[1], v[2], v[3]); });
    }
}
__device__ __forceinline__ void ph_outproj(CP p, int l, int bid, int nblk, char* smem) {
    pg8::Gemm g; g.A = p.mixed; g.Bt = p.Wo; g.M = NTOK; g.N = DM; g.K = DM; g.lda = DM; g.ldb = DM;
    pg8::StaticOrder S; S.init(NTOK, DM, nblk, bid);
    pg8::EpiResid E; E.O = p.x1; E.X = l == 0 ? p.in[I_X] : p.x1; E.gate = p.mods + (size_t)l * 4 * 6144 + 2 * 1024;
    pg8::gemm_phase((PG8_LAS unsigned char*)smem, g, S, E);
}

__constant__ int c_pair_lo[6] = {0, 0, 0, 1, 1, 2};
__constant__ int c_pair_hi[6] = {1, 2, 3, 2, 3, 3};
__device__ __forceinline__ void ph_norm2_router(CP p, int l, int bid, int nblk, char* smem) {
    float* rw = (float*)smem;
    for (int i = otid(); i < DM * 16; i += 512) rw[i] = p.in[I_ROUTW][i];
    __syncthreads();
    const int lane = otid() & 63, wv = otid() >> 6;
    for (int tok = bid * 8 + wv; tok < NTOK; tok += nblk * 8) {
        const int b = tok / SEQ;
        const float* xr = p.x1 + (size_t)tok * DM;
        f32x4 v[4]; float ss = 0.f;
#pragma unroll
        for (int i = 0; i < 4; ++i) { v[i] = *(const f32x4*)(xr + i * 256 + lane * 4); ss += v[i][0] * v[i][0] + v[i][1] * v[i][1] + v[i][2] * v[i][2] + v[i][3] * v[i][3]; }
        ss = wave_sum(ss);
        const float rs = rsqrtf(ss * (1.f / DM) + 1e-6f);
        const float* g = p.in[I_FNG] + l * DM;
        const float* md = p.mods + ((size_t)l * 4 + b) * 6144;
        float lg[16];
#pragma unroll
        for (int e = 0; e < 16; ++e) lg[e] = 0.f;
#pragma unroll 1
        for (int i = 0; i < 4; ++i) {
            const int c = i * 256 + lane * 4;
            f32x4 gg = *(const f32x4*)(g + c), sh = *(const f32x4*)(md + 3 * 1024 + c), sc = *(const f32x4*)(md + 4 * 1024 + c);
            float hv[4];
#pragma unroll
            for (int e = 0; e < 4; ++e) hv[e] = v[i][e] * rs * gg[e] * (1.f + sc[e]) + sh[e];
            *(h16x4*)(p.h_hi + (size_t)tok * DM + c) = pack4(hv[0], hv[1], hv[2], hv[3]);
#pragma unroll 1
            for (int e = 0; e < 4; ++e) {
                const float* rr = rw + (c + e) * 16;
                const float hve = e == 0 ? hv[0] : e == 1 ? hv[1] : e == 2 ? hv[2] : hv[3];
#pragma unroll
                for (int x4 = 0; x4 < 4; ++x4) { const f32x4 r4 = *(const f32x4*)(rr + x4 * 4); lg[x4 * 4] += hve * r4[0]; lg[x4 * 4 + 1] += hve * r4[1]; lg[x4 * 4 + 2] += hve * r4[2]; lg[x4 * 4 + 3] += hve * r4[3]; }
            }
        }
#pragma unroll
        for (int e = 0; e < 16; ++e) lg[e] = wave_sum(lg[e]);
        if (lane == 0) {
            float sc[16], bi[16];
#pragma unroll
            for (int e = 0; e < 16; ++e) { sc[e] = 1.f / (1.f + expf(-lg[e])); bi[e] = sc[e] + p.in[I_ROUTB][e]; }
            int bg = 0; float bgs = -INFINITY;
#pragma unroll
            for (int gI = 0; gI < 4; ++gI) {
                float m1 = -INFINITY, m2 = -INFINITY;
#pragma unroll
                for (int j = 0; j < 4; ++j) { const float x = bi[gI * 4 + j]; if (x > m1) { m2 = m1; m1 = x; } else if (x > m2) m2 = x; }
                const float gs = m1 + m2;
                if (gs > bgs) { bgs = gs; bg = gI; }
            }
            int e0 = 0; float b0 = -INFINITY;
#pragma unroll
            for (int j = 0; j < 4; ++j) { float x = -INFINITY;
#pragma unroll
                for (int gI = 0; gI < 4; ++gI) if (gI == bg) x = bi[gI * 4 + j];
                if (x > b0) { b0 = x; e0 = j; } }
            int e1 = 0; float b1 = -INFINITY;
#pragma unroll
            for (int j = 0; j < 4; ++j) { float x = -INFINITY;
#pragma unroll
                for (int gI = 0; gI < 4; ++gI) if (gI == bg) x = bi[gI * 4 + j];
                if (j != e0 && x > b1) { b1 = x; e1 = j; } }
            float s0 = 0.f, s1 = 0.f;
#pragma unroll
            for (int e = 0; e < 16; ++e) { if (e == bg * 4 + e0) s0 = sc[e]; if (e == bg * 4 + e1) s1 = sc[e]; }
            const float wsum = s0 + s1; const float wa = s0 / wsum, wb = s1 / wsum;
            const int lo = e0 < e1 ? e0 : e1, hi = e0 < e1 ? e1 : e0;
            const float clo = e0 < e1 ? wa : wb, chi = e0 < e1 ? wb : wa;
            int pr = 0;
#pragma unroll
            for (int q = 0; q < 6; ++q) if (c_pair_lo[q] == lo && c_pair_hi[q] == hi) pr = q;
            const int bucket = bg * 6 + pr;
            const int pos = atomicAdd(&p.bcnt[bucket], 1);
            p.lists[(size_t)bucket * LCAP + pos] = tok;
            p.cw[(size_t)tok * 2] = clo; p.cw[(size_t)tok * 2 + 1] = chi;
        }
    }
}

struct MoeTile { int bucket, i0, cnt, ea, eb; };
__device__ __forceinline__ bool moe_tile(const int* bcnt, int mt, MoeTile& o) {
    int acc = 0;
    for (int b = 0; b < 24; ++b) {
        const int c = bcnt[b]; const int nt = (c + 127) >> 7;
        if (mt < acc + nt) { o.bucket = b; o.i0 = (mt - acc) * 128; o.cnt = c; const int g = b / 6, pr = b % 6; o.ea = g * 4 + c_pair_lo[pr]; o.eb = g * 4 + c_pair_hi[pr]; return true; }
        acc += nt;
    }
    return false;
}
#define MOE_MAXT 152
__device__ __forceinline__ void ph_moe1(CP p, int bid, int nblk, char* smem) {
    for (int u = bid; u < MOE_MAXT * 16; u += nblk) {
        const int mt = u >> 4, nt = u & 15;
        MoeTile T; if (!moe_tile(p.bcnt, mt, T)) break;
        const int* lst = p.lists + (size_t)T.bucket * LCAP; const int i0 = T.i0, cnt = T.cnt;
        const h16* H = p.h_hi;
        const int second = nt >= 8;
        const h16* B = p.We13 + ((size_t)(second ? T.eb : T.ea) * 1024 + (nt & 7) * 128) * DM;
        f32x4 acc[2][4]; zero_acc<128>(acc);
        gemm_kloop<128>(smem, DM, [=](int r, int k) { const int i = i0 + r; const int tok = lst[i < cnt ? i : 0]; return H + (size_t)tok * DM + k; },
                        [=](int r, int k) { return B + (size_t)r * DM + k; }, acc);
        const int lane = otid() & 63, wave = otid() >> 6, wm = wave >> 1, wn = wave & 1;
#pragma unroll
        for (int i = 0; i < 2; ++i) {
            const int ml = wm * 32 + i * 16 + (lane & 15);
            const int ii = i0 + ml; const bool valid = ii < cnt;
            const float cwv = valid ? p.cw[(size_t)lst[ii] * 2 + second] : 0.f;
            h16* O = p.act + ((size_t)mt * 128 + ml) * 1024 + second * 512;
#pragma unroll
            for (int jj = 0; jj < 2; ++jj) {
                const f32x4 a = acc[i][2 * jj], bq = acc[i][2 * jj + 1];
                const int col = ((nt & 7) * 128 + wn * 64 + jj * 32) / 2 + 4 * (lane >> 4);
                float o[4];
#pragma unroll
                for (int e = 0; e < 4; ++e) o[e] = valid ? cwv * (a[e] * sigm(a[e])) * bq[e] : 0.f;
                *(h16x4*)(O + col) = pack4(o[0], o[1], o[2], o[3]);
            }
        }
    }
}
__device__ __forceinline__ void ph_moe2(CP p, int l, int bid, int nblk, char* smem) {
    for (int u = bid; u < MOE_MAXT * 8; u += nblk) {
        const int mt = u >> 3, nt = u & 7, n0 = nt * 128;
        MoeTile T; if (!moe_tile(p.bcnt, mt, T)) break;
        const int* lst = p.lists + (size_t)T.bucket * LCAP; const int i0 = T.i0, cnt = T.cnt;
        const h16* A = p.act + (size_t)mt * 128 * 1024;
        const h16* Ba = p.We2 + ((size_t)T.ea * 1024 + n0) * 512; const h16* Bb = p.We2 + ((size_t)T.eb * 1024 + n0) * 512;
        f32x4 acc[2][4]; zero_acc<128>(acc);
        gemm_kloop<128>(smem, 1024, [=](int r, int k) { return A + (size_t)r * 1024 + k; },
                        [=](int r, int k) { return (k < 512 ? Ba + k : Bb + (k - 512)) + (size_t)r * 512; }, acc);
        const float* md = p.mods + (size_t)l * 4 * 6144 + 5 * 1024 + n0;
        float* X = p.x1;
        gemm_epi<128>(acc, [=](int ml, int nl, f32x4 v) { const int ii = i0 + ml; if (ii < cnt) { const int tok = lst[ii]; const f32x4 gg = *(const f32x4*)(md + (size_t)(tok / SEQ) * 6144 + nl);
                                                          float* xp = X + (size_t)tok * DM + n0 + nl; *(f32x4*)xp = *(const f32x4*)xp + gg * v; } });
    }
}

__device__ __forceinline__ void ph_moe_gather(CP p, int bid, int nblk, char* smem) {
    int* tb = (int*)smem;
    const int tid = otid(), lane = tid & 63, wv = tid >> 6;
    __syncthreads();
    if (tid == 0) { int acc = 0; for (int b = 0; b < 24; ++b) { tb[b] = acc; acc += (p.bcnt[b] + 255) >> 8; } tb[24] = acc; }
    __syncthreads();
    const int nrows = tb[24] * 256;
    for (int R = bid * 8 + wv; R < nrows; R += nblk * 8) {
        const int mt = R >> 8, r = R & 255;
        int b = 0;
#pragma unroll 1
        for (int q = 1; q < 24; ++q) if (tb[q] <= mt) b = q;
        const int ii = (mt - tb[b]) * 256 + r;
        u32x4 v0 = {0u, 0u, 0u, 0u}, v1 = v0;
        if (ii < p.bcnt[b]) { const int tok = p.lists[(size_t)b * LCAP + ii]; const u32x4* src = (const u32x4*)(p.h_hi + (size_t)tok * DM); v0 = src[lane]; v1 = src[64 + lane]; }
        u32x4* dst = (u32x4*)(p.h2s + (size_t)R * DM); dst[lane] = v0; dst[64 + lane] = v1;
    }
}
__device__ __forceinline__ void ph_moe1b(CP p, int bid, int nblk, char* smem) {
    pg8::Gemm g; g.A = p.h2s; g.Bt = p.We13; g.M = 0; g.N = 0; g.K = DM; g.lda = DM; g.ldb = DM;
    pg8::MoeOrder<1> S; S.bcnt = p.bcnt; S.W = p.We13; S.G = nblk; S.c = bid;
    pg8::EpiMoe1 E; E.act = p.act; E.lists = p.lists; E.cw = p.cw;
    pg8::gemm_phase((PG8_LAS unsigned char*)smem, g, S, E);
}
__device__ __forceinline__ void ph_moe2b(CP p, int l, int bid, int nblk, char* smem) {
    pg8::Gemm g; g.A = p.act; g.Bt = p.We2; g.M = 0; g.N = 0; g.K = DM; g.lda = DM; g.ldb = 512;
    pg8::MoeOrder<2> S; S.bcnt = p.bcnt; S.W = p.We2; S.G = nblk; S.c = bid;
    pg8::EpiMoe2 E; E.x1 = p.x1; E.lists = p.lists; E.gate = p.mods + (size_t)l * 4 * 6144 + 5 * 1024;
    pg8::gemm_phase((PG8_LAS unsigned char*)smem, g, S, E);
}

__device__ __forceinline__ void ph_final(CP p, int bid, int nblk) {
    const int lane = otid() & 63, wv = otid() >> 6;
    for (int tok = bid * 8 + wv; tok < NTOK; tok += nblk * 8) {
        const float* xr = p.x1 + (size_t)tok * DM;
        f32x4 v[4]; float ss = 0.f;
#pragma unroll
        for (int i = 0; i < 4; ++i) { v[i] = *(const f32x4*)(xr + i * 256 + lane * 4); ss += v[i][0] * v[i][0] + v[i][1] * v[i][1] + v[i][2] * v[i][2] + v[i][3] * v[i][3]; }
        ss = wave_sum(ss);
        const float rs = rsqrtf(ss * (1.f / DM) + 1e-6f);
#pragma unroll
        for (int i = 0; i < 4; ++i) { const int c = i * 256 + lane * 4; const f32x4 gg = *(const f32x4*)(p.in[I_FINALG] + c); *(f32x4*)(p.out + (size_t)tok * DM + c) = v[i] * rs * gg; }
    }
}

#define XB_TMO      128
#define XB_XCNT(j)  (256  + 64 * (j))
#define XB_XSUB(j)  (1280 + 64 * (j))
#define XB_XGEN(j)  (2304 + 64 * (j))
#define XB_TOP      3328
#define XB_TOPGEN   3392
#define XCD_BAR_WORDS 3456
#define XB_SPIN_CAP (1u << 24)
#define LAS __attribute__((address_space(3)))

typedef __attribute__((address_space(1))) unsigned gu32;
__device__ __forceinline__ unsigned xb_ld(gu32* p)              { return __hip_atomic_load(p, __ATOMIC_RELAXED, __HIP_MEMORY_SCOPE_AGENT); }
__device__ __forceinline__ unsigned xb_add(gu32* p, unsigned v) { return __hip_atomic_fetch_add(p, v, __ATOMIC_RELAXED, __HIP_MEMORY_SCOPE_AGENT); }
__device__ __forceinline__ unsigned xb_xcc_id() { return (unsigned)__builtin_amdgcn_s_getreg((3 << 11) | 20) & 0xFu; }
#define XB_SPIN(cond, bar) do { unsigned _sp = 0; while (cond) { __builtin_amdgcn_s_sleep(1); \
    if ((++_sp & 255u) == 0u) { if (xb_ld(&(bar)[XB_TMO])) break; if (_sp > XB_SPIN_CAP) { xb_add(&(bar)[XB_TMO], 1u); break; } } } } while (0)

struct XcdBarrier { unsigned* bar; unsigned x; volatile LAS unsigned* st; };

__device__ __forceinline__ XcdBarrier xcd_barrier_post(unsigned* bar, volatile LAS unsigned* st) {
    XcdBarrier b; b.bar = bar; b.x = xb_xcc_id(); b.st = st;
    if (threadIdx.x == 0) (void)xb_add(&((gu32*)bar)[XB_XCNT(b.x)], 1u);
    return b;
}
__device__ __forceinline__ void xcd_barrier_complete(gu32* bar, unsigned x, unsigned& nloc, unsigned& nx) {
    const unsigned G = gridDim.x * gridDim.y * gridDim.z;
    unsigned sum, cnt, mine, sp = 0u;
    for (;;) {
        sum = 0u; cnt = 0u; mine = 0u;
#pragma unroll
        for (unsigned j = 0; j < 16; ++j) { const unsigned c = xb_ld(&bar[XB_XCNT(j)]); sum += c; cnt += (c > 0u) ? 1u : 0u; mine = (j == x) ? c : mine; }
        if (sum == G) break;
        __builtin_amdgcn_s_sleep(1);
        if ((++sp & 255u) == 0u) { if (xb_ld(&bar[XB_TMO])) break; if (sp > XB_SPIN_CAP) { xb_add(&bar[XB_TMO], 1u); break; } }
    }
    nloc = mine > 0u ? mine : 1u; nx = cnt > 0u ? cnt : 1u;
}
__device__ __forceinline__ void xcd_barrier(const XcdBarrier& b0) {
    asm volatile("s_waitcnt vmcnt(0)" ::: "memory");
    __syncthreads();
    if (threadIdx.x == 0) {
        unsigned long long ba = (unsigned long long)b0.bar;
        asm volatile("" : "+s"(ba));
        gu32* bar = (gu32*)ba;
        const unsigned x = xb_xcc_id();
        volatile LAS unsigned* st = b0.st;
        __builtin_amdgcn_s_waitcnt(0);
        unsigned nloc = st[0], nx = st[1];
        if (nloc == 0u) { xcd_barrier_complete(bar, x, nloc, nx); st[0] = nloc; st[1] = nx; }
        const unsigned old = xb_add(&bar[XB_XSUB(x)], 1u);
        const unsigned gen = old / nloc;
        if (old + 1u == (gen + 1u) * nloc) {
            __builtin_amdgcn_fence(__ATOMIC_RELEASE, "agent");
            asm volatile("s_waitcnt vmcnt(0)" ::: "memory");
            const unsigned og = xb_add(&bar[XB_TOP], 1u);
            const unsigned tg = og / nx;
            if (og + 1u == (tg + 1u) * nx) xb_add(&bar[XB_TOPGEN], 1u);
            else XB_SPIN(xb_ld(&bar[XB_TOPGEN]) == tg, bar);
            __builtin_amdgcn_fence(__ATOMIC_ACQUIRE, "agent");
            xb_add(&bar[XB_XGEN(x)], 1u);
            asm volatile("s_waitcnt vmcnt(0)" ::: "memory");
        } else {
            XB_SPIN(xb_ld(&bar[XB_XGEN(x)]) == gen, bar);
            __builtin_amdgcn_fence(__ATOMIC_ACQUIRE, "agent");
            asm volatile("s_waitcnt vmcnt(0)" ::: "memory");
        }
    }
    __syncthreads();
}

__device__ __forceinline__ const __attribute__((address_space(4))) Params* lp(const __attribute__((address_space(4))) Params* q) { asm volatile("" : "+s"(q)); return q; }
#define MEGA_LDS (155648 + 2560 + 16)
__global__ void __launch_bounds__(512) k_mega(Params p) {
    extern __shared__ __attribute__((aligned(16))) char smem[];
    volatile LAS unsigned* xbw = (volatile LAS unsigned*)(smem + MEGA_LDS - 16);
    if (threadIdx.x == 0) { xbw[0] = 0u; xbw[1] = 0u; }
    __syncthreads();
    XcdBarrier bar = xcd_barrier_post(p.bar, xbw);
    const int bid0 = blockIdx.x, nblk0 = gridDim.x;
    const __attribute__((address_space(4))) Params* kp = (const __attribute__((address_space(4))) Params*)__builtin_amdgcn_kernarg_segment_ptr();
#define PQ (*lp(kp))
#define BID oint(bid0)
#define NBLK oint(nblk0)
    ph_mods(PQ, BID, NBLK, smem);
    ph_tables(PQ, BID, NBLK);
#if PROBE == 9
    __syncthreads(); ph_mods(PQ, BID, NBLK, smem); ph_tables(PQ, BID, NBLK);
#endif
    ph_convert_mix(PQ, 0, BID, NBLK, smem);
#if PROBE == 1
    ph_convert_mix(PQ, 0, BID, NBLK, smem);
#endif
    xcd_barrier(bar);
    for (int l0 = 0; l0 < 2; ++l0) {
#define LL oint(l0)
        ph_norm1(PQ, LL, BID, NBLK);
        xcd_barrier(bar);
        ph_gemm1(PQ, BID, NBLK, smem);
#if PROBE == 2
        ph_gemm1(PQ, BID, NBLK, smem);
#endif
        xcd_barrier(bar);
        ph_s5_scan<1>(PQ, LL, BID, NBLK, smem);
        __syncthreads();
        ph_rg_a(PQ, LL, BID, NBLK, smem);
        __syncthreads();
        ph_rw_a(PQ, LL, BID, NBLK, smem);
#if PROBE == 13
        __syncthreads(); ph_s5_scan<1>(PQ, LL, BID, NBLK, smem);
#endif
#if PROBE == 14
        __syncthreads(); ph_rg_a(PQ, LL, BID, NBLK, smem);
#endif
#if PROBE == 15
        __syncthreads(); ph_rw_a(PQ, LL, BID, NBLK, smem);
#endif
#if PROBE == 3
        __syncthreads(); ph_s5_scan<1>(PQ, LL, BID, NBLK, smem); __syncthreads(); ph_rg_a(PQ, LL, BID, NBLK, smem); __syncthreads(); ph_rw_a(PQ, LL, BID, NBLK, smem);
#endif
        __syncthreads();
        __syncthreads();
        ph_dsa_pre2(PQ, BID, NBLK, smem);
        xcd_barrier(bar);
        if (BID < 16) ph_rw_b(PQ, BID, smem);
        else {
            ph_s5_carry(PQ, LL, BID - 16, NBLK - 16);
            ph_rg_c(PQ, LL, BID - 16, NBLK - 16, smem);
            __syncthreads();
        }
#if PROBE == 4 || PROBE == 11
        if (BID < 16) ph_rw_b(PQ, BID, smem);
#endif
        __syncthreads();
        ph_dsa_a(PQ, LL, smem);
        xcd_barrier(bar);
        ph_dsa_b(PQ, BID, NBLK, smem);
        __syncthreads();
        ph_s5_scan<3>(PQ, LL, BID, NBLK, smem);
        ph_rw_c(PQ, LL, BID, NBLK);
#if PROBE == 5
        __syncthreads(); ph_dsa_b(PQ, BID, NBLK, smem);
#endif
#if PROBE == 17
        ph_s5_scan<3>(PQ, LL, BID, NBLK, smem);
#endif
#if PROBE == 18
        ph_rw_c(PQ, LL, BID, NBLK);
#endif
#if PROBE == 6
        ph_s5_scan<3>(PQ, LL, BID, NBLK, smem); ph_rw_c(PQ, LL, BID, NBLK);
#endif
        xcd_barrier(bar);
        ph_dsa_merge(PQ, BID, NBLK);
        ph_s5_glu(PQ, LL, BID, NBLK, smem);
        __syncthreads();
        ph_gates(PQ, LL, BID, NBLK, smem);
#if PROBE == 7
        ph_gates(PQ, LL, BID, NBLK, smem);
#endif
        xcd_barrier(bar);
        ph_merge(PQ, LL, BID, NBLK, smem);
#if PROBE == 10
        ph_merge(PQ, LL, BID, NBLK, smem);
#endif
        xcd_barrier(bar);
        ph_outproj(PQ, LL, BID, NBLK, smem);
        ph_convert_moe(PQ, LL, BID, NBLK, smem);
#if PROBE == 1
        ph_convert_moe(PQ, LL, BID, NBLK, smem);
#endif
        xcd_barrier(bar);
        ph_norm2_router(PQ, LL, BID, NBLK, smem);
        xcd_barrier(bar);
        ph_moe_gather(PQ, BID, NBLK, smem);
        xcd_barrier(bar);
        ph_moe1b(PQ, BID, NBLK, smem);
#if PROBE == 8
        ph_moe1b(PQ, BID, NBLK, smem);
#endif
        xcd_barrier(bar);
        ph_moe2b(PQ, LL, BID, NBLK, smem);
        if (LL == 0 && BID >= 64) ph_convert_mix(PQ, 1, BID - 64, NBLK - 64, smem);
        xcd_barrier(bar);
    }
    ph_final(PQ, BID, NBLK);
}

static inline size_t al(size_t x) { return (x + 255) & ~(size_t)255; }
extern "C" void kernel_launch(void* const* d_in, const int* in_sizes, int n_in, void* d_out, int out_size, void* d_ws, size_t ws_size, hipStream_t stream) {
    Params p{};
    for (int i = 0; i < N_IN; ++i) p.in[i] = (const float*)d_in[i];
    p.pos = (const int*)d_in[I_POS];
    p.out = (float*)d_out;
    char* w = (char*)d_ws; size_t off = 0;
    auto take = [&](size_t bytes) { char* r = w + off; off += al(bytes); return r; };
    p.bar = (unsigned*)take(XCD_BAR_WORDS * 4);
    p.mods = (float*)take(2 * 4 * 6144 * 4);
    p.bcnt = (int*)take(256); p.qctr = (int*)take(256);
    p.s5c = (float*)take((size_t)2 * 16 * 64 * 36 * 4); p.ropet = (float*)take((size_t)NTOK * 32 * 2 * 4);
    p.Wp = (h16*)take((size_t)2560 * DM * 2); p.Widx = (h16*)take((size_t)256 * 3072 * 2); p.Wg = (h16*)take((size_t)4096 * DM * 2);
    p.Wb = (h16*)take((size_t)4096 * 256 * 2); p.Wo = (h16*)take((size_t)DM * DM * 2); p.Wglu = (h16*)take(256 * 256 * 2);
    p.x1 = (float*)take((size_t)NTOK * DM * 4);
    p.h_hi = (h16*)take((size_t)NTOK * DM * 2); p.h_lo = (h16*)take((size_t)NTOK * DM * 2); p.branches = p.h_lo;
    p.cw = (float*)take((size_t)NTOK * 2 * 4);
    p.lists = (int*)take((size_t)24 * LCAP * 4);
    const size_t offR = off;
    p.proj = (h16*)take((size_t)NTOK * PJ * 2); p.idxf = (float*)take((size_t)NTOK * IDXLD * 4);
    p.vT = (h16*)take((size_t)4 * 256 * SEQ * 2); p.dmask = (unsigned long long*)take((size_t)4 * 133120 * 8); p.s5E = (float*)take((size_t)4 * 64 * 16 * 64 * 2 * 4); p.s5H = (float*)take((size_t)4 * 64 * 16 * 64 * 2 * 4);
    p.rg_hl = (float*)take((size_t)NTOK * 256 * 4); p.rg_cp = (float*)take((size_t)NTOK * 256 * 4); p.rg_agg = (float*)take((size_t)4 * 128 * 256 * 2 * 4);
    p.rw_g = (h16*)take((size_t)NTOK * 256 * 2); p.rw_bonus = (h16*)take((size_t)NTOK * 256 * 2);
    p.rw_W = (h16*)take((size_t)1024 * 4096 * 2); p.rw_U0 = (h16*)take((size_t)1024 * 4096 * 2); p.rw_Ry = (h16*)take((size_t)1024 * 4096 * 2); p.rw_Y0 = (h16*)take((size_t)1024 * 4096 * 2);
    p.rw_Be = (h16*)take((size_t)1024 * 4096 * 2); p.rw_VK = (h16*)take((size_t)1024 * 4096 * 2); p.rw_S0 = (h16*)take((size_t)1024 * 4096 * 2); p.rw_gam = (float*)take((size_t)1024 * 64 * 4);
    const size_t endMix = off;
    p.ybuf = p.rw_Be;
    p.dsa_op = p.rw_W; p.dsa_ml = (float*)p.rw_VK;
    p.gates = p.proj;
    p.mixed = p.rw_g;
    if ((char*)p.gates + (size_t)NTOK * 4096 * 2 > (char*)p.mixed) { fprintf(stderr, "gates/mixed overlap\n"); return; }
    off = offR;
    p.We13 = (h16*)take((size_t)16 * 1024 * DM * 2); p.We2 = (h16*)take((size_t)16 * 1024 * 512 * 2); p.act = (h16*)take((size_t)88 * 256 * 1024 * 2); p.h2s = (h16*)take((size_t)88 * 256 * 1024 * 2);
    const size_t endMoe = off;
    const size_t need = endMix > endMoe ? endMix : endMoe;
    if (need > ws_size || (char*)p.h2s + (size_t)88 * 256 * 1024 * 2 > (char*)p.mixed) { fprintf(stderr, "workspace layout problem: need %zu have %zu\n", need, ws_size); return; }

    static int grid = 0;
    if (!grid) {
        (void)hipFuncSetAttribute((const void*)k_mega, hipFuncAttributeMaxDynamicSharedMemorySize, MEGA_LDS);
        int dev = 0, cus = 0, per_cu = 0;
        (void)hipGetDevice(&dev);
        (void)hipDeviceGetAttribute(&cus, hipDeviceAttributeMultiprocessorCount, dev);
        (void)hipOccupancyMaxActiveBlocksPerMultiprocessor(&per_cu, (const void*)k_mega, 512, MEGA_LDS);
        if (per_cu < 1) { fprintf(stderr, "k_mega not launchable (occupancy 0)\n"); return; }
        grid = cus;
        fprintf(stderr, "k_mega: grid %d (cus %d, per_cu %d), ws need %zu have %zu\n", grid, cus, per_cu, need, ws_size);
    }
    (void)hipMemsetAsync(p.bar, 0, XCD_BAR_WORDS * 4, stream);
    k_mega<<<grid, 512, MEGA_LDS, stream>>>(p);
}
```

```cpp
#ifndef PROBE
#define PROBE 0
#endif
#include <hip/hip_runtime.h>
#include <stdint.h>
#include <stdio.h>
#include <math.h>

typedef _Float16 h16;
typedef _Float16 h16x8 __attribute__((ext_vector_type(8)));
typedef _Float16 h16x4 __attribute__((ext_vector_type(4)));
typedef _Float16 h16x2 __attribute__((ext_vector_type(2)));
typedef float f32x4 __attribute__((ext_vector_type(4)));
typedef __bf16 bf16x8_t __attribute__((ext_vector_type(8)));
typedef unsigned u32x4 __attribute__((ext_vector_type(4)));

#define NTOK 16384
#define SEQ 4096
#define NBATCH 4
#define DM 1024
#define DINW 2596
#define PJ 2432
#define IDXLD 192
#define P_U 0
#define P_Q 256
#define P_K 512
#define P_V 768
#define P_RGX 1024
#define P_RGG 1280
#define P_RW 1536
#define LCAP 16384

enum { I_X = 0, I_C, I_POS, I_ADAW, I_ADAB, I_MNG, I_WIN, I_GATEW, I_GATEB, I_BRW, I_OUTW,
       I_S5LRE, I_S5LIM, I_S5LS, I_S5BRE, I_S5BIM, I_S5CRE, I_S5CIM, I_S5D, I_S5GW, I_S5GB,
       I_RGCW, I_RGCB, I_RGWR, I_RGBR, I_RGWI, I_RGBI, I_RGLAM,
       I_RWMU, I_RWW0, I_RWWUP, I_RWA0, I_RWAUP, I_RWGUP, I_RWKK, I_RWKA, I_RWRK, I_RWGNW, I_RWGNB,
       I_FNG, I_ROUTW, I_ROUTB, I_W1, I_W3, I_W2, I_FINALG, N_IN };

struct Params {
    const float* in[N_IN];
    const int* pos;
    float* out;
    unsigned* bar;
    float* mods;
    h16 *Wp, *Widx, *Wg, *Wb, *Wo, *Wglu, *We13, *We2, *Wrg;
    float* x1;
    h16 *h_hi, *h_lo, *branches;
    h16* proj; float* idxf;
    h16* ybuf; float *s5E, *s5H, *s5c, *ropet;
    h16* vT; unsigned long long* dmask; int* qctr; float* dsa_ml; h16* dsa_op;
    float *rg_hl, *rg_cp, *rg_agg;
    h16 *rw_r, *rw_w, *rw_k, *rw_kk, *rw_b, *rw_g, *rw_bonus, *rw_v; float* rw_y;
    h16 *rw_W, *rw_U0, *rw_Ry, *rw_Y0, *rw_Be, *rw_VK, *rw_S0; float* rw_gam;
    h16* mixed; h16* gates;
    h16* act; h16* h2s; int* lists; int* bcnt; float* cw;
};

typedef const __attribute__((address_space(4))) Params& CP;
__device__ __forceinline__ float sigm(float x) { return __builtin_amdgcn_rcpf(1.f + __expf(-x)); }
__device__ __forceinline__ float tanh_fast(float x) { return 1.f - 2.f * __builtin_amdgcn_rcpf(1.f + __expf(2.f * x)); }
__device__ __forceinline__ float gelu_tanh(float x) { return 0.5f * x * (1.f + tanh_fast(0.7978845608028654f * (x + 0.044715f * x * x * x))); }
__device__ __forceinline__ float softplusf_(float x) { return fmaxf(x, 0.f) + __logf(1.f + __expf(-fabsf(x))); }
template <int CTRL> __device__ __forceinline__ float dppf(float x) { return __int_as_float(__builtin_amdgcn_update_dpp(0, __float_as_int(x), CTRL, 0xf, 0xf, false)); }
__device__ __forceinline__ float x16_sum(float x) { auto r = __builtin_amdgcn_permlane16_swap(__float_as_uint(x), __float_as_uint(x), false, false); return __uint_as_float(r[0]) + __uint_as_float(r[1]); }
__device__ __forceinline__ float x32_sum(float x) { auto r = __builtin_amdgcn_permlane32_swap(__float_as_uint(x), __float_as_uint(x), false, false); return __uint_as_float(r[0]) + __uint_as_float(r[1]); }
__device__ __forceinline__ float x16_max(float x) { auto r = __builtin_amdgcn_permlane16_swap(__float_as_uint(x), __float_as_uint(x), false, false); return fmaxf(__uint_as_float(r[0]), __uint_as_float(r[1])); }
__device__ __forceinline__ float x32_max(float x) { auto r = __builtin_amdgcn_permlane32_swap(__float_as_uint(x), __float_as_uint(x), false, false); return fmaxf(__uint_as_float(r[0]), __uint_as_float(r[1])); }
__device__ __forceinline__ int x16_isum(int x) { auto r = __builtin_amdgcn_permlane16_swap((unsigned)x, (unsigned)x, false, false); return (int)(r[0] + r[1]); }
__device__ __forceinline__ int x32_isum(int x) { auto r = __builtin_amdgcn_permlane32_swap((unsigned)x, (unsigned)x, false, false); return (int)(r[0] + r[1]); }
__device__ __forceinline__ float rows_sum(float x) { return x32_sum(x16_sum(x)); }
__device__ __forceinline__ float rows_max(float x) { return x32_max(x16_max(x)); }
__device__ __forceinline__ int rows_isum(int x) { return x32_isum(x16_isum(x)); }
template <int CTRL> __device__ __forceinline__ int dppi(int x) { return __builtin_amdgcn_update_dpp(0, x, CTRL, 0xf, 0xf, false); }
__device__ __forceinline__ unsigned umax_(unsigned a, unsigned b) { return a > b ? a : b; }
__device__ __forceinline__ unsigned wave_umax(unsigned v) {
    v = umax_(v, (unsigned)dppi<0xB1>((int)v)); v = umax_(v, (unsigned)dppi<0x4E>((int)v)); v = umax_(v, (unsigned)dppi<0x124>((int)v)); v = umax_(v, (unsigned)dppi<0x128>((int)v));
    { auto r = __builtin_amdgcn_permlane16_swap(v, v, false, false); v = umax_(r[0], r[1]); }
    { auto r = __builtin_amdgcn_permlane32_swap(v, v, false, false); v = umax_(r[0], r[1]); }
    return v;
}
__device__ __forceinline__ int wave_isum(int v) { v += dppi<0xB1>(v); v += dppi<0x4E>(v); v += dppi<0x124>(v); v += dppi<0x128>(v); return rows_isum(v); }
__device__ __forceinline__ float wave_sum(float v) { v += dppf<0xB1>(v); v += dppf<0x4E>(v); v += dppf<0x124>(v); v += dppf<0x128>(v); return rows_sum(v); }
__device__ __forceinline__ float wave_max(float v) { v = fmaxf(v, dppf<0xB1>(v)); v = fmaxf(v, dppf<0x4E>(v)); v = fmaxf(v, dppf<0x124>(v)); v = fmaxf(v, dppf<0x128>(v)); return rows_max(v); }
__device__ __forceinline__ float egl_get(const float* egl, int k) { return egl[k]; }
__device__ __forceinline__ h16x4 pack4(float a, float b, float c, float d) { h16x4 r; r[0] = (h16)a; r[1] = (h16)b; r[2] = (h16)c; r[3] = (h16)d; return r; }

__device__ __forceinline__ int oint(int x) { asm volatile("" : "+s"(x)); return x; }
__device__ __forceinline__ int otid() { int t = threadIdx.x; asm volatile("" : "+v"(t)); return t; }
__device__ __forceinline__ void st16_wt(void* ptr, h16x8 v) { asm volatile("global_store_dwordx4 %0, %1, off sc1\n\ts_nop 1" :: "v"(ptr), "v"(__builtin_bit_cast(u32x4, v)) : "memory"); }
__device__ __forceinline__ void wave_lds_sync() { asm volatile("s_waitcnt lgkmcnt(0)" ::: "memory"); __builtin_amdgcn_wave_barrier(); }
__device__ __forceinline__ void lds_barrier() { asm volatile("s_waitcnt lgkmcnt(0)\n\ts_barrier" ::: "memory"); }
__device__ __forceinline__ void ph_mods(CP p, int bid, int nblk, char* smem) {
    float* ca = (float*)smem;
    float* part = ca + 4 * DM;
    const int tid = otid();
    __syncthreads();
    for (int i = tid; i < 4 * DM; i += 512) { float c = p.in[I_C][i]; ca[i] = c * sigm(c); }
    __syncthreads();
    for (int u = bid; u < 192; u += nblk) {
        const int l = u / 96, j = (u % 96) * 64 + (tid & 63), ks = tid >> 6;
        const float* w = p.in[I_ADAW] + (size_t)l * DM * 6144 + (size_t)(ks * 128) * 6144 + j;
        float a0 = 0, a1 = 0, a2 = 0, a3 = 0;
#pragma unroll 32
        for (int k = 0; k < 128; ++k) { const float wv = w[(size_t)k * 6144]; const int kk = ks * 128 + k; a0 += ca[kk] * wv; a1 += ca[DM + kk] * wv; a2 += ca[2 * DM + kk] * wv; a3 += ca[3 * DM + kk] * wv; }
        __syncthreads();
        part[(ks * 4 + 0) * 64 + (tid & 63)] = a0; part[(ks * 4 + 1) * 64 + (tid & 63)] = a1; part[(ks * 4 + 2) * 64 + (tid & 63)] = a2; part[(ks * 4 + 3) * 64 + (tid & 63)] = a3;
        __syncthreads();
        if (tid < 256) {
            const int bb = tid >> 6, cc = tid & 63; float sum = p.in[I_ADAB][l * 6144 + (u % 96) * 64 + cc];
#pragma unroll
            for (int q = 0; q < 8; ++q) sum += part[(q * 4 + bb) * 64 + cc];
            p.mods[(size_t)l * 4 * 6144 + (size_t)bb * 6144 + (u % 96) * 64 + cc] = sum;
        }
    }
    __syncthreads();
}
__device__ __forceinline__ void ph_tables(CP p, int bid, int nblk) {
    const int gt = bid * 512 + otid(), gn = nblk * 512;
    if (gt < 2) p.qctr[gt] = 0;
    {
        const double wf = exp(-(double)(gt & 31) * (1.0 / 32.0) * 9.210340371976184);
        for (int i = gt; i < NTOK * 32; i += gn) {
            const int tok = i >> 5;
            const double ang = (double)p.pos[tok] * wf;
            const double red = ang - 6.283185307179586476925 * rint(ang * 0.15915494309189533577);
            float sn, cs; sincosf((float)red, &sn, &cs);
            p.ropet[(size_t)i * 2] = cs; p.ropet[(size_t)i * 2 + 1] = sn;
        }
    }
    for (int i = gt; i < 2 * 16 * 64; i += gn) {
        const int g = (i >> 6) & 15, l = i >> 10;
        const double lre = p.in[I_S5LRE][i], lim = p.in[I_S5LIM][i], st = exp((double)p.in[I_S5LS][l * 16 + g]);
        const double er = exp(lre * st); double sn, cs; sincos(lim * st, &sn, &cs);
        const double lbr = er * cs, lbi = er * sn;
        const double nr = lbr - 1.0, ni = lbi, den = lre * lre + lim * lim;
        const double fr = (nr * lre + ni * lim) / den, fi = (ni * lre - nr * lim) / den;
        const double e64 = exp(64.0 * lre * st); double s64, c64; sincos(64.0 * lim * st, &s64, &c64);
        float* o = p.s5c + (size_t)i * 36;
        o[0] = (float)lbr; o[1] = (float)lbi; o[2] = (float)(e64 * c64); o[3] = (float)(e64 * s64);
        for (int cc = 0; cc < 16; ++cc) { const double br = p.in[I_S5BRE][(size_t)i * 16 + cc], bi = p.in[I_S5BIM][(size_t)i * 16 + cc];
                                          o[4 + cc] = (float)(fr * br - fi * bi); o[20 + cc] = (float)(fr * bi + fi * br); }
    }
}
__host__ __device__ __forceinline__ int gate_col(int nidx) {
    const int pn = nidx >> 8, o = nidx & 255, bj = o >> 7, wc = (o >> 5) & 3, fq = (o >> 3) & 3, n = (o >> 2) & 1, e = o & 3;
    const int t = pn * 16 + wc * 4 + fq;
    return (t >> 6) * 1024 + ((t >> 3) & 7) * 128 + ((t >> 2) & 1) * 64 + (2 * bj + n) * 16 + 4 * (t & 3) + e;
}
template <class SRC>
__device__ __forceinline__ void convT(h16* dst, int dstld, int nrows, int K, int koff, const SRC& src, int bid, int nblk, char* smem) {
    h16* tl = (h16*)smem;
    const int tid = otid();
    const int ntn = nrows >> 6, ntk = K >> 6, ntl = ntn * ntk;
    for (int t0 = bid * 4; t0 < ntl; t0 += nblk * 4) {
        float v[4][8];
#pragma unroll
        for (int j = 0; j < 4; ++j) {
            const int t = t0 + j < ntl ? t0 + j : ntl - 1;
            const int n0 = (t % ntn) * 64, k0 = (t / ntn) * 64;
#pragma unroll
            for (int q = 0; q < 8; ++q) v[j][q] = src(n0 + (tid & 63), k0 + (tid >> 6) + 8 * q);
        }
        __syncthreads();
#pragma unroll
        for (int j = 0; j < 4; ++j)
#pragma unroll
            for (int q = 0; q < 8; ++q) tl[j * (64 * 72) + (tid & 63) * 72 + (tid >> 6) + 8 * q] = (h16)v[j][q];
        __syncthreads();
#pragma unroll
        for (int j = 0; j < 4; ++j) {
            const int t = t0 + j;
            if (t < ntl) {
                const int n0 = (t % ntn) * 64, k0 = (t / ntn) * 64;
                *(h16x8*)(dst + (size_t)(n0 + (tid >> 3)) * dstld + koff + k0 + (tid & 7) * 8) = *(const h16x8*)&tl[j * (64 * 72) + (tid >> 3) * 72 + (tid & 7) * 8];
            }
        }
    }
    __syncthreads();
}
__device__ __forceinline__ void ph_convert_mix(CP p, int l, int bid, int nblk, char* smem) {
    { const float* s = p.in[I_WIN] + (size_t)l * DM * DINW;
      convT(p.Wp, DM, 2560, DM, 0, [=](int n, int k) { return n < PJ ? s[(size_t)k * DINW + (n < 1024 ? n : n + 164)] : 0.f; }, bid, nblk, smem);
      convT(p.Widx, 3072, 256, DM, 0, [=](int n, int k) { return n < 164 ? s[(size_t)k * DINW + 1024 + n] : 0.f; }, bid, nblk, smem);
    }
    { const float* s = p.in[I_GATEW] + (size_t)l * DM * 4096;
      convT(p.Wg, DM, 4096, DM, 0, [=](int n, int k) { return s[(size_t)k * 4096 + gate_col(n)]; }, bid, nblk, smem); }
    { const float* s = p.in[I_BRW] + (size_t)l * 4 * 256 * DM;
      convT(p.Wb, 256, 4096, 256, 0, [=](int n, int k) { int br = n >> 10, d = n & 1023; return s[(size_t)br * 256 * DM + (size_t)k * DM + d]; }, bid, nblk, smem); }
    { const float* s = p.in[I_OUTW] + (size_t)l * DM * DM;
      convT(p.Wo, DM, DM, DM, 0, [=](int n, int k) { return s[(size_t)k * DM + n]; }, bid, nblk, smem); }
    { const float* sr = p.in[I_RGWR] + (size_t)l * 4 * 64 * 64; const float* si = p.in[I_RGWI] + (size_t)l * 4 * 64 * 64;
      convT(p.Wrg, 64, 256, 64, 0, [=](int n, int k) { return sr[(size_t)(n >> 6) * 4096 + (size_t)k * 64 + (n & 63)]; }, bid, nblk, smem);
      convT(p.Wrg + 4 * 64 * 64, 64, 256, 64, 0, [=](int n, int k) { return si[(size_t)(n >> 6) * 4096 + (size_t)k * 64 + (n & 63)]; }, bid, nblk, smem); }
    { const float* s = p.in[I_S5GW] + (size_t)l * 256 * 256;
      convT(p.Wglu, 256, 256, 256, 0, [=](int n, int k) { return s[(size_t)k * 256 + n]; }, bid, nblk, smem); }
}
__device__ __forceinline__ void ph_convert_moe(CP p, int l, int bid, int nblk, char* smem) {
    const float* s1 = p.in[I_W1] + (size_t)l * 16 * DM * 512;
    const float* s3 = p.in[I_W3] + (size_t)l * 16 * DM * 512;
    const float* s2 = p.in[I_W2] + (size_t)l * 16 * 512 * DM;
    convT(p.We13, DM, 16 * 1024, DM, 0, [=](int n, int k) { int e = n >> 10, r = n & 1023; int c = (r >> 3) * 4 + (r & 3); const float* s = ((r >> 2) & 1) ? s3 : s1;
                                                           return s[(size_t)e * DM * 512 + (size_t)k * 512 + c]; }, bid, nblk, smem);
    convT(p.We2, 512, 16 * 1024, 512, 0, [=](int n, int k) { int e = n >> 10, c = n & 1023; return s2[(size_t)e * 512 * DM + (size_t)k * DM + c]; }, bid, nblk, smem);
}

__device__ __forceinline__ void ph_norm1(CP p, int l, int bid, int nblk) {
    const float* xin = l == 0 ? p.in[I_X] : p.x1;
    const int lane = otid() & 63, wv = otid() >> 6;
    if (bid == 0 && otid() < 24) p.bcnt[otid()] = 0;
    const float* g = p.in[I_MNG] + l * DM;
    f32x4 gg[4];
#pragma unroll
    for (int i = 0; i < 4; ++i) gg[i] = *(const f32x4*)(g + i * 256 + lane * 4);
    int tok = bid * 8 + wv;
    f32x4 vn[4], shn[4], scn[4];
    if (tok < NTOK) {
        const float* md = p.mods + ((size_t)l * 4 + tok / SEQ) * 6144;
#pragma unroll
        for (int i = 0; i < 4; ++i) { vn[i] = *(const f32x4*)(xin + (size_t)tok * DM + i * 256 + lane * 4); shn[i] = *(const f32x4*)(md + i * 256 + lane * 4); scn[i] = *(const f32x4*)(md + 1024 + i * 256 + lane * 4); }
    }
    for (; tok < NTOK; tok += nblk * 8) {
        f32x4 v[4], sh[4], sc[4];
#pragma unroll
        for (int i = 0; i < 4; ++i) { v[i] = vn[i]; sh[i] = shn[i]; sc[i] = scn[i]; }
        const int tn = tok + nblk * 8;
        if (tn < NTOK) {
            const float* md = p.mods + ((size_t)l * 4 + tn / SEQ) * 6144;
#pragma unroll
            for (int i = 0; i < 4; ++i) { vn[i] = *(const f32x4*)(xin + (size_t)tn * DM + i * 256 + lane * 4); shn[i] = *(const f32x4*)(md + i * 256 + lane * 4); scn[i] = *(const f32x4*)(md + 1024 + i * 256 + lane * 4); }
        }
        float ss = 0.f;
#pragma unroll
        for (int i = 0; i < 4; ++i) ss += v[i][0] * v[i][0] + v[i][1] * v[i][1] + v[i][2] * v[i][2] + v[i][3] * v[i][3];
        ss = wave_sum(ss);
        const float rs = rsqrtf(ss * (1.f / DM) + 1e-6f);
#pragma unroll
        for (int i = 0; i < 4; ++i) {
            const int c = i * 256 + lane * 4;
            h16x4 hi;
#pragma unroll
            for (int e = 0; e < 4; ++e) hi[e] = (h16)(v[i][e] * rs * gg[i][e] * (1.f + sc[i][e]) + sh[i][e]);
            *(h16x4*)(p.h_hi + (size_t)tok * DM + c) = hi;
        }
    }
}

#define LDT 72
template <int BM, class AF, class BF, class SEG>
__device__ __forceinline__ void gemm_kloop_seg(char* smem, int K, const AF& af, const BF& bf, f32x4 (&acc)[BM / 64][4], const SEG& seg) {
    constexpr int MT = BM / 64, WM = BM / 4, NA = BM / 64;
    h16* sA = (h16*)smem; h16* sB = sA + 2 * BM * LDT;
    const int tid = otid(), lane = tid & 63, wave = tid >> 6, wm = wave >> 1, wn = wave & 1;
    const int lrow = tid >> 3, lkc = (tid & 7) * 8;
    u32x4 ra0[NA], rb0[2], ra1[NA], rb1[2];
    const int nk = K / 64;
#define GK_LOAD(RA, RB, KT) do { const int k_ = (KT) * 64 + lkc; \
        _Pragma("unroll") for (int i = 0; i < NA; ++i) RA[i] = *(const u32x4*)af(lrow + i * 64, k_); \
        _Pragma("unroll") for (int i = 0; i < 2; ++i) RB[i] = *(const u32x4*)bf(lrow + i * 64, k_); } while (0)
#define GK_STORE(RA, RB, BUF) do { h16* nA_ = sA + (BUF) * BM * LDT; h16* nB_ = sB + (BUF) * 128 * LDT; \
        _Pragma("unroll") for (int i = 0; i < NA; ++i) *(u32x4*)&nA_[(lrow + i * 64) * LDT + lkc] = RA[i]; \
        _Pragma("unroll") for (int i = 0; i < 2; ++i) *(u32x4*)&nB_[(lrow + i * 64) * LDT + lkc] = RB[i]; } while (0)
#define GK_COMPUTE(BUF) do { const h16* cA = sA + (BUF) * BM * LDT; const h16* cB = sB + (BUF) * 128 * LDT; \
        _Pragma("unroll") for (int ks = 0; ks < 2; ++ks) { h16x8 a[MT], b[4]; \
            _Pragma("unroll") for (int i = 0; i < MT; ++i) a[i] = *(const h16x8*)&cA[(wm * WM + i * 16 + (lane & 15)) * LDT + ks * 32 + (lane >> 4) * 8]; \
            _Pragma("unroll") for (int j = 0; j < 4; ++j) b[j] = *(const h16x8*)&cB[(wn * 64 + j * 16 + (lane & 15)) * LDT + ks * 32 + (lane >> 4) * 8]; \
            _Pragma("unroll") for (int i = 0; i < MT; ++i) _Pragma("unroll") for (int j = 0; j < 4; ++j) acc[i][j] = __builtin_amdgcn_mfma_f32_16x16x32_f16(b[j], a[i], acc[i][j], 0, 0, 0); } } while (0)
    GK_LOAD(ra0, rb0, 0);
    if (nk > 1) GK_LOAD(ra1, rb1, 1);
    GK_STORE(ra0, rb0, 0);
    lds_barrier();
    for (int kt = 0; kt < nk; kt += 2) {
        if (kt + 2 < nk) GK_LOAD(ra0, rb0, kt + 2);
        GK_COMPUTE(0);
        seg(kt);
        if (kt + 1 < nk) GK_STORE(ra1, rb1, 1);
        lds_barrier();
        if (kt + 1 < nk) {
            if (kt + 3 < nk) GK_LOAD(ra1, rb1, kt + 3);
            GK_COMPUTE(1);
            seg(kt + 1);
            if (kt + 2 < nk) GK_STORE(ra0, rb0, 0);
            lds_barrier();
        }
    }
#undef GK_LOAD
#undef GK_STORE
#undef GK_COMPUTE
}
template <int BM, class AF, class BF>
__device__ __forceinline__ void gemm_kloop(char* smem, int K, const AF& af, const BF& bf, f32x4 (&acc)[BM / 64][4]) {
    gemm_kloop_seg<BM>(smem, K, af, bf, acc, [](int) {});
}
template <int BM> __device__ __forceinline__ void zero_acc(f32x4 (&acc)[BM / 64][4]) {
#pragma unroll
    for (int i = 0; i < BM / 64; ++i)
#pragma unroll
        for (int j = 0; j < 4; ++j) acc[i][j] = (f32x4){0.f, 0.f, 0.f, 0.f};
}
template <int BM, class EPI>
__device__ __forceinline__ void gemm_epi(const f32x4 (&acc)[BM / 64][4], const EPI& epi) {
    const int lane = otid() & 63, wave = otid() >> 6, wm = wave >> 1, wn = wave & 1;
#pragma unroll
    for (int i = 0; i < BM / 64; ++i)
#pragma unroll
        for (int j = 0; j < 4; ++j) epi(wm * (BM / 4) + i * 16 + (lane & 15), wn * 64 + j * 16 + 4 * (lane >> 4), acc[i][j]);
}
#define GEMM_LDS(BM) (2 * (BM) * LDT * 2 + 2 * 128 * LDT * 2)


namespace pg8 {
#define PG8_LAS __attribute__((address_space(3)))
constexpr int BM = 256, BK = 64, HALF = 128, HTB = HALF * BK * 2, STAGE_BYTES = 8 * HTB, NXCD = 8, WGM = 8;
__device__ __forceinline__ int lds_byte(int r, int c) { const int st = (r >> 4) * 2 + (c >> 5), rr = r & 15, cc = c & 31, ob = rr * 64 + cc * 2; return st * 1024 + (ob ^ (((ob >> 9) & 1) << 5)); }
__device__ __forceinline__ void stage_rc(int b, int& R, int& C) { const int st = b / 1024, sb = b % 1024, swz = sb ^ (((sb >> 9) & 1) << 5); R = (st >> 1) * 16 + swz / 64; C = (st & 1) * 32 + (swz % 64) / 2; }
__device__ __forceinline__ int perm32(int rho) { const int n = rho >> 4, i = rho & 15; return 8 * (i >> 2) + 4 * n + (i & 3); }
struct Unit { int pm, pn; int bucket, i0, cnt, ea, eb; };
struct Gemm { const h16* A; const h16* Bt; int M, N, K, lda, ldb; };
struct StaticOrder {
    int nM, nN, nwg, G, c;
    __device__ void init(int M, int N, int G_, int c_) { nM = M / BM; nN = N / BM; nwg = nM * nN; G = G_; c = c_; }
    __device__ bool next(int i, Unit& u) const {
        const long L = (long)i * G + c; if (L >= nwg) return false;
        int wgid = (int)L; { const int q = nwg / NXCD, r = nwg % NXCD, xcd = wgid % NXCD, off = wgid / NXCD; wgid = (xcd < r ? xcd * (q + 1) : r * (q + 1) + (xcd - r) * q) + off; }
        const int nig = WGM * nN, gid = wgid / nig, fm = gid * WGM, gsz = (nM - fm) < WGM ? (nM - fm) : WGM;
        u.pm = fm + ((wgid % nig) % gsz); u.pn = (wgid % nig) / gsz; return true;
    }
    __device__ __forceinline__ int ksplit() const { return 1 << 30; }
    __device__ __forceinline__ void b_ptr(const Gemm& g, const Unit& u, size_t tsB, const char*& lo, const char*& hi) const { lo = hi = (const char*)g.Bt + (size_t)u.pn * tsB; }
};
template <class Epi, class Sched>
__device__ __forceinline__ void gemm_phase(PG8_LAS unsigned char* lds, const Gemm g, const Sched& S, const Epi& E) {
    const int tid = otid(), wid = __builtin_amdgcn_readfirstlane(tid >> 6), lane = tid & 63, wr = wid >> 2, wc = wid & 3, fr = lane & 15, fq = lane >> 4;
    const int K = g.K, nt = K / BK;
    unsigned voffA[2], voffB[2];
#pragma unroll
    for (int i = 0; i < 2; ++i) { int R, C; stage_rc(tid * 16 + i * 8192, R, C); const int Rb = Epi::PERM ? ((R & ~31) + perm32(R & 31)) : R;
        voffA[i] = (unsigned)(R * g.lda + C) * 2u; voffB[i] = (unsigned)(Rb * g.ldb + C) * 2u; }
    const size_t kstep = (size_t)(BK * 2);
    const size_t hsA = (size_t)HALF * g.lda * 2, hsB = (size_t)HALF * g.ldb * 2;
    const int ksp = S.ksplit();
    const size_t tsA = 2 * hsA, tsB = 2 * hsB;
    const unsigned ldsw = (unsigned)wid * 1024u;
    const int aoff = lds_byte(wr * 64 + fr, fq * 8), boff = lds_byte(wc * 32 + fr, fq * 8);
#define PG8_SA(b, h) (((b) * 2 + (h)) * HTB)
#define PG8_SB(b, h) ((4 + (b) * 2 + (h)) * HTB)
#define PG8_STAGE(bufoff, gbase, voff) do { _Pragma("unroll") for (int _i = 0; _i < 2; ++_i) \
        __builtin_amdgcn_global_load_lds((const unsigned*)((const char*)(gbase) + (voff)[_i]), (PG8_LAS unsigned*)(lds + (bufoff) + ldsw + _i * 8192), 16, 0, 0); } while (0)
#define PG8_LDA(dst, b, h) do { _Pragma("unroll") for (int m = 0; m < 4; ++m) _Pragma("unroll") for (int k = 0; k < 2; ++k) dst[m][k] = *(const PG8_LAS h16x8*)(lds + PG8_SA(b, h) + aoff + m * 2048 + k * 1024); } while (0)
#define PG8_LDB(dst, b, h) do { _Pragma("unroll") for (int n = 0; n < 2; ++n) _Pragma("unroll") for (int k = 0; k < 2; ++k) dst[n][k] = *(const PG8_LAS h16x8*)(lds + PG8_SB(b, h) + boff + n * 2048 + k * 1024); } while (0)
#define PG8_MMA(ai, bj, At, Bt) do { __builtin_amdgcn_s_setprio(1); _Pragma("unroll") for (int m = 0; m < 4; ++m) _Pragma("unroll") for (int n = 0; n < 2; ++n) _Pragma("unroll") for (int k = 0; k < 2; ++k) \
        acc[ai][bj][m][n] = __builtin_amdgcn_mfma_f32_16x16x32_f16(Bt[n][k], At[m][k], acc[ai][bj][m][n], 0, 0, 0); __builtin_amdgcn_s_setprio(0); } while (0)
#define PG8_WAIT_V(n) asm volatile("s_waitcnt vmcnt(" #n ")" ::: "memory")
#define PG8_WAIT_L(n) asm volatile("s_waitcnt lgkmcnt(" #n ")" ::: "memory")
#define PG8_BAR __builtin_amdgcn_s_barrier()
#define PG8_SCHED __builtin_amdgcn_sched_barrier(0)
    Unit cur, nxt; int ui = 0;
    if (!S.next(0, cur)) return;
    f32x4 acc[2][2][4][2];
#pragma unroll
    for (int a = 0; a < 2; ++a)
#pragma unroll
        for (int b = 0; b < 2; ++b)
#pragma unroll
            for (int m = 0; m < 4; ++m)
#pragma unroll
                for (int n = 0; n < 2; ++n) acc[a][b][m][n] = (f32x4){0.f, 0.f, 0.f, 0.f};
    h16x8 At[4][2], B0[2][2], B1[2][2];
    const char* cA = (const char*)g.A + (size_t)cur.pm * tsA; const char* cB; const char* cBh; S.b_ptr(g, cur, tsB, cB, cBh);
    PG8_STAGE(PG8_SB(0, 0), cB, voffB); PG8_STAGE(PG8_SA(0, 0), cA, voffA); PG8_STAGE(PG8_SB(0, 1), cB + hsB, voffB); PG8_STAGE(PG8_SA(0, 1), cA + hsA, voffA);
    if (wr == 1) PG8_BAR;
    PG8_WAIT_V(4); PG8_BAR;
    PG8_STAGE(PG8_SB(1, 0), cB + kstep, voffB); PG8_STAGE(PG8_SA(1, 0), cA + kstep, voffA); PG8_STAGE(PG8_SB(1, 1), cB + hsB + kstep, voffB);
    PG8_WAIT_V(6); PG8_BAR;
    for (;;) {
        const bool has_next = S.next(ui + 1, nxt);
        const char* nA = has_next ? (const char*)g.A + (size_t)nxt.pm * tsA : cA; const char* nB = cB; const char* nBh = cBh; if (has_next) S.b_ptr(g, nxt, tsB, nB, nBh);
        for (int t = 0; t < nt; t += 2) {
            const bool last = (t == nt - 2);
            const char* a1 = cA + (size_t)(t + 1) * kstep;
            const char* a2 = last ? nA : cA + (size_t)(t + 2) * kstep; const char* b2 = last ? nB : ((t + 2) < ksp ? cB : cBh) + (size_t)(t + 2) * kstep;
            const char* a3 = a2 + kstep; const char* b3 = b2 + kstep;
            PG8_LDB(B0, 0, 0); PG8_SCHED; PG8_LDA(At, 0, 0); PG8_STAGE(PG8_SA(1, 1), a1 + hsA, voffA);
            PG8_WAIT_L(8); PG8_BAR; PG8_WAIT_L(0); PG8_MMA(0, 0, At, B0); PG8_BAR; PG8_SCHED;
            PG8_LDB(B1, 0, 1); PG8_STAGE(PG8_SB(0, 0), b2, voffB);
            PG8_BAR; PG8_WAIT_L(0); PG8_MMA(0, 1, At, B1); PG8_BAR;
            PG8_LDA(At, 0, 1); PG8_STAGE(PG8_SA(0, 0), a2, voffA);
            PG8_BAR; PG8_WAIT_L(0); PG8_MMA(1, 0, At, B0); PG8_BAR; PG8_SCHED;
            PG8_STAGE(PG8_SB(0, 1), b2 + hsB, voffB);
            PG8_WAIT_V(6); PG8_BAR; PG8_MMA(1, 1, At, B1); PG8_BAR;
            PG8_LDB(B0, 1, 0); PG8_SCHED; PG8_LDA(At, 1, 0); PG8_STAGE(PG8_SA(0, 1), a2 + hsA, voffA);
            PG8_WAIT_L(8); PG8_BAR; PG8_WAIT_L(0); PG8_MMA(0, 0, At, B0); PG8_BAR; PG8_SCHED;
            PG8_LDB(B1, 1, 1); PG8_STAGE(PG8_SB(1, 0), b3, voffB);
            PG8_BAR; PG8_WAIT_L(0); PG8_MMA(0, 1, At, B1); PG8_BAR;
            PG8_LDA(At, 1, 1); PG8_STAGE(PG8_SA(1, 0), a3, voffA);
            PG8_BAR; PG8_WAIT_L(0); PG8_MMA(1, 0, At, B0); PG8_BAR; PG8_SCHED;
            PG8_STAGE(PG8_SB(1, 1), b3 + hsB, voffB);
            PG8_WAIT_V(6); PG8_BAR; PG8_MMA(1, 1, At, B1); PG8_BAR;
        }
        E(acc, cur, wr, wc, fr, fq);
        if (!has_next) break;
#pragma unroll
        for (int a = 0; a < 2; ++a)
#pragma unroll
            for (int b = 0; b < 2; ++b)
#pragma unroll
                for (int m = 0; m < 4; ++m)
#pragma unroll
                    for (int n = 0; n < 2; ++n) acc[a][b][m][n] = (f32x4){0.f, 0.f, 0.f, 0.f};
        cur = nxt; cA = nA; cB = nB; cBh = nBh; ++ui;
    }
    PG8_WAIT_V(0);
    if (wr == 0) PG8_BAR;
    PG8_BAR;
#undef PG8_SA
#undef PG8_SB
#undef PG8_STAGE
#undef PG8_LDA
#undef PG8_LDB
#undef PG8_MMA
#undef PG8_WAIT_V
#undef PG8_WAIT_L
#undef PG8_BAR
#undef PG8_SCHED
}
__device__ __forceinline__ h16x8 pack8(const f32x4& a, const f32x4& b) { h16x8 r; r[0] = (h16)a[0]; r[1] = (h16)a[1]; r[2] = (h16)a[2]; r[3] = (h16)a[3]; r[4] = (h16)b[0]; r[5] = (h16)b[1]; r[6] = (h16)b[2]; r[7] = (h16)b[3]; return r; }
template <int ACT> struct EpiH16 {
    static constexpr bool PERM = true;
    h16* O; int ldc; int ncols; const float* bias;
    __device__ __forceinline__ void operator()(const f32x4 (&acc)[2][2][4][2], const Unit& u, int wr, int wc, int fr, int fq) const {
        const int row0 = u.pm * BM + wr * 64 + fr, col0 = u.pn * BM + wc * 32 + 8 * fq;
#pragma unroll
        for (int bj = 0; bj < 2; ++bj) {
            const int col = col0 + bj * HALF;
            if (col < ncols) {
                f32x4 b0 = {0.f, 0.f, 0.f, 0.f}, b1 = b0;
                if (ACT == 1) { b0 = *(const f32x4*)(bias + col); b1 = *(const f32x4*)(bias + col + 4); }
#pragma unroll
                for (int ai = 0; ai < 2; ++ai)
#pragma unroll
                    for (int m = 0; m < 4; ++m) {
                        f32x4 v0 = acc[ai][bj][m][0] + b0, v1 = acc[ai][bj][m][1] + b1;
                        if (ACT == 1) {
#pragma unroll
                            for (int e = 0; e < 4; ++e) { v0[e] = sigm(v0[e]); v1[e] = sigm(v1[e]); }
                        }
                        st16_wt(O + (size_t)(row0 + ai * HALF + m * 16) * ldc + col, pack8(v0, v1));
                    }
            }
        }
    }
};
struct EpiResid {
    static constexpr bool PERM = false;
    float* O; const float* X; const float* gate;
    __device__ __forceinline__ void operator()(const f32x4 (&acc)[2][2][4][2], const Unit& u, int wr, int wc, int fr, int fq) const {
        const int row0 = u.pm * BM + wr * 64 + fr, col0 = u.pn * BM + wc * 32 + 4 * fq;
        const float* gr = gate + (size_t)((u.pm * BM) / SEQ) * 6144;
#pragma unroll
        for (int bj = 0; bj < 2; ++bj)
#pragma unroll
            for (int n = 0; n < 2; ++n) {
                const int col = col0 + bj * HALF + n * 16;
                const f32x4 gg = *(const f32x4*)(gr + col);
#pragma unroll
                for (int ai = 0; ai < 2; ++ai)
#pragma unroll
                    for (int m = 0; m < 4; ++m) {
                        const size_t o = (size_t)(row0 + ai * HALF + m * 16) * DM + col;
                        *(f32x4*)(O + o) = *(const f32x4*)(X + o) + gg * acc[ai][bj][m][n];
                    }
            }
    }
};

template <int STAGE> struct MoeOrder {
    const int* bcnt; const h16* W; int G, c, rounds;
    static constexpr int NCOL = STAGE == 1 ? 8 : 4;
    __device__ bool next(int i, Unit& u) const {
        if (i >= rounds) return false;
        const long L = (long)i * G + c; const int mt = (int)(L / NCOL);
        if (mt >= 88) return false;
        int acc = 0, found = 0;
        for (int b = 0; b < 24; ++b) {
            const int cn = bcnt[b]; const int ntl = (cn + 255) >> 8;
            if (!found && mt < acc + ntl) { found = 1; u.bucket = b; u.i0 = (mt - acc) * 256; u.cnt = cn; }
            acc += ntl;
        }
        if (!__builtin_amdgcn_readfirstlane(found)) return false;
        u.bucket = __builtin_amdgcn_readfirstlane(u.bucket); u.i0 = __builtin_amdgcn_readfirstlane(u.i0); u.cnt = __builtin_amdgcn_readfirstlane(u.cnt);
        const int gI = u.bucket / 6, pr = u.bucket % 6;
        u.ea = gI * 4 + (pr < 3 ? 0 : pr < 5 ? 1 : 2); u.eb = gI * 4 + (pr == 0 ? 1 : pr == 1 ? 2 : pr == 2 ? 3 : pr == 3 ? 2 : 3);
        u.pm = mt; u.pn = (int)(L % NCOL); return true;
    }
    __device__ __forceinline__ int ksplit() const { return STAGE == 1 ? (1 << 30) : 8; }
    __device__ __forceinline__ void b_ptr(const Gemm&, const Unit& u, size_t, const char*& lo, const char*& hi) const {
        if (STAGE == 1) { const int e = u.pn < 4 ? u.ea : u.eb; lo = hi = (const char*)(W + ((size_t)e * 1024 + (u.pn & 3) * 256) * 1024); }
        else { lo = (const char*)(W + ((size_t)u.ea * 1024 + u.pn * 256) * 512); hi = (const char*)(W + ((size_t)u.eb * 1024 + u.pn * 256) * 512) - 8 * (size_t)(BK * 2); }
    }
};
struct EpiGate {
    static constexpr bool PERM = true;
    unsigned char* O; const float* bias;
    __device__ __forceinline__ void operator()(const f32x4 (&acc)[2][2][4][2], const Unit& u, int wr, int wc, int fr, int fq) const {
        asm volatile("" : "+v"(fr), "+v"(fq));
        const int t = u.pn * 16 + wc * 4 + fq;
        const float* bp = bias + (t >> 6) * 1024 + ((t >> 3) & 7) * 128 + ((t >> 2) & 1) * 64 + 4 * (t & 3);
        f32x4 bs[4];
#pragma unroll
        for (int j = 0; j < 4; ++j) bs[j] = *(const f32x4*)(bp + 16 * j);
#pragma unroll
        for (int ai = 0; ai < 2; ++ai)
#pragma unroll
            for (int m = 0; m < 4; ++m) {
                u32x4 w = {0u, 0u, 0u, 0u};
#pragma unroll
                for (int j = 0; j < 4; ++j) {
                    const f32x4 v = acc[ai][j >> 1][m][j & 1] + bs[j];
                    unsigned q = 0u;
#pragma unroll
                    for (int e = 0; e < 4; ++e) q = __builtin_amdgcn_cvt_pk_u8_f32(sigm(v[e]) * 255.f, e, q);
                    w[j] = q;
                }
                st16_wt(O + (size_t)(u.pm * BM + ai * HALF + wr * 64 + m * 16 + fr) * 4096 + t * 16, __builtin_bit_cast(h16x8, w));
                __builtin_amdgcn_sched_barrier(0);
            }
    }
};
struct EpiMoe1 {
    static constexpr bool PERM = true;
    h16* act; const int* lists; const float* cw;
    __device__ __forceinline__ void operator()(const f32x4 (&acc)[2][2][4][2], const Unit& u, int wr, int wc, int fr, int fq) const {
        asm volatile("" : "+v"(fr), "+v"(fq));
        const int* lst = lists + (size_t)u.bucket * LCAP;
        const int second = u.pn >= 4;
        const int colb = ((u.pn & 3) * 256 + wc * 32) / 2 + 4 * fq + second * 512;
#pragma unroll
        for (int ai = 0; ai < 2; ++ai)
#pragma unroll
            for (int m = 0; m < 4; ++m) {
                const int r = ai * HALF + wr * 64 + m * 16 + fr, ii = u.i0 + r; const bool valid = ii < u.cnt;
                const float cwv = valid ? cw[(size_t)lst[valid ? ii : 0] * 2 + second] : 0.f;
                h16* O = act + ((size_t)u.pm * 256 + r) * 1024 + colb;
#pragma unroll
                for (int bj = 0; bj < 2; ++bj) {
                    const f32x4 a = acc[ai][bj][m][0], bq = acc[ai][bj][m][1];
                    *(h16x4*)(O + bj * 64) = pack4(cwv * (a[0] * sigm(a[0])) * bq[0], cwv * (a[1] * sigm(a[1])) * bq[1], cwv * (a[2] * sigm(a[2])) * bq[2], cwv * (a[3] * sigm(a[3])) * bq[3]);
                }
                __builtin_amdgcn_sched_barrier(0);
            }
    }
};
struct EpiMoe2 {
    static constexpr bool PERM = false;
    float* x1; const int* lists; const float* gate;
    __device__ __forceinline__ void operator()(const f32x4 (&acc)[2][2][4][2], const Unit& u, int wr, int wc, int fr, int fq) const {
        asm volatile("" : "+v"(fr), "+v"(fq));
        const int* lst = lists + (size_t)u.bucket * LCAP;
#pragma unroll
        for (int ai = 0; ai < 2; ++ai)
#pragma unroll
            for (int m = 0; m < 4; ++m) {
                const int r = ai * HALF + wr * 64 + m * 16 + fr, ii = u.i0 + r;
                if (ii < u.cnt) {
                    const int tok = lst[ii];
                    const float* gr = gate + (size_t)(tok / SEQ) * 6144;
                    float* xr = x1 + (size_t)tok * DM;
#pragma unroll
                    for (int bj = 0; bj < 2; ++bj)
#pragma unroll
                        for (int n = 0; n < 2; ++n) {
                            const int col = u.pn * 256 + bj * HALF + wc * 32 + n * 16 + 4 * fq;
                            *(f32x4*)(xr + col) = *(const f32x4*)(xr + col) + *(const f32x4*)(gr + col) * acc[ai][bj][m][n];
                        }
                }
            }
    }
};
}

__device__ __forceinline__ void ph_gemm1(CP p, int bid, int nblk, char* smem) {
    {
        pg8::Gemm g; g.A = p.h_hi; g.Bt = p.Wp; g.M = NTOK; g.N = 2560; g.K = DM; g.lda = DM; g.ldb = DM;
        pg8::StaticOrder S; S.init(NTOK, 2560, nblk, bid);
        pg8::EpiH16<0> E; E.O = p.proj; E.ldc = PJ; E.ncols = PJ; E.bias = nullptr;
        pg8::gemm_phase(( PG8_LAS unsigned char*)smem, g, S, E);
    }
    __syncthreads();
    for (int u = bid - 128; u >= 0 && u < 128; u += nblk) {
        f32x4 acc[4][4]; zero_acc<256>(acc);
        const int mt = u >> 1, nt = u & 1, m0 = mt * 256, n0 = nt * 128;
        const h16* Ah = p.h_hi + (size_t)m0 * DM; const h16* B = p.Widx + (size_t)n0 * 3072;
        gemm_kloop<256>(smem, 1024, [=](int r, int k) { return Ah + (size_t)r * DM + k; },
                        [=](int r, int k) { return B + (size_t)r * 3072 + k; }, acc);
        float* O = p.idxf + (size_t)m0 * IDXLD + n0;
        gemm_epi<256>(acc, [=](int ml, int nl, f32x4 v) { if (n0 + nl < IDXLD) *(f32x4*)(O + (size_t)ml * IDXLD + nl) = v; });
    }
}

#define BU_LD 132
template <int PASS>
__device__ __forceinline__ void ph_s5_scan(CP p, int l, int bid, int nblk, char* smem) {
    const int lane = otid() & 63, wv = otid() >> 6;
    const int cc = lane & 15, gq = lane >> 4;
    h16* us = (h16*)smem + wv * (64 * 16);
    float* bu = (float*)(smem + 16384) + wv * (16 * BU_LD);
    h16* Hs = (h16*)(smem + 16384 + 8 * 16 * BU_LD * 4) + wv * (16 * 136);
    int gprev = -1;
    float lr = 0.f, li = 0.f, dsk = 0.f; h16x4 bB[8]; h16x8 bf[4];
    h16x8 a0n, a1n; float hrn = 0.f, hin = 0.f;
#define S5_PREFETCH(UU) do { const int g_ = (UU) & 15, c_ = ((UU) >> 4) & 63, b_ = (UU) >> 10; \
        const h16* up_ = p.proj + (size_t)(b_ * SEQ + c_ * 64 + lane) * PJ + P_U + g_ * 16; a0n = *(const h16x8*)up_; a1n = *(const h16x8*)(up_ + 8); \
        if (PASS == 3) { const size_t hix_ = ((((size_t)b_ * 64 + c_) * 16 + g_) * 64 + lane) * 2; hrn = p.s5H[hix_]; hin = p.s5H[hix_ + 1]; } } while (0)
    if (bid * 8 + wv < 4096) S5_PREFETCH(bid * 8 + wv);
    for (int u = bid * 8 + wv; u < 4096; u += nblk * 8) {
        const int g = u & 15, c = (u >> 4) & 63, b = u >> 10;
        if (g != gprev) {
            gprev = g;
            const float* scg = p.s5c + (size_t)((l * 16 + g) * 64) * 36;
            lr = scg[lane * 36]; li = scg[lane * 36 + 1];
#pragma unroll
            for (int nt = 0; nt < 8; ++nt) {
                const f32x4 v = *(const f32x4*)(scg + ((nt & 3) * 16 + cc) * 36 + 4 + (nt >> 2) * 16 + 4 * gq);
                bB[nt][0] = (h16)v[0]; bB[nt][1] = (h16)v[1]; bB[nt][2] = (h16)v[2]; bB[nt][3] = (h16)v[3];
            }
            if (PASS == 3) {
                const float* cre = p.in[I_S5CRE] + ((size_t)(l * 16 + g) * 16 + cc) * 64 + 8 * gq;
                const float* cim = p.in[I_S5CIM] + ((size_t)(l * 16 + g) * 16 + cc) * 64 + 8 * gq;
#pragma unroll
                for (int ks = 0; ks < 2; ++ks)
#pragma unroll
                    for (int j = 0; j < 8; ++j) { bf[ks][j] = (h16)cre[ks * 32 + j]; bf[2 + ks][j] = (h16)(-cim[ks * 32 + j]); }
                dsk = p.in[I_S5D][l * 256 + g * 16 + cc];
            }
        }
        float hr = PASS == 3 ? hrn : 0.f, hi = PASS == 3 ? hin : 0.f;
        const int t0 = b * SEQ + c * 64;
        {
            wave_lds_sync();
            *(h16x8*)&us[lane * 16] = a0n; *(h16x8*)&us[lane * 16 + 8] = a1n;
            wave_lds_sync();
        }
        if (u + nblk * 8 < 4096) S5_PREFETCH(u + nblk * 8);
#pragma unroll 1
        for (int tt = 0; tt < 4; ++tt) {
            const h16x4 ua = *(const h16x4*)&us[(16 * tt + cc) * 16 + 4 * gq];
#pragma unroll
            for (int nt = 0; nt < 8; ++nt) {
                const f32x4 z4 = {0.f, 0.f, 0.f, 0.f};
                const f32x4 a = __builtin_amdgcn_mfma_f32_16x16x16f16(ua, bB[nt], z4, 0, 0, 0);
#pragma unroll
                for (int r = 0; r < 4; ++r) bu[(4 * gq + r) * BU_LD + nt * 16 + cc] = a[r];
            }
            wave_lds_sync();
#pragma unroll
            for (int s = 0; s < 16; ++s) {
                const float br = bu[s * BU_LD + lane], bi = bu[s * BU_LD + 64 + lane];
                const float nhr = lr * hr - li * hi + br, nhi = lr * hi + li * hr + bi;
                hr = nhr; hi = nhi;
                if (PASS == 3) { Hs[s * 136 + lane] = (h16)hr; Hs[s * 136 + 64 + lane] = (h16)hi; }
            }
            if (PASS == 3) {
                wave_lds_sync();
                f32x4 acc = {0.f, 0.f, 0.f, 0.f};
#pragma unroll
                for (int ks = 0; ks < 4; ++ks) acc = __builtin_amdgcn_mfma_f32_16x16x32_f16(*(const h16x8*)&Hs[cc * 136 + ks * 32 + 8 * gq], bf[ks], acc, 0, 0, 0);
#pragma unroll
                for (int r = 0; r < 4; ++r) {
                    const int t = 16 * tt + 4 * gq + r;
                    const float y = acc[r] + dsk * (float)us[t * 16 + cc];
                    p.ybuf[(size_t)(t0 + t) * 256 + g * 16 + cc] = (h16)gelu_tanh(y);
                }
            }
            wave_lds_sync();
        }
        if (PASS == 1) { const size_t eix = ((((size_t)b * 64 + c) * 16 + g) * 64 + lane) * 2; p.s5E[eix] = hr; p.s5E[eix + 1] = hi; }
    }
}
__device__ __forceinline__ void ph_s5_carry(CP p, int l, int bid, int nblk) {
    if (bid >= 8) return;
    const int gid = bid * 512 + otid();
    const int pp = gid & 63, g = (gid >> 6) & 15, b = gid >> 10;
    const int pidx = (l * 16 + g) * 64 + pp;
    const float ar = p.s5c[(size_t)pidx * 36 + 2], ai = p.s5c[(size_t)pidx * 36 + 3];
    float hr = 0.f, hi = 0.f;
#pragma unroll 1
    for (int c0 = 0; c0 < 64; c0 += 16) {
        float2 e[16];
#pragma unroll
        for (int q = 0; q < 16; ++q) e[q] = *(const float2*)&p.s5E[((((size_t)b * 64 + c0 + q) * 16 + g) * 64 + pp) * 2];
#pragma unroll
        for (int q = 0; q < 16; ++q) {
            *(float2*)&p.s5H[((((size_t)b * 64 + c0 + q) * 16 + g) * 64 + pp) * 2] = make_float2(hr, hi);
            const float nr = ar * hr - ai * hi + e[q].x, ni = ar * hi + ai * hr + e[q].y;
            hr = nr; hi = ni;
        }
    }
}
__device__ __forceinline__ void ph_s5_glu(CP p, int l, int bid, int nblk, char* smem) {
    for (int u = bid; u < 128; u += nblk) {
        const int mt = u >> 1, nt = u & 1, m0 = mt * 256, n0 = nt * 128;
        f32x4 acc[4][4]; zero_acc<256>(acc);
        const h16* A = p.ybuf + (size_t)m0 * 256; const h16* B = p.Wglu + (size_t)n0 * 256;
        gemm_kloop<256>(smem, 256, [=](int r, int k) { return A + (size_t)r * 256 + k; }, [=](int r, int k) { return B + (size_t)r * 256 + k; }, acc);
        const float* gb = p.in[I_S5GB] + l * 256 + n0;
        const h16* Y = p.ybuf + (size_t)m0 * 256 + n0; h16* O = p.branches + (size_t)m0 * DM + n0;
        gemm_epi<256>(acc, [=](int ml, int nl, f32x4 v) {
            h16x4 y = *(const h16x4*)(Y + (size_t)ml * 256 + nl); f32x4 bb = *(const f32x4*)(gb + nl);
            *(h16x4*)(O + (size_t)ml * DM + nl) = pack4((float)y[0] * sigm(v[0] + bb[0]), (float)y[1] * sigm(v[1] + bb[1]), (float)y[2] * sigm(v[2] + bb[2]), (float)y[3] * sigm(v[3] + bb[3])); });
    }
}

__device__ __forceinline__ void ph_rg_a(CP p, int l, int bid, int nblk, char* smem) {
    float* xc = (float*)smem;
    float* aa = xc + 32 * 256;
    float* bx = aa + 32 * 256;
    h16* xh = (h16*)(bx + 32 * 256);
    const int tid = otid();
    const int ch_c = tid & 255, par = tid >> 8;
    const float w0 = p.in[I_RGCW][(l * 4 + 0) * 256 + ch_c], w1 = p.in[I_RGCW][(l * 4 + 1) * 256 + ch_c], w2 = p.in[I_RGCW][(l * 4 + 2) * 256 + ch_c], w3 = p.in[I_RGCW][(l * 4 + 3) * 256 + ch_c];
    const float cb = p.in[I_RGCB][l * 256 + ch_c];
    const int lane = tid & 63, wave = tid >> 6, blk = wave >> 1, mt = wave & 1, g = lane >> 4, c16 = lane & 15;
    h16x8 br_[4][2], bi_[4][2]; float brb[4], bib[4], spl[4];
    {
        const h16* wb = p.Wrg + ((size_t)blk * 64) * 64;
#pragma unroll
        for (int nt = 0; nt < 4; ++nt) {
#pragma unroll
            for (int ks = 0; ks < 2; ++ks) {
                br_[nt][ks] = *(const h16x8*)(wb + (size_t)(nt * 16 + c16) * 64 + ks * 32 + 8 * g);
                bi_[nt][ks] = *(const h16x8*)(wb + 4 * 64 * 64 + (size_t)(nt * 16 + c16) * 64 + ks * 32 + 8 * g);
            }
            const int ch = blk * 64 + nt * 16 + c16;
            brb[nt] = p.in[I_RGBR][l * 256 + ch]; bib[nt] = p.in[I_RGBI][l * 256 + ch];
            spl[nt] = softplusf_(-p.in[I_RGLAM][l * 256 + ch]);
        }
    }
    h16 rows[19];
#define RG_ROWS(UU) do { const int b_ = (UU) >> 7, t0_ = ((UU) & 127) * 32; \
        _Pragma("unroll") for (int k = 0; k < 19; ++k) { const int tt = t0_ + 16 * par - 3 + k; rows[k] = tt >= 0 ? p.proj[(size_t)(b_ * SEQ + tt) * PJ + P_RGX + ch_c] : (h16)0.f; } } while (0)
    if (bid < 512) RG_ROWS(bid);
    for (int u = bid; u < 512; u += nblk) {
        const int b = u >> 7, c = u & 127, t0 = c * 32;
        lds_barrier();
        {
#pragma unroll
            for (int m = 0; m < 16; ++m)
            { const float xv = cb + w3 * (float)rows[m + 3] + w2 * (float)rows[m + 2] + w1 * (float)rows[m + 1] + w0 * (float)rows[m]; xc[(16 * par + m) * 256 + ch_c] = xv; xh[(16 * par + m) * 264 + ch_c] = (h16)xv; }
        }
        if (u + nblk < 512) RG_ROWS(u + nblk);
        lds_barrier();
        {
            h16x8 af[2];
#pragma unroll
            for (int ks = 0; ks < 2; ++ks) af[ks] = *(const h16x8*)&xh[(16 * mt + c16) * 264 + blk * 64 + ks * 32 + 8 * g];
#pragma unroll
            for (int nt = 0; nt < 4; ++nt) {
                f32x4 ar = {0.f, 0.f, 0.f, 0.f}, ai = ar;
#pragma unroll
                for (int ks = 0; ks < 2; ++ks) {
                    ar = __builtin_amdgcn_mfma_f32_16x16x32_f16(af[ks], br_[nt][ks], ar, 0, 0, 0);
                    ai = __builtin_amdgcn_mfma_f32_16x16x32_f16(af[ks], bi_[nt][ks], ai, 0, 0, 0);
                }
                const int ch = blk * 64 + nt * 16 + c16;
#pragma unroll
                for (int r = 0; r < 4; ++r) {
                    const int tk = 16 * mt + 4 * g + r;
                    const float rr = sigm(ar[r] + brb[nt]), ig = sigm(ai[r] + bib[nt]);
                    const float la = -8.f * rr * spl[nt];
                    const float a = __expf(la), mult = sqrtf(fmaxf(1.f - __expf(2.f * la), 0.f));
                    aa[tk * 256 + ch] = a; bx[tk * 256 + ch] = mult * ig * xc[tk * 256 + ch];
                }
            }
        }
        lds_barrier();
        if (tid < 256) {
            const int ch = tid;
            float h = 0.f, cp = 1.f;
            unsigned* hc = (unsigned*)p.rg_hl + (size_t)(b * SEQ + t0) * 256 + ch;
            for (int t = 0; t < 32; ++t) { const float a = aa[t * 256 + ch]; h = a * h + bx[t * 256 + ch]; cp *= a; h16x2 w2; w2[0] = (h16)h; w2[1] = (h16)cp; hc[(size_t)t * 256] = __builtin_bit_cast(unsigned, w2); }
            p.rg_agg[((size_t)(b * 128 + c) * 256 + ch) * 2] = cp; p.rg_agg[((size_t)(b * 128 + c) * 256 + ch) * 2 + 1] = h;
        }
    }
#undef RG_ROWS
}
__device__ __forceinline__ void ph_rg_c(CP p, int l, int bid, int nblk, char* smem) {
    float* carry = (float*)smem;
    const int tid = otid();
    for (int u = bid; u < 512; u += nblk) {
        const int b = u >> 7, c = u & 127, t0 = c * 32;
        __syncthreads();
        const int ch = tid & 255;
        {
            const int par = tid >> 8, half = (c + 1) >> 1;
            const int hiE = par ? c : half;
            float h = 0.f, pr = 1.f;
            const float2* ag = (const float2*)p.rg_agg + (size_t)b * 128 * 256 + ch;
#pragma unroll 1
            for (int cc = par ? half : 0; cc < hiE; cc += 16) {
                float2 v[16];
#pragma unroll
                for (int q = 0; q < 16; ++q) { const int ci = cc + q < hiE ? cc + q : hiE - 1; v[q] = ag[(size_t)ci * 256]; }
#pragma unroll
                for (int q = 0; q < 16; ++q) if (cc + q < hiE) { h = v[q].x * h + v[q].y; pr *= v[q].x; }
            }
            carry[par * 512 + ch] = h; carry[par * 512 + 256 + ch] = pr;
        }
        __syncthreads();
        {
            const int par = tid >> 8;
            float hl_[16], cp_[16]; h16 gt_[16];
#pragma unroll
            for (int m = 0; m < 16; ++m) { const size_t tok = (size_t)b * SEQ + t0 + 16 * par + m; const h16x2 w2 = __builtin_bit_cast(h16x2, ((const unsigned*)p.rg_hl)[tok * 256 + ch]); hl_[m] = (float)w2[0]; cp_[m] = (float)w2[1]; gt_[m] = p.proj[tok * PJ + P_RGG + ch]; }
            const float cr = carry[512 + 256 + ch] * carry[ch] + carry[512 + ch];
#pragma unroll
            for (int m = 0; m < 16; ++m) { const size_t tok = (size_t)b * SEQ + t0 + 16 * par + m; p.branches[tok * DM + 512 + ch] = (h16)((hl_[m] + cp_[m] * cr) * gelu_tanh((float)gt_[m])); }
        }
    }
}

#define RS 68
template <int MODE>
__device__ __forceinline__ void mm_nt(float* out, const float* X, const float* Y, int wave, int base, int lane) {
    const int g = lane >> 4, c = lane & 15;
    for (int t10 = (wave - base) & 7; t10 < 10; t10 += 8) {
        const int ti = t10 >= 6 ? 3 : t10 >= 3 ? 2 : t10 >= 1 ? 1 : 0, tj = t10 - ((ti * (ti + 1)) >> 1);
        f32x4 acc = {0.f, 0.f, 0.f, 0.f};
#pragma unroll
        for (int ks = 0; ks < 2; ++ks) {
            const float* xp = &X[(ti * 16 + c) * RS + ks * 32 + 8 * g]; const float* yp = &Y[(tj * 16 + c) * RS + ks * 32 + 8 * g];
            const f32x4 x0 = *(const f32x4*)xp, x1 = *(const f32x4*)(xp + 4), y0 = *(const f32x4*)yp, y1 = *(const f32x4*)(yp + 4);
            bf16x8_t a, b;
#pragma unroll
            for (int j = 0; j < 4; ++j) { a[j] = (__bf16)x0[j]; a[4 + j] = (__bf16)x1[j]; b[j] = (__bf16)y0[j]; b[4 + j] = (__bf16)y1[j]; }
            acc = __builtin_amdgcn_mfma_f32_16x16x32_bf16(a, b, acc, 0, 0, 0);
        }
#pragma unroll
        for (int r = 0; r < 4; ++r) {
            const int row = ti * 16 + 4 * g + r, col = tj * 16 + c;
            float v = acc[r];
            if (MODE == 1 && col >= row) v = 0.f;
            if (MODE == 2 && col > row) v = 0.f;
            out[row * RS + col] = v;
        }
    }
}
__device__ __forceinline__ f32x4 mm_nn_tile(f32x4 acc, const float* X, const float* Y, int ti, int tj, int lane, float sign) {
    const int g = lane >> 4, c = lane & 15;
    for (int kb = 0; kb <= ti; ++kb) {
        const f32x4 a4 = *(const f32x4*)&X[(ti * 16 + c) * RS + kb * 16 + 4 * g];
#pragma unroll
        for (int i = 0; i < 4; ++i) acc = __builtin_amdgcn_mfma_f32_16x16x4f32(sign * a4[i], Y[(kb * 16 + 4 * g + i) * RS + tj * 16 + c], acc, 0, 0, 0);
    }
    return acc;
}
__device__ __forceinline__ f32x4 mm_nn_tile_h(f32x4 acc, const float* X, const float* Y, int ti, int tj, int lane, float sign) {
    const int g = lane >> 4, c = lane & 15;
    for (int ks = 0; 2 * ks <= ti; ++ks) {
        const float* xp = &X[(ti * 16 + c) * RS + ks * 32 + 8 * g];
        f32x4 x0 = *(const f32x4*)xp, x1 = *(const f32x4*)(xp + 4);
        if (2 * ks + (g >> 1) > ti) { x0 = f32x4{0.f, 0.f, 0.f, 0.f}; x1 = x0; }
        h16x8 a, b;
#pragma unroll
        for (int j = 0; j < 4; ++j) { a[j] = (h16)(sign * x0[j]); a[4 + j] = (h16)(sign * x1[j]); }
#pragma unroll
        for (int j = 0; j < 8; ++j) b[j] = (h16)Y[(ks * 32 + 8 * g + j) * RS + tj * 16 + c];
        acc = __builtin_amdgcn_mfma_f32_16x16x32_f16(a, b, acc, 0, 0, 0);
    }
    return acc;
}
template <int T> struct FwdRow {
    static __device__ __forceinline__ void run(float (&x)[64], const float* Nm) {
        FwdRow<T - 1>::run(x, Nm);
        float acc = x[T];
#pragma unroll
        for (int s4 = 0; s4 < (T + 3) / 4; ++s4) {
            const f32x4 n4 = *(const f32x4*)&Nm[T * RS + s4 * 4];
#pragma unroll
            for (int e = 0; e < 4; ++e) if (s4 * 4 + e < T) acc -= n4[e] * x[s4 * 4 + e];
        }
        x[T] = acc;
    }
};
template <> struct FwdRow<0> { static __device__ __forceinline__ void run(float (&)[64], const float*) {} };
#define RWA_LDS (16384 + 8 * 64 * RS * 4)
__device__ __forceinline__ void ph_rw_a(CP p, int l, int bid, int nblk, char* smem) {
    h16* fs = (h16*)smem;
    float* Ah = (float*)(smem + 16384);
    float* Rh = Ah + 64 * RS; float* Bh = Rh + 64 * RS; float* Kh = Bh + 64 * RS; float* Vv = Kh + 64 * RS;
    float* Nm = Vv + 64 * RS; float* Mm = Nm + 64 * RS; float* T1 = Mm + 64 * RS;
    float* tot = (float*)(smem + RWA_LDS);
    float* egl = tot + 8 * 64;
    float pw[8]; h16 pr_[9], pk_[9], pv_[9]; float wq[2][32];
#define RWA_PREFETCH(UU) do { \
        const int tid_ = otid(), lane_ = tid_ & 63, wave_ = tid_ >> 6, g_ = lane_ >> 4, cc_ = lane_ & 15, tjp_ = wave_ >> 2; \
        const int ll_ = oint(l); const float* mu_ = p.in[I_RWMU] + ll_ * 896; \
        const int h_ = (UU) & 3, c_ = ((UU) >> 2) & 63, b_ = (UU) >> 8, ch_ = h_ * 64 + lane_; \
        const int t0_ = c_ * 64; const size_t tok0_ = (size_t)b_ * SEQ + t0_; \
        pw[0] = p.in[I_RWW0][ll_ * 256 + ch_]; pw[1] = p.in[I_RWA0][ll_ * 256 + ch_]; pw[2] = p.in[I_RWKK][ll_ * 256 + ch_]; pw[3] = p.in[I_RWKA][ll_ * 256 + ch_]; pw[4] = p.in[I_RWRK][ll_ * 256 + ch_]; \
        pw[5] = mu_[ch_]; pw[6] = mu_[256 + ch_]; pw[7] = mu_[512 + ch_]; \
        _Pragma("unroll") for (int q = 0; q < 9; ++q) { const int t = wave_ * 8 + q - 1; const bool ok = (t0_ + t) >= 0; const h16* pc = p.proj + (tok0_ + t) * PJ + P_RW + ch_; \
            pr_[q] = ok ? pc[0] : (h16)0.f; pk_[q] = ok ? pc[256] : (h16)0.f; pv_[q] = ok ? pc[512] : (h16)0.f; } \
        _Pragma("unroll") for (int tj2 = 0; tj2 < 2; ++tj2) { const int chg = h_ * 64 + (tjp_ * 2 + tj2) * 16 + cc_; \
            const float* wu = p.in[I_RWWUP] + ((size_t)ll_ * 32 + 8 * g_) * 256 + chg; const float* au = p.in[I_RWAUP] + ((size_t)ll_ * 32 + 8 * g_) * 256 + chg; const float* gu = p.in[I_RWGUP] + ((size_t)ll_ * 64 + 8 * g_) * 256 + chg; \
            _Pragma("unroll") for (int j = 0; j < 8; ++j) { wq[tj2][j] = wu[j * 256]; wq[tj2][8 + j] = au[j * 256]; wq[tj2][16 + j] = gu[j * 256]; wq[tj2][24 + j] = gu[(32 + j) * 256]; } } \
    } while (0)
    if (bid * 4 < 1024) RWA_PREFETCH(bid * 4);
    for (int u4 = bid * 4; u4 < 1024; u4 += (nblk & ~0) * 4)
    for (int u = u4; u < u4 + 4; ++u) {
        int tid = otid(), lane = tid & 63, wave = tid >> 6;
        const float* mu = p.in[I_RWMU] + oint(l) * 896;
        const int h = u & 3, c = (u >> 2) & 63, b = u >> 8;
        const int t0 = c * 64; const size_t tok0 = (size_t)b * SEQ + t0;
        lds_barrier();
        if (h == 0)
        {
            h16 cu_[16], pv_[16];
#pragma unroll
            for (int q = 0; q < 16; ++q) {
                const int i = tid + 512 * q; const int t = i >> 7, j = i & 127; const size_t tok = tok0 + t;
                const h16* pc = p.proj + tok * PJ + P_RW + 768 + j;
                cu_[q] = pc[0];
                pv_[q] = pc[(t0 + t) ? -(long)PJ : 0];
            }
#pragma unroll
            for (int q = 0; q < 16; ++q) {
                const int i = tid + 512 * q; const int t = i >> 7, j = i & 127;
                const float cur = (float)cu_[q]; const float prv = (t0 + t) ? (float)pv_[q] : 0.f;
                float v = cur + (prv - cur) * mu[768 + j];
                if (j < 32) v = tanh_fast(v); else if (j >= 64) v = sigm(v);
                fs[t * 128 + ((((j >> 3) ^ (t & 15)) << 3) | (j & 7))] = (h16)v;
            }
        }
        lds_barrier();
        tid = otid(); lane = tid & 63; wave = tid >> 6;
        {
            const int ll = oint(l);
            const int ch = h * 64 + lane;
            const float w0 = pw[0], a0 = pw[1], kkw = pw[2], kaw = pw[3], rkw = pw[4];
            const float mur = pw[5], muk = pw[6], muv = pw[7];
            float run = 0.f;
            {
                const int g = lane >> 4, cc = lane & 15, ti = wave & 3, tjp = wave >> 2;
                h16x8 af[4];
#pragma unroll
                for (int ks = 0; ks < 4; ++ks) af[ks] = *(const h16x8*)&fs[(ti * 16 + cc) * 128 + (((ks * 4 + g) ^ cc) << 3)];
#pragma unroll
                for (int tj2 = 0; tj2 < 2; ++tj2) {
                    const int chl = (tjp * 2 + tj2) * 16 + cc, chg = h * 64 + chl;
                    h16x8 bw, ba, bg0, bg1;
#pragma unroll
                    for (int j = 0; j < 8; ++j) { bw[j] = (h16)wq[tj2][j]; ba[j] = (h16)wq[tj2][8 + j]; bg0[j] = (h16)wq[tj2][16 + j]; bg1[j] = (h16)wq[tj2][24 + j]; }
                    const f32x4 z4 = {0.f, 0.f, 0.f, 0.f};
                    const f32x4 cw = __builtin_amdgcn_mfma_f32_16x16x32_f16(af[0], bw, z4, 0, 0, 0);
                    const f32x4 ca = __builtin_amdgcn_mfma_f32_16x16x32_f16(af[1], ba, z4, 0, 0, 0);
                    f32x4 cg = __builtin_amdgcn_mfma_f32_16x16x32_f16(af[2], bg0, z4, 0, 0, 0);
                    cg = __builtin_amdgcn_mfma_f32_16x16x32_f16(af[3], bg1, cg, 0, 0, 0);
#pragma unroll
                    for (int r = 0; r < 4; ++r) {
                        const int t = ti * 16 + 4 * g + r;
                        Nm[t * RS + chl] = cw[r]; Mm[t * RS + chl] = ca[r];
                        p.rw_g[(tok0 + t) * 256 + chg] = (h16)cg[r];
                    }
                }
            }
            lds_barrier();
#pragma unroll
            for (int q = 0; q < 8; ++q) {
                const int t = wave * 8 + q; const size_t tok = tok0 + t;
                const float lw = Nm[t * RS + lane], la = Mm[t * RS + lane];
                const float rc = (float)pr_[q + 1], kc = (float)pk_[q + 1], vc = (float)pv_[q + 1];
                const float rp = (float)pr_[q], kp_ = (float)pk_[q], vp = (float)pv_[q];
                const float r = rc + (rp - rc) * mur, k = kc + (kp_ - kc) * muk, v = vc + (vp - vc) * muv;
                const float wl = -0.60653066f * sigm(w0 + lw);
                const float a = sigm(a0 + la);
                float kk = k * kkw;
                const float nrm = sqrtf(wave_sum(kk * kk));
                kk = kk * __builtin_amdgcn_rcpf(fmaxf(nrm, 1e-12f));
                const float k2 = k * (1.f + (a - 1.f) * kaw);
                const float sb = wave_sum(r * k2 * rkw);
                p.rw_bonus[tok * 256 + ch] = (h16)(sb * v);
                run += wl;
                Ah[t * RS + lane] = kk; Rh[t * RS + lane] = r; Bh[t * RS + lane] = kk * a; Kh[t * RS + lane] = k2; Vv[t * RS + lane] = v; T1[t * RS + lane] = run;
            }
            lds_barrier();
            tot[wave * 64 + lane] = run;
            lds_barrier();
            float offs = 0.f, gl = 0.f;
#pragma unroll
            for (int w8 = 0; w8 < 8; ++w8) { const float tv = tot[w8 * 64 + lane]; if (w8 < wave) offs += tv; gl += tv; }
            if (wave == 0) { egl[lane] = __expf(gl); p.rw_gam[(size_t)u * 64 + lane] = __expf(gl); }
            float gprev = offs;
#pragma unroll
            for (int q = 0; q < 8; ++q) {
                const int t = wave * 8 + q;
                const float G = offs + T1[t * RS + lane];
                const float eg = __expf(G), egp = __expf(gprev), egi = __expf(-G);
                Ah[t * RS + lane] *= egp; Rh[t * RS + lane] *= eg; Bh[t * RS + lane] *= egi; Kh[t * RS + lane] *= egi;
                gprev = G;
            }
        }
        lds_barrier();
        tid = otid(); lane = tid & 63; wave = tid >> 6;
        mm_nt<1>(Nm, Ah, Bh, wave, 0, lane);
        mm_nt<1>(Mm, Ah, Kh, wave, 2, lane);
        lds_barrier();
        tid = otid(); lane = tid & 63; wave = tid >> 6;
        for (int hf = 0; hf < 2; ++hf) {
            const int tj = wave & 3, ti = wave < 4 ? (hf ? 3 : 0) : (hf ? 2 : 1);
            f32x4 acc = {0.f, 0.f, 0.f, 0.f};
            acc = mm_nn_tile_h(acc, Mm, Vv, ti, tj, lane, 1.f);
#pragma unroll
            for (int r = 0; r < 4; ++r) T1[(ti * 16 + 4 * (lane >> 4) + r) * RS + tj * 16 + (lane & 15)] = acc[r];
        }
        if (wave < 4) {
            const int g = lane >> 4, cc = lane & 15;
            float* nb = Nm + (16 * wave) * RS + 16 * wave;
            const f32x4 nA = *(const f32x4*)&nb[cc * RS + 4 * g];
            f32x4 nC;
#pragma unroll
            for (int i = 0; i < 4; ++i) nC[i] = nb[(4 * g + i) * RS + cc];
            const f32x4 z4 = {0.f, 0.f, 0.f, 0.f};
#define NIL_MM(X, Y, ACC) __builtin_amdgcn_mfma_f32_16x16x16f16(pack4((X)[0], (X)[1], (X)[2], (X)[3]), pack4((Y)[0], (Y)[1], (Y)[2], (Y)[3]), ACC, 0, 0, 0)
            const f32x4 p2A = NIL_MM(nC, nA, z4), p2C = NIL_MM(nA, nC, z4);
            const f32x4 p4A = NIL_MM(p2C, p2A, z4), p4C = NIL_MM(p2A, p2C, z4);
            f32x4 m = NIL_MM(p4A, p4C, z4), t4;
#pragma unroll
            for (int r = 0; r < 4; ++r) m[r] += (4 * g + r == cc) ? 1.f : 0.f;
            t4 = NIL_MM(p4A, m, m); m = t4;
            t4 = NIL_MM(p2A, m, m); m = t4;
            { const f32x4 nn = -nA; t4 = NIL_MM(nn, m, m); }
#undef NIL_MM
#pragma unroll
            for (int r = 0; r < 4; ++r) nb[(4 * g + r) * RS + cc] = t4[r];
        }
        lds_barrier();
        tid = otid(); lane = tid & 63; wave = tid >> 6;
        const size_t ub = (size_t)u * 4096;
        {
            mm_nt<2>(Mm, Rh, Bh, wave, 0, lane);
            for (int i = tid; i < 4096; i += 512) { const int k = i >> 6, t = i & 63; p.rw_Be[ub + i] = (h16)(-Bh[t * RS + k] * egl_get(egl, k)); }
            for (int idx = wave; idx < 16; idx += 8) {
                const int ti = idx >> 2, tj = idx & 3, g = lane >> 4, cc = lane & 15;
                f32x4 acc = {0.f, 0.f, 0.f, 0.f};
                const float eg = egl_get(egl, ti * 16 + cc);
#pragma unroll
                for (int ks = 0; ks < 2; ++ks) {
                    h16x8 a, bq;
#pragma unroll
                    for (int j = 0; j < 8; ++j) { const int t = ks * 32 + 8 * g + j; a[j] = (h16)(Kh[t * RS + ti * 16 + cc] * eg); bq[j] = (h16)Vv[t * RS + tj * 16 + cc]; }
                    acc = __builtin_amdgcn_mfma_f32_16x16x32_f16(a, bq, acc, 0, 0, 0);
                }
#pragma unroll
                for (int r = 0; r < 4; ++r) { const int k = ti * 16 + 4 * g + r; p.rw_VK[ub + k * 64 + tj * 16 + cc] = (h16)acc[r]; }
            }
        }
        {
            float* src = wave < 4 ? Ah : T1;
            h16* og = (wave < 4 ? p.rw_W : p.rw_U0) + ub;
            const int col0 = (wave & 3) * 16, g = lane >> 4, cc = lane & 15;
            f32x4 xr[4];
#pragma unroll
            for (int I = 0; I < 4; ++I) {
                f32x4 acc;
#pragma unroll
                for (int r = 0; r < 4; ++r) acc[r] = src[(16 * I + 4 * g + r) * RS + col0 + cc];
#pragma unroll
                for (int kb = 0; kb < I; ++kb) {
                    const f32x4 a4 = *(const f32x4*)&Nm[(16 * I + cc) * RS + kb * 16 + 4 * g];
#pragma unroll
                    for (int i = 0; i < 4; ++i) acc = __builtin_amdgcn_mfma_f32_16x16x4f32(-a4[i], xr[kb][i], acc, 0, 0, 0);
                }
                const f32x4 ti4 = *(const f32x4*)&Nm[(16 * I + cc) * RS + 16 * I + 4 * g];
                f32x4 xn = {0.f, 0.f, 0.f, 0.f};
#pragma unroll
                for (int i = 0; i < 4; ++i) xn = __builtin_amdgcn_mfma_f32_16x16x4f32(ti4[i], acc[i], xn, 0, 0, 0);
                xr[I] = xn;
            }
#pragma unroll
            for (int I = 0; I < 4; ++I)
#pragma unroll
                for (int r = 0; r < 4; ++r) { src[(16 * I + 4 * g + r) * RS + col0 + cc] = xr[I][r]; og[(16 * I + 4 * g + r) * 64 + col0 + cc] = (h16)xr[I][r]; }
        }
        { const int un = (u + 1 < u4 + 4) ? u + 1 : u4 + nblk * 4; if (un < 1024) RWA_PREFETCH(un); }
        lds_barrier();
        tid = otid(); lane = tid & 63; wave = tid >> 6;
        mm_nt<2>(Nm, Rh, Kh, wave, 0, lane);
        lds_barrier();
        tid = otid(); lane = tid & 63; wave = tid >> 6;
        for (int hf = 0; hf < 2; ++hf) {
            const int tj = wave & 3, ti = wave < 4 ? (hf ? 3 : 0) : (hf ? 2 : 1), g = lane >> 4, cc = lane & 15;
            f32x4 a1, a2 = {0.f, 0.f, 0.f, 0.f};
#pragma unroll
            for (int r = 0; r < 4; ++r) a1[r] = Rh[(ti * 16 + 4 * g + r) * RS + tj * 16 + cc];
            a1 = mm_nn_tile_h(a1, Mm, Ah, ti, tj, lane, -1.f);
            a2 = mm_nn_tile_h(a2, Nm, Vv, ti, tj, lane, 1.f);
            a2 = mm_nn_tile_h(a2, Mm, T1, ti, tj, lane, -1.f);
#pragma unroll
            for (int r = 0; r < 4; ++r) { const int row = ti * 16 + 4 * g + r, col = tj * 16 + cc; p.rw_Ry[ub + row * 64 + col] = (h16)a1[r]; p.rw_Y0[ub + row * 64 + col] = (h16)a2[r]; }
        }
    }
}
__device__ __forceinline__ void ph_rw_b(CP p, int bid, char* smem) {
    h16* Sh = (h16*)smem;
    h16* Uh = Sh + 64 * 72;
    const int tid = otid(), lane = tid & 63, wave = tid >> 6, g = lane >> 4, cc = lane & 15;
    const int vt = wave >> 1, hf = wave & 1;
    const int b = bid >> 2, h = bid & 3;
    f32x4 S[2];
    S[0] = (f32x4){0.f, 0.f, 0.f, 0.f}; S[1] = S[0];
#define RWB_DECL(X) h16x8 X##W00, X##W01, X##W10, X##W11, X##B00, X##B01, X##B10, X##B11; h16x4 X##U0, X##U1, X##V0, X##V1; float X##G0 = 0.f, X##G1 = 0.f
#define RWB_LD(X, C_) do { const int c_ = (C_) < 64 ? (C_) : 63; const size_t ub = ((size_t)(b * 64 + c_) * 4 + h) * 4096; \
        const int r0 = (2 * hf) * 16 + cc, r1 = (2 * hf + 1) * 16 + cc; \
        X##W00 = *(const h16x8*)(p.rw_W + ub + r0 * 64 + 8 * g); X##W01 = *(const h16x8*)(p.rw_W + ub + r0 * 64 + 32 + 8 * g); \
        X##W10 = *(const h16x8*)(p.rw_W + ub + r1 * 64 + 8 * g); X##W11 = *(const h16x8*)(p.rw_W + ub + r1 * 64 + 32 + 8 * g); \
        X##B00 = *(const h16x8*)(p.rw_Be + ub + r0 * 64 + 8 * g); X##B01 = *(const h16x8*)(p.rw_Be + ub + r0 * 64 + 32 + 8 * g); \
        X##B10 = *(const h16x8*)(p.rw_Be + ub + r1 * 64 + 8 * g); X##B11 = *(const h16x8*)(p.rw_Be + ub + r1 * 64 + 32 + 8 * g); \
        X##U0 = *(const h16x4*)(p.rw_U0 + ub + r0 * 64 + vt * 16 + 4 * g); X##U1 = *(const h16x4*)(p.rw_U0 + ub + r1 * 64 + vt * 16 + 4 * g); \
        X##V0 = *(const h16x4*)(p.rw_VK + ub + r0 * 64 + vt * 16 + 4 * g); X##V1 = *(const h16x4*)(p.rw_VK + ub + r1 * 64 + vt * 16 + 4 * g); \
        X##G0 = p.rw_gam[((size_t)(b * 64 + c_) * 4 + h) * 64 + r0]; X##G1 = p.rw_gam[((size_t)(b * 64 + c_) * 4 + h) * 64 + r1]; } while (0)
#define RWB_BODY(X, C_) do { \
        _Pragma("unroll") for (int j = 0; j < 2; ++j) _Pragma("unroll") for (int r = 0; r < 4; ++r) Sh[(vt * 16 + 4 * g + r) * 72 + (2 * hf + j) * 16 + cc] = (h16)S[j][r]; \
        lds_barrier(); \
          \
        { const int row = tid >> 3, kc = (tid & 7) * 8; if ((C_) >= 3) *(h16x8*)(p.rw_S0 + ((size_t)(b * 64 + (C_) - 3) * 4 + h) * 4096 + row * 64 + kc) = pd0; pd0 = pd1; pd1 = pd2; pd2 = *(const h16x8*)&Sh[row * 72 + kc]; } \
        h16x8 Af0 = *(const h16x8*)&Sh[(vt * 16 + cc) * 72 + 8 * g], Af1 = *(const h16x8*)&Sh[(vt * 16 + cc) * 72 + 32 + 8 * g]; \
        f32x4 Ut0 = {(float)X##U0[0], (float)X##U0[1], (float)X##U0[2], (float)X##U0[3]}, Ut1 = {(float)X##U1[0], (float)X##U1[1], (float)X##U1[2], (float)X##U1[3]}; \
        Ut0 = __builtin_amdgcn_mfma_f32_16x16x32_f16(Af0, X##W00, Ut0, 0, 0, 0); Ut1 = __builtin_amdgcn_mfma_f32_16x16x32_f16(Af0, X##W10, Ut1, 0, 0, 0); \
        Ut0 = __builtin_amdgcn_mfma_f32_16x16x32_f16(Af1, X##W01, Ut0, 0, 0, 0); Ut1 = __builtin_amdgcn_mfma_f32_16x16x32_f16(Af1, X##W11, Ut1, 0, 0, 0); \
        _Pragma("unroll") for (int r = 0; r < 4; ++r) { Uh[(vt * 16 + 4 * g + r) * 72 + (2 * hf) * 16 + cc] = (h16)Ut0[r]; Uh[(vt * 16 + 4 * g + r) * 72 + (2 * hf + 1) * 16 + cc] = (h16)Ut1[r]; } \
        lds_barrier(); \
        Af0 = *(const h16x8*)&Uh[(vt * 16 + cc) * 72 + 8 * g]; Af1 = *(const h16x8*)&Uh[(vt * 16 + cc) * 72 + 32 + 8 * g]; \
        f32x4 a0, a1; \
        _Pragma("unroll") for (int r = 0; r < 4; ++r) { a0[r] = S[0][r] * X##G0 + (float)X##V0[r]; a1[r] = S[1][r] * X##G1 + (float)X##V1[r]; } \
        a0 = __builtin_amdgcn_mfma_f32_16x16x32_f16(Af0, X##B00, a0, 0, 0, 0); a1 = __builtin_amdgcn_mfma_f32_16x16x32_f16(Af0, X##B10, a1, 0, 0, 0); \
        a0 = __builtin_amdgcn_mfma_f32_16x16x32_f16(Af1, X##B01, a0, 0, 0, 0); a1 = __builtin_amdgcn_mfma_f32_16x16x32_f16(Af1, X##B11, a1, 0, 0, 0); \
        S[0] = a0; S[1] = a1; } while (0)
    RWB_DECL(x_); RWB_DECL(y_); RWB_DECL(z_);
    h16x8 pd0 = {}, pd1 = {}, pd2 = {};
    RWB_LD(x_, 0); RWB_LD(y_, 1);
    for (int c = 0; c < 66; c += 3) {
        RWB_LD(z_, c + 2);
        if (c < 64) RWB_BODY(x_, c);
        RWB_LD(x_, c + 3);
        if (c + 1 < 64) RWB_BODY(y_, c + 1);
        RWB_LD(y_, c + 4);
        if (c + 2 < 64) RWB_BODY(z_, c + 2);
    }
    { const int row = tid >> 3, kc = (tid & 7) * 8;
      *(h16x8*)(p.rw_S0 + ((size_t)(b * 64 + 61) * 4 + h) * 4096 + row * 64 + kc) = pd0; *(h16x8*)(p.rw_S0 + ((size_t)(b * 64 + 62) * 4 + h) * 4096 + row * 64 + kc) = pd1; *(h16x8*)(p.rw_S0 + ((size_t)(b * 64 + 63) * 4 + h) * 4096 + row * 64 + kc) = pd2; }
#undef RWB_DECL
#undef RWB_LD
#undef RWB_BODY
}
__device__ __forceinline__ void ph_rw_c(CP p, int l, int bid, int nblk) {
    const int tid = otid(), lane = tid & 63, wave = tid >> 6, g = lane >> 4, cc = lane & 15;
    const int h = wave >> 1, th = wave & 1;
    f32x4 gw[4], gb[4];
#pragma unroll
    for (int vt = 0; vt < 4; ++vt) { gw[vt] = *(const f32x4*)(p.in[I_RWGNW] + l * 256 + h * 64 + vt * 16 + 4 * g); gb[vt] = *(const f32x4*)(p.in[I_RWGNB] + l * 256 + h * 64 + vt * 16 + 4 * g); }
    for (int u = bid; u < 256; u += nblk) {
        const int b = u >> 6, c = u & 63;
        const size_t ub = ((size_t)(b * 64 + c) * 4 + h) * 4096;
        h16x8 Af[4][2], B0[2], B1[2]; h16x4 yi[2][4], bo[2][4], gg[2][4];
#pragma unroll
        for (int vt = 0; vt < 4; ++vt)
#pragma unroll
            for (int ks = 0; ks < 2; ++ks) Af[vt][ks] = *(const h16x8*)(p.rw_S0 + ub + (vt * 16 + cc) * 64 + ks * 32 + 8 * g);
#pragma unroll
        for (int j = 0; j < 2; ++j) {
            const int t = (2 * th + j) * 16 + cc;
            const size_t tok = (size_t)b * SEQ + c * 64 + t;
            B0[j] = *(const h16x8*)(p.rw_Ry + ub + t * 64 + 8 * g); B1[j] = *(const h16x8*)(p.rw_Ry + ub + t * 64 + 32 + 8 * g);
#pragma unroll
            for (int vt = 0; vt < 4; ++vt) {
                const int ch = h * 64 + vt * 16 + 4 * g;
                yi[j][vt] = *(const h16x4*)(p.rw_Y0 + ub + t * 64 + vt * 16 + 4 * g);
                bo[j][vt] = *(const h16x4*)(p.rw_bonus + tok * 256 + ch); gg[j][vt] = *(const h16x4*)(p.rw_g + tok * 256 + ch);
            }
        }
#pragma unroll
        for (int j = 0; j < 2; ++j) {
            const int t = (2 * th + j) * 16 + cc;
            f32x4 y[4]; float sum = 0.f;
#pragma unroll
            for (int vt = 0; vt < 4; ++vt) {
                f32x4 acc = {(float)yi[j][vt][0], (float)yi[j][vt][1], (float)yi[j][vt][2], (float)yi[j][vt][3]};
                acc = __builtin_amdgcn_mfma_f32_16x16x32_f16(Af[vt][0], B0[j], acc, 0, 0, 0);
                acc = __builtin_amdgcn_mfma_f32_16x16x32_f16(Af[vt][1], B1[j], acc, 0, 0, 0);
                y[vt] = acc; sum += acc[0] + acc[1] + acc[2] + acc[3];
            }
            sum = rows_sum(sum);
            const float mean = sum * (1.f / 64.f);
            float vs = 0.f;
#pragma unroll
            for (int vt = 0; vt < 4; ++vt)
#pragma unroll
                for (int r = 0; r < 4; ++r) { const float d = y[vt][r] - mean; vs += d * d; }
            vs = rows_sum(vs);
            const float rstd = rsqrtf(vs * (1.f / 64.f) + 64e-5f);
            const size_t tok = (size_t)b * SEQ + c * 64 + t;
#pragma unroll
            for (int vt = 0; vt < 4; ++vt) {
                const int ch = h * 64 + vt * 16 + 4 * g;
                float o[4];
#pragma unroll
                for (int r = 0; r < 4; ++r) o[r] = ((y[vt][r] - mean) * rstd * gw[vt][r] + gb[vt][r] + (float)bo[j][vt][r]) * (float)gg[j][vt][r];
                *(h16x4*)(p.branches + tok * DM + 768 + ch) = pack4(o[0], o[1], o[2], o[3]);
            }
        }
    }
}

__device__ __forceinline__ unsigned f2key(float x) { unsigned u = __float_as_uint(x); return (u & 0x80000000u) ? ~u : (u | 0x80000000u); }
#define IDXH (2 * IDXLD)
__device__ __forceinline__ float idx_score(const f32x4 (&d)[4], const float (&w)[4], int r) {
    float sc = w[0] * fmaxf(d[0][r], 0.f);
    sc = __fmaf_rn(w[1], fmaxf(d[1][r], 0.f), sc);
    sc = __fmaf_rn(w[2], fmaxf(d[2][r], 0.f), sc);
    sc = __fmaf_rn(w[3], fmaxf(d[3][r], 0.f), sc);
    return sc + 0.f;
}
__device__ __forceinline__ f32x4 idx_dot(h16x8 khi, h16x8 klo, h16x8 qhi, h16x8 qlo) {
    f32x4 acc = {0.f, 0.f, 0.f, 0.f};
    acc = __builtin_amdgcn_mfma_f32_16x16x32_f16(khi, qhi, acc, 0, 0, 0);
    return acc;
}
__device__ __forceinline__ void ph_dsa_pre2(CP p, int bid, int nblk, char* smem) {
    h16* vt_s = (h16*)smem;
    for (int u = bid; u < NTOK / 64; u += nblk) {
        const int tid = otid(), lane = tid & 63, wv = tid >> 6;
        const int tok0 = u * 64;
        __syncthreads();
#pragma unroll 1
        for (int qb = 0; qb < 1; ++qb) {
            const int i = lane & 31, i2 = lane & 15;
            const int base = (lane < 32) ? P_Q : P_K;
            const float scl = (lane < 32) ? 0.125f * 1.4426950408889634f : 1.f;
            h16 a1[8][4], a2[8][4]; float rc[8], rs[8], rc2[8], rs2[8], j1[8][4], j2[8][4]; h16x4 vr[8];
#pragma unroll
            for (int q = 0; q < 8; ++q) {
                const int tok = tok0 + wv * 8 + qb * 8 + q;
                rc[q] = p.ropet[((size_t)tok * 32 + i) * 2]; rs[q] = p.ropet[((size_t)tok * 32 + i) * 2 + 1];
                const h16* src = p.proj + (size_t)tok * PJ + base;
#pragma unroll
                for (int h = 0; h < 4; ++h) { a1[q][h] = src[h * 64 + i]; a2[q][h] = src[h * 64 + 32 + i]; }
                rc2[q] = p.ropet[((size_t)tok * 32 + 2 * i2) * 2]; rs2[q] = p.ropet[((size_t)tok * 32 + 2 * i2) * 2 + 1];
                const float* xf = p.idxf + (size_t)tok * IDXLD;
                if (lane < 16) {
#pragma unroll
                    for (int h = 0; h < 4; ++h) { j1[q][h] = xf[h * 32 + i2]; j2[q][h] = xf[h * 32 + 16 + i2]; }
                } else if (lane < 32) { j1[q][0] = xf[128 + i2]; j2[q][0] = xf[128 + 16 + i2]; }
                vr[q] = *(const h16x4*)(p.proj + (size_t)tok * PJ + P_V + lane * 4);
            }
            asm volatile("s_waitcnt vmcnt(0)" ::: "memory");
            __builtin_amdgcn_wave_barrier();
#pragma unroll
            for (int q = 0; q < 8; ++q) {
                const int tok = tok0 + wv * 8 + qb * 8 + q;
                h16* dst = p.proj + (size_t)tok * PJ + base;
#pragma unroll
                for (int h = 0; h < 4; ++h) {
                    const float x1 = (float)a1[q][h], x2 = (float)a2[q][h];
                    dst[h * 64 + i] = (h16)((x1 * rc[q] - x2 * rs[q]) * scl);
                    dst[h * 64 + 32 + i] = (h16)((x2 * rc[q] + x1 * rs[q]) * scl);
                }
                h16* xh = (h16*)(p.idxf + (size_t)tok * IDXLD);
                if (lane < 16) {
#pragma unroll
                    for (int h = 0; h < 4; ++h) {
                        const float o1 = j1[q][h] * rc2[q] - j2[q][h] * rs2[q], o2 = j2[q][h] * rc2[q] + j1[q][h] * rs2[q];
                        const h16 h1 = (h16)o1, h2 = (h16)o2;
                        xh[h * 32 + i2] = h1; xh[h * 32 + 16 + i2] = h2;
                    }
                } else if (lane < 32) {
                    const float o1 = j1[q][0] * rc2[q] - j2[q][0] * rs2[q], o2 = j2[q][0] * rc2[q] + j1[q][0] * rs2[q];
                    const h16 h1 = (h16)o1, h2 = (h16)o2;
                    xh[256 + i2] = h1; xh[256 + 16 + i2] = h2;
                }
                *(h16x4*)&vt_s[(wv * 8 + qb * 8 + q) * 264 + lane * 4] = vr[q];
            }
        }
        __syncthreads();
        {
            const int dim = tid >> 1, hf = tid & 1, b = tok0 / SEQ, t0 = tok0 % SEQ;
            h16* dst = p.vT + ((size_t)b * 256 + dim) * SEQ + t0 + hf * 32;
#pragma unroll
            for (int k8 = 0; k8 < 4; ++k8) {
                h16x8 v;
#pragma unroll
                for (int e = 0; e < 8; ++e) v[e] = vt_s[(hf * 32 + k8 * 8 + e) * 264 + dim];
                *(h16x8*)(dst + k8 * 8) = v;
            }
        }
    }
}
__device__ __forceinline__ void cnt4(int& a0, int& a1, int& a2, int& a3, unsigned k0, unsigned k1, unsigned k2, unsigned k3, unsigned cand) {
    unsigned long long m0, m1, m2, m3;
    asm volatile("v_cmp_le_u32_e64 %4, %12, %8\n\t"
                 "v_cmp_le_u32_e64 %5, %12, %9\n\t"
                 "v_cmp_le_u32_e64 %6, %12, %10\n\t"
                 "v_cmp_le_u32_e64 %7, %12, %11\n\t"
                 "v_addc_co_u32_e64 %0, %4, %0, 0, %4\n\t"
                 "v_addc_co_u32_e64 %1, %5, %1, 0, %5\n\t"
                 "v_addc_co_u32_e64 %2, %6, %2, 0, %6\n\t"
                 "v_addc_co_u32_e64 %3, %7, %3, 0, %7"
                 : "+v"(a0), "+v"(a1), "+v"(a2), "+v"(a3), "=&s"(m0), "=&s"(m1), "=&s"(m2), "=&s"(m3)
                 : "v"(k0), "v"(k1), "v"(k2), "v"(k3), "s"(cand));
}
#define KQ_LD 4112
#define DSAA_LDS (8 * KQ_LD * 4)
__device__ __forceinline__ size_t dmask_off(int b, int t) { const int a = t >> 6, r = t & 63; return (size_t)b * 133120 + (size_t)32 * a * (a + 1) + (size_t)r * (a + 1); }
__device__ __forceinline__ void ph_dsa_a(CP p, int l, char* smem) {
    unsigned* Kq = (unsigned*)smem;
    int* qslot = (int*)(smem + DSAA_LDS + 2048);
    for (;;) {
        const int tid = otid(), lane = tid & 63, wave = __builtin_amdgcn_readfirstlane(tid >> 6), g = lane >> 4, c = lane & 15;
        __syncthreads();
        if (tid == 0) *qslot = atomicAdd(&p.qctr[l], 1);
        __syncthreads();
        const int kq = __builtin_amdgcn_readfirstlane(*qslot);
        if (kq >= 1024) break;
        const int b = kq < 960 ? (kq & 3) : ((kq - 960) >> 4), qb = kq < 960 ? 255 - (kq >> 2) : ((kq - 960) & 15), q0 = qb * 16;
        if (qb < 16) {
            if (tid < 64) { const int t = q0 + (tid >> 2), wd = tid & 3, a = t >> 6;
                if (wd <= a) p.dmask[dmask_off(b, t) + wd] = (wd < a) ? ~0ull : (~0ull >> (63 - (t & 63))); }
            continue; }
        const size_t tokq = (size_t)b * SEQ + q0 + c;
        const h16* qrow = (const h16*)(p.idxf + tokq * IDXLD);
        h16x8 qh[4], ql[4]; float w[4];
#pragma unroll
        for (int h = 0; h < 4; ++h) { qh[h] = *(const h16x8*)(qrow + h * 32 + 8 * g); ql[h] = *(const h16x8*)(qrow + 128 + h * 32 + 8 * g); w[h] = p.idxf[tokq * IDXLD + 160 + h]; }
        const int ntiles = qb + 1;
        const int nslots = (ntiles - wave + 7) >> 3;
        const int nch = (16 * ntiles + 63) >> 6;
        const int tq = q0 + c;
        const h16* kbase = (const h16*)(p.idxf + ((size_t)b * SEQ + c) * IDXLD) + 256 + 8 * g;
        u32x4 K4[32];
        {
#pragma unroll
            for (int ib = 0; ib < 4; ++ib) {
                if (ib * 8 < nslots) {
                    h16x8 kh[8], kl[8];
#pragma unroll
                    for (int q = 0; q < 8; ++q) {
                        int j = wave + 8 * (ib * 8 + q); j = j < ntiles ? j : ntiles - 1;
                        kh[q] = *(const h16x8*)(kbase + (size_t)16 * j * IDXH); kl[q] = *(const h16x8*)(kbase + (size_t)16 * j * IDXH + 32);
                    }
#pragma unroll
                    for (int q = 0; q < 8; ++q) {
                        const int i = ib * 8 + q, j = wave + 8 * i;
                        f32x4 d[4];
#pragma unroll
                        for (int h = 0; h < 4; ++h) d[h] = idx_dot(kh[q], kl[q], qh[h], ql[h]);
#pragma unroll
                        for (int r = 0; r < 4; ++r) { const int sidx = 16 * j + 4 * g + r; const unsigned kk = f2key(idx_score(d, w, r)); K4[i][r] = (i < nslots && sidx <= tq) ? kk : 0u; }
                    }
                } else {
#pragma unroll
                    for (int q = 0; q < 8; ++q) K4[ib * 8 + q] = (u32x4){0u, 0u, 0u, 0u};
                }
            }
        }
#pragma unroll 1
        for (int bt = 0; bt < 2; ++bt) {
            __syncthreads();
            if ((c >> 3) == bt) {
#pragma unroll
                for (int i = 0; i < 32; ++i) if (i < nslots) *(u32x4*)&Kq[(c & 7) * KQ_LD + 16 * (wave + 8 * i) + 4 * g] = K4[i];
            }
            __syncthreads();
            {
                const unsigned* myk = Kq + wave * KQ_LD + lane;
                unsigned kv[64];
#pragma unroll
                for (int m = 0; m < 64; ++m) kv[m] = (m < nch && lane + 64 * m < 16 * ntiles) ? myk[64 * m] : 0u;
                const int nchs = __builtin_amdgcn_readfirstlane(nch);
                unsigned kmx = 0u;
#pragma unroll
                for (int m = 0; m < 64; ++m) kmx = umax_(kmx, kv[m]);
                const unsigned kmaxs = __builtin_amdgcn_readfirstlane(wave_umax(kmx));
                unsigned v = 0u; int cut = 4095; bool done = false;
                int cabove = 0;
#define DSAA_FULLCOUNT(CN) do { int cl0 = 0, cl1 = 0, cl2 = 0, cl3 = 0; \
                    _Pragma("unroll") for (int mg = 0; mg < 8; ++mg) if (nchs > mg * 8) { \
                        cnt4(cl0, cl1, cl2, cl3, kv[mg * 8 + 0], kv[mg * 8 + 1], kv[mg * 8 + 2], kv[mg * 8 + 3], cands); \
                        cnt4(cl0, cl1, cl2, cl3, kv[mg * 8 + 4], kv[mg * 8 + 5], kv[mg * 8 + 6], kv[mg * 8 + 7], cands); } \
                    CN = __builtin_amdgcn_readfirstlane(wave_isum((cl0 + cl1) + (cl2 + cl3))); } while (0)
#pragma unroll 1
                for (int bit = 31; bit >= 20; --bit) {
                    const unsigned cand = v | (1u << bit);
                    const unsigned cands = __builtin_amdgcn_readfirstlane(cand);
                    if (cands > kmaxs) { cabove = 0; continue; }
                    int cn; DSAA_FULLCOUNT(cn);
                    if (cn == 256) { v = cand - 1u; cut = -1; done = true; break; }
                    if (cn > 256) v = cand; else cabove = cn;
                }
                if (!done) {
                    const unsigned pfx = __builtin_amdgcn_readfirstlane(v >> 20);
                    unsigned* cbuf = (unsigned*)(smem + DSAA_LDS + 8192) + wave * 512;
                    int base = 0;
#pragma unroll
                    for (int mg = 0; mg < 8; ++mg) if (nchs > mg * 8) {
#pragma unroll
                        for (int m = mg * 8; m < mg * 8 + 8; ++m) {
                            const bool isc = (kv[m] >> 20) == pfx;
                            const unsigned long long mk = __ballot(isc);
                            if (mk) {
                                const int pos = base + (int)__builtin_amdgcn_mbcnt_hi((unsigned)(mk >> 32), __builtin_amdgcn_mbcnt_lo((unsigned)mk, 0u));
                                if (isc && pos < 512) cbuf[pos] = kv[m];
                                base += __popcll(mk);
                            }
                        }
                    }
                    base = __builtin_amdgcn_readfirstlane(base);
                    const bool compact = base <= 512 && pfx != 0u;
                    unsigned ck[8];
                    wave_lds_sync();
#pragma unroll
                    for (int j = 0; j < 8; ++j) ck[j] = (compact && lane + 64 * j < base) ? cbuf[lane + 64 * j] : 0u;
#pragma unroll 1
                    for (int bit = 19; bit >= 0; --bit) {
                        const unsigned cand = v | (1u << bit);
                        const unsigned cands = __builtin_amdgcn_readfirstlane(cand);
                        if (cands > kmaxs) continue;
                        int cn;
                        if (compact) {
                            int cl = 0;
#pragma unroll
                            for (int j = 0; j < 8; ++j) cl += (ck[j] >= cands) ? 1 : 0;
                            cn = cabove + __builtin_amdgcn_readfirstlane(wave_isum(cl));
                        } else DSAA_FULLCOUNT(cn);
                        if (cn == 256) { v = cand - 1u; cut = -1; done = true; break; }
                        if (cn > 256) v = cand;
                    }
                    if (!done) {
                        int cgt, ceq;
                        if (compact) {
                            int cgl = 0, cel = 0;
#pragma unroll
                            for (int j = 0; j < 8; ++j) { cgl += (ck[j] > v) ? 1 : 0; cel += (ck[j] == v) ? 1 : 0; }
                            cgt = cabove + __builtin_amdgcn_readfirstlane(wave_isum(cgl)); ceq = __builtin_amdgcn_readfirstlane(wave_isum(cel));
                        } else {
                            int cgl = 0, cel = 0;
#pragma unroll
                            for (int mg = 0; mg < 8; ++mg) if (nchs > mg * 8) {
#pragma unroll
                                for (int m = mg * 8; m < mg * 8 + 8; ++m) { cgl += (kv[m] > v) ? 1 : 0; cel += (kv[m] == v) ? 1 : 0; }
                            }
                            cgt = __builtin_amdgcn_readfirstlane(wave_isum(cgl)); ceq = __builtin_amdgcn_readfirstlane(wave_isum(cel));
                        }
                        const int need = 256 - cgt;
                        if (ceq > need) {
                            int run = 0; cut = 4095; bool found = false;
#pragma unroll
                            for (int m = 0; m < 64; ++m) {
                                unsigned long long mk = __ballot(kv[m] == v);
                                const int pc = __popcll(mk);
                                if (!found && run + pc >= need) {
                                    int kth = need - run;
                                    while (kth > 1) { mk &= mk - 1ull; --kth; }
                                    cut = (int)__builtin_ctzll(mk) + 64 * m; found = true;
                                }
                                run += pc;
                            }
                        }
                    }
                }
#undef DSAA_FULLCOUNT
                {
                    unsigned long long myw = 0ull;
#pragma unroll 1
                    for (int m0 = 0; m0 < nch; m0 += 8) {
                        unsigned kx[8];
#pragma unroll
                        for (int j = 0; j < 8; ++j) kx[j] = (m0 + j < nch && lane + 64 * (m0 + j) < 16 * ntiles) ? myk[64 * (m0 + j)] : 0u;
#pragma unroll
                        for (int j = 0; j < 8; ++j) {
                            const int cm_ = cut - 64 * (m0 + j);
                            const unsigned long long mk = __ballot(kx[j] > v || (kx[j] == v && lane <= cm_));
                            if (lane == m0 + j) myw = mk;
                        }
                    }
                    if (lane < nch) p.dmask[dmask_off(b, q0 + bt * 8 + wave) + lane] = myw;
                }
            }
        }
    }
}
#define KS_LD 264
#define VT_LD 72
#define IK_LD 72
#define DSAB_LDS (64 * KS_LD * 2 + 256 * VT_LD * 2 + 64 * KS_LD * 2)
__device__ __forceinline__ void ph_dsa_b(CP p, int bid, int nblk, char* smem) {
    h16* Ks = (h16*)smem;
    h16* Vt = Ks + 64 * KS_LD;
    h16* Qs = Vt + 256 * VT_LD;
    float* mrg = (float*)smem;
    for (int wi = bid; wi < 512; wi += nblk) {
        const int tid = otid(), lane = tid & 63, wave = tid >> 6, g = lane >> 4, c = lane & 15;
        const int qt = wave & 3, kg = wave >> 2;
        const int half = wi >> 8;
        const int x_ = wi & 7, r_ = (wi & 255) >> 3;
        const int b = (nblk == 256) ? (x_ >> 1) : ((wi & 255) >> 6), j_ = (nblk == 256) ? ((x_ & 1) * 32 + r_) : (wi & 63);
        const int qblk = half ? j_ : 63 - j_, q0 = qblk * 64;
        const int tq = q0 + 16 * qt + c;
        const size_t tokq = (size_t)b * SEQ + tq;
        __syncthreads();
        const unsigned long long* mrow = p.dmask + dmask_off(b, tq);
        f32x4 O[4][4];
        float mrun[4], lrun[4];
#pragma unroll
        for (int h = 0; h < 4; ++h) { mrun[h] = -1e30f; lrun[h] = 0.f;
#pragma unroll
            for (int dt = 0; dt < 4; ++dt) O[h][dt] = (f32x4){0.f, 0.f, 0.f, 0.f}; }
        const int nall = qblk + 1, hs_ = (nall + 1) >> 1;
        const int sb = half ? hs_ : 0, nsteps = half ? nall : hs_;
        u32x4 rk[4], rv[4]; unsigned long long mw, mwn = 0ull;
#define DSAB_GLOAD(S_) do { const size_t kb_ = (size_t)b * SEQ + 64 * (S_); \
            _Pragma("unroll") for (int i = 0; i < 4; ++i) { const int ch = tid + 512 * i; rk[i] = *(const u32x4*)(p.proj + (kb_ + (ch >> 5)) * PJ + P_K + (ch & 31) * 8); } \
            _Pragma("unroll") for (int i = 0; i < 4; ++i) { const int ch = tid + 512 * i; rv[i] = *(const u32x4*)(p.vT + ((size_t)b * 256 + (ch >> 3)) * SEQ + 64 * (S_) + (ch & 7) * 8); } \
            mwn = mrow[(S_)]; } while (0)
#define DSAB_LSTORE() do { \
            _Pragma("unroll") for (int i = 0; i < 4; ++i) { const int ch = tid + 512 * i; *(u32x4*)&Ks[(ch >> 5) * KS_LD + (ch & 31) * 8] = rk[i]; } \
            _Pragma("unroll") for (int i = 0; i < 4; ++i) { const int ch = tid + 512 * i; *(u32x4*)&Vt[(ch >> 3) * VT_LD + (ch & 7) * 8] = rv[i]; } \
            } while (0)
        if (sb < nsteps) DSAB_GLOAD(sb);
        h16x8 qf[4][2];
#pragma unroll
        for (int h = 0; h < 4; ++h) { qf[h][0] = *(const h16x8*)(p.proj + tokq * PJ + P_Q + h * 64 + 8 * g); qf[h][1] = *(const h16x8*)(p.proj + tokq * PJ + P_Q + h * 64 + 32 + 8 * g); }
        if (sb < nsteps) DSAB_LSTORE();
        __syncthreads();
        for (int s = sb; s < nsteps; ++s) {
            mw = mwn;
            if (s + 1 < nsteps) DSAB_GLOAD(s + 1);
            bool msk[2][4];
            {
                const unsigned w32 = (unsigned)(mw >> (32 * kg));
#pragma unroll
                for (int jt = 0; jt < 2; ++jt)
#pragma unroll
                    for (int r = 0; r < 4; ++r) msk[jt][r] = (w32 >> (16 * jt + 4 * g + r)) & 1u;
            }
#pragma unroll
            for (int h = 0; h < 4; ++h) {
                f32x4 S[2];
                {
                    const h16x8 q0_ = qf[h][0], q1_ = qf[h][1];
#pragma unroll
                    for (int jt = 0; jt < 2; ++jt) {
                        const int row = 32 * kg + 16 * jt + c;
                        f32x4 acc = {0.f, 0.f, 0.f, 0.f};
                        acc = __builtin_amdgcn_mfma_f32_16x16x32_f16(*(const h16x8*)&Ks[row * KS_LD + h * 64 + 8 * g], q0_, acc, 0, 0, 0);
                        acc = __builtin_amdgcn_mfma_f32_16x16x32_f16(*(const h16x8*)&Ks[row * KS_LD + h * 64 + 32 + 8 * g], q1_, acc, 0, 0, 0);
                        S[jt] = acc;
                    }
                }
                float mx = -1e30f;
#pragma unroll
                for (int jt = 0; jt < 2; ++jt)
#pragma unroll
                    for (int r = 0; r < 4; ++r) mx = fmaxf(mx, msk[jt][r] ? S[jt][r] : -1e30f);
                mx = rows_max(mx);
                const float mnew = fmaxf(mrun[h], mx);
                const float scale = __builtin_amdgcn_exp2f(mrun[h] - mnew);
                mrun[h] = mnew;
                float ps = 0.f; h16x8 pb;
#pragma unroll
                for (int jt = 0; jt < 2; ++jt)
#pragma unroll
                    for (int r = 0; r < 4; ++r) { const float pe = msk[jt][r] ? __builtin_amdgcn_exp2f(S[jt][r] - mnew) : 0.f; ps += pe; pb[jt * 4 + r] = (h16)pe; }
                lrun[h] = lrun[h] * scale + ps;
#pragma unroll
                for (int dt = 0; dt < 4; ++dt) {
                    f32x4 o = O[h][dt] * scale;
                    const int vrow = h * 64 + 16 * dt + c;
                    const h16x4 va = *(const h16x4*)&Vt[vrow * VT_LD + 32 * kg + 4 * g], vb = *(const h16x4*)&Vt[vrow * VT_LD + 32 * kg + 16 + 4 * g];
                    h16x8 av; av[0] = va[0]; av[1] = va[1]; av[2] = va[2]; av[3] = va[3]; av[4] = vb[0]; av[5] = vb[1]; av[6] = vb[2]; av[7] = vb[3];
                    O[h][dt] = __builtin_amdgcn_mfma_f32_16x16x32_f16(av, pb, o, 0, 0, 0);
                }
            }
            lds_barrier();
            if (s + 1 < nsteps) DSAB_LSTORE();
            lds_barrier();
        }
#pragma unroll
        for (int h = 0; h < 4; ++h) lrun[h] = rows_sum(lrun[h]);
        float* my = mrg + (size_t)(qt * 64 + lane) * 73;
        if (kg == 1) {
#pragma unroll
            for (int h = 0; h < 4; ++h) { my[h] = mrun[h]; my[4 + h] = lrun[h];
#pragma unroll
                for (int dt = 0; dt < 4; ++dt)
#pragma unroll
                    for (int r = 0; r < 4; ++r) my[8 + (h * 4 + dt) * 4 + r] = O[h][dt][r]; }
        }
        __syncthreads();
        if (kg == 0) {
            const size_t pq = ((size_t)((b * 64 + qblk) * 2 + half) * 64 + 16 * qt + c);
#pragma unroll
            for (int h = 0; h < 4; ++h) {
                const float m1 = my[h], l1 = my[4 + h];
                const float m = fmaxf(mrun[h], m1);
                const float e0 = __builtin_amdgcn_exp2f(mrun[h] - m), e1 = __builtin_amdgcn_exp2f(m1 - m);
                const float lt = lrun[h] * e0 + l1 * e1;
                const float inv = lt > 0.f ? 1.f / lt : 0.f;
                if (g == 0) { p.dsa_ml[pq * 8 + h * 2] = m; p.dsa_ml[pq * 8 + h * 2 + 1] = lt; }
#pragma unroll
                for (int dt = 0; dt < 4; ++dt) {
                    float o[4];
#pragma unroll
                    for (int r = 0; r < 4; ++r) o[r] = (O[h][dt][r] * e0 + my[8 + (h * 4 + dt) * 4 + r] * e1) * inv;
                    *(h16x4*)(p.dsa_op + pq * 256 + h * 64 + 16 * dt + 4 * g) = pack4(o[0], o[1], o[2], o[3]);
                }
            }
        }
        __syncthreads();
    }
}

__device__ __forceinline__ void ph_dsa_merge(CP p, int bid, int nblk) {
    const int lane = otid() & 63, wv = otid() >> 6;
    const int h = lane >> 4;
    for (int tokb = bid * 8 + wv; tokb < NTOK; tokb += nblk * 64) {
        float m0[8], l0[8], m1[8], l1[8]; h16x4 o0[8], o1[8];
#pragma unroll
        for (int q = 0; q < 8; ++q) {
            int tok = tokb + q * nblk * 8; tok = tok < NTOK ? tok : NTOK - 1;
            const int b = tok / SEQ, t = tok % SEQ;
            const size_t p0 = ((size_t)((b * 64 + (t >> 6)) * 2) * 64 + (t & 63)), p1 = p0 + 64;
            m0[q] = p.dsa_ml[p0 * 8 + h * 2]; l0[q] = p.dsa_ml[p0 * 8 + h * 2 + 1]; m1[q] = p.dsa_ml[p1 * 8 + h * 2]; l1[q] = p.dsa_ml[p1 * 8 + h * 2 + 1];
            o0[q] = *(const h16x4*)(p.dsa_op + p0 * 256 + lane * 4); o1[q] = *(const h16x4*)(p.dsa_op + p1 * 256 + lane * 4);
        }
#pragma unroll
        for (int q = 0; q < 8; ++q) {
            const int tok = tokb + q * nblk * 8;
            const float m = fmaxf(m0[q], m1[q]);
            const float w0 = l0[q] * __builtin_amdgcn_exp2f(m0[q] - m), w1 = l1[q] * __builtin_amdgcn_exp2f(m1[q] - m);
            const float inv = 1.f / (w0 + w1);
            if (tok < NTOK)
                *(h16x4*)(p.branches + (size_t)tok * DM + 256 + lane * 4) = pack4(((float)o0[q][0] * w0 + (float)o1[q][0] * w1) * inv, ((float)o0[q][1] * w0 + (float)o1[q][1] * w1) * inv,
                                                                                 ((float)o0[q][2] * w0 + (float)o1[q][2] * w1) * inv, ((float)o0[q][3] * w0 + (float)o1[q][3] * w1) * inv);
        }
    }
}
__device__ __forceinline__ void ph_gates(CP p, int l, int bid, int nblk, char* smem) {
    pg8::Gemm g; g.A = p.h_hi; g.Bt = p.Wg; g.M = NTOK; g.N = 4096; g.K = DM; g.lda = DM; g.ldb = DM;
    pg8::StaticOrder S; S.init(NTOK, 4096, nblk, bid);
    pg8::EpiGate E; E.O = (unsigned char*)p.gates; E.bias = p.in[I_GATEB] + (size_t)l * 4096;
    pg8::gemm_phase((PG8_LAS unsigned char*)smem, g, S, E);
}
__device__ __forceinline__ void ph_merge(CP p, int l, int bid, int nblk, char* smem) {
    for (int u = bid; u < 64 * 8; u += nblk) {
        const int mt = u >> 3, nt = u & 7, m0 = mt * 256, n0 = nt * 128;
        f32x4 mx[4][4]; zero_acc<256>(mx);
        f32x4 au[4][4]; zero_acc<256>(au);
        const int tid_ = otid(); const int lane = tid_ & 63, wave = tid_ >> 6, wm = wave >> 1, wn = wave & 1;
        const h16* A = p.branches + (size_t)m0 * DM; const h16* B = p.Wb + (size_t)n0 * 256;
        const unsigned char* G = (const unsigned char*)p.gates + (size_t)(m0 + wm * 64 + (lane & 15)) * 4096 + (nt * 8 + wn * 4 + (lane >> 4)) * 16;
        gemm_kloop_seg<256>(smem, DM, [=](int r, int k) { return A + (size_t)r * DM + k; },
                            [=](int r, int k) { return B + ((size_t)(k >> 8) * 1024 + r) * 256 + (k & 255); }, au,
                            [&](int kt) {
                                if ((kt & 3) == 3) {
                                    const int n = kt >> 2;
#pragma unroll
                                    for (int i = 0; i < 4; ++i) {
                                        const u32x4 w4 = *(const u32x4*)(G + (size_t)i * 16 * 4096 + n * 1024);
#pragma unroll
                                        for (int j = 0; j < 4; ++j) {
                                            const unsigned w = w4[j];
                                            mx[i][j][0] += (float)(w & 255u) * au[i][j][0]; mx[i][j][1] += (float)((w >> 8) & 255u) * au[i][j][1];
                                            mx[i][j][2] += (float)((w >> 16) & 255u) * au[i][j][2]; mx[i][j][3] += (float)(w >> 24) * au[i][j][3];
                                            au[i][j] = (f32x4){0.f, 0.f, 0.f, 0.f};
                                        }
                                    }
                                }
                            });
        h16* O = p.mixed + (size_t)m0 * DM + n0;
        gemm_epi<256>(mx, [=](int ml, int nl, f32x4 v) { const float q = 1.f / 255.f; *(h16x4*)(O + (size_t)ml * DM + nl) = pack4(v[0] * q, v[1] * q, v[2] * q, v[3] * q); });
    }
}
__device__ __forceinline__ void ph_outproj(CP p, int l, int bid, int nblk, char* smem) {
    pg8::Gemm g; g.A = p.mixed; g.Bt = p.Wo; g.M = NTOK; g.N = DM; g.K = DM; g.lda = DM; g.ldb = DM;
    pg8::StaticOrder S; S.init(NTOK, DM, nblk, bid);
    pg8::EpiResid E; E.O = p.x1; E.X = l == 0 ? p.in[I_X] : p.x1; E.gate = p.mods + (size_t)l * 4 * 6144 + 2 * 1024;
    pg8::gemm_phase((PG8_LAS unsigned char*)smem, g, S, E);
}

__constant__ int c_pair_lo[6] = {0, 0, 0, 1, 1, 2};
__constant__ int c_pair_hi[6] = {1, 2, 3, 2, 3, 3};
__device__ __forceinline__ void ph_norm2_router(CP p, int l, int bid, int nblk, char* smem) {
    float* rw = (float*)smem;
    float* H = rw + DM * 16;
    float* part = H + 16 * 1028;
    float* lgt = part + 8 * 256;
    int* s_bk = (int*)(lgt + 256);
    int* s_tk = s_bk + 64;
    int* s_base = s_tk + 64;
    const int tid = otid(), lane = tid & 63, wv = tid >> 6;
    for (int i = tid; i < DM * 16; i += 512) rw[i] = p.in[I_ROUTW][i];
    if (tid < 64) s_bk[tid] = -1;
    __syncthreads();
    int tl = 0;
    f32x4 gg[4], vn[2][4], shn[4], scn[4];
#pragma unroll
    for (int i = 0; i < 4; ++i) gg[i] = *(const f32x4*)(p.in[I_FNG] + l * DM + i * 256 + lane * 4);
#define N2_PREFETCH(TILE) do { \
        const float* md_ = p.mods + ((size_t)l * 4 + ((TILE) * 16) / SEQ) * 6144; \
        _Pragma("unroll") for (int q = 0; q < 2; ++q) _Pragma("unroll") for (int i = 0; i < 4; ++i) vn[q][i] = *(const f32x4*)(p.x1 + (size_t)((TILE) * 16 + 2 * wv + q) * DM + i * 256 + lane * 4); \
        _Pragma("unroll") for (int i = 0; i < 4; ++i) { shn[i] = *(const f32x4*)(md_ + 3 * 1024 + i * 256 + lane * 4); scn[i] = *(const f32x4*)(md_ + 4 * 1024 + i * 256 + lane * 4); } \
    } while (0)
    if (bid < NTOK / 16) N2_PREFETCH(bid);
    for (int tile = bid; tile < NTOK / 16; tile += nblk, ++tl) {
#pragma unroll
        for (int q = 0; q < 2; ++q) {
            const int tk = 2 * wv + q, tok = tile * 16 + tk;
            float ss = 0.f;
#pragma unroll
            for (int i = 0; i < 4; ++i) ss += vn[q][i][0] * vn[q][i][0] + vn[q][i][1] * vn[q][i][1] + vn[q][i][2] * vn[q][i][2] + vn[q][i][3] * vn[q][i][3];
            ss = wave_sum(ss);
            const float rs = rsqrtf(ss * (1.f / DM) + 1e-6f);
#pragma unroll
            for (int i = 0; i < 4; ++i) {
                const int c = i * 256 + lane * 4;
                f32x4 hv;
#pragma unroll
                for (int e = 0; e < 4; ++e) hv[e] = vn[q][i][e] * rs * gg[i][e] * (1.f + scn[i][e]) + shn[i][e];
                *(h16x4*)(p.h_hi + (size_t)tok * DM + c) = pack4(hv[0], hv[1], hv[2], hv[3]);
                *(f32x4*)&H[tk * 1028 + c] = hv;
            }
        }
        if (tile + nblk < NTOK / 16) N2_PREFETCH(tile + nblk);
        lds_barrier();
        {
            const int g4 = lane >> 4, c16 = lane & 15;
            f32x4 acc = {0.f, 0.f, 0.f, 0.f};
#pragma unroll
            for (int qk = 0; qk < 8; ++qk) {
                const int k0 = wv * 128 + qk * 16 + 4 * g4;
                const f32x4 a4 = *(const f32x4*)&H[c16 * 1028 + k0];
#pragma unroll
                for (int i = 0; i < 4; ++i) acc = __builtin_amdgcn_mfma_f32_16x16x4f32(a4[i], rw[(k0 + i) * 16 + c16], acc, 0, 0, 0);
            }
#pragma unroll
            for (int r = 0; r < 4; ++r) part[wv * 256 + (4 * g4 + r) * 16 + c16] = acc[r];
        }
        lds_barrier();
        if (tid < 256) { float sum = 0.f;
#pragma unroll
            for (int w8 = 0; w8 < 8; ++w8) sum += part[w8 * 256 + tid];
            const float sg = 1.f / (1.f + expf(-sum));
            lgt[tid] = sg; part[tid] = sg + p.in[I_ROUTB][tid & 15]; }
        lds_barrier();
        if (tid < 16) {
            const int tok = tile * 16 + tid;
            float sc[16], bi[16];
#pragma unroll
            for (int e = 0; e < 16; ++e) { sc[e] = lgt[tid * 16 + e]; bi[e] = part[tid * 16 + e]; }
            int bg = 0; float bgs = -INFINITY;
#pragma unroll
            for (int gI = 0; gI < 4; ++gI) {
                float m1 = -INFINITY, m2 = -INFINITY;
#pragma unroll
                for (int j = 0; j < 4; ++j) { const float x = bi[gI * 4 + j]; if (x > m1) { m2 = m1; m1 = x; } else if (x > m2) m2 = x; }
                const float gs = m1 + m2;
                if (gs > bgs) { bgs = gs; bg = gI; }
            }
            int e0 = 0; float b0 = -INFINITY;
#pragma unroll
            for (int j = 0; j < 4; ++j) { float x = -INFINITY;
#pragma unroll
                for (int gI = 0; gI < 4; ++gI) if (gI == bg) x = bi[gI * 4 + j];
                if (x > b0) { b0 = x; e0 = j; } }
            int e1 = 0; float b1 = -INFINITY;
#pragma unroll
            for (int j = 0; j < 4; ++j) { float x = -INFINITY;
#pragma unroll
                for (int gI = 0; gI < 4; ++gI) if (gI == bg) x = bi[gI * 4 + j];
                if (j != e0 && x > b1) { b1 = x; e1 = j; } }
            float s0 = 0.f, s1 = 0.f;
#pragma unroll
            for (int e = 0; e < 16; ++e) { if (e == bg * 4 + e0) s0 = sc[e]; if (e == bg * 4 + e1) s1 = sc[e]; }
            const float wsum = s0 + s1; const float wa = s0 / wsum, wb = s1 / wsum;
            const int lo = e0 < e1 ? e0 : e1, hi = e0 < e1 ? e1 : e0;
            const float clo = e0 < e1 ? wa : wb, chi = e0 < e1 ? wb : wa;
            int pr = 0;
#pragma unroll
            for (int q = 0; q < 6; ++q) if (c_pair_lo[q] == lo && c_pair_hi[q] == hi) pr = q;
            const int bucket = bg * 6 + pr;
            p.cw[(size_t)tok * 2] = clo; p.cw[(size_t)tok * 2 + 1] = chi;
            if (tl < 4) { s_bk[tl * 16 + tid] = bucket; s_tk[tl * 16 + tid] = tok; }
            else { const int pos = atomicAdd(&p.bcnt[bucket], 1); p.lists[(size_t)bucket * LCAP + pos] = tok; }
        }
        lds_barrier();
    }
    __syncthreads();
    if (tid < 24) { int cn = 0; for (int i = 0; i < 64; ++i) cn += (s_bk[i] == tid); s_base[tid] = cn ? atomicAdd(&p.bcnt[tid], cn) : 0; }
    __syncthreads();
    if (tid < 64 && s_bk[tid] >= 0) { const int bk = s_bk[tid]; int rk = 0; for (int i = 0; i < tid; ++i) rk += (s_bk[i] == bk); p.lists[(size_t)bk * LCAP + s_base[bk] + rk] = s_tk[tid]; }
}

__device__ __forceinline__ void ph_moe_gather(CP p, int bid, int nblk, char* smem) {
    int* tb = (int*)smem;
    int* cb = tb + 32;
    int* tbk = tb + 64;
    const int tid = otid(), lane = tid & 63, wv = tid >> 6;
    __syncthreads();
    if (tid < 24) cb[tid] = p.bcnt[tid];
    __syncthreads();
    if (tid == 0) { int acc = 0; for (int b = 0; b < 24; ++b) { tb[b] = acc; acc += (cb[b] + 255) >> 8; } tb[24] = acc; }
    __syncthreads();
    if (tid < tb[24]) { int b = 0; for (int q = 1; q < 24; ++q) if (tb[q] <= tid) b = q; tbk[tid] = b; }
    __syncthreads();
    const int nrows = tb[24] * 256;
    for (int R0 = bid * 8 + wv; R0 < nrows; R0 += nblk * 32) {
        int tok[4];
#pragma unroll
        for (int q = 0; q < 4; ++q) {
            const int R = R0 + q * nblk * 8;
            tok[q] = -1;
            if (R < nrows) { const int mt = R >> 8, b = tbk[mt], ii = (mt - tb[b]) * 256 + (R & 255); if (ii < cb[b]) tok[q] = p.lists[(size_t)b * LCAP + ii]; }
        }
        u32x4 v0[4], v1[4];
#pragma unroll
        for (int q = 0; q < 4; ++q) {
            v0[q] = (u32x4){0u, 0u, 0u, 0u}; v1[q] = v0[q];
            if (tok[q] >= 0) { const u32x4* src = (const u32x4*)(p.h_hi + (size_t)tok[q] * DM); v0[q] = src[lane]; v1[q] = src[64 + lane]; }
        }
#pragma unroll
        for (int q = 0; q < 4; ++q) {
            const int R = R0 + q * nblk * 8;
            if (R < nrows) { u32x4* dst = (u32x4*)(p.h2s + (size_t)R * DM); dst[lane] = v0[q]; dst[64 + lane] = v1[q]; }
        }
    }
}
__device__ __forceinline__ void ph_moe1b(CP p, int bid, int nblk, char* smem) {
    int tot = 0;
    for (int b = 0; b < 24; ++b) tot += (p.bcnt[b] + 255) >> 8;
    const int units = tot * 8, full = units / nblk, left = units - full * nblk;
    const bool split = left * 2 <= nblk;
    pg8::Gemm g; g.A = p.h2s; g.Bt = p.We13; g.M = 0; g.N = 0; g.K = DM; g.lda = DM; g.ldb = DM;
    pg8::MoeOrder<1> S; S.bcnt = p.bcnt; S.W = p.We13; S.G = nblk; S.c = bid; S.rounds = split ? full : (1 << 30);
    pg8::EpiMoe1 E; E.act = p.act; E.lists = p.lists; E.cw = p.cw;
    pg8::gemm_phase((PG8_LAS unsigned char*)smem, g, S, E);
    if (split) {
        __syncthreads();
        for (int sq = bid; sq < left * 2; sq += nblk) {
            pg8::MoeOrder<1> T; T.bcnt = p.bcnt; T.W = p.We13; T.G = 1 << 24; T.c = full * nblk + (sq >> 1); T.rounds = 1;
            pg8::Unit u;
            if (!T.next(0, u)) continue;
            const int h2 = sq & 1, second = u.pn >= 4, ex = second ? u.eb : u.ea;
            const h16* A = p.h2s + (size_t)u.pm * 256 * 1024;
            const h16* W = p.We13 + ((size_t)ex * 1024 + (u.pn & 3) * 256 + h2 * 128) * 1024;
            f32x4 acc[4][4]; zero_acc<256>(acc);
            gemm_kloop<256>(smem, 1024, [=](int r, int k) { return A + (size_t)r * 1024 + k; },
                            [=](int r, int k) { const int j_ = (r >> 4) & 3, cl = (r >> 6) * 32 + (j_ >> 1) * 16 + (r & 15); return W + (size_t)((cl >> 2) * 8 + (j_ & 1) * 4 + (cl & 3)) * 1024 + k; }, acc);
            const int tid = otid(), lane = tid & 63, wave = tid >> 6, wm = wave >> 1, wn = wave & 1, g4 = lane >> 4;
            const int* lst = p.lists + (size_t)u.bucket * LCAP;
#pragma unroll
            for (int i = 0; i < 4; ++i) {
                const int r = wm * 64 + i * 16 + (lane & 15), ii = u.i0 + r; const bool valid = ii < u.cnt;
                const float cwv = valid ? p.cw[(size_t)lst[valid ? ii : 0] * 2 + second] : 0.f;
                h16* O = p.act + ((size_t)u.pm * 256 + r) * 1024 + second * 512 + (u.pn & 3) * 128 + h2 * 64 + wn * 32 + 4 * g4;
#pragma unroll
                for (int jp = 0; jp < 2; ++jp) {
                    const f32x4 a = acc[i][2 * jp], bq = acc[i][2 * jp + 1];
                    *(h16x4*)(O + jp * 16) = pack4(cwv * (a[0] * sigm(a[0])) * bq[0], cwv * (a[1] * sigm(a[1])) * bq[1], cwv * (a[2] * sigm(a[2])) * bq[2], cwv * (a[3] * sigm(a[3])) * bq[3]);
                }
            }
        }
    }
}
__device__ __forceinline__ void ph_moe2b(CP p, int l, int bid, int nblk, char* smem) {
    pg8::Gemm g; g.A = p.act; g.Bt = p.We2; g.M = 0; g.N = 0; g.K = DM; g.lda = DM; g.ldb = 512;
    pg8::MoeOrder<2> S; S.bcnt = p.bcnt; S.W = p.We2; S.G = nblk; S.c = bid; S.rounds = 1;
    pg8::EpiMoe2 E; E.x1 = p.x1; E.lists = p.lists; E.gate = p.mods + (size_t)l * 4 * 6144 + 5 * 1024;
    pg8::gemm_phase((PG8_LAS unsigned char*)smem, g, S, E);
    __syncthreads();
    int tot = 0;
    for (int b = 0; b < 24; ++b) tot += (p.bcnt[b] + 255) >> 8;
    const int nsub = (tot * 4 - nblk) * 4;
    for (int sq = bid; sq < nsub; sq += nblk) {
        pg8::MoeOrder<2> T; T.bcnt = p.bcnt; T.W = p.We2; T.G = 1 << 24; T.c = nblk + (sq >> 2); T.rounds = 1;
        pg8::Unit u;
        if (!T.next(0, u)) continue;
        const int rh = (sq >> 1) & 1, n0 = u.pn * 256 + (sq & 1) * 128;
        f32x4 acc[2][4]; zero_acc<128>(acc);
        const h16* A = p.act + ((size_t)u.pm * 256 + rh * 128) * 1024;
        const h16* Ba = p.We2 + ((size_t)u.ea * 1024 + n0) * 512; const h16* Bb = p.We2 + ((size_t)u.eb * 1024 + n0) * 512;
        gemm_kloop<128>(smem, 1024, [=](int r, int k) { return A + (size_t)r * 1024 + k; }, [=](int r, int k) { return (k < 512 ? Ba : Bb) + (size_t)r * 512 + (k & 511); }, acc);
        const int* lst = p.lists + (size_t)u.bucket * LCAP; const int i0 = u.i0 + rh * 128, cnt = u.cnt;
        const float* gate = p.mods + (size_t)l * 4 * 6144 + 5 * 1024; float* x1 = p.x1;
        gemm_epi<128>(acc, [=](int ml, int nl, f32x4 v) {
            const int ii = i0 + ml;
            if (ii < cnt) { const int tok = lst[ii]; float* xr = x1 + (size_t)tok * DM + n0 + nl; const float* gr = gate + (size_t)(tok / SEQ) * 6144 + n0 + nl;
                *(f32x4*)xr = *(const f32x4*)xr + *(const f32x4*)gr * v; } });
    }
}

__device__ __forceinline__ void ph_final(CP p, int bid, int nblk) {
    const int lane = otid() & 63, wv = otid() >> 6;
    f32x4 gg[4];
#pragma unroll
    for (int i = 0; i < 4; ++i) gg[i] = *(const f32x4*)(p.in[I_FINALG] + i * 256 + lane * 4);
    int tok = bid * 8 + wv;
    f32x4 vn[4];
    if (tok < NTOK) {
#pragma unroll
        for (int i = 0; i < 4; ++i) vn[i] = *(const f32x4*)(p.x1 + (size_t)tok * DM + i * 256 + lane * 4);
    }
    for (; tok < NTOK; tok += nblk * 8) {
        f32x4 v[4];
#pragma unroll
        for (int i = 0; i < 4; ++i) v[i] = vn[i];
        const int tn = tok + nblk * 8;
        if (tn < NTOK) {
#pragma unroll
            for (int i = 0; i < 4; ++i) vn[i] = *(const f32x4*)(p.x1 + (size_t)tn * DM + i * 256 + lane * 4);
        }
        float ss = 0.f;
#pragma unroll
        for (int i = 0; i < 4; ++i) ss += v[i][0] * v[i][0] + v[i][1] * v[i][1] + v[i][2] * v[i][2] + v[i][3] * v[i][3];
        ss = wave_sum(ss);
        const float rs = rsqrtf(ss * (1.f / DM) + 1e-6f);
#pragma unroll
        for (int i = 0; i < 4; ++i) { const int c = i * 256 + lane * 4; *(f32x4*)(p.out + (size_t)tok * DM + c) = v[i] * rs * gg[i]; }
    }
}

#define XB_TMO      128
#define XB_XCNT(j)  (256  + 64 * (j))
#define XB_XSUB(j)  (1280 + 64 * (j))
#define XB_XGEN(j)  (2304 + 64 * (j))
#define XB_TOP      3328
#define XB_TOPGEN   3392
#define XCD_BAR_WORDS 3456
#define XB_SPIN_CAP (1u << 24)
#define LAS __attribute__((address_space(3)))

typedef __attribute__((address_space(1))) unsigned gu32;
__device__ __forceinline__ unsigned xb_ld(gu32* p)              { return __hip_atomic_load(p, __ATOMIC_RELAXED, __HIP_MEMORY_SCOPE_AGENT); }
__device__ __forceinline__ unsigned xb_add(gu32* p, unsigned v) { return __hip_atomic_fetch_add(p, v, __ATOMIC_RELAXED, __HIP_MEMORY_SCOPE_AGENT); }
__device__ __forceinline__ unsigned xb_xcc_id() { return (unsigned)__builtin_amdgcn_s_getreg((3 << 11) | 20) & 0xFu; }
#define XB_SPIN(cond, bar) do { unsigned _sp = 0; while (cond) { __builtin_amdgcn_s_sleep(1); \
    if ((++_sp & 255u) == 0u) { if (xb_ld(&(bar)[XB_TMO])) break; if (_sp > XB_SPIN_CAP) { xb_add(&(bar)[XB_TMO], 1u); break; } } } } while (0)

struct XcdBarrier { unsigned* bar; unsigned x; volatile LAS unsigned* st; };

__device__ __forceinline__ XcdBarrier xcd_barrier_post(unsigned* bar, volatile LAS unsigned* st) {
    XcdBarrier b; b.bar = bar; b.x = xb_xcc_id(); b.st = st;
    if (threadIdx.x == 0) (void)xb_add(&((gu32*)bar)[XB_XCNT(b.x)], 1u);
    return b;
}
__device__ __forceinline__ void xcd_barrier_complete(gu32* bar, unsigned x, unsigned& nloc, unsigned& nx) {
    const unsigned G = gridDim.x * gridDim.y * gridDim.z;
    unsigned sum, cnt, mine, sp = 0u;
    for (;;) {
        sum = 0u; cnt = 0u; mine = 0u;
#pragma unroll
        for (unsigned j = 0; j < 16; ++j) { const unsigned c = xb_ld(&bar[XB_XCNT(j)]); sum += c; cnt += (c > 0u) ? 1u : 0u; mine = (j == x) ? c : mine; }
        if (sum == G) break;
        __builtin_amdgcn_s_sleep(1);
        if ((++sp & 255u) == 0u) { if (xb_ld(&bar[XB_TMO])) break; if (sp > XB_SPIN_CAP) { xb_add(&bar[XB_TMO], 1u); break; } }
    }
    nloc = mine > 0u ? mine : 1u; nx = cnt > 0u ? cnt : 1u;
}
__device__ __forceinline__ void xcd_barrier(const XcdBarrier& b0) {
    asm volatile("s_waitcnt vmcnt(0)" ::: "memory");
    __syncthreads();
    if (threadIdx.x == 0) {
        unsigned long long ba = (unsigned long long)b0.bar;
        asm volatile("" : "+s"(ba));
        gu32* bar = (gu32*)ba;
        const unsigned x = xb_xcc_id();
        volatile LAS unsigned* st = b0.st;
        __builtin_amdgcn_s_waitcnt(0);
        unsigned nloc = st[0], nx = st[1];
        if (nloc == 0u) { xcd_barrier_complete(bar, x, nloc, nx); st[0] = nloc; st[1] = nx; }
        const unsigned old = xb_add(&bar[XB_XSUB(x)], 1u);
        const unsigned gen = old / nloc;
        if (old + 1u == (gen + 1u) * nloc) {
            __builtin_amdgcn_fence(__ATOMIC_RELEASE, "agent");
            asm volatile("s_waitcnt vmcnt(0)" ::: "memory");
            const unsigned og = xb_add(&bar[XB_TOP], 1u);
            const unsigned tg = og / nx;
            if (og + 1u == (tg + 1u) * nx) xb_add(&bar[XB_TOPGEN], 1u);
            else XB_SPIN(xb_ld(&bar[XB_TOPGEN]) == tg, bar);
            __builtin_amdgcn_fence(__ATOMIC_ACQUIRE, "agent");
            xb_add(&bar[XB_XGEN(x)], 1u);
            asm volatile("s_waitcnt vmcnt(0)" ::: "memory");
        } else {
            XB_SPIN(xb_ld(&bar[XB_XGEN(x)]) == gen, bar);
            __builtin_amdgcn_fence(__ATOMIC_ACQUIRE, "agent");
            asm volatile("s_waitcnt vmcnt(0)" ::: "memory");
        }
    }
    __syncthreads();
}

__device__ __forceinline__ const __attribute__((address_space(4))) Params* lp(const __attribute__((address_space(4))) Params* q) { asm volatile("" : "+s"(q)); return q; }
#define MEGA_LDS (155648 + 2560 + 16)
__global__ void __launch_bounds__(512) k_mega(Params p) {
    extern __shared__ __attribute__((aligned(16))) char smem[];
    volatile LAS unsigned* xbw = (volatile LAS unsigned*)(smem + MEGA_LDS - 16);
    if (threadIdx.x == 0) { xbw[0] = 0u; xbw[1] = 0u; }
    __syncthreads();
    XcdBarrier bar = xcd_barrier_post(p.bar, xbw);
    const int bid0 = blockIdx.x, nblk0 = gridDim.x;
    const __attribute__((address_space(4))) Params* kp = (const __attribute__((address_space(4))) Params*)__builtin_amdgcn_kernarg_segment_ptr();
#define PQ (*lp(kp))
#define BID oint(bid0)
#define NBLK oint(nblk0)
    ph_mods(PQ, BID, NBLK, smem);
    xcd_barrier(bar);
    ph_norm1(PQ, 0, BID, NBLK);
    ph_tables(PQ, BID, NBLK);
    __syncthreads();
    ph_convert_mix(PQ, 0, BID, NBLK, smem);
    xcd_barrier(bar);
    for (int l0 = 0; l0 < 2; ++l0) {
#define LL oint(l0)
        ph_gemm1(PQ, BID, NBLK, smem);
#if PROBE == 2
        ph_gemm1(PQ, BID, NBLK, smem);
#endif
        xcd_barrier(bar);
        ph_s5_scan<1>(PQ, LL, BID, NBLK, smem);
        __syncthreads();
        ph_rg_a(PQ, LL, BID, NBLK, smem);
        __syncthreads();
        ph_rw_a(PQ, LL, BID, NBLK, smem);
#if PROBE == 13
        __syncthreads(); ph_s5_scan<1>(PQ, LL, BID, NBLK, smem);
#endif
#if PROBE == 14
        __syncthreads(); ph_rg_a(PQ, LL, BID, NBLK, smem);
#endif
#if PROBE == 15
        __syncthreads(); ph_rw_a(PQ, LL, BID, NBLK, smem);
#endif
#if PROBE == 3
        __syncthreads(); ph_s5_scan<1>(PQ, LL, BID, NBLK, smem); __syncthreads(); ph_rg_a(PQ, LL, BID, NBLK, smem); __syncthreads(); ph_rw_a(PQ, LL, BID, NBLK, smem);
#endif
        __syncthreads();
        __syncthreads();
        ph_dsa_pre2(PQ, BID, NBLK, smem);
        xcd_barrier(bar);
        if (BID < 16) ph_rw_b(PQ, BID, smem);
        else {
            ph_s5_carry(PQ, LL, BID - 16, NBLK - 16);
            ph_rg_c(PQ, LL, BID - 16, NBLK - 16, smem);
            __syncthreads();
        }
#if PROBE == 4 || PROBE == 11
        if (BID < 16) ph_rw_b(PQ, BID, smem);
#endif
        __syncthreads();
        ph_dsa_a(PQ, LL, smem);
        xcd_barrier(bar);
        ph_dsa_b(PQ, BID, NBLK, smem);
        __syncthreads();
        ph_s5_scan<3>(PQ, LL, BID, NBLK, smem);
        ph_rw_c(PQ, LL, BID, NBLK);
#if PROBE == 5
        __syncthreads(); ph_dsa_b(PQ, BID, NBLK, smem);
#endif
#if PROBE == 17
        ph_s5_scan<3>(PQ, LL, BID, NBLK, smem);
#endif
#if PROBE == 18
        ph_rw_c(PQ, LL, BID, NBLK);
#endif
#if PROBE == 6
        ph_s5_scan<3>(PQ, LL, BID, NBLK, smem); ph_rw_c(PQ, LL, BID, NBLK);
#endif
        xcd_barrier(bar);
        ph_dsa_merge(PQ, BID, NBLK);
        ph_s5_glu(PQ, LL, BID, NBLK, smem);
        __syncthreads();
        ph_gates(PQ, LL, BID, NBLK, smem);
#if PROBE == 7
        ph_gates(PQ, LL, BID, NBLK, smem);
#endif
        xcd_barrier(bar);
        ph_merge(PQ, LL, BID, NBLK, smem);
#if PROBE == 10
        ph_merge(PQ, LL, BID, NBLK, smem);
#endif
        xcd_barrier(bar);
        ph_outproj(PQ, LL, BID, NBLK, smem);
        ph_convert_moe(PQ, LL, BID, NBLK, smem);
#if PROBE == 1
        ph_convert_moe(PQ, LL, BID, NBLK, smem);
#endif
        xcd_barrier(bar);
        ph_norm2_router(PQ, LL, BID, NBLK, smem);
        xcd_barrier(bar);
        ph_moe_gather(PQ, BID, NBLK, smem);
        xcd_barrier(bar);
        ph_moe1b(PQ, BID, NBLK, smem);
#if PROBE == 8
        ph_moe1b(PQ, BID, NBLK, smem);
#endif
        xcd_barrier(bar);
        ph_moe2b(PQ, LL, BID, NBLK, smem);
        if (LL == 0 && BID >= 64) ph_convert_mix(PQ, 1, BID - 64, NBLK - 64, smem);
        xcd_barrier(bar);
        if (l0 == 0) { ph_norm1(PQ, 1, BID, NBLK); xcd_barrier(bar); }
    }
    ph_final(PQ, BID, NBLK);
}

static inline size_t al(size_t x) { return (x + 255) & ~(size_t)255; }
extern "C" void kernel_launch(void* const* d_in, const int* in_sizes, int n_in, void* d_out, int out_size, void* d_ws, size_t ws_size, hipStream_t stream) {
    Params p{};
    for (int i = 0; i < N_IN; ++i) p.in[i] = (const float*)d_in[i];
    p.pos = (const int*)d_in[I_POS];
    p.out = (float*)d_out;
    char* w = (char*)d_ws; size_t off = 0;
    auto take = [&](size_t bytes) { char* r = w + off; off += al(bytes); return r; };
    p.bar = (unsigned*)take(XCD_BAR_WORDS * 4);
    p.mods = (float*)take(2 * 4 * 6144 * 4);
    p.bcnt = (int*)take(256); p.qctr = (int*)take(256);
    p.s5c = (float*)take((size_t)2 * 16 * 64 * 36 * 4); p.ropet = (float*)take((size_t)NTOK * 32 * 2 * 4);
    p.Wp = (h16*)take((size_t)2560 * DM * 2); p.Widx = (h16*)take((size_t)256 * 3072 * 2); p.Wg = (h16*)take((size_t)4096 * DM * 2);
    p.Wb = (h16*)take((size_t)4096 * 256 * 2); p.Wo = (h16*)take((size_t)DM * DM * 2); p.Wglu = (h16*)take(256 * 256 * 2); p.Wrg = (h16*)take(2 * 4 * 64 * 64 * 2);
    p.x1 = (float*)take((size_t)NTOK * DM * 4);
    p.h_hi = (h16*)take((size_t)NTOK * DM * 2); p.h_lo = (h16*)take((size_t)NTOK * DM * 2); p.branches = p.h_lo;
    p.cw = (float*)take((size_t)NTOK * 2 * 4);
    p.lists = (int*)take((size_t)24 * LCAP * 4);
    const size_t offR = off;
    p.proj = (h16*)take((size_t)NTOK * PJ * 2); p.idxf = (float*)take((size_t)NTOK * IDXLD * 4);
    p.vT = (h16*)take((size_t)4 * 256 * SEQ * 2); p.dmask = (unsigned long long*)take((size_t)4 * 133120 * 8); p.s5E = (float*)take((size_t)4 * 64 * 16 * 64 * 2 * 4); p.s5H = (float*)take((size_t)4 * 64 * 16 * 64 * 2 * 4);
    p.rg_hl = (float*)take((size_t)NTOK * 256 * 4); p.rg_cp = (float*)take((size_t)NTOK * 256 * 4); p.rg_agg = (float*)take((size_t)4 * 128 * 256 * 2 * 4);
    p.rw_g = (h16*)take((size_t)NTOK * 256 * 2); p.rw_bonus = (h16*)take((size_t)NTOK * 256 * 2);
    p.rw_W = (h16*)take((size_t)1024 * 4096 * 2); p.rw_U0 = (h16*)take((size_t)1024 * 4096 * 2); p.rw_Ry = (h16*)take((size_t)1024 * 4096 * 2); p.rw_Y0 = (h16*)take((size_t)1024 * 4096 * 2);
    p.rw_Be = (h16*)take((size_t)1024 * 4096 * 2); p.rw_VK = (h16*)take((size_t)1024 * 4096 * 2); p.rw_S0 = (h16*)take((size_t)1024 * 4096 * 2); p.rw_gam = (float*)take((size_t)1024 * 64 * 4);
    const size_t endMix = off;
    p.ybuf = p.rw_Be;
    p.dsa_op = p.rw_W; p.dsa_ml = (float*)p.rw_VK;
    p.gates = p.proj;
    p.mixed = p.rw_g;
    if ((char*)p.gates + (size_t)NTOK * 4096 * 2 > (char*)p.mixed) { fprintf(stderr, "gates/mixed overlap\n"); return; }
    off = offR;
    p.We13 = (h16*)take((size_t)16 * 1024 * DM * 2); p.We2 = (h16*)take((size_t)16 * 1024 * 512 * 2); p.act = (h16*)take((size_t)88 * 256 * 1024 * 2); p.h2s = (h16*)take((size_t)88 * 256 * 1024 * 2);
    const size_t endMoe = off;
    const size_t need = endMix > endMoe ? endMix : endMoe;
    if (need > ws_size || (char*)p.h2s + (size_t)88 * 256 * 1024 * 2 > (char*)p.mixed) { fprintf(stderr, "workspace layout problem: need %zu have %zu\n", need, ws_size); return; }

    static int grid = 0;
    if (!grid) {
        (void)hipFuncSetAttribute((const void*)k_mega, hipFuncAttributeMaxDynamicSharedMemorySize, MEGA_LDS);
        int dev = 0, cus = 0, per_cu = 0;
        (void)hipGetDevice(&dev);
        (void)hipDeviceGetAttribute(&cus, hipDeviceAttributeMultiprocessorCount, dev);
        (void)hipOccupancyMaxActiveBlocksPerMultiprocessor(&per_cu, (const void*)k_mega, 512, MEGA_LDS);
        if (per_cu < 1) { fprintf(stderr, "k_mega not launchable (occupancy 0)\n"); return; }
        grid = cus;
        fprintf(stderr, "k_mega: grid %d (cus %d, per_cu %d), ws need %zu have %zu\n", grid, cus, per_cu, need, ws_size);
    }
    (void)hipMemsetAsync(p.bar, 0, XCD_BAR_WORDS * 4, stream);
    k_mega<<<grid, 512, MEGA_LDS, stream>>>(p);
}
```
